# Optimizing an MI355X kernel written in HIP

```python
import jax, jax.numpy as jnp
from jax import lax
import numpy as np

D_MODEL = 1024
BATCH = 2
SEQ = 8192
DEPTH = 1

GRID_W = 64
CTX_LEN = 256
D_MIX = 1024
D_FOURIER = 256
N_FOURIER_GROUPS = 4
FOURIER_GROUP = D_FOURIER // N_FOURIER_GROUPS
HEAD_DIM = 64
N_NA_HEADS = 12
D_NA = N_NA_HEADS * HEAD_DIM
NA_ROWS_MAX = 8
NA_COLS = 16
ROPE_THETA = 10000.0
N_GROUPS = 4
EXPERTS_PER_GROUP = 8
N_EXPERTS = N_GROUPS * EXPERTS_PER_GROUP
TOP_K = 2
D_EXPERT = 512
MOE_BLOCK = 128
N_MOD = 6
D_IN_PROJ = D_FOURIER + 3 * D_NA
EPS = 1e-6

kernel_name = "hymba_fnet_natten_hmoe_dit"


def rmsnorm(x, g):
    xf = x.astype(jnp.float32)
    r = lax.rsqrt(jnp.mean(xf * xf, axis=-1, keepdims=True) + EPS)
    return (xf * r * g.astype(jnp.float32)).astype(x.dtype)


def adaln(cond, w, b):
    mod = jax.nn.silu(cond) @ w + b
    return [m[:, None, :] for m in jnp.split(mod, N_MOD, axis=-1)]


def modulate(h, shift, scale):
    return h * (1.0 + scale) + shift


def fourier_mix(f, w_fmix):
    b, n, _ = f.shape
    fg = f.astype(jnp.float32).reshape(b, n, N_FOURIER_GROUPS, FOURIER_GROUP)
    fr = jnp.fft.fft2(fg, axes=(1, 3), norm="ortho").real
    return fr.reshape(b, n, D_FOURIER).astype(f.dtype) @ w_fmix


def _rotate(x, pos):
    half = x.shape[-1] // 2
    inv = ROPE_THETA ** (-jnp.arange(half, dtype=jnp.float32) / half)
    ang = pos.astype(jnp.float32)[:, None] * inv[None, :]
    cos = jnp.cos(ang)[None, :, None, :]
    sin = jnp.sin(ang)[None, :, None, :]
    x1, x2 = x[..., :half], x[..., half:]
    return jnp.concatenate([x1 * cos - x2 * sin, x1 * sin + x2 * cos], axis=-1)


def axial_rope(x):
    n = x.shape[1]
    t = jnp.arange(n)
    row, col = t // GRID_W, t % GRID_W
    xf = x.astype(jnp.float32)
    r = HEAD_DIM // 2
    out = jnp.concatenate([_rotate(xf[..., :r], row), _rotate(xf[..., r:], col)], axis=-1)
    return out.astype(x.dtype)


def neighbourhood_attention(q, k, v, k_ctx, v_ctx, rpb):
    b, n, h, hd = q.shape
    rows = n // GRID_W
    ks_r = min(NA_ROWS_MAX, rows)
    scale = HEAD_DIM ** -0.5
    qr = axial_rope(q).reshape(b, rows, GRID_W, h, hd)
    kg = axial_rope(k).reshape(b, rows, GRID_W, h, hd)
    vg = v.reshape(b, rows, GRID_W, h, hd)
    qp = q.reshape(b, rows, GRID_W, h, hd)
    r = jnp.arange(rows)
    row_start = jnp.clip(r - ks_r // 2, 0, rows - ks_r)
    row_idx = row_start[:, None] + jnp.arange(ks_r)[None, :]
    k_blk = kg[:, row_idx]
    v_blk = vg[:, row_idx]
    s_loc = jnp.einsum('brqhd,brkwhd->bhrqkw', qr, k_blk,
                       preferred_element_type=jnp.float32) * scale
    cidx = jnp.arange(GRID_W)
    col_start = jnp.clip(cidx - NA_COLS // 2, 0, GRID_W - NA_COLS)
    col_valid = (cidx[None, :] >= col_start[:, None]) & (cidx[None, :] < col_start[:, None] + NA_COLS)
    dr = row_idx - r[:, None] + (NA_ROWS_MAX - 1)
    dc = jnp.clip(cidx[None, :] - cidx[:, None] + (NA_COLS - 1), 0, 2 * NA_COLS - 2)
    bias = rpb[:, dr[:, None, :, None], dc[None, :, None, :]]
    s_loc = s_loc + bias[None].astype(jnp.float32)
    s_loc = jnp.where(col_valid[None, None, None, :, None, :], s_loc, jnp.finfo(jnp.float32).min)
    s_loc = s_loc.reshape(b, h, rows, GRID_W, ks_r * GRID_W)
    s_ctx = jnp.einsum('brqhd,blhd->bhrql', qp, k_ctx,
                       preferred_element_type=jnp.float32) * scale
    p = jax.nn.softmax(jnp.concatenate([s_loc, s_ctx], axis=-1), axis=-1)
    n_loc = ks_r * GRID_W
    p_loc = p[..., :n_loc].reshape(b, h, rows, GRID_W, ks_r, GRID_W).astype(v.dtype)
    p_ctx = p[..., n_loc:].astype(v.dtype)
    out = (jnp.einsum('bhrqkw,brkwhd->brqhd', p_loc, v_blk)
           + jnp.einsum('bhrql,blhd->brqhd', p_ctx, v_ctx))
    return out.reshape(b, n, h * hd)


def context_attention(q, k, v):
    b, l, h, hd = q.shape
    s = jnp.einsum('blhd,bmhd->bhlm', q, k, preferred_element_type=jnp.float32) * (HEAD_DIM ** -0.5)
    p = jax.nn.softmax(s, axis=-1).astype(v.dtype)
    return jnp.einsum('bhlm,bmhd->blhd', p, v).reshape(b, l, h * hd)


def hierarchical_moe(h2, w_rg, w_re, w_gate, w_up, w_down):
    n, d = h2.shape
    lg = (h2 @ w_rg).astype(jnp.float32)
    pg = jax.nn.softmax(lg, axis=-1)
    g_sel = jnp.argmax(lg, axis=-1)
    le = (h2 @ w_re).astype(jnp.float32).reshape(n, N_GROUPS, EXPERTS_PER_GROUP)
    le_sel = jnp.take_along_axis(le, g_sel[:, None, None], axis=1)[:, 0]
    pe = jax.nn.softmax(le_sel, axis=-1)
    top_w, top_i = lax.top_k(pe, TOP_K)
    top_w = top_w / jnp.sum(top_w, axis=-1, keepdims=True)
    gate = top_w * jnp.take_along_axis(pg, g_sel[:, None], axis=1)
    eid = g_sel[:, None] * EXPERTS_PER_GROUP + top_i
    m = n * TOP_K
    e_flat = eid.reshape(-1)
    tok_flat = jnp.repeat(jnp.arange(n, dtype=jnp.int32), TOP_K)
    gate_flat = gate.reshape(-1)
    order = jnp.argsort(e_flat)
    e_s, tok_s, gate_s = e_flat[order], tok_flat[order], gate_flat[order]
    counts = jnp.bincount(e_flat, length=N_EXPERTS)
    starts = jnp.cumsum(counts) - counts
    pcounts = ((counts + MOE_BLOCK - 1) // MOE_BLOCK) * MOE_BLOCK
    pends = jnp.cumsum(pcounts)
    pstarts = pends - pcounts
    dest = pstarts[e_s] + (jnp.arange(m) - starts[e_s])
    n_blocks = -(-m // MOE_BLOCK) + N_EXPERTS
    p_slots = n_blocks * MOE_BLOCK
    slot_tok = jnp.zeros((p_slots,), jnp.int32).at[dest].set(tok_s)
    slot_gate = jnp.zeros((p_slots,), jnp.float32).at[dest].set(gate_s)
    block_expert = jnp.minimum(
        jnp.searchsorted(pends, jnp.arange(n_blocks) * MOE_BLOCK, side='right'), N_EXPERTS - 1)
    xs = h2[slot_tok].reshape(n_blocks, MOE_BLOCK, d)

    def expert_block(args):
        xb, e = args
        return (jax.nn.silu(xb @ w_gate[e]) * (xb @ w_up[e])) @ w_down[e]

    ys = lax.map(expert_block, (xs, block_expert)).reshape(p_slots, d)
    ys = ys * slot_gate[:, None].astype(ys.dtype)
    return jnp.zeros((n, d), h2.dtype).at[slot_tok].add(ys)


def setup_inputs(seed: int = 0) -> dict:
    key = jax.random.key(seed)
    ks = jax.random.split(key, 20)
    f32 = jnp.float32
    nrm = lambda k, shape, s: jax.random.normal(k, shape, f32) * s
    return {
        "x": nrm(ks[0], (BATCH, SEQ, D_MODEL), 1.0),
        "c": nrm(ks[1], (BATCH, D_MODEL), 1.0),
        "ctx": nrm(ks[2], (BATCH, CTX_LEN, D_MODEL), 1.0),
        "c_ctx": nrm(ks[3], (D_MODEL,), 1.0),
        "w_ada": nrm(ks[4], (DEPTH, D_MODEL, N_MOD * D_MODEL), 0.5 * D_MODEL ** -0.5),
        "b_ada": nrm(ks[5], (DEPTH, N_MOD * D_MODEL), 0.02),
        "g_norm1": 1.0 + nrm(ks[6], (DEPTH, D_MODEL), 0.05),
        "w_in": nrm(ks[7], (DEPTH, D_MODEL, D_IN_PROJ), D_MODEL ** -0.5),
        "w_fmix": nrm(ks[8], (DEPTH, D_FOURIER, D_FOURIER), D_FOURIER ** -0.5),
        "rpb": nrm(ks[9], (DEPTH, N_NA_HEADS, 2 * NA_ROWS_MAX - 1, 2 * NA_COLS - 1), 0.2),
        "g_out": 1.0 + nrm(ks[10], (DEPTH, D_MIX), 0.05),
        "w_out": nrm(ks[11], (DEPTH, D_MIX, D_MODEL), D_MIX ** -0.5),
        "g_norm2": 1.0 + nrm(ks[12], (DEPTH, D_MODEL), 0.05),
        "w_router_group": nrm(ks[13], (DEPTH, D_MODEL, N_GROUPS), D_MODEL ** -0.5),
        "w_router_expert": nrm(ks[14], (DEPTH, D_MODEL, N_EXPERTS), D_MODEL ** -0.5),
        "w_gate": nrm(ks[15], (DEPTH, N_EXPERTS, D_MODEL, D_EXPERT), D_MODEL ** -0.5),
        "w_up": nrm(ks[16], (DEPTH, N_EXPERTS, D_MODEL, D_EXPERT), D_MODEL ** -0.5),
        "w_down": nrm(ks[17], (DEPTH, N_EXPERTS, D_EXPERT, D_MODEL), D_EXPERT ** -0.5),
        "g_final": 1.0 + nrm(ks[18], (D_MODEL,), 0.05),
    }


def reference(x, c, ctx, c_ctx, w_ada, b_ada, g_norm1, w_in, w_fmix, rpb, g_out, w_out, g_norm2,
              w_router_group, w_router_expert, w_gate, w_up, w_down, g_final):
    b, n, d = x.shape
    l = ctx.shape[1]
    xc = ctx
    q_end = D_FOURIER + D_NA
    k_end = D_FOURIER + 2 * D_NA
    for i in range(DEPTH):
        last = i == DEPTH - 1
        sh1, sc1, gt1, sh2, sc2, gt2 = adaln(c, w_ada[i], b_ada[i])
        csh1, csc1, cgt1, csh2, csc2, cgt2 = adaln(c_ctx[None, :], w_ada[i], b_ada[i])

        h = modulate(rmsnorm(x, g_norm1[i]), sh1, sc1)
        hc = modulate(rmsnorm(xc, g_norm1[i]), csh1, csc1)
        p = h @ w_in[i]
        pc = hc @ w_in[i]
        q = p[..., D_FOURIER:q_end].reshape(b, n, N_NA_HEADS, HEAD_DIM)
        k = p[..., q_end:k_end].reshape(b, n, N_NA_HEADS, HEAD_DIM)
        v = p[..., k_end:].reshape(b, n, N_NA_HEADS, HEAD_DIM)
        kc = pc[..., q_end:k_end].reshape(b, l, N_NA_HEADS, HEAD_DIM)
        vc = pc[..., k_end:].reshape(b, l, N_NA_HEADS, HEAD_DIM)
        f_out = fourier_mix(p[..., :D_FOURIER], w_fmix[i])
        na_out = neighbourhood_attention(q, k, v, kc, vc, rpb[i])
        y = jnp.concatenate([rmsnorm(f_out, g_out[i][:D_FOURIER]),
                             rmsnorm(na_out, g_out[i][D_FOURIER:])], axis=-1) @ w_out[i]
        x = x + gt1 * y
        if not last:
            qc = pc[..., D_FOURIER:q_end].reshape(b, l, N_NA_HEADS, HEAD_DIM)
            fc_out = fourier_mix(pc[..., :D_FOURIER], w_fmix[i])
            nac_out = context_attention(qc, kc, vc)
            yc = jnp.concatenate([rmsnorm(fc_out, g_out[i][:D_FOURIER]),
                                  rmsnorm(nac_out, g_out[i][D_FOURIER:])], axis=-1) @ w_out[i]
            xc = xc + cgt1 * yc

        h2 = modulate(rmsnorm(x, g_norm2[i]), sh2, sc2)
        moe = hierarchical_moe(h2.reshape(b * n, d), w_router_group[i], w_router_expert[i],
                               w_gate[i], w_up[i], w_down[i]).reshape(b, n, d)
        x = x + gt2 * moe
        if not last:
            h2c = modulate(rmsnorm(xc, g_norm2[i]), csh2, csc2)
            moec = hierarchical_moe(h2c.reshape(b * l, d), w_router_group[i], w_router_expert[i],
                                    w_gate[i], w_up[i], w_down[i]).reshape(b, l, d)
            xc = xc + cgt2 * moec
    return rmsnorm(x, g_final)
```

```cpp
#include <hip/hip_runtime.h>
#include <hip/hip_cooperative_groups.h>
#include <cstdio>
#include <cstdint>
namespace cg = cooperative_groups;

constexpr int D = 1024, NBATCH = 2, SEQ = 8192, NTOK = NBATCH * SEQ, LCTX = 256, NCTX = NBATCH * LCTX, NROWS = NTOK + NCTX;
constexpr int DIN = 2560, DF = 256, NH = 12, HD = 64, DNA = 768, QOFF = 256, KOFF = 1024, VOFF = 1792;
constexpr int GW = 64, GROWS = 128, NEXP = 32, DEXP = 512, NMOD = 6;
constexpr float EPS = 1e-6f;
constexpr int NT = 512;

struct Params {
    const float *x, *c, *ctx, *c_ctx, *w_ada, *b_ada, *g_norm1, *w_in, *w_fmix, *rpb, *g_out, *w_out, *g_norm2, *w_rg, *w_re, *w_gate, *w_up, *w_down, *g_final;
    float* out;
    float *mod, *cosN, *sinN, *ropeR, *ropeC;
    float *hbuf, *pbuf, *na;
    float *Tcat, *FR, *fo, *A2, *x1, *h2, *moe;
    int *cnt, *list; float* tokgate;
};

__device__ __forceinline__ float wave_sum(float v) {
#pragma unroll
    for (int o = 32; o > 0; o >>= 1) v += __shfl_xor(v, o);
    return v;
}
__device__ __forceinline__ float wave_max(float v) {
#pragma unroll
    for (int o = 32; o > 0; o >>= 1) v = fmaxf(v, __shfl_xor(v, o));
    return v;
}
__device__ __forceinline__ float block_sum(float v, float* red) {
    v = wave_sum(v);
    const int w = threadIdx.x >> 6, l = threadIdx.x & 63;
    __syncthreads();
    if (l == 0) red[w] = v;
    __syncthreads();
    float s = 0.f;
#pragma unroll
    for (int i = 0; i < NT / 64; ++i) s += red[i];
    return s;
}

template <class AF, class BF, class EF>
__device__ void ngemm(float* lds, int M, int N, int K, AF af, BF bf, EF ef) {
    float* As = lds;
    float* Bs = lds + 16 * 132;
    const int tid = threadIdx.x, ty = tid >> 4, tx = tid & 15;
    const int tn = N / 128, nt = (M / 128) * tn;
    for (int t = blockIdx.x; t < nt; t += gridDim.x) {
        const int m0 = (t / tn) * 128, n0 = (t % tn) * 128;
        float acc[4][8];
#pragma unroll
        for (int i = 0; i < 4; ++i)
#pragma unroll
            for (int j = 0; j < 8; ++j) acc[i][j] = 0.f;
        for (int k0 = 0; k0 < K; k0 += 16) {
#pragma unroll
            for (int i = 0; i < 4; ++i) { const int idx = tid + NT * i, kk = idx & 15, m = idx >> 4; As[kk * 132 + m] = af(m0 + m, k0 + kk); }
#pragma unroll
            for (int i = 0; i < 4; ++i) { const int idx = tid + NT * i, n = idx & 127, kk = idx >> 7; Bs[kk * 128 + n] = bf(m0, k0 + kk, n0 + n); }
            __syncthreads();
#pragma unroll
            for (int kk = 0; kk < 16; ++kk) {
                const float4 a = *(const float4*)(As + kk * 132 + ty * 4);
                const float4 b0 = *(const float4*)(Bs + kk * 128 + tx * 8), b1 = *(const float4*)(Bs + kk * 128 + tx * 8 + 4);
                const float av[4] = {a.x, a.y, a.z, a.w}, bv[8] = {b0.x, b0.y, b0.z, b0.w, b1.x, b1.y, b1.z, b1.w};
#pragma unroll
                for (int i = 0; i < 4; ++i)
#pragma unroll
                    for (int j = 0; j < 8; ++j) acc[i][j] = fmaf(av[i], bv[j], acc[i][j]);
            }
            __syncthreads();
        }
#pragma unroll
        for (int i = 0; i < 4; ++i)
#pragma unroll
            for (int j = 0; j < 8; ++j) ef(m0 + ty * 4 + i, n0 + tx * 8 + j, acc[i][j]);
    }
}

__device__ void ph_adaln_tables(const Params& p, float* lds) {
    const int tid = threadIdx.x, gid = blockIdx.x * NT + tid, gsz = gridDim.x * NT;
    for (int i = tid; i < 3 * D; i += NT) { const int r = i / D, k = i % D; const float v = r < 2 ? p.c[r * D + k] : p.c_ctx[k]; lds[i] = v / (1.f + expf(-v)); }
    __syncthreads();
    if (gid < NMOD * D) {
        float a0 = 0.f, a1 = 0.f, a2 = 0.f;
        for (int k = 0; k < D; ++k) { const float w = p.w_ada[(size_t)k * (NMOD * D) + gid]; a0 = fmaf(lds[k], w, a0); a1 = fmaf(lds[D + k], w, a1); a2 = fmaf(lds[2 * D + k], w, a2); }
        const float b = p.b_ada[gid];
        p.mod[gid] = a0 + b; p.mod[NMOD * D + gid] = a1 + b; p.mod[2 * NMOD * D + gid] = a2 + b;
    }
    for (int i = gid; i < SEQ; i += gsz) { p.cosN[i] = cospif(2.f * (float)i / (float)SEQ); p.sinN[i] = sinpif(2.f * (float)i / (float)SEQ); }
    for (int i = gid; i < (GROWS + GW) * 16; i += gsz) {
        const int pos = i / 16, f = i % 16; const float inv = powf(10000.f, -(float)f / 16.f);
        if (pos < GROWS) { const float a = (float)pos * inv; p.ropeR[2 * i] = cosf(a); p.ropeR[2 * i + 1] = sinf(a); }
        else { const int pc = pos - GROWS; const float a = (float)pc * inv; p.ropeC[2 * (pc * 16 + f)] = cosf(a); p.ropeC[2 * (pc * 16 + f) + 1] = sinf(a); }
    }
    if (gid < NEXP) p.cnt[gid] = 0;
}

__device__ void ph_hrows(const Params& p, float* lds) {
    const int tid = threadIdx.x;
    for (int row = blockIdx.x; row < NROWS; row += gridDim.x) {
        const float* src = row < NTOK ? p.x + (size_t)row * D : p.ctx + (size_t)(row - NTOK) * D;
        const int mr = row < NTOK ? row / SEQ : 2;
        const float* sh = p.mod + mr * NMOD * D, * sc = sh + D;
        const float v0 = src[tid], v1 = src[tid + NT];
        const float ss = block_sum(v0 * v0 + v1 * v1, lds);
        const float r = rsqrtf(ss / (float)D + EPS);
        p.hbuf[(size_t)row * D + tid] = v0 * r * p.g_norm1[tid] * (1.f + sc[tid]) + sh[tid];
        p.hbuf[(size_t)row * D + tid + NT] = v1 * r * p.g_norm1[tid + NT] * (1.f + sc[tid + NT]) + sh[tid + NT];
    }
}

__device__ void ph_inproj(const Params& p, float* lds) {
    const float* h = p.hbuf; const float* w = p.w_in; float* pb = p.pbuf;
    ngemm(lds, NROWS, DIN, D,
          [=](int m, int k) { return h[(size_t)m * D + k]; },
          [=](int, int k, int n) { return w[(size_t)k * DIN + n]; },
          [=](int m, int n, float v) { pb[(size_t)m * DIN + n] = v; });
}

__device__ void ph_chdft_rope(const Params& p, float* lds) {
    const int tid = threadIdx.x, gid = blockIdx.x * NT + tid, gsz = gridDim.x * NT;
    if (tid < 64) { lds[tid] = cospif(2.f * (float)tid / 64.f); lds[64 + tid] = sinpif(2.f * (float)tid / 64.f); }
    __syncthreads();
    for (int i = gid; i < NTOK * DF; i += gsz) {
        const int tok = i / DF, ch = i % DF, g = ch / 64, l = ch % 64;
        const float* f = p.pbuf + (size_t)tok * DIN + g * 64;
        float sr = 0.f, si = 0.f;
        for (int c = 0; c < 64; ++c) { const int m = (l * c) & 63; sr = fmaf(f[c], lds[m], sr); si = fmaf(f[c], lds[64 + m], si); }
        const int b = tok / SEQ, n = tok % SEQ;
        p.Tcat[((size_t)b * 2 * SEQ + n) * DF + ch] = sr;
        p.Tcat[((size_t)b * 2 * SEQ + SEQ + n) * DF + ch] = -si;
    }
    for (int i = gid; i < NTOK * NH * 32; i += gsz) {
        const int fi = i & 15, blk = (i >> 4) & 1, hh = (i >> 5) % NH, tok = i / (32 * NH);
        const int n = tok % SEQ, row = n / GW, col = n % GW;
        const float* tb = blk == 0 ? p.ropeR + 2 * (row * 16 + fi) : p.ropeC + 2 * (col * 16 + fi);
        const float cs = tb[0], sn = tb[1];
        float* kp = p.pbuf + (size_t)tok * DIN + KOFF + hh * HD + blk * 32 + fi;
        const float x1 = kp[0], x2 = kp[16];
        kp[0] = x1 * cs - x2 * sn; kp[16] = x1 * sn + x2 * cs;
    }
}

__device__ void ph_posdft(const Params& p, float* lds) {
    const float* cn = p.cosN; const float* sn = p.sinN; const float* T = p.Tcat; float* FR = p.FR;
    const float norm = 1.0f / sqrtf((float)SEQ * 64.f);
    ngemm(lds, NTOK, DF, 2 * SEQ,
          [=](int m, int k) { const int kk = m & (SEQ - 1); const int idx = (kk * (k & (SEQ - 1))) & (SEQ - 1); return k < SEQ ? cn[idx] : sn[idx]; },
          [=](int m0, int k, int n) { return T[((size_t)(m0 / SEQ) * 2 * SEQ + k) * DF + n]; },
          [=](int m, int n, float v) { FR[(size_t)m * DF + n] = v * norm; });
}

__device__ void ph_fmix(const Params& p, float* lds) {
    const float* FR = p.FR; const float* w = p.w_fmix; float* fo = p.fo;
    ngemm(lds, NTOK, DF, DF,
          [=](int m, int k) { return FR[(size_t)m * DF + k]; },
          [=](int, int k, int n) { return w[(size_t)k * DF + n]; },
          [=](int m, int n, float v) { fo[(size_t)m * DF + n] = v; });
}

__device__ void ph_attn(const Params& p, float* lds) {
    const int tid = threadIdx.x, wv = tid >> 6, lane = tid & 63;
    float* qr = lds + wv * 128; float* qp = qr + 64;
    const int nw = gridDim.x * (NT / 64), gw = blockIdx.x * (NT / 64) + wv;
    for (int task = gw; task < NTOK * NH; task += nw) {
        const int n = task % SEQ, hh = (task / SEQ) % NH, b = task / (SEQ * NH);
        const int tok = b * SEQ + n, row = n / GW, col = n % GW;
        const int rs = min(max(row - 4, 0), GROWS - 8), cs = min(max(col - 8, 0), GW - 16);
        {
            const float* qv = p.pbuf + (size_t)tok * DIN + QOFF + hh * HD;
            const int blk = lane >> 5, dd = lane & 31, fi = dd & 15;
            const float* tb = blk == 0 ? p.ropeR + 2 * (row * 16 + fi) : p.ropeC + 2 * (col * 16 + fi);
            const float c0 = tb[0], s0 = tb[1];
            const float x1 = qv[blk * 32 + fi], x2 = qv[blk * 32 + 16 + fi];
            qr[lane] = dd < 16 ? x1 * c0 - x2 * s0 : x1 * s0 + x2 * c0;
            qp[lane] = qv[lane];
        }
        __builtin_amdgcn_wave_barrier();
        __builtin_amdgcn_s_waitcnt(0);
        float s[6];
#pragma unroll
        for (int g = 0; g < 2; ++g) {
            const int j = 64 * g + lane, kr = j >> 4, kc = cs + (j & 15);
            const float* kv = p.pbuf + (size_t)(b * SEQ + (rs + kr) * GW + kc) * DIN + KOFF + hh * HD;
            float a = 0.f;
            for (int d = 0; d < HD; ++d) a = fmaf(qr[d], kv[d], a);
            s[g] = a * 0.125f + p.rpb[(hh * 15 + (rs + kr - row + 7)) * 31 + (kc - col + 15)];
        }
#pragma unroll
        for (int g = 2; g < 6; ++g) {
            const int m = 64 * (g - 2) + lane;
            const float* kv = p.pbuf + (size_t)(NTOK + b * LCTX + m) * DIN + KOFF + hh * HD;
            float a = 0.f;
            for (int d = 0; d < HD; ++d) a = fmaf(qp[d], kv[d], a);
            s[g] = a * 0.125f;
        }
        float mx = s[0];
#pragma unroll
        for (int g = 1; g < 6; ++g) mx = fmaxf(mx, s[g]);
        mx = wave_max(mx);
        float sum = 0.f;
#pragma unroll
        for (int g = 0; g < 6; ++g) { s[g] = expf(s[g] - mx); sum += s[g]; }
        sum = wave_sum(sum);
        float o = 0.f;
#pragma unroll
        for (int g = 0; g < 2; ++g)
            for (int jj = 0; jj < 64; ++jj) {
                const int j = 64 * g + jj, kr = j >> 4, kc = cs + (j & 15);
                const float pj = __shfl(s[g], jj);
                o = fmaf(pj, p.pbuf[(size_t)(b * SEQ + (rs + kr) * GW + kc) * DIN + VOFF + hh * HD + lane], o);
            }
#pragma unroll
        for (int g = 2; g < 6; ++g)
            for (int jj = 0; jj < 64; ++jj) {
                const int m = 64 * (g - 2) + jj;
                const float pj = __shfl(s[g], jj);
                o = fmaf(pj, p.pbuf[(size_t)(NTOK + b * LCTX + m) * DIN + VOFF + hh * HD + lane], o);
            }
        p.na[(size_t)tok * DNA + hh * HD + lane] = o / sum;
        __builtin_amdgcn_wave_barrier();
    }
}

__device__ void ph_a2rows(const Params& p, float* lds) {
    const int tid = threadIdx.x;
    for (int tok = blockIdx.x; tok < NTOK; tok += gridDim.x) {
        const float v0 = tid < DF ? p.fo[(size_t)tok * DF + tid] : p.na[(size_t)tok * DNA + tid - DF];
        const float v1 = p.na[(size_t)tok * DNA + tid + NT - DF];
        const float sf = block_sum(tid < DF ? v0 * v0 : 0.f, lds);
        const float sn = block_sum((tid < DF ? 0.f : v0 * v0) + v1 * v1, lds);
        const float rf = rsqrtf(sf / (float)DF + EPS), rn = rsqrtf(sn / (float)DNA + EPS);
        p.A2[(size_t)tok * D + tid] = v0 * (tid < DF ? rf : rn) * p.g_out[tid];
        p.A2[(size_t)tok * D + tid + NT] = v1 * rn * p.g_out[tid + NT];
    }
}

__device__ void ph_outproj(const Params& p, float* lds) {
    const float* A2 = p.A2; const float* w = p.w_out; const float* x = p.x; const float* mod = p.mod; float* x1 = p.x1;
    ngemm(lds, NTOK, D, D,
          [=](int m, int k) { return A2[(size_t)m * D + k]; },
          [=](int, int k, int n) { return w[(size_t)k * D + n]; },
          [=](int m, int n, float v) { x1[(size_t)m * D + n] = x[(size_t)m * D + n] + mod[(m / SEQ) * NMOD * D + 2 * D + n] * v; });
}

__device__ void ph_router(const Params& p, float* lds) {
    const int tid = threadIdx.x, wv = tid >> 6, lane = tid & 63;
    const int nw = gridDim.x * (NT / 64), gw = blockIdx.x * (NT / 64) + wv;
    for (int tok = gw; tok < NTOK; tok += nw) {
        const int b = tok / SEQ;
        const float* sh = p.mod + b * NMOD * D + 3 * D, * sc = sh + D;
        float hv[16]; float ss = 0.f;
#pragma unroll
        for (int i = 0; i < 16; ++i) { hv[i] = p.x1[(size_t)tok * D + lane + 64 * i]; ss = fmaf(hv[i], hv[i], ss); }
        ss = wave_sum(ss);
        const float r = rsqrtf(ss / (float)D + EPS);
#pragma unroll
        for (int i = 0; i < 16; ++i) { const int e = lane + 64 * i; hv[i] = hv[i] * r * p.g_norm2[e] * (1.f + sc[e]) + sh[e]; p.h2[(size_t)tok * D + e] = hv[i]; p.moe[(size_t)tok * D + e] = 0.f; }
        float lg[4];
#pragma unroll
        for (int o = 0; o < 4; ++o) { float a = 0.f;
#pragma unroll
            for (int i = 0; i < 16; ++i) a = fmaf(hv[i], p.w_rg[(size_t)(lane + 64 * i) * 4 + o], a);
            lg[o] = wave_sum(a); }
        int gs = 0; float gm = lg[0];
#pragma unroll
        for (int o = 1; o < 4; ++o) if (lg[o] > gm) { gm = lg[o]; gs = o; }
        float gz = 0.f;
#pragma unroll
        for (int o = 0; o < 4; ++o) gz += expf(lg[o] - gm);
        const float pg = 1.f / gz;
        float le[8];
#pragma unroll
        for (int o = 0; o < 8; ++o) { float a = 0.f;
#pragma unroll
            for (int i = 0; i < 16; ++i) a = fmaf(hv[i], p.w_re[(size_t)(lane + 64 * i) * NEXP + gs * 8 + o], a);
            le[o] = wave_sum(a); }
        int i0 = 0; float m0 = le[0];
#pragma unroll
        for (int o = 1; o < 8; ++o) if (le[o] > m0) { m0 = le[o]; i0 = o; }
        int i1 = -1; float m1 = -3.0e38f;
#pragma unroll
        for (int o = 0; o < 8; ++o) if (o != i0 && le[o] > m1) { m1 = le[o]; i1 = o; }
        const float e1 = expf(m1 - m0);
        const float g0 = pg / (1.f + e1), g1 = pg * e1 / (1.f + e1);
        if (lane == 0) {
            const int ea = gs * 8 + i0, eb = gs * 8 + i1;
            const int sa = atomicAdd(&p.cnt[ea], 1); p.list[ea * NTOK + sa] = tok * 2;
            const int sb = atomicAdd(&p.cnt[eb], 1); p.list[eb * NTOK + sb] = tok * 2 + 1;
            p.tokgate[tok * 2] = g0; p.tokgate[tok * 2 + 1] = g1;
        }
    }
}

__device__ void ph_moe(const Params& p, float* lds) {
    const int tid = threadIdx.x;
    float* hrows = lds;
    float* hid = lds + 16 * D;
    int* meta = (int*)(lds + 16 * D + 16 * DEXP);
    int total = 0;
    for (int e = 0; e < NEXP; ++e) total += (p.cnt[e] + 15) >> 4;
    for (int item = blockIdx.x; item < total; item += gridDim.x) {
        int e = 0, base = 0;
        for (;;) { const int nc = (p.cnt[e] + 15) >> 4; if (item < base + nc) break; base += nc; ++e; }
        const int s0 = (item - base) * 16, ns = min(16, p.cnt[e] - s0);
        __syncthreads();
        if (tid < 16) meta[tid] = tid < ns ? p.list[e * NTOK + s0 + tid] : -1;
        __syncthreads();
        for (int i = tid; i < 16 * D; i += NT) { const int t = i / D, k = i % D; const int ent = meta[t]; hrows[i] = ent >= 0 ? p.h2[(size_t)(ent >> 1) * D + k] : 0.f; }
        __syncthreads();
        float ag[16], au[16];
#pragma unroll
        for (int t = 0; t < 16; ++t) { ag[t] = 0.f; au[t] = 0.f; }
        const float* wg = p.w_gate + (size_t)e * D * DEXP + tid; const float* wu = p.w_up + (size_t)e * D * DEXP + tid;
        for (int k = 0; k < D; k += 4) {
            const float g0 = wg[(size_t)k * DEXP], g1 = wg[(size_t)(k + 1) * DEXP], g2 = wg[(size_t)(k + 2) * DEXP], g3 = wg[(size_t)(k + 3) * DEXP];
            const float u0 = wu[(size_t)k * DEXP], u1 = wu[(size_t)(k + 1) * DEXP], u2 = wu[(size_t)(k + 2) * DEXP], u3 = wu[(size_t)(k + 3) * DEXP];
#pragma unroll
            for (int t = 0; t < 16; ++t) {
                const float4 h = *(const float4*)(hrows + t * D + k);
                ag[t] = fmaf(h.x, g0, ag[t]); ag[t] = fmaf(h.y, g1, ag[t]); ag[t] = fmaf(h.z, g2, ag[t]); ag[t] = fmaf(h.w, g3, ag[t]);
                au[t] = fmaf(h.x, u0, au[t]); au[t] = fmaf(h.y, u1, au[t]); au[t] = fmaf(h.z, u2, au[t]); au[t] = fmaf(h.w, u3, au[t]);
            }
        }
#pragma unroll
        for (int t = 0; t < 16; ++t) hid[t * DEXP + tid] = ag[t] / (1.f + expf(-ag[t])) * au[t];
        __syncthreads();
        float a0[16], a1[16];
#pragma unroll
        for (int t = 0; t < 16; ++t) { a0[t] = 0.f; a1[t] = 0.f; }
        const float* wd = p.w_down + (size_t)e * DEXP * D + tid;
        for (int j = 0; j < DEXP; j += 4) {
            float w0[4], w1[4];
#pragma unroll
            for (int q = 0; q < 4; ++q) { w0[q] = wd[(size_t)(j + q) * D]; w1[q] = wd[(size_t)(j + q) * D + NT]; }
#pragma unroll
            for (int t = 0; t < 16; ++t) {
                const float4 h = *(const float4*)(hid + t * DEXP + j);
                a0[t] = fmaf(h.x, w0[0], a0[t]); a0[t] = fmaf(h.y, w0[1], a0[t]); a0[t] = fmaf(h.z, w0[2], a0[t]); a0[t] = fmaf(h.w, w0[3], a0[t]);
                a1[t] = fmaf(h.x, w1[0], a1[t]); a1[t] = fmaf(h.y, w1[1], a1[t]); a1[t] = fmaf(h.z, w1[2], a1[t]); a1[t] = fmaf(h.w, w1[3], a1[t]);
            }
        }
#pragma unroll
        for (int t = 0; t < 16; ++t) {
            const int ent = meta[t];
            if (ent >= 0) { const float g = p.tokgate[ent]; atomicAdd(&p.moe[(size_t)(ent >> 1) * D + tid], g * a0[t]); atomicAdd(&p.moe[(size_t)(ent >> 1) * D + tid + NT], g * a1[t]); }
        }
    }
}

__device__ void ph_final(const Params& p, float* lds) {
    const int tid = threadIdx.x;
    for (int tok = blockIdx.x; tok < NTOK; tok += gridDim.x) {
        const float* gt2 = p.mod + (tok / SEQ) * NMOD * D + 5 * D;
        const float v0 = p.x1[(size_t)tok * D + tid] + gt2[tid] * p.moe[(size_t)tok * D + tid];
        const float v1 = p.x1[(size_t)tok * D + tid + NT] + gt2[tid + NT] * p.moe[(size_t)tok * D + tid + NT];
        const float ss = block_sum(v0 * v0 + v1 * v1, lds);
        const float r = rsqrtf(ss / (float)D + EPS);
        p.out[(size_t)tok * D + tid] = v0 * r * p.g_final[tid];
        p.out[(size_t)tok * D + tid + NT] = v1 * r * p.g_final[tid + NT];
    }
}

extern __shared__ __attribute__((aligned(16))) float smem[];

__global__ void __launch_bounds__(NT) mega(Params p) {
    cg::grid_group grid = cg::this_grid();
    ph_adaln_tables(p, smem); grid.sync();
    ph_hrows(p, smem); grid.sync();
    ph_inproj(p, smem); grid.sync();
    ph_chdft_rope(p, smem); grid.sync();
    ph_posdft(p, smem); grid.sync();
    ph_fmix(p, smem); ph_attn(p, smem); grid.sync();
    ph_a2rows(p, smem); grid.sync();
    ph_outproj(p, smem); grid.sync();
    ph_router(p, smem); grid.sync();
    ph_moe(p, smem); grid.sync();
    ph_final(p, smem);
}

extern "C" void kernel_launch(void* const* d_in, const int* in_sizes, int n_in, void* d_out, int out_size, void* d_ws, size_t ws_size, hipStream_t stream) {
    constexpr size_t kDynLds = 100 * 1024;
    static int grid_blocks = 0;
    if (!grid_blocks) {
        int dev = 0, cus = 0, per_cu = 0;
        hipGetDevice(&dev);
        hipDeviceGetAttribute(&cus, hipDeviceAttributeMultiprocessorCount, dev);
        hipFuncSetAttribute((const void*)mega, hipFuncAttributeMaxDynamicSharedMemorySize, (int)kDynLds);
        hipOccupancyMaxActiveBlocksPerMultiprocessor(&per_cu, (const void*)mega, NT, kDynLds);
        if (per_cu > 1) per_cu = 1;
        grid_blocks = cus * per_cu;
    }
    Params p{};
    p.x = (const float*)d_in[0]; p.c = (const float*)d_in[1]; p.ctx = (const float*)d_in[2]; p.c_ctx = (const float*)d_in[3];
    p.w_ada = (const float*)d_in[4]; p.b_ada = (const float*)d_in[5]; p.g_norm1 = (const float*)d_in[6]; p.w_in = (const float*)d_in[7];
    p.w_fmix = (const float*)d_in[8]; p.rpb = (const float*)d_in[9]; p.g_out = (const float*)d_in[10]; p.w_out = (const float*)d_in[11];
    p.g_norm2 = (const float*)d_in[12]; p.w_rg = (const float*)d_in[13]; p.w_re = (const float*)d_in[14]; p.w_gate = (const float*)d_in[15];
    p.w_up = (const float*)d_in[16]; p.w_down = (const float*)d_in[17]; p.g_final = (const float*)d_in[18];
    p.out = (float*)d_out;
    float* w = (float*)d_ws; size_t o = 0;
    auto take = [&](size_t n) { float* r = w + o; o += (n + 63) & ~(size_t)63; return r; };
    p.mod = take(3 * NMOD * D); p.cosN = take(SEQ); p.sinN = take(SEQ); p.ropeR = take(GROWS * 32); p.ropeC = take(GW * 32);
    p.cnt = (int*)take(64); p.list = (int*)take((size_t)NEXP * NTOK); p.tokgate = take(2 * NTOK);
    p.hbuf = take((size_t)NROWS * D); p.pbuf = take((size_t)NROWS * DIN); p.na = take((size_t)NTOK * DNA);
    p.Tcat = p.hbuf; p.FR = p.hbuf + (size_t)2 * NTOK * DF; p.fo = p.FR + (size_t)NTOK * DF;
    p.A2 = p.pbuf; p.x1 = p.pbuf + (size_t)NTOK * D; p.moe = p.pbuf; p.h2 = p.hbuf;
    void* args[] = {&p};
    hipError_t e = hipLaunchCooperativeKernel((const void*)mega, dim3(grid_blocks), dim3(NT), args, kDynLds, stream);
    if (e != hipSuccess) fprintf(stderr, "cooperative launch failed: %s (grid %d)\n", hipGetErrorString(e), grid_blocks);
}
```

```cpp
#include <hip/hip_runtime.h>
#include <hip/hip_cooperative_groups.h>
#include <cstdio>
#include <cstdint>
namespace cg = cooperative_groups;

constexpr int D = 1024, NBATCH = 2, SEQ = 8192, NTOK = NBATCH * SEQ, LCTX = 256, NCTX = NBATCH * LCTX, NROWS = NTOK + NCTX;
constexpr int DIN = 2560, DF = 256, NH = 12, HD = 64, DNA = 768, QOFF = 256, KOFF = 1024, VOFF = 1792;
constexpr int GW = 64, GROWS = 128, NEXP = 32, DEXP = 512, NMOD = 6;
constexpr float EPS = 1e-6f;
constexpr int NT = 512;
constexpr float QSCALE = 0.125f * 1.4426950408889634f;
typedef unsigned short bf16_t;
typedef short bf16x8 __attribute__((ext_vector_type(8)));
typedef float f32x16 __attribute__((ext_vector_type(16)));
typedef float f32x4 __attribute__((ext_vector_type(4)));
__device__ __forceinline__ unsigned cvt_pk_bf16(float lo, float hi) { unsigned r; asm volatile("v_cvt_pk_bf16_f32 %0, %1, %2" : "=v"(r) : "v"(lo), "v"(hi)); return r; }
__device__ __forceinline__ bf16_t f2bf(float v) { return (bf16_t)(cvt_pk_bf16(v, 0.f) & 0xffffu); }
__device__ __forceinline__ float bf2f(bf16_t v) { return __uint_as_float((unsigned)v << 16); }

struct Params {
    const float *x, *c, *ctx, *c_ctx, *w_ada, *b_ada, *g_norm1, *w_in, *w_fmix, *rpb, *g_out, *w_out, *g_norm2, *w_rg, *w_re, *w_gate, *w_up, *w_down, *g_final;
    float* out;
    float *mod, *cosN, *sinN, *ropeR, *ropeC;
    float *na;
    float *x1;
    int *cnt, *list; float* tokgate;
    bf16_t *WinT, *WoutT, *WgT, *WuT, *WdT;
    bf16_t *hb, *A2b;
    bf16_t *h2b, *act, *ybuf;
    bf16_t *fX, *Qr, *Qp, *Kr, *Vt, *Kc, *Vct;
    bf16_t *W64cs, *G128, *WmixT;
    bf16_t *Zb, *P2;
};

__device__ __forceinline__ float wave_sum(float v) {
#pragma unroll
    for (int o = 32; o > 0; o >>= 1) v += __shfl_xor(v, o);
    return v;
}
__device__ __forceinline__ float wave_max(float v) {
#pragma unroll
    for (int o = 32; o > 0; o >>= 1) v = fmaxf(v, __shfl_xor(v, o));
    return v;
}
__device__ __forceinline__ float block_sum(float v, float* red) {
    v = wave_sum(v);
    const int w = threadIdx.x >> 6, l = threadIdx.x & 63;
    __syncthreads();
    if (l == 0) red[w] = v;
    __syncthreads();
    float s = 0.f;
#pragma unroll
    for (int i = 0; i < NT / 64; ++i) s += red[i];
    return s;
}

template <class AF, class BF, class EF>
__device__ void ngemm(float* lds, int M, int N, int K, AF af, BF bf, EF ef) {
    float* As = lds;
    float* Bs = lds + 16 * 132;
    const int tid = threadIdx.x, ty = tid >> 4, tx = tid & 15;
    const int tn = N / 128, nt = (M / 128) * tn;
    for (int t = blockIdx.x; t < nt; t += gridDim.x) {
        const int m0 = (t / tn) * 128, n0 = (t % tn) * 128;
        float acc[4][8];
#pragma unroll
        for (int i = 0; i < 4; ++i)
#pragma unroll
            for (int j = 0; j < 8; ++j) acc[i][j] = 0.f;
        for (int k0 = 0; k0 < K; k0 += 16) {
#pragma unroll
            for (int i = 0; i < 4; ++i) { const int idx = tid + NT * i, kk = idx & 15, m = idx >> 4; As[kk * 132 + m] = af(m0 + m, k0 + kk); }
#pragma unroll
            for (int i = 0; i < 4; ++i) { const int idx = tid + NT * i, n = idx & 127, kk = idx >> 7; Bs[kk * 128 + n] = bf(m0, k0 + kk, n0 + n); }
            __syncthreads();
#pragma unroll
            for (int kk = 0; kk < 16; ++kk) {
                const float4 a = *(const float4*)(As + kk * 132 + ty * 4);
                const float4 b0 = *(const float4*)(Bs + kk * 128 + tx * 8), b1 = *(const float4*)(Bs + kk * 128 + tx * 8 + 4);
                const float av[4] = {a.x, a.y, a.z, a.w}, bv[8] = {b0.x, b0.y, b0.z, b0.w, b1.x, b1.y, b1.z, b1.w};
#pragma unroll
                for (int i = 0; i < 4; ++i)
#pragma unroll
                    for (int j = 0; j < 8; ++j) acc[i][j] = fmaf(av[i], bv[j], acc[i][j]);
            }
            __syncthreads();
        }
#pragma unroll
        for (int i = 0; i < 4; ++i)
#pragma unroll
            for (int j = 0; j < 8; ++j) ef(m0 + ty * 4 + i, n0 + tx * 8 + j, acc[i][j]);
    }
}

#define LAS __attribute__((address_space(3)))
#define SCS(tid) (((tid) & 7) ^ ((((tid) >> 3) >> 1) & 7))
__device__ __forceinline__ void gemm256(LAS unsigned char* lds, const int tid, const char* Pb, const unsigned (&po)[4], const char* Qb, const unsigned (&qo)[4], int nk, f32x16 (&acc)[4][2]) {
    const int lane = tid & 63, wid = __builtin_amdgcn_readfirstlane(tid >> 6), wr = wid >> 2, wc = wid & 3;
    const int r = lane & 31, h = lane >> 5, swz = (r >> 1) & 7;
    const unsigned ldsw = (unsigned)wid * 1024u;
#pragma unroll
    for (int i = 0; i < 4; ++i)
#pragma unroll
        for (int j = 0; j < 2; ++j)
#pragma unroll
            for (int v = 0; v < 16; ++v) acc[i][j][v] = 0.f;
    __syncthreads();
#pragma unroll
    for (int i = 0; i < 4; ++i) {
        __builtin_amdgcn_global_load_lds((const unsigned*)(Pb + po[i]), (LAS unsigned*)(lds + ldsw + i * 8192), 16, 0, 0);
        __builtin_amdgcn_global_load_lds((const unsigned*)(Qb + qo[i]), (LAS unsigned*)(lds + 32768 + ldsw + i * 8192), 16, 0, 0);
    }
    __syncthreads();
    const int prd = (wr * 128 + r) * 128, qrd = 32768 + (wc * 64 + r) * 128;
    const int ko0 = ((0 + h) ^ swz) << 4, ko1 = ((2 + h) ^ swz) << 4, ko2 = ((4 + h) ^ swz) << 4, ko3 = ((6 + h) ^ swz) << 4;
#define G256_LD(pf, qf, ko) do { _Pragma("unroll") for (int i = 0; i < 4; ++i) pf[i] = *(const LAS bf16x8*)(lds + cb + prd + i * 4096 + (ko)); \
                                 _Pragma("unroll") for (int j = 0; j < 2; ++j) qf[j] = *(const LAS bf16x8*)(lds + cb + qrd + j * 4096 + (ko)); } while (0)
#define G256_MM(pf, qf) do { _Pragma("unroll") for (int i = 0; i < 4; ++i) _Pragma("unroll") for (int j = 0; j < 2; ++j) \
                                 acc[i][j] = __builtin_amdgcn_mfma_f32_32x32x16_bf16(pf[i], qf[j], acc[i][j], 0, 0, 0); } while (0)
#pragma unroll 1
    for (int kt = 0; kt < nk; ++kt) {
        const int cb = (kt & 1) * 65536, nb = 65536 - cb;
        {
            const unsigned koff = (unsigned)min(kt + 1, nk - 1) * 128u;
#pragma unroll
            for (int i = 0; i < 4; ++i) {
                __builtin_amdgcn_global_load_lds((const unsigned*)(Pb + (size_t)(po[i] + koff)), (LAS unsigned*)(lds + nb + ldsw + i * 8192), 16, 0, 0);
                __builtin_amdgcn_global_load_lds((const unsigned*)(Qb + (size_t)(qo[i] + koff)), (LAS unsigned*)(lds + nb + 32768 + ldsw + i * 8192), 16, 0, 0);
            }
        }
        bf16x8 pa[4], qa[2], pb[4], qb[2];
        G256_LD(pa, qa, ko0);
        G256_LD(pb, qb, ko1);
        G256_MM(pa, qa);
        G256_LD(pa, qa, ko2);
        G256_MM(pb, qb);
        G256_LD(pb, qb, ko3);
        G256_MM(pa, qa);
        G256_MM(pb, qb);
        __syncthreads();
    }
    asm volatile("" ::: "memory");
}

__device__ void transpose_job(float* lds, const float* src, bf16_t* dst, int R, int C, int batch, int& tbase, int gstride, int& next) {
    const int tid = threadIdx.x;
    const int tr = R / 64, tc = C / 64, ntile = batch * tr * tc;
    while (next < tbase + ntile) {
        const int t = next - tbase; next += gstride;
        const int bb = t / (tr * tc), rem = t % (tr * tc), r0 = (rem / tc) * 64, c0 = (rem % tc) * 64;
        const float* s = src + (size_t)bb * R * C; bf16_t* d = dst + (size_t)bb * R * C;
        __syncthreads();
#pragma unroll
        for (int i = 0; i < 8; ++i) { const int rr = (tid >> 6) + 8 * i, cc = tid & 63; lds[rr * 65 + cc] = s[(size_t)(r0 + rr) * C + c0 + cc]; }
        __syncthreads();
#pragma unroll
        for (int i = 0; i < 4; ++i) { const int cc = (tid >> 5) + 16 * i, r2 = (tid & 31) * 2;
            *(unsigned*)(d + (size_t)(c0 + cc) * R + r0 + r2) = cvt_pk_bf16(lds[r2 * 65 + cc], lds[(r2 + 1) * 65 + cc]); }
    }
    tbase += ntile;
}

__device__ void ph_adaln_tables(const Params& p, float* lds) {
    const int tid = threadIdx.x, gid = blockIdx.x * NT + tid, gsz = gridDim.x * NT;
    for (int i = tid; i < 3 * D; i += NT) { const int r = i / D, k = i % D; const float v = r < 2 ? p.c[r * D + k] : p.c_ctx[k]; lds[i] = v / (1.f + expf(-v)); }
    __syncthreads();
    if (gid < NMOD * D) {
        float a0 = 0.f, a1 = 0.f, a2 = 0.f;
        for (int k = 0; k < D; ++k) { const float w = p.w_ada[(size_t)k * (NMOD * D) + gid]; a0 = fmaf(lds[k], w, a0); a1 = fmaf(lds[D + k], w, a1); a2 = fmaf(lds[2 * D + k], w, a2); }
        const float b = p.b_ada[gid];
        p.mod[gid] = a0 + b; p.mod[NMOD * D + gid] = a1 + b; p.mod[2 * NMOD * D + gid] = a2 + b;
    }
    for (int i = gid; i < SEQ; i += gsz) { p.cosN[i] = cospif(2.f * (float)i / (float)SEQ); p.sinN[i] = sinpif(2.f * (float)i / (float)SEQ); }
    for (int i = gid; i < (GROWS + GW) * 16; i += gsz) {
        const int pos = i / 16, f = i % 16; const float inv = powf(10000.f, -(float)f / 16.f);
        if (pos < GROWS) { const float a = (float)pos * inv; p.ropeR[2 * i] = cosf(a); p.ropeR[2 * i + 1] = sinf(a); }
        else { const int pc = pos - GROWS; const float a = (float)pc * inv; p.ropeC[2 * (pc * 16 + f)] = cosf(a); p.ropeC[2 * (pc * 16 + f) + 1] = sinf(a); }
    }
    if (gid < NEXP) p.cnt[gid] = 0;
    for (int i = gid; i < 256 * 64; i += gsz) {
        const int rho = i >> 6, n1 = i & 63, blk = rho >> 5, k1 = (blk >> 1) * 32 + (rho & 31);
        float v = 0.f;
        if (blk < 4) { const float a = 2.f * (float)((k1 * n1) & 63) / 64.f; v = (blk & 1) ? -sinpif(a) : cospif(a); }
        p.W64cs[i] = f2bf(v);
    }
    for (int i = gid; i < 256 * 256; i += gsz) {
        const int rho = i >> 8, kap = i & 255, ro = rho >> 7, k2 = rho & 127, ri = kap >> 7, n2 = kap & 127;
        const float a = 2.f * (float)((k2 * n2) & 127) / 128.f; const float c = cospif(a), s = sinpif(a);
        p.G128[i] = f2bf(ro == ri ? c : (ro == 0 ? s : -s));
    }
    for (int i = gid; i < 256 * 512; i += gsz) {
        const int j = i >> 9, kap = i & 511, ro = kap >> 8, ch = kap & 255, g = ch >> 6, c = ch & 63;
        float acc = 0.f;
        for (int l = 0; l < 64; ++l) { const float a = 2.f * (float)((l * c) & 63) / 64.f; acc = fmaf(ro ? sinpif(a) : cospif(a), p.w_fmix[(size_t)(64 * g + l) * DF + j], acc); }
        p.WmixT[i] = f2bf(acc * (1.0f / 724.0773439350247f));
    }
    __syncthreads();
    int tbase = 0, next = blockIdx.x;
    transpose_job(lds, p.w_in, p.WinT, D, DIN, 1, tbase, gridDim.x, next);
    transpose_job(lds, p.w_out, p.WoutT, D, D, 1, tbase, gridDim.x, next);
    transpose_job(lds, p.w_gate, p.WgT, D, DEXP, NEXP, tbase, gridDim.x, next);
    transpose_job(lds, p.w_up, p.WuT, D, DEXP, NEXP, tbase, gridDim.x, next);
    transpose_job(lds, p.w_down, p.WdT, DEXP, D, NEXP, tbase, gridDim.x, next);
}

__device__ void ph_hrows(const Params& p, float* lds) {
    const int tid = threadIdx.x;
    for (int row = blockIdx.x; row < NROWS; row += gridDim.x) {
        const float* src = row < NTOK ? p.x + (size_t)row * D : p.ctx + (size_t)(row - NTOK) * D;
        const int mr = row < NTOK ? row / SEQ : 2;
        const float* sh = p.mod + mr * NMOD * D, * sc = sh + D;
        const float2 v = *(const float2*)(src + 2 * tid);
        const float ss = block_sum(v.x * v.x + v.y * v.y, lds);
        const float r = rsqrtf(ss / (float)D + EPS);
        const float o0 = v.x * r * p.g_norm1[2 * tid] * (1.f + sc[2 * tid]) + sh[2 * tid];
        const float o1 = v.y * r * p.g_norm1[2 * tid + 1] * (1.f + sc[2 * tid + 1]) + sh[2 * tid + 1];
        *(unsigned*)(p.hb + (size_t)row * D + 2 * tid) = cvt_pk_bf16(o0, o1);
    }
}

__device__ void ph_inproj(const Params& p, float* ldsf) {
    LAS unsigned char* lds = (LAS unsigned char*)ldsf;
    int tid = threadIdx.x; asm volatile("" : "+v"(tid));
    const int lane = tid & 63, wid = tid >> 6, wr = wid >> 2, wc = wid & 3, r = lane & 31, h = lane >> 5;
    const int srow = tid >> 3, sc = SCS(tid);
    constexpr int NPM = NROWS / 256, NPN = DIN / 256;
    for (int u = blockIdx.x; u < NPM * NPN; u += gridDim.x) {
        const int pm = u / NPN, pn = u % NPN;
        if (pm >= 64 && pn < 4) continue;
        unsigned po[4], qo[4];
#pragma unroll
        for (int i = 0; i < 4; ++i) {
            const int rt = srow + 64 * i;
            po[i] = (unsigned)((pn * 256 + rt) * D * 2 + sc * 16);
            int rowidx;
            if (pn == 0) rowidx = (pm >> 5) * SEQ + 128 * (rt & 63) + 4 * (pm & 31) + (rt >> 6);
            else rowidx = pm * 256 + rt;
            qo[i] = (unsigned)rowidx * (unsigned)(D * 2) + sc * 16;
        }
        f32x16 acc[4][2];
        gemm256(lds, tid, (const char*)p.WinT, po, (const char*)p.hb, qo, D / 64, acc);
        int opq = 0; asm volatile("" : "+v"(opq));
        const int r_ = r + opq, h_ = h + opq;
        if (pn == 0) {
            const int b = pm >> 5, n2 = 4 * (pm & 31) + wc;
#pragma unroll
            for (int i = 0; i < 4; ++i) {
#pragma unroll
                for (int j = 0; j < 2; ++j) {
                    const unsigned base = (unsigned)(((b * DF + wr * 128 + i * 32 + 4 * h_) * 128 + n2) * 64 + j * 32 + r_);
#pragma unroll
                    for (int v = 0; v < 16; ++v) p.fX[base + (unsigned)(((v & 3) + 8 * (v >> 2)) * 128 * 64)] = f2bf(acc[i][j][v]);
                }
                asm volatile("" ::: "memory");
            }
        } else if (pn < 7) {
            const bool isq = pn < 4; const int hg = ((pn - 1) % 3) * 4 + wr * 2;
            const bool isctx = pm >= 64;
            const int b = isctx ? pm - 64 : (pm >> 5);
#pragma unroll
            for (int j = 0; j < 2; ++j) {
                const int n = (isctx ? 0 : (pm & 31) * 256) + wc * 64 + j * 32 + r_;
                const int grow = n >> 6, gcol = n & 63;
#pragma unroll
                for (int i = 0; i < 4; ++i) {
                    const int hh = hg + (i >> 1), blk = i & 1;
                    if (isctx) {
                        const unsigned base = (unsigned)(((b * NH + hh) * LCTX + n) * HD + blk * 32 + 4 * h_);
#pragma unroll
                        for (int q = 0; q < 4; ++q) {
                            uint2 w;
                            w.x = cvt_pk_bf16(acc[i][j][4 * q], acc[i][j][4 * q + 1]); w.y = cvt_pk_bf16(acc[i][j][4 * q + 2], acc[i][j][4 * q + 3]);
                            *(uint2*)(p.Kc + base + 8 * q) = w;
                        }
                    } else {
                        const float* tb = (blk == 0 ? p.ropeR + 32 * grow : p.ropeC + 32 * gcol) + 8 * h_;
                        float o1[8], o2[8];
#pragma unroll
                        for (int v = 0; v < 8; ++v) {
                            const float2 cs = *(const float2*)(tb + 2 * ((v & 3) + 8 * (v >> 2)));
                            const float x1 = acc[i][j][v], x2 = acc[i][j][v + 8];
                            o1[v] = x1 * cs.x - x2 * cs.y; o2[v] = x1 * cs.y + x2 * cs.x;
                        }
                        const unsigned base = (unsigned)(((b * NH + hh) * SEQ + n) * HD + blk * 32 + 4 * h_);
                        if (isq) {
#pragma unroll
                            for (int q = 0; q < 2; ++q) {
                                uint2 w;
                                w.x = cvt_pk_bf16(o1[4 * q] * QSCALE, o1[4 * q + 1] * QSCALE); w.y = cvt_pk_bf16(o1[4 * q + 2] * QSCALE, o1[4 * q + 3] * QSCALE);
                                *(uint2*)(p.Qr + base + 8 * q) = w;
                                w.x = cvt_pk_bf16(o2[4 * q] * QSCALE, o2[4 * q + 1] * QSCALE); w.y = cvt_pk_bf16(o2[4 * q + 2] * QSCALE, o2[4 * q + 3] * QSCALE);
                                *(uint2*)(p.Qr + base + 16 + 8 * q) = w;
                            }
#pragma unroll
                            for (int q = 0; q < 4; ++q) {
                                uint2 w;
                                w.x = cvt_pk_bf16(acc[i][j][4 * q] * QSCALE, acc[i][j][4 * q + 1] * QSCALE); w.y = cvt_pk_bf16(acc[i][j][4 * q + 2] * QSCALE, acc[i][j][4 * q + 3] * QSCALE);
                                *(uint2*)(p.Qp + base + 8 * q) = w;
                            }
                        } else {
#pragma unroll
                            for (int q = 0; q < 2; ++q) {
                                uint2 w;
                                w.x = cvt_pk_bf16(o1[4 * q], o1[4 * q + 1]); w.y = cvt_pk_bf16(o1[4 * q + 2], o1[4 * q + 3]);
                                *(uint2*)(p.Kr + base + 8 * q) = w;
                                w.x = cvt_pk_bf16(o2[4 * q], o2[4 * q + 1]); w.y = cvt_pk_bf16(o2[4 * q + 2], o2[4 * q + 3]);
                                *(uint2*)(p.Kr + base + 16 + 8 * q) = w;
                            }
                        }
                    }
                    asm volatile("" ::: "memory");
                }
            }
        } else {
            const int hg = (pn - 7) * 4 + wr * 2;
            const bool isctx = pm >= 64;
            const int b = isctx ? pm - 64 : (pm >> 5);
            const int ld = isctx ? LCTX : SEQ; bf16_t* vb = isctx ? p.Vct : p.Vt;
#pragma unroll
            for (int j = 0; j < 2; ++j) {
                const int n = (isctx ? 0 : (pm & 31) * 256) + wc * 64 + j * 32 + r_;
#pragma unroll
                for (int i = 0; i < 4; ++i) {
                    const unsigned base = (unsigned)(((b * NH + hg + (i >> 1)) * HD + (i & 1) * 32 + 4 * h_) * ld + n);
#pragma unroll
                    for (int v = 0; v < 16; ++v) vb[base + (unsigned)(((v & 3) + 8 * (v >> 2)) * ld)] = f2bf(acc[i][j][v]);
                    asm volatile("" ::: "memory");
                }
            }
        }
    }
}

__device__ void ph_four1(const Params& p, float* ldsf) {
    LAS unsigned char* lds = (LAS unsigned char*)ldsf;
    int tid = threadIdx.x; asm volatile("" : "+v"(tid));
    const int lane = tid & 63, wid = tid >> 6, wr = wid >> 2, wc = wid & 3, r = lane & 31, h = lane >> 5;
    const int srow = tid >> 3, sc = SCS(tid);
    for (int u = blockIdx.x; u < NBATCH * DF * 128 / 256; u += gridDim.x) {
        unsigned po[4], qo[4];
#pragma unroll
        for (int i = 0; i < 4; ++i) { const int rt = srow + 64 * i; po[i] = (unsigned)rt * 128u + sc * 16; qo[i] = (unsigned)(u * 256 + rt) * 128u + sc * 16; }
        f32x16 acc[4][2];
        gemm256(lds, tid, (const char*)p.W64cs, po, (const char*)p.fX, qo, 1, acc);
        if (wr == 0) {
            int opq = 0; asm volatile("" : "+v"(opq));
            const int r_ = r + opq, h_ = h + opq;
#pragma unroll
            for (int j = 0; j < 2; ++j) {
                const int qrow = u * 256 + wc * 64 + j * 32 + r_;
                const int n2 = qrow & 127, bc = qrow >> 7;
#pragma unroll
                for (int a = 0; a < 2; ++a) {
#pragma unroll
                    for (int v = 0; v < 16; ++v) {
                        const int k1 = a * 32 + (v & 3) + 8 * (v >> 2) + 4 * h_;
                        const int idx = n2 * k1;
                        const float cs = p.cosN[idx], sn = p.sinN[idx];
                        const float yr = acc[2 * a][j][v], yi = acc[2 * a + 1][j][v];
                        const unsigned base = (unsigned)((bc * 64 + k1) * 256 + n2);
                        p.Zb[base] = f2bf(yr * cs + yi * sn); p.Zb[base + 128] = f2bf(yi * cs - yr * sn);
                    }
                    asm volatile("" ::: "memory");
                }
            }
        }
    }
}

__device__ void ph_four2(const Params& p, float* ldsf) {
    LAS unsigned char* lds = (LAS unsigned char*)ldsf;
    int tid = threadIdx.x; asm volatile("" : "+v"(tid));
    const int lane = tid & 63, wid = tid >> 6, wr = wid >> 2, wc = wid & 3, r = lane & 31, h = lane >> 5;
    const int srow = tid >> 3, sc = SCS(tid);
    for (int u = blockIdx.x; u < NBATCH * 64; u += gridDim.x) {
        const int b = u >> 6, k1 = u & 63;
        unsigned po[4], qo[4];
#pragma unroll
        for (int i = 0; i < 4; ++i) { const int rt = srow + 64 * i; po[i] = (unsigned)rt * 512u + sc * 16; qo[i] = (unsigned)(((b * DF + rt) * 64 + k1) * 512) + sc * 16; }
        f32x16 acc[4][2];
        gemm256(lds, tid, (const char*)p.G128, po, (const char*)p.Zb, qo, 4, acc);
        int opq = 0; asm volatile("" : "+v"(opq));
        const int r_ = r + opq, h_ = h + opq;
#pragma unroll
        for (int i = 0; i < 4; ++i) {
#pragma unroll
            for (int j = 0; j < 2; ++j) {
                bf16_t* dst = p.P2 + (unsigned)((b * SEQ + k1 + 64 * (i * 32 + 4 * h_)) * 512 + wr * 256 + wc * 64 + j * 32 + r_);
#pragma unroll
                for (int v = 0; v < 16; ++v) dst[((v & 3) + 8 * (v >> 2)) * 64 * 512] = f2bf(acc[i][j][v]);
                asm volatile("" ::: "memory");
            }
        }
    }
}

__device__ void ph_fmix(const Params& p, float* ldsf) {
    LAS unsigned char* lds = (LAS unsigned char*)ldsf;
    int tid = threadIdx.x; asm volatile("" : "+v"(tid));
    const int lane = tid & 63, wid = tid >> 6, wr = wid >> 2, wc = wid & 3, r = lane & 31, h = lane >> 5;
    const int srow = tid >> 3, sc = SCS(tid);
    for (int u = blockIdx.x; u < NTOK / 256; u += gridDim.x) {
        unsigned po[4], qo[4];
#pragma unroll
        for (int i = 0; i < 4; ++i) { const int rt = srow + 64 * i; po[i] = (unsigned)rt * 1024u + sc * 16; qo[i] = (unsigned)(u * 256 + rt) * 1024u + sc * 16; }
        f32x16 acc[4][2];
        gemm256(lds, tid, (const char*)p.WmixT, po, (const char*)p.P2, qo, 8, acc);
        float ss[2];
#pragma unroll
        for (int j = 0; j < 2; ++j) { float s = 0.f;
#pragma unroll
            for (int i = 0; i < 4; ++i)
#pragma unroll
                for (int v = 0; v < 16; ++v) s = fmaf(acc[i][j][v], acc[i][j][v], s);
            ss[j] = s + __shfl_xor(s, 32); }
        float* red = ldsf;
        if (h == 0) { red[wr * 256 + wc * 64 + r] = ss[0]; red[wr * 256 + wc * 64 + 32 + r] = ss[1]; }
        __syncthreads();
        int opq = 0; asm volatile("" : "+v"(opq));
        const int r_ = r + opq, h_ = h + opq;
#pragma unroll
        for (int j = 0; j < 2; ++j) {
            const int tl = wc * 64 + j * 32 + r_;
            const float rstd = rsqrtf((red[tl] + red[256 + tl]) / (float)DF + EPS);
            bf16_t* dst = p.A2b + (unsigned)((u * 256 + tl) * D + wr * 128 + 4 * h_);
            const float* gp = p.g_out + wr * 128 + 4 * h_;
#pragma unroll
            for (int i = 0; i < 4; ++i) {
#pragma unroll
                for (int q = 0; q < 4; ++q) {
                    const float4 g = *(const float4*)(gp + i * 32 + 8 * q);
                    uint2 w; w.x = cvt_pk_bf16(acc[i][j][4 * q] * rstd * g.x, acc[i][j][4 * q + 1] * rstd * g.y); w.y = cvt_pk_bf16(acc[i][j][4 * q + 2] * rstd * g.z, acc[i][j][4 * q + 3] * rstd * g.w);
                    *(uint2*)(dst + i * 32 + 8 * q) = w;
                }
                asm volatile("" ::: "memory");
            }
        }
    }
}

typedef short s16x4 __attribute__((ext_vector_type(4)));
constexpr float LOG2E = 1.4426950408889634f;
__device__ void ph_attn(const Params& p, float* ldsf) {
    int tid = threadIdx.x; asm volatile("" : "+v"(tid));
    const int lane = tid & 63, wv = tid >> 6, l31 = lane & 31, h = lane >> 5;
    __syncthreads();
    for (int i = tid; i < NH * 15 * 128; i += NT) { const int dcx = (i & 127) - 48, dr = (i >> 7) % 15, hh = i / (15 * 128);
        ldsf[i] = (dcx >= 0 && dcx <= 30) ? p.rpb[(hh * 15 + dr) * 31 + dcx] * LOG2E : 0.f; }
    __syncthreads();
    const int half = wv & 1;
    for (int g = blockIdx.x; g < NBATCH * NH * (GROWS / 4); g += gridDim.x) {
        const int bh = g / (GROWS / 4), row = (g % (GROWS / 4)) * 4 + (wv >> 1), hh = bh % NH;
        const int rs = min(max(row - 4, 0), GROWS - 8);
        const int qc = 32 * half + l31, cs = min(max(qc - 8, 0), GW - 16);
        const int nq = row * GW + qc;
        const bf16_t* Kh = p.Kr + (size_t)bh * SEQ * HD; const bf16_t* Vh = p.Vt + (size_t)bh * HD * SEQ;
        const bf16_t* Kch = p.Kc + (size_t)bh * LCTX * HD; const bf16_t* Vch = p.Vct + (size_t)bh * HD * LCTX;
        bf16x8 qr[4], qp[4];
#pragma unroll
        for (int s = 0; s < 4; ++s) { qr[s] = *(const bf16x8*)(p.Qr + ((size_t)bh * SEQ + nq) * HD + 16 * s + 8 * h); qp[s] = *(const bf16x8*)(p.Qp + ((size_t)bh * SEQ + nq) * HD + 16 * s + 8 * h); }
        f32x16 o0, o1;
#pragma unroll
        for (int v = 0; v < 16; ++v) { o0[v] = 0.f; o1[v] = 0.f; }
        float m = -1e30f, lsum = 0.f;
        const float* rph = ldsf + hh * 15 * 128;
        for (int t = 0; t < 20; ++t) {
            const bool loc = t < 12;
            const bf16_t* kptr; const bf16_t* vptr0; int vstr;
            int krow0 = 0, blk = 0;
            if (loc) { const int pr = t / 3; blk = half + (t - 3 * pr); krow0 = rs + 2 * pr;
                kptr = Kh + (size_t)((krow0 + (l31 >> 4)) * GW + 16 * blk + (l31 & 15)) * HD + 8 * h;
                vptr0 = Vh + (size_t)l31 * SEQ + krow0 * GW + 16 * blk + 4 * h; vstr = SEQ;
            } else { const int m0 = 32 * (t - 12);
                kptr = Kch + (size_t)(m0 + l31) * HD + 8 * h;
                vptr0 = Vch + (size_t)l31 * LCTX + m0 + 4 * h; vstr = LCTX; }
            const int krs = loc ? GW : 16;
            bf16x8 kf[4];
#pragma unroll
            for (int s = 0; s < 4; ++s) kf[s] = *(const bf16x8*)(kptr + 16 * s);
            s16x4 va[2][2][2];
#pragma unroll
            for (int dt = 0; dt < 2; ++dt)
#pragma unroll
                for (int kk = 0; kk < 2; ++kk)
#pragma unroll
                    for (int pt = 0; pt < 2; ++pt) va[dt][kk][pt] = *(const s16x4*)(vptr0 + (size_t)dt * 32 * vstr + kk * krs + 8 * pt);
            f32x16 sa;
#pragma unroll
            for (int v = 0; v < 16; ++v) sa[v] = 0.f;
#pragma unroll
            for (int s = 0; s < 4; ++s) sa = __builtin_amdgcn_mfma_f32_32x32x16_bf16(kf[s], loc ? qr[s] : qp[s], sa, 0, 0, 0);
            float tmax;
            if (loc) {
                const float* bp = rph + (krow0 - row + 7) * 128 + (16 * blk + 4 * h - qc + 15 + 48);
#pragma unroll
                for (int v = 0; v < 16; ++v) sa[v] += bp[(v >> 3) * 128 + (v & 3) + 8 * ((v >> 2) & 1)];
            }
            tmax = sa[0];
#pragma unroll
            for (int v = 1; v < 16; ++v) tmax = fmaxf(tmax, sa[v]);
            tmax = fmaxf(tmax, __shfl_xor(tmax, 32));
            const float mn = fmaxf(m, tmax), alpha = __builtin_amdgcn_exp2f(m - mn);
            m = mn;
            float ps = 0.f;
            const int w0 = 16 * blk + 4 * h - cs;
#pragma unroll
            for (int v = 0; v < 16; ++v) {
                float e = __builtin_amdgcn_exp2f(sa[v] - mn);
                if (loc) e = ((unsigned)(w0 + (v & 3) + 8 * ((v >> 2) & 1)) < 16u) ? e : 0.f;
                sa[v] = e; ps += e;
            }
            lsum = lsum * alpha + ps;
#pragma unroll
            for (int v = 0; v < 16; ++v) { o0[v] *= alpha; o1[v] *= alpha; }
            bf16x8 pf[2];
#pragma unroll
            for (int kk = 0; kk < 2; ++kk) {
                const unsigned w0_ = cvt_pk_bf16(sa[8 * kk + 0], sa[8 * kk + 1]), w1_ = cvt_pk_bf16(sa[8 * kk + 2], sa[8 * kk + 3]);
                const unsigned w2_ = cvt_pk_bf16(sa[8 * kk + 4], sa[8 * kk + 5]), w3_ = cvt_pk_bf16(sa[8 * kk + 6], sa[8 * kk + 7]);
                const uint4 w = make_uint4(w0_, w1_, w2_, w3_);
                pf[kk] = __builtin_bit_cast(bf16x8, w);
            }
#pragma unroll
            for (int kk = 0; kk < 2; ++kk) {
                bf16x8 a0, a1;
#pragma unroll
                for (int j = 0; j < 4; ++j) { a0[j] = va[0][kk][0][j]; a0[4 + j] = va[0][kk][1][j]; a1[j] = va[1][kk][0][j]; a1[4 + j] = va[1][kk][1][j]; }
                o0 = __builtin_amdgcn_mfma_f32_32x32x16_bf16(a0, pf[kk], o0, 0, 0, 0);
                o1 = __builtin_amdgcn_mfma_f32_32x32x16_bf16(a1, pf[kk], o1, 0, 0, 0);
            }
        }
        lsum += __shfl_xor(lsum, 32);
        const float inv = 1.f / lsum;
        float* op = p.na + (size_t)((bh / NH) * SEQ + nq) * DNA + hh * HD + 4 * h;
#pragma unroll
        for (int q = 0; q < 4; ++q) {
            *(float4*)(op + 8 * q) = make_float4(o0[4 * q] * inv, o0[4 * q + 1] * inv, o0[4 * q + 2] * inv, o0[4 * q + 3] * inv);
            *(float4*)(op + 32 + 8 * q) = make_float4(o1[4 * q] * inv, o1[4 * q + 1] * inv, o1[4 * q + 2] * inv, o1[4 * q + 3] * inv);
        }
    }
}

__device__ void ph_a2rows(const Params& p, float* lds) {
    const int tid = threadIdx.x, wv = tid >> 6, lane = tid & 63;
    const int nw = gridDim.x * (NT / 64), gw = blockIdx.x * (NT / 64) + wv;
    for (int tok = gw; tok < NTOK; tok += nw) {
        float4 v[3]; float ss = 0.f;
#pragma unroll
        for (int i = 0; i < 3; ++i) { v[i] = *(const float4*)(p.na + (size_t)tok * DNA + 4 * lane + 256 * i); ss += v[i].x * v[i].x + v[i].y * v[i].y + v[i].z * v[i].z + v[i].w * v[i].w; }
        ss = wave_sum(ss);
        const float rn = rsqrtf(ss / (float)DNA + EPS);
#pragma unroll
        for (int i = 0; i < 3; ++i) { const float4 g = *(const float4*)(p.g_out + DF + 4 * lane + 256 * i);
            uint2 w; w.x = cvt_pk_bf16(v[i].x * rn * g.x, v[i].y * rn * g.y); w.y = cvt_pk_bf16(v[i].z * rn * g.z, v[i].w * rn * g.w);
            *(uint2*)(p.A2b + (size_t)tok * D + DF + 4 * lane + 256 * i) = w; }
    }
}

__device__ void ph_outproj(const Params& p, float* ldsf) {
    LAS unsigned char* lds = (LAS unsigned char*)ldsf;
    int tid = threadIdx.x; asm volatile("" : "+v"(tid));
    const int lane = tid & 63, wid = tid >> 6, wr = wid >> 2, wc = wid & 3, r = lane & 31, h = lane >> 5;
    const int srow = tid >> 3, sc = SCS(tid);
    for (int u = blockIdx.x; u < (NTOK / 256) * (D / 256); u += gridDim.x) {
        const int pm = u >> 2, pn = u & 3;
        unsigned po[4], qo[4];
#pragma unroll
        for (int i = 0; i < 4; ++i) { const int rt = srow + 64 * i; po[i] = (unsigned)(pm * 256 + rt) * (unsigned)(D * 2) + sc * 16; qo[i] = (unsigned)(pn * 256 + rt) * (unsigned)(D * 2) + sc * 16; }
        f32x16 acc[4][2];
        gemm256(lds, tid, (const char*)p.A2b, po, (const char*)p.WoutT, qo, D / 64, acc);
        const float* gt1 = p.mod + (pm >> 5) * NMOD * D + 2 * D;
        int opq = 0; asm volatile("" : "+v"(opq));
        const int r_ = r + opq, h_ = h + opq;
#pragma unroll
        for (int j = 0; j < 2; ++j) {
            const int feat = pn * 256 + wc * 64 + j * 32 + r_; const float g = gt1[feat];
#pragma unroll
            for (int i = 0; i < 4; ++i) {
                const unsigned base = (unsigned)((pm * 256 + wr * 128 + i * 32 + 4 * h_) * D + feat);
                const float* xp = p.x + base; float* op = p.x1 + base;
#pragma unroll
                for (int hf = 0; hf < 2; ++hf) {
                    float xv[8];
#pragma unroll
                    for (int v = 0; v < 8; ++v) xv[v] = xp[((v & 3) + 8 * (v >> 2) + 16 * hf) * D];
#pragma unroll
                    for (int v = 0; v < 8; ++v) op[((v & 3) + 8 * (v >> 2) + 16 * hf) * D] = xv[v] + g * acc[i][j][8 * hf + v];
                    asm volatile("" ::: "memory");
                }
            }
        }
    }
}

__device__ void ph_router(const Params& p, float* lds) {
    const int tid = threadIdx.x, wv = tid >> 6, lane = tid & 63;
    const int nw = gridDim.x * (NT / 64), gw = blockIdx.x * (NT / 64) + wv;
    for (int tok = gw; tok < NTOK; tok += nw) {
        const int b = tok / SEQ;
        const float* sh = p.mod + b * NMOD * D + 3 * D, * sc = sh + D;
        float hv[16]; float ss = 0.f;
#pragma unroll
        for (int i = 0; i < 16; ++i) { hv[i] = p.x1[(size_t)tok * D + lane + 64 * i]; ss = fmaf(hv[i], hv[i], ss); }
        ss = wave_sum(ss);
        const float r = rsqrtf(ss / (float)D + EPS);
#pragma unroll
        for (int i = 0; i < 16; ++i) { const int e = lane + 64 * i; hv[i] = hv[i] * r * p.g_norm2[e] * (1.f + sc[e]) + sh[e]; p.h2b[(size_t)tok * D + e] = f2bf(hv[i]); }
        float lg[4];
#pragma unroll
        for (int o = 0; o < 4; ++o) { float a = 0.f;
#pragma unroll
            for (int i = 0; i < 16; ++i) a = fmaf(hv[i], p.w_rg[(size_t)(lane + 64 * i) * 4 + o], a);
            lg[o] = wave_sum(a); }
        int gs = 0; float gm = lg[0];
#pragma unroll
        for (int o = 1; o < 4; ++o) if (lg[o] > gm) { gm = lg[o]; gs = o; }
        float gz = 0.f;
#pragma unroll
        for (int o = 0; o < 4; ++o) gz += expf(lg[o] - gm);
        const float pg = 1.f / gz;
        float le[8];
#pragma unroll
        for (int o = 0; o < 8; ++o) { float a = 0.f;
#pragma unroll
            for (int i = 0; i < 16; ++i) a = fmaf(hv[i], p.w_re[(size_t)(lane + 64 * i) * NEXP + gs * 8 + o], a);
            le[o] = wave_sum(a); }
        int i0 = 0; float m0 = le[0];
#pragma unroll
        for (int o = 1; o < 8; ++o) if (le[o] > m0) { m0 = le[o]; i0 = o; }
        int i1 = -1; float m1 = -3.0e38f;
#pragma unroll
        for (int o = 0; o < 8; ++o) if (o != i0 && le[o] > m1) { m1 = le[o]; i1 = o; }
        const float e1 = expf(m1 - m0);
        const float g0 = pg / (1.f + e1), g1 = pg * e1 / (1.f + e1);
        if (lane == 0) {
            const int ea = gs * 8 + i0, eb = gs * 8 + i1;
            const int sa = atomicAdd(&p.cnt[ea], 1); p.list[ea * NTOK + sa] = tok * 2;
            const int sb = atomicAdd(&p.cnt[eb], 1); p.list[eb * NTOK + sb] = tok * 2 + 1;
            p.tokgate[tok * 2] = g0; p.tokgate[tok * 2 + 1] = g1;
        }
    }
}

struct ETile { int e, s0, ns, sbase; };
__device__ __forceinline__ int moe_ntiles(const Params& p) { int t = 0; for (int e = 0; e < NEXP; ++e) t += (p.cnt[e] + 255) >> 8; return t; }
__device__ __forceinline__ ETile moe_tile(const Params& p, int tile) {
    int e = 0, base = 0, sb = 0;
    for (;;) { const int c = p.cnt[e], nc = (c + 255) >> 8; if (tile < base + nc) break; base += nc; sb += c; ++e; }
    ETile t; t.e = e; t.s0 = (tile - base) * 256; t.ns = min(256, p.cnt[e] - t.s0); t.sbase = sb; return t;
}

__device__ void ph_moe_gu(const Params& p, float* ldsf) {
    LAS unsigned char* lds = (LAS unsigned char*)ldsf;
    int tid = threadIdx.x; asm volatile("" : "+v"(tid));
    const int lane = tid & 63, wid = tid >> 6, wr = wid >> 2, wc = wid & 3, r = lane & 31, h = lane >> 5;
    const int srow = tid >> 3, sc = SCS(tid);
    const int nunits = moe_ntiles(p) * 4;
    for (int u = blockIdx.x; u < nunits; u += gridDim.x) {
        const ETile t = moe_tile(p, u >> 2); const int fc = u & 3;
        unsigned po[4], qo[4];
#pragma unroll
        for (int i = 0; i < 4; ++i) {
            const int rt = srow + 64 * i;
            const int ent = rt < t.ns ? p.list[t.e * NTOK + t.s0 + rt] : 0;
            po[i] = (unsigned)(ent >> 1) * (unsigned)(D * 2) + sc * 16;
            const int f = fc * 128 + (rt >> 6) * 32 + (rt & 31), up = (rt >> 5) & 1;
            qo[i] = (unsigned)((up * NEXP + t.e) * DEXP + f) * (unsigned)(D * 2) + sc * 16;
        }
        f32x16 acc[4][2];
        gemm256(lds, tid, (const char*)p.h2b, po, (const char*)p.WgT, qo, D / 64, acc);
        int opq = 0; asm volatile("" : "+v"(opq));
        const int r_ = r + opq, h_ = h + opq;
        const int f = fc * 128 + wc * 32 + r_;
#pragma unroll
        for (int i = 0; i < 4; ++i) {
            const int s = wr * 128 + i * 32 + 4 * h_;
#pragma unroll
            for (int v = 0; v < 16; ++v) {
                const int sv = s + (v & 3) + 8 * (v >> 2);
                const float g = acc[i][0][v], uu = acc[i][1][v];
                if (sv < t.ns) p.act[(unsigned)((t.sbase + t.s0 + sv) * DEXP + f)] = f2bf(g / (1.f + __expf(-g)) * uu);
            }
            asm volatile("" ::: "memory");
        }
    }
}

__device__ void ph_moe_down(const Params& p, float* ldsf) {
    LAS unsigned char* lds = (LAS unsigned char*)ldsf;
    int tid = threadIdx.x; asm volatile("" : "+v"(tid));
    const int lane = tid & 63, wid = tid >> 6, wr = wid >> 2, wc = wid & 3, r = lane & 31, h = lane >> 5;
    const int srow = tid >> 3, sc = SCS(tid);
    const int nunits = moe_ntiles(p) * 4;
    for (int u = blockIdx.x; u < nunits; u += gridDim.x) {
        const ETile t = moe_tile(p, u >> 2); const int pn = u & 3;
        unsigned po[4], qo[4];
#pragma unroll
        for (int i = 0; i < 4; ++i) {
            const int rt = srow + 64 * i;
            po[i] = (unsigned)(t.sbase + t.s0 + (rt < t.ns ? rt : 0)) * (unsigned)(DEXP * 2) + sc * 16;
            qo[i] = (unsigned)(t.e * D + pn * 256 + rt) * (unsigned)(DEXP * 2) + sc * 16;
        }
        f32x16 acc[4][2];
        gemm256(lds, tid, (const char*)p.act, po, (const char*)p.WdT, qo, DEXP / 64, acc);
        int opq = 0; asm volatile("" : "+v"(opq));
        const int r_ = r + opq, h_ = h + opq;
#pragma unroll
        for (int i = 0; i < 4; ++i) {
            const int s = wr * 128 + i * 32 + 4 * h_;
#pragma unroll
            for (int v = 0; v < 16; ++v) {
                const int sv = s + (v & 3) + 8 * (v >> 2);
                if (sv < t.ns) {
                    const int ent = p.list[t.e * NTOK + t.s0 + sv]; const float g = p.tokgate[ent];
                    const unsigned base = (unsigned)ent * D + pn * 256 + wc * 64 + r_;
                    p.ybuf[base] = f2bf(g * acc[i][0][v]); p.ybuf[base + 32] = f2bf(g * acc[i][1][v]);
                }
            }
            asm volatile("" ::: "memory");
        }
    }
}

__device__ void ph_final(const Params& p, float* lds) {
    const int tid = threadIdx.x;
    for (int tok = blockIdx.x; tok < NTOK; tok += gridDim.x) {
        const float* gt2 = p.mod + (tok / SEQ) * NMOD * D + 5 * D;
        const unsigned ya = *(const unsigned*)(p.ybuf + (size_t)(2 * tok) * D + 2 * tid), yb = *(const unsigned*)(p.ybuf + (size_t)(2 * tok + 1) * D + 2 * tid);
        const float2 xv = *(const float2*)(p.x1 + (size_t)tok * D + 2 * tid);
        const float m0 = __uint_as_float(ya << 16) + __uint_as_float(yb << 16), m1 = __uint_as_float(ya & 0xffff0000u) + __uint_as_float(yb & 0xffff0000u);
        const float v0 = xv.x + gt2[2 * tid] * m0, v1 = xv.y + gt2[2 * tid + 1] * m1;
        const float ss = block_sum(v0 * v0 + v1 * v1, lds);
        const float rr = rsqrtf(ss / (float)D + EPS);
        *(float2*)(p.out + (size_t)tok * D + 2 * tid) = make_float2(v0 * rr * p.g_final[2 * tid], v1 * rr * p.g_final[2 * tid + 1]);
    }
}

extern __shared__ __attribute__((aligned(16))) float smem[];

__global__ void __launch_bounds__(NT) mega(Params p) {
    cg::grid_group grid = cg::this_grid();
    ph_adaln_tables(p, smem); grid.sync();
    ph_hrows(p, smem); grid.sync();
    ph_inproj(p, smem); grid.sync();
    ph_four1(p, smem); grid.sync();
    ph_four2(p, smem); grid.sync();
    ph_attn(p, smem); grid.sync();
    ph_fmix(p, smem); ph_a2rows(p, smem); grid.sync();
    ph_outproj(p, smem); grid.sync();
    ph_router(p, smem); grid.sync();
    ph_moe_gu(p, smem); grid.sync();
    ph_moe_down(p, smem); grid.sync();
    ph_final(p, smem);
}

extern "C" void kernel_launch(void* const* d_in, const int* in_sizes, int n_in, void* d_out, int out_size, void* d_ws, size_t ws_size, hipStream_t stream) {
    constexpr size_t kDynLds = 128 * 1024 + 1024;
    static int grid_blocks = 0;
    if (!grid_blocks) {
        int dev = 0, cus = 0, per_cu = 0;
        (void)hipGetDevice(&dev);
        (void)hipDeviceGetAttribute(&cus, hipDeviceAttributeMultiprocessorCount, dev);
        (void)hipFuncSetAttribute((const void*)mega, hipFuncAttributeMaxDynamicSharedMemorySize, (int)kDynLds);
        (void)hipOccupancyMaxActiveBlocksPerMultiprocessor(&per_cu, (const void*)mega, NT, kDynLds);
        if (per_cu > 1) per_cu = 1;
        grid_blocks = cus * per_cu;
    }
    Params p{};
    p.x = (const float*)d_in[0]; p.c = (const float*)d_in[1]; p.ctx = (const float*)d_in[2]; p.c_ctx = (const float*)d_in[3];
    p.w_ada = (const float*)d_in[4]; p.b_ada = (const float*)d_in[5]; p.g_norm1 = (const float*)d_in[6]; p.w_in = (const float*)d_in[7];
    p.w_fmix = (const float*)d_in[8]; p.rpb = (const float*)d_in[9]; p.g_out = (const float*)d_in[10]; p.w_out = (const float*)d_in[11];
    p.g_norm2 = (const float*)d_in[12]; p.w_rg = (const float*)d_in[13]; p.w_re = (const float*)d_in[14]; p.w_gate = (const float*)d_in[15];
    p.w_up = (const float*)d_in[16]; p.w_down = (const float*)d_in[17]; p.g_final = (const float*)d_in[18];
    p.out = (float*)d_out;
    char* w = (char*)d_ws; size_t o = 0;
    auto take = [&](size_t bytes) { char* r = w + o; o += (bytes + 255) & ~(size_t)255; return r; };
    p.mod = (float*)take(3 * NMOD * D * 4); p.cosN = (float*)take(SEQ * 4); p.sinN = (float*)take(SEQ * 4); p.ropeR = (float*)take(GROWS * 32 * 4); p.ropeC = (float*)take(GW * 32 * 4);
    p.cnt = (int*)take(256); p.list = (int*)take((size_t)NEXP * NTOK * 4); p.tokgate = (float*)take(2 * NTOK * 4);
    p.WinT = (bf16_t*)take((size_t)DIN * D * 2); p.WoutT = (bf16_t*)take((size_t)D * D * 2);
    p.W64cs = (bf16_t*)take(256 * 64 * 2); p.G128 = (bf16_t*)take(256 * 256 * 2); p.WmixT = (bf16_t*)take(256 * 512 * 2);
    p.WgT = (bf16_t*)take((size_t)NEXP * DEXP * D * 2); p.WuT = (bf16_t*)take((size_t)NEXP * DEXP * D * 2); p.WdT = (bf16_t*)take((size_t)NEXP * DEXP * D * 2);
    char* R1 = take((size_t)NTOK * D * 4 + 256);
    p.hb = (bf16_t*)R1; p.Zb = (bf16_t*)R1; p.na = (float*)R1; p.P2 = (bf16_t*)(R1 + (size_t)NTOK * DNA * 4); p.h2b = (bf16_t*)R1; p.act = p.h2b + (size_t)NTOK * D;
    const size_t qkv = (size_t)NTOK * DNA * 2;
    char* R2 = take((size_t)NTOK * DF * 2 + 4 * qkv + 2 * (size_t)NCTX * DNA * 2 + 4096);
    p.fX = (bf16_t*)R2; p.Qr = (bf16_t*)(R2 + (size_t)NTOK * DF * 2); p.Qp = p.Qr + (size_t)NTOK * DNA; p.Kr = p.Qp + (size_t)NTOK * DNA; p.Vt = p.Kr + (size_t)NTOK * DNA;
    p.Kc = p.Vt + (size_t)NTOK * DNA; p.Vct = p.Kc + (size_t)NCTX * DNA;
    p.A2b = (bf16_t*)R2; p.x1 = (float*)(R2 + (size_t)NTOK * DF * 2 + 4 * qkv + 2 * (size_t)NCTX * DNA * 2 - (size_t)NTOK * D * 4);
    p.ybuf = (bf16_t*)p.out;
    void* args[] = {&p};
    hipError_t e = hipLaunchCooperativeKernel((const void*)mega, dim3(grid_blocks), dim3(NT), args, kDynLds, stream);
    if (e != hipSuccess) fprintf(stderr, "cooperative launch failed: %s (grid %d)\n", hipGetErrorString(e), grid_blocks);
}
```

```cpp
#include <hip/hip_runtime.h>
#include <cstdio>
#include <cstdint>

constexpr int D = 1024, NBATCH = 2, SEQ = 8192, NTOK = NBATCH * SEQ, LCTX = 256, NCTX = NBATCH * LCTX, NROWS = NTOK + NCTX;
constexpr int DIN = 2560, DF = 256, NH = 12, HD = 64, DNA = 768, QOFF = 256, KOFF = 1024, VOFF = 1792;
constexpr int GW = 64, GROWS = 128, NEXP = 32, DEXP = 512, NMOD = 6;
constexpr float EPS = 1e-6f;
constexpr int NT = 512;
constexpr float QSCALE = 0.125f * 1.4426950408889634f;
typedef unsigned short bf16_t;
typedef short bf16x8 __attribute__((ext_vector_type(8)));
typedef float f32x16 __attribute__((ext_vector_type(16)));
typedef float f32x4 __attribute__((ext_vector_type(4)));
__device__ __forceinline__ unsigned cvt_pk_bf16(float lo, float hi) { unsigned r; asm volatile("v_cvt_pk_bf16_f32 %0, %1, %2" : "=v"(r) : "v"(lo), "v"(hi)); return r; }
__device__ __forceinline__ bf16_t f2bf(float v) { return (bf16_t)(cvt_pk_bf16(v, 0.f) & 0xffffu); }
__device__ __forceinline__ float bf2f(bf16_t v) { return __uint_as_float((unsigned)v << 16); }

struct Params {
    const float *x, *c, *ctx, *c_ctx, *w_ada, *b_ada, *g_norm1, *w_in, *w_fmix, *rpb, *g_out, *w_out, *g_norm2, *w_rg, *w_re, *w_gate, *w_up, *w_down, *g_final;
    float* out;
    float *mod, *cosN, *sinN, *ropeR, *ropeC;
    float *na;
    float *x1;
    int *cnt, *list; float* tokgate; unsigned* bar;
    bf16_t *WinT, *WoutT, *WgT, *WuT, *WdT;
    bf16_t *hb, *A2b;
    bf16_t *h2b, *act, *ybuf;
    bf16_t *fX, *Qr, *Qp, *Kr, *Vt, *Kc, *Vct;
    bf16_t *W64cs, *G128, *WmixT;
    bf16_t *Zb, *P2;
};

__device__ __forceinline__ float wave_sum(float v) {
#pragma unroll
    for (int o = 32; o > 0; o >>= 1) v += __shfl_xor(v, o);
    return v;
}
__device__ __forceinline__ float wave_max(float v) {
#pragma unroll
    for (int o = 32; o > 0; o >>= 1) v = fmaxf(v, __shfl_xor(v, o));
    return v;
}
__device__ __forceinline__ float block_sum(float v, float* red) {
    v = wave_sum(v);
    const int w = threadIdx.x >> 6, l = threadIdx.x & 63;
    __syncthreads();
    if (l == 0) red[w] = v;
    __syncthreads();
    float s = 0.f;
#pragma unroll
    for (int i = 0; i < NT / 64; ++i) s += red[i];
    return s;
}

template <class AF, class BF, class EF>
__device__ void ngemm(float* lds, int M, int N, int K, AF af, BF bf, EF ef) {
    float* As = lds;
    float* Bs = lds + 16 * 132;
    const int tid = threadIdx.x, ty = tid >> 4, tx = tid & 15;
    const int tn = N / 128, nt = (M / 128) * tn;
    for (int t = blockIdx.x; t < nt; t += gridDim.x) {
        const int m0 = (t / tn) * 128, n0 = (t % tn) * 128;
        float acc[4][8];
#pragma unroll
        for (int i = 0; i < 4; ++i)
#pragma unroll
            for (int j = 0; j < 8; ++j) acc[i][j] = 0.f;
        for (int k0 = 0; k0 < K; k0 += 16) {
#pragma unroll
            for (int i = 0; i < 4; ++i) { const int idx = tid + NT * i, kk = idx & 15, m = idx >> 4; As[kk * 132 + m] = af(m0 + m, k0 + kk); }
#pragma unroll
            for (int i = 0; i < 4; ++i) { const int idx = tid + NT * i, n = idx & 127, kk = idx >> 7; Bs[kk * 128 + n] = bf(m0, k0 + kk, n0 + n); }
            __syncthreads();
#pragma unroll
            for (int kk = 0; kk < 16; ++kk) {
                const float4 a = *(const float4*)(As + kk * 132 + ty * 4);
                const float4 b0 = *(const float4*)(Bs + kk * 128 + tx * 8), b1 = *(const float4*)(Bs + kk * 128 + tx * 8 + 4);
                const float av[4] = {a.x, a.y, a.z, a.w}, bv[8] = {b0.x, b0.y, b0.z, b0.w, b1.x, b1.y, b1.z, b1.w};
#pragma unroll
                for (int i = 0; i < 4; ++i)
#pragma unroll
                    for (int j = 0; j < 8; ++j) acc[i][j] = fmaf(av[i], bv[j], acc[i][j]);
            }
            __syncthreads();
        }
#pragma unroll
        for (int i = 0; i < 4; ++i)
#pragma unroll
            for (int j = 0; j < 8; ++j) ef(m0 + ty * 4 + i, n0 + tx * 8 + j, acc[i][j]);
    }
}

#define LAS __attribute__((address_space(3)))
#define SCS(tid) (((tid) & 7) ^ ((((tid) >> 3) >> 1) & 7))
__device__ __forceinline__ void gemm256(LAS unsigned char* lds, const int tid, const char* Pb, const unsigned (&po)[4], const char* Qb, const unsigned (&qo)[4], int nk, f32x16 (&acc)[4][2]) {
    const int lane = tid & 63, wid = __builtin_amdgcn_readfirstlane(tid >> 6), wr = wid >> 2, wc = wid & 3;
    const int r = lane & 31, h = lane >> 5, swz = (r >> 1) & 7;
    const unsigned ldsw = (unsigned)wid * 1024u;
#pragma unroll
    for (int i = 0; i < 4; ++i)
#pragma unroll
        for (int j = 0; j < 2; ++j)
#pragma unroll
            for (int v = 0; v < 16; ++v) acc[i][j][v] = 0.f;
    __syncthreads();
#pragma unroll
    for (int i = 0; i < 4; ++i) {
        __builtin_amdgcn_global_load_lds((const unsigned*)(Pb + po[i]), (LAS unsigned*)(lds + ldsw + i * 8192), 16, 0, 0);
        __builtin_amdgcn_global_load_lds((const unsigned*)(Qb + qo[i]), (LAS unsigned*)(lds + 32768 + ldsw + i * 8192), 16, 0, 0);
    }
    __syncthreads();
    const int prd = (wr * 128 + r) * 128, qrd = 32768 + (wc * 64 + r) * 128;
    const int ko0 = ((0 + h) ^ swz) << 4, ko1 = ((2 + h) ^ swz) << 4, ko2 = ((4 + h) ^ swz) << 4, ko3 = ((6 + h) ^ swz) << 4;
#define G256_LD(pf, qf, ko) do { _Pragma("unroll") for (int i = 0; i < 4; ++i) pf[i] = *(const LAS bf16x8*)(lds + cb + prd + i * 4096 + (ko)); \
                                 _Pragma("unroll") for (int j = 0; j < 2; ++j) qf[j] = *(const LAS bf16x8*)(lds + cb + qrd + j * 4096 + (ko)); } while (0)
#define G256_MM(pf, qf) do { _Pragma("unroll") for (int i = 0; i < 4; ++i) _Pragma("unroll") for (int j = 0; j < 2; ++j) \
                                 acc[i][j] = __builtin_amdgcn_mfma_f32_32x32x16_bf16(pf[i], qf[j], acc[i][j], 0, 0, 0); } while (0)
#pragma unroll 1
    for (int kt = 0; kt < nk; ++kt) {
        const int cb = (kt & 1) * 65536, nb = 65536 - cb;
        {
            const unsigned koff = (unsigned)min(kt + 1, nk - 1) * 128u;
#pragma unroll
            for (int i = 0; i < 4; ++i) {
                __builtin_amdgcn_global_load_lds((const unsigned*)(Pb + (size_t)(po[i] + koff)), (LAS unsigned*)(lds + nb + ldsw + i * 8192), 16, 0, 0);
                __builtin_amdgcn_global_load_lds((const unsigned*)(Qb + (size_t)(qo[i] + koff)), (LAS unsigned*)(lds + nb + 32768 + ldsw + i * 8192), 16, 0, 0);
            }
        }
        bf16x8 pa[4], qa[2], pb[4], qb[2];
        G256_LD(pa, qa, ko0);
        G256_LD(pb, qb, ko1);
        G256_MM(pa, qa);
        G256_LD(pa, qa, ko2);
        G256_MM(pb, qb);
        G256_LD(pb, qb, ko3);
        G256_MM(pa, qa);
        G256_MM(pb, qb);
        __syncthreads();
    }
    asm volatile("" ::: "memory");
}

#define XB_TMO      128
#define XB_XCNT(j)  (256  + 64 * (j))
#define XB_XSUB(j)  (1280 + 64 * (j))
#define XB_XGEN(j)  (2304 + 64 * (j))
#define XB_TOP      3328
#define XB_TOPGEN   3392
#define XCD_BAR_WORDS 3456
#define XB_SPIN_CAP (1u << 18)
__device__ __forceinline__ unsigned xb_ld(unsigned* p)              { return __hip_atomic_load(p, __ATOMIC_RELAXED, __HIP_MEMORY_SCOPE_AGENT); }
__device__ __forceinline__ unsigned xb_add(unsigned* p, unsigned v) { return __hip_atomic_fetch_add(p, v, __ATOMIC_RELAXED, __HIP_MEMORY_SCOPE_AGENT); }
__device__ __forceinline__ unsigned xb_xcc_id() { return (unsigned)__builtin_amdgcn_s_getreg((3 << 11) | 20) & 0xFu; }
#define XB_SPIN(cond, bar) do { unsigned _sp = 0; while (cond) { __builtin_amdgcn_s_sleep(1); \
    if ((++_sp & 255u) == 0u) { if (xb_ld(&(bar)[XB_TMO])) break; if (_sp > XB_SPIN_CAP) { atomicAdd(&(bar)[XB_TMO], 1u); break; } } } } while (0)
struct XcdBarrier { unsigned* bar; unsigned x; volatile LAS unsigned* st; };
__device__ __forceinline__ XcdBarrier xcd_barrier_post(unsigned* bar, volatile LAS unsigned* st) {
    XcdBarrier b; b.bar = bar; b.x = xb_xcc_id(); b.st = st;
    if (threadIdx.x == 0) (void)xb_add(&bar[XB_XCNT(b.x)], 1u);
    return b;
}
__device__ __forceinline__ void xcd_barrier_complete(unsigned* bar, unsigned x, unsigned& nloc, unsigned& nx) {
    const unsigned G = gridDim.x * gridDim.y * gridDim.z;
    unsigned sum, cnt, mine, sp = 0u;
    for (;;) {
        sum = 0u; cnt = 0u; mine = 0u;
#pragma unroll
        for (unsigned j = 0; j < 16; ++j) { const unsigned c = xb_ld(&bar[XB_XCNT(j)]); sum += c; cnt += (c > 0u) ? 1u : 0u; mine = (j == x) ? c : mine; }
        if (sum == G) break;
        __builtin_amdgcn_s_sleep(1);
        if ((++sp & 255u) == 0u) { if (xb_ld(&bar[XB_TMO])) break; if (sp > XB_SPIN_CAP) { atomicAdd(&bar[XB_TMO], 1u); break; } }
    }
    nloc = mine > 0u ? mine : 1u; nx = cnt > 0u ? cnt : 1u;
}
__device__ __forceinline__ void xcd_barrier(const XcdBarrier& b) {
    asm volatile("s_waitcnt vmcnt(0)" ::: "memory");
    __syncthreads();
    if (threadIdx.x == 0) {
        unsigned* bar = b.bar;
        __builtin_amdgcn_s_waitcnt(0);
        unsigned nloc = b.st[0], nx = b.st[1];
        if (nloc == 0u) { xcd_barrier_complete(bar, b.x, nloc, nx); b.st[0] = nloc; b.st[1] = nx; }
        const unsigned old = xb_add(&bar[XB_XSUB(b.x)], 1u);
        const unsigned gen = old / nloc;
        if (old + 1u == (gen + 1u) * nloc) {
            __builtin_amdgcn_fence(__ATOMIC_RELEASE, "agent");
            asm volatile("s_waitcnt vmcnt(0)" ::: "memory");
            const unsigned og = xb_add(&bar[XB_TOP], 1u);
            const unsigned tg = og / nx;
            if (og + 1u == (tg + 1u) * nx) xb_add(&bar[XB_TOPGEN], 1u);
            else XB_SPIN(xb_ld(&bar[XB_TOPGEN]) == tg, bar);
            __builtin_amdgcn_fence(__ATOMIC_ACQUIRE, "agent");
            xb_add(&bar[XB_XGEN(b.x)], 1u);
            asm volatile("s_waitcnt vmcnt(0)" ::: "memory");
        } else {
            XB_SPIN(xb_ld(&bar[XB_XGEN(b.x)]) == gen, bar);
            __builtin_amdgcn_fence(__ATOMIC_ACQUIRE, "agent");
            asm volatile("s_waitcnt vmcnt(0)" ::: "memory");
        }
    }
    __syncthreads();
}

__device__ void transpose_job(float* lds, const float* src, bf16_t* dst, int R, int C, int batch, int& tbase, int gstride, int& next) {
    const int tid = threadIdx.x;
    const int tr = R / 64, tc = C / 64, ntile = batch * tr * tc;
    while (next < tbase + ntile) {
        const int t = next - tbase; next += gstride;
        const int bb = t / (tr * tc), rem = t % (tr * tc), r0 = (rem / tc) * 64, c0 = (rem % tc) * 64;
        const float* s = src + (size_t)bb * R * C; bf16_t* d = dst + (size_t)bb * R * C;
        __syncthreads();
#pragma unroll
        for (int i = 0; i < 8; ++i) { const int rr = (tid >> 6) + 8 * i, cc = tid & 63; lds[rr * 65 + cc] = s[(size_t)(r0 + rr) * C + c0 + cc]; }
        __syncthreads();
#pragma unroll
        for (int i = 0; i < 4; ++i) { const int cc = (tid >> 5) + 16 * i, r2 = (tid & 31) * 2;
            *(unsigned*)(d + (size_t)(c0 + cc) * R + r0 + r2) = cvt_pk_bf16(lds[r2 * 65 + cc], lds[(r2 + 1) * 65 + cc]); }
    }
    tbase += ntile;
}

__device__ void ph_adaln_tables(const Params& p, float* lds) {
    const int tid = threadIdx.x, gid = blockIdx.x * NT + tid, gsz = gridDim.x * NT;
    for (int i = tid; i < 3 * D; i += NT) { const int r = i / D, k = i % D; const float v = r < 2 ? p.c[r * D + k] : p.c_ctx[k]; lds[i] = v / (1.f + expf(-v)); }
    __syncthreads();
    if (gid < NMOD * D) {
        float a0 = 0.f, a1 = 0.f, a2 = 0.f;
        for (int k = 0; k < D; ++k) { const float w = p.w_ada[(size_t)k * (NMOD * D) + gid]; a0 = fmaf(lds[k], w, a0); a1 = fmaf(lds[D + k], w, a1); a2 = fmaf(lds[2 * D + k], w, a2); }
        const float b = p.b_ada[gid];
        p.mod[gid] = a0 + b; p.mod[NMOD * D + gid] = a1 + b; p.mod[2 * NMOD * D + gid] = a2 + b;
    }
    for (int i = gid; i < SEQ; i += gsz) { p.cosN[i] = cospif(2.f * (float)i / (float)SEQ); p.sinN[i] = sinpif(2.f * (float)i / (float)SEQ); }
    for (int i = gid; i < (GROWS + GW) * 16; i += gsz) {
        const int pos = i / 16, f = i % 16; const float inv = powf(10000.f, -(float)f / 16.f);
        if (pos < GROWS) { const float a = (float)pos * inv; p.ropeR[2 * i] = cosf(a); p.ropeR[2 * i + 1] = sinf(a); }
        else { const int pc = pos - GROWS; const float a = (float)pc * inv; p.ropeC[2 * (pc * 16 + f)] = cosf(a); p.ropeC[2 * (pc * 16 + f) + 1] = sinf(a); }
    }
    if (gid < NEXP) p.cnt[gid] = 0;
    for (int i = gid; i < 256 * 64; i += gsz) {
        const int rho = i >> 6, n1 = i & 63, blk = rho >> 5, k1 = (blk >> 1) * 32 + (rho & 31);
        float v = 0.f;
        if (blk < 4) { const float a = 2.f * (float)((k1 * n1) & 63) / 64.f; v = (blk & 1) ? -sinpif(a) : cospif(a); }
        p.W64cs[i] = f2bf(v);
    }
    for (int i = gid; i < 256 * 256; i += gsz) {
        const int rho = i >> 8, kap = i & 255, ro = rho >> 7, k2 = rho & 127, ri = kap >> 7, n2 = kap & 127;
        const float a = 2.f * (float)((k2 * n2) & 127) / 128.f; const float c = cospif(a), s = sinpif(a);
        p.G128[i] = f2bf(ro == ri ? c : (ro == 0 ? s : -s));
    }
    for (int i = gid; i < 256 * 512; i += gsz) {
        const int j = i >> 9, kap = i & 511, ro = kap >> 8, ch = kap & 255, g = ch >> 6, c = ch & 63;
        float acc = 0.f;
        for (int l = 0; l < 64; ++l) { const float a = 2.f * (float)((l * c) & 63) / 64.f; acc = fmaf(ro ? sinpif(a) : cospif(a), p.w_fmix[(size_t)(64 * g + l) * DF + j], acc); }
        p.WmixT[i] = f2bf(acc * (1.0f / 724.0773439350247f));
    }
    __syncthreads();
    int tbase = 0, next = blockIdx.x;
    transpose_job(lds, p.w_in, p.WinT, D, DIN, 1, tbase, gridDim.x, next);
    transpose_job(lds, p.w_out, p.WoutT, D, D, 1, tbase, gridDim.x, next);
    transpose_job(lds, p.w_gate, p.WgT, D, DEXP, NEXP, tbase, gridDim.x, next);
    transpose_job(lds, p.w_up, p.WuT, D, DEXP, NEXP, tbase, gridDim.x, next);
    transpose_job(lds, p.w_down, p.WdT, DEXP, D, NEXP, tbase, gridDim.x, next);
}

__device__ void ph_hrows(const Params& p, float* lds) {
    const int tid = threadIdx.x;
    for (int row = blockIdx.x; row < NROWS; row += gridDim.x) {
        const float* src = row < NTOK ? p.x + (size_t)row * D : p.ctx + (size_t)(row - NTOK) * D;
        const int mr = row < NTOK ? row / SEQ : 2;
        const float* sh = p.mod + mr * NMOD * D, * sc = sh + D;
        const float2 v = *(const float2*)(src + 2 * tid);
        const float ss = block_sum(v.x * v.x + v.y * v.y, lds);
        const float r = rsqrtf(ss / (float)D + EPS);
        const float o0 = v.x * r * p.g_norm1[2 * tid] * (1.f + sc[2 * tid]) + sh[2 * tid];
        const float o1 = v.y * r * p.g_norm1[2 * tid + 1] * (1.f + sc[2 * tid + 1]) + sh[2 * tid + 1];
        *(unsigned*)(p.hb + (size_t)row * D + 2 * tid) = cvt_pk_bf16(o0, o1);
    }
}

__device__ void ph_inproj(const Params& p, float* ldsf) {
    LAS unsigned char* lds = (LAS unsigned char*)ldsf;
    int tid = threadIdx.x; asm volatile("" : "+v"(tid));
    const int lane = tid & 63, wid = tid >> 6, wr = wid >> 2, wc = wid & 3, r = lane & 31, h = lane >> 5;
    const int srow = tid >> 3, sc = SCS(tid);
    constexpr int NPM = NROWS / 256, NPN = DIN / 256;
    for (int u = blockIdx.x; u < NPM * NPN; u += gridDim.x) {
        const int pm = u / NPN, pn = u % NPN;
        if (pm >= 64 && pn < 4) continue;
        unsigned po[4], qo[4];
#pragma unroll
        for (int i = 0; i < 4; ++i) {
            const int rt = srow + 64 * i;
            po[i] = (unsigned)((pn * 256 + rt) * D * 2 + sc * 16);
            int rowidx;
            if (pn == 0) rowidx = (pm >> 5) * SEQ + 128 * (rt & 63) + 4 * (pm & 31) + (rt >> 6);
            else rowidx = pm * 256 + rt;
            qo[i] = (unsigned)rowidx * (unsigned)(D * 2) + sc * 16;
        }
        f32x16 acc[4][2];
        gemm256(lds, tid, (const char*)p.WinT, po, (const char*)p.hb, qo, D / 64, acc);
        int opq = 0; asm volatile("" : "+v"(opq));
        const int r_ = r + opq, h_ = h + opq;
        if (pn == 0) {
            const int b = pm >> 5, n2 = 4 * (pm & 31) + wc;
#pragma unroll
            for (int i = 0; i < 4; ++i) {
#pragma unroll
                for (int j = 0; j < 2; ++j) {
                    const unsigned base = (unsigned)(((b * DF + wr * 128 + i * 32 + 4 * h_) * 128 + n2) * 64 + j * 32 + r_);
#pragma unroll
                    for (int v = 0; v < 16; ++v) p.fX[base + (unsigned)(((v & 3) + 8 * (v >> 2)) * 128 * 64)] = f2bf(acc[i][j][v]);
                }
                asm volatile("" ::: "memory");
            }
        } else if (pn < 7) {
            const bool isq = pn < 4; const int hg = ((pn - 1) % 3) * 4 + wr * 2;
            const bool isctx = pm >= 64;
            const int b = isctx ? pm - 64 : (pm >> 5);
#pragma unroll
            for (int j = 0; j < 2; ++j) {
                const int n = (isctx ? 0 : (pm & 31) * 256) + wc * 64 + j * 32 + r_;
                const int grow = n >> 6, gcol = n & 63;
#pragma unroll
                for (int i = 0; i < 4; ++i) {
                    const int hh = hg + (i >> 1), blk = i & 1;
                    if (isctx) {
                        const unsigned base = (unsigned)(((b * NH + hh) * LCTX + n) * HD + blk * 32 + 4 * h_);
#pragma unroll
                        for (int q = 0; q < 4; ++q) {
                            uint2 w;
                            w.x = cvt_pk_bf16(acc[i][j][4 * q], acc[i][j][4 * q + 1]); w.y = cvt_pk_bf16(acc[i][j][4 * q + 2], acc[i][j][4 * q + 3]);
                            *(uint2*)(p.Kc + base + 8 * q) = w;
                        }
                    } else {
                        const float* tb = (blk == 0 ? p.ropeR + 32 * grow : p.ropeC + 32 * gcol) + 8 * h_;
                        float o1[8], o2[8];
#pragma unroll
                        for (int v = 0; v < 8; ++v) {
                            const float2 cs = *(const float2*)(tb + 2 * ((v & 3) + 8 * (v >> 2)));
                            const float x1 = acc[i][j][v], x2 = acc[i][j][v + 8];
                            o1[v] = x1 * cs.x - x2 * cs.y; o2[v] = x1 * cs.y + x2 * cs.x;
                        }
                        const unsigned base = (unsigned)(((b * NH + hh) * SEQ + n) * HD + blk * 32 + 4 * h_);
                        if (isq) {
#pragma unroll
                            for (int q = 0; q < 2; ++q) {
                                uint2 w;
                                w.x = cvt_pk_bf16(o1[4 * q] * QSCALE, o1[4 * q + 1] * QSCALE); w.y = cvt_pk_bf16(o1[4 * q + 2] * QSCALE, o1[4 * q + 3] * QSCALE);
                                *(uint2*)(p.Qr + base + 8 * q) = w;
                                w.x = cvt_pk_bf16(o2[4 * q] * QSCALE, o2[4 * q + 1] * QSCALE); w.y = cvt_pk_bf16(o2[4 * q + 2] * QSCALE, o2[4 * q + 3] * QSCALE);
                                *(uint2*)(p.Qr + base + 16 + 8 * q) = w;
                            }
#pragma unroll
                            for (int q = 0; q < 4; ++q) {
                                uint2 w;
                                w.x = cvt_pk_bf16(acc[i][j][4 * q] * QSCALE, acc[i][j][4 * q + 1] * QSCALE); w.y = cvt_pk_bf16(acc[i][j][4 * q + 2] * QSCALE, acc[i][j][4 * q + 3] * QSCALE);
                                *(uint2*)(p.Qp + base + 8 * q) = w;
                            }
                        } else {
#pragma unroll
                            for (int q = 0; q < 2; ++q) {
                                uint2 w;
                                w.x = cvt_pk_bf16(o1[4 * q], o1[4 * q + 1]); w.y = cvt_pk_bf16(o1[4 * q + 2], o1[4 * q + 3]);
                                *(uint2*)(p.Kr + base + 8 * q) = w;
                                w.x = cvt_pk_bf16(o2[4 * q], o2[4 * q + 1]); w.y = cvt_pk_bf16(o2[4 * q + 2], o2[4 * q + 3]);
                                *(uint2*)(p.Kr + base + 16 + 8 * q) = w;
                            }
                        }
                    }
                    asm volatile("" ::: "memory");
                }
            }
        } else {
            const int hg = (pn - 7) * 4 + wr * 2;
            const bool isctx = pm >= 64;
            const int b = isctx ? pm - 64 : (pm >> 5);
            const int ld = isctx ? LCTX : SEQ; bf16_t* vb = isctx ? p.Vct : p.Vt;
#pragma unroll
            for (int j = 0; j < 2; ++j) {
                const int n = (isctx ? 0 : (pm & 31) * 256) + wc * 64 + j * 32 + r_;
#pragma unroll
                for (int i = 0; i < 4; ++i) {
                    const unsigned base = (unsigned)(((b * NH + hg + (i >> 1)) * HD + (i & 1) * 32 + 4 * h_) * ld + n);
#pragma unroll
                    for (int v = 0; v < 16; ++v) vb[base + (unsigned)(((v & 3) + 8 * (v >> 2)) * ld)] = f2bf(acc[i][j][v]);
                    asm volatile("" ::: "memory");
                }
            }
        }
    }
}

__device__ void ph_four1(const Params& p, float* ldsf) {
    LAS unsigned char* lds = (LAS unsigned char*)ldsf;
    int tid = threadIdx.x; asm volatile("" : "+v"(tid));
    const int lane = tid & 63, wid = tid >> 6, wr = wid >> 2, wc = wid & 3, r = lane & 31, h = lane >> 5;
    const int srow = tid >> 3, sc = SCS(tid);
    for (int u = blockIdx.x; u < NBATCH * DF * 128 / 256; u += gridDim.x) {
        unsigned po[4], qo[4];
#pragma unroll
        for (int i = 0; i < 4; ++i) { const int rt = srow + 64 * i; po[i] = (unsigned)rt * 128u + sc * 16; qo[i] = (unsigned)(u * 256 + rt) * 128u + sc * 16; }
        f32x16 acc[4][2];
        gemm256(lds, tid, (const char*)p.W64cs, po, (const char*)p.fX, qo, 1, acc);
        if (wr == 0) {
            int opq = 0; asm volatile("" : "+v"(opq));
            const int r_ = r + opq, h_ = h + opq;
#pragma unroll
            for (int j = 0; j < 2; ++j) {
                const int qrow = u * 256 + wc * 64 + j * 32 + r_;
                const int n2 = qrow & 127, bc = qrow >> 7;
#pragma unroll
                for (int a = 0; a < 2; ++a) {
#pragma unroll
                    for (int v = 0; v < 16; ++v) {
                        const int k1 = a * 32 + (v & 3) + 8 * (v >> 2) + 4 * h_;
                        const int idx = n2 * k1;
                        const float cs = p.cosN[idx], sn = p.sinN[idx];
                        const float yr = acc[2 * a][j][v], yi = acc[2 * a + 1][j][v];
                        const unsigned base = (unsigned)((bc * 64 + k1) * 256 + n2);
                        p.Zb[base] = f2bf(yr * cs + yi * sn); p.Zb[base + 128] = f2bf(yi * cs - yr * sn);
                    }
                    asm volatile("" ::: "memory");
                }
            }
        }
    }
}

__device__ void ph_four2(const Params& p, float* ldsf) {
    LAS unsigned char* lds = (LAS unsigned char*)ldsf;
    int tid = threadIdx.x; asm volatile("" : "+v"(tid));
    const int lane = tid & 63, wid = tid >> 6, wr = wid >> 2, wc = wid & 3, r = lane & 31, h = lane >> 5;
    const int srow = tid >> 3, sc = SCS(tid);
    for (int u = blockIdx.x; u < NBATCH * 64; u += gridDim.x) {
        const int b = u >> 6, k1 = u & 63;
        unsigned po[4], qo[4];
#pragma unroll
        for (int i = 0; i < 4; ++i) { const int rt = srow + 64 * i; po[i] = (unsigned)rt * 512u + sc * 16; qo[i] = (unsigned)(((b * DF + rt) * 64 + k1) * 512) + sc * 16; }
        f32x16 acc[4][2];
        gemm256(lds, tid, (const char*)p.G128, po, (const char*)p.Zb, qo, 4, acc);
        int opq = 0; asm volatile("" : "+v"(opq));
        const int r_ = r + opq, h_ = h + opq;
#pragma unroll
        for (int i = 0; i < 4; ++i) {
#pragma unroll
            for (int j = 0; j < 2; ++j) {
                bf16_t* dst = p.P2 + (unsigned)((b * SEQ + k1 + 64 * (i * 32 + 4 * h_)) * 512 + wr * 256 + wc * 64 + j * 32 + r_);
#pragma unroll
                for (int v = 0; v < 16; ++v) dst[((v & 3) + 8 * (v >> 2)) * 64 * 512] = f2bf(acc[i][j][v]);
                asm volatile("" ::: "memory");
            }
        }
    }
}

__device__ void ph_fmix(const Params& p, float* ldsf) {
    LAS unsigned char* lds = (LAS unsigned char*)ldsf;
    int tid = threadIdx.x; asm volatile("" : "+v"(tid));
    const int lane = tid & 63, wid = tid >> 6, wr = wid >> 2, wc = wid & 3, r = lane & 31, h = lane >> 5;
    const int srow = tid >> 3, sc = SCS(tid);
    for (int u = blockIdx.x; u < NTOK / 256; u += gridDim.x) {
        unsigned po[4], qo[4];
#pragma unroll
        for (int i = 0; i < 4; ++i) { const int rt = srow + 64 * i; po[i] = (unsigned)rt * 1024u + sc * 16; qo[i] = (unsigned)(u * 256 + rt) * 1024u + sc * 16; }
        f32x16 acc[4][2];
        gemm256(lds, tid, (const char*)p.WmixT, po, (const char*)p.P2, qo, 8, acc);
        float ss[2];
#pragma unroll
        for (int j = 0; j < 2; ++j) { float s = 0.f;
#pragma unroll
            for (int i = 0; i < 4; ++i)
#pragma unroll
                for (int v = 0; v < 16; ++v) s = fmaf(acc[i][j][v], acc[i][j][v], s);
            ss[j] = s + __shfl_xor(s, 32); }
        float* red = ldsf;
        if (h == 0) { red[wr * 256 + wc * 64 + r] = ss[0]; red[wr * 256 + wc * 64 + 32 + r] = ss[1]; }
        __syncthreads();
        int opq = 0; asm volatile("" : "+v"(opq));
        const int r_ = r + opq, h_ = h + opq;
#pragma unroll
        for (int j = 0; j < 2; ++j) {
            const int tl = wc * 64 + j * 32 + r_;
            const float rstd = rsqrtf((red[tl] + red[256 + tl]) / (float)DF + EPS);
            bf16_t* dst = p.A2b + (unsigned)((u * 256 + tl) * D + wr * 128 + 4 * h_);
            const float* gp = p.g_out + wr * 128 + 4 * h_;
#pragma unroll
            for (int i = 0; i < 4; ++i) {
#pragma unroll
                for (int q = 0; q < 4; ++q) {
                    const float4 g = *(const float4*)(gp + i * 32 + 8 * q);
                    uint2 w; w.x = cvt_pk_bf16(acc[i][j][4 * q] * rstd * g.x, acc[i][j][4 * q + 1] * rstd * g.y); w.y = cvt_pk_bf16(acc[i][j][4 * q + 2] * rstd * g.z, acc[i][j][4 * q + 3] * rstd * g.w);
                    *(uint2*)(dst + i * 32 + 8 * q) = w;
                }
                asm volatile("" ::: "memory");
            }
        }
    }
}

typedef short s16x4 __attribute__((ext_vector_type(4)));
constexpr float LOG2E = 1.4426950408889634f;
__device__ void ph_attn(const Params& p, float* ldsf) {
    int tid = threadIdx.x; asm volatile("" : "+v"(tid));
    const int lane = tid & 63, wv = tid >> 6, l31 = lane & 31, h = lane >> 5;
    __syncthreads();
    for (int i = tid; i < NH * 15 * 128; i += NT) { const int dcx = (i & 127) - 48, dr = (i >> 7) % 15, hh = i / (15 * 128);
        ldsf[i] = (dcx >= 0 && dcx <= 30) ? p.rpb[(hh * 15 + dr) * 31 + dcx] * LOG2E : 0.f; }
    __syncthreads();
    const int half = wv & 1;
    for (int g = blockIdx.x; g < NBATCH * NH * (GROWS / 4); g += gridDim.x) {
        const int bh = g / (GROWS / 4), row = (g % (GROWS / 4)) * 4 + (wv >> 1), hh = bh % NH;
        const int rs = min(max(row - 4, 0), GROWS - 8);
        const int qc = 32 * half + l31, cs = min(max(qc - 8, 0), GW - 16);
        const int nq = row * GW + qc;
        const bf16_t* Kh = p.Kr + (size_t)bh * SEQ * HD; const bf16_t* Vh = p.Vt + (size_t)bh * HD * SEQ;
        const bf16_t* Kch = p.Kc + (size_t)bh * LCTX * HD; const bf16_t* Vch = p.Vct + (size_t)bh * HD * LCTX;
        bf16x8 qr[4], qp[4];
#pragma unroll
        for (int s = 0; s < 4; ++s) { qr[s] = *(const bf16x8*)(p.Qr + ((size_t)bh * SEQ + nq) * HD + 16 * s + 8 * h); qp[s] = *(const bf16x8*)(p.Qp + ((size_t)bh * SEQ + nq) * HD + 16 * s + 8 * h); }
        f32x16 o0, o1;
#pragma unroll
        for (int v = 0; v < 16; ++v) { o0[v] = 0.f; o1[v] = 0.f; }
        float m = -1e30f, lsum = 0.f;
        const float* rph = ldsf + hh * 15 * 128;
        for (int t = 0; t < 20; ++t) {
            const bool loc = t < 12;
            const bf16_t* kptr; const bf16_t* vptr0; int vstr;
            int krow0 = 0, blk = 0;
            if (loc) { const int pr = t / 3; blk = half + (t - 3 * pr); krow0 = rs + 2 * pr;
                kptr = Kh + (size_t)((krow0 + (l31 >> 4)) * GW + 16 * blk + (l31 & 15)) * HD + 8 * h;
                vptr0 = Vh + (size_t)l31 * SEQ + krow0 * GW + 16 * blk + 4 * h; vstr = SEQ;
            } else { const int m0 = 32 * (t - 12);
                kptr = Kch + (size_t)(m0 + l31) * HD + 8 * h;
                vptr0 = Vch + (size_t)l31 * LCTX + m0 + 4 * h; vstr = LCTX; }
            const int krs = loc ? GW : 16;
            bf16x8 kf[4];
#pragma unroll
            for (int s = 0; s < 4; ++s) kf[s] = *(const bf16x8*)(kptr + 16 * s);
            s16x4 va[2][2][2];
#pragma unroll
            for (int dt = 0; dt < 2; ++dt)
#pragma unroll
                for (int kk = 0; kk < 2; ++kk)
#pragma unroll
                    for (int pt = 0; pt < 2; ++pt) va[dt][kk][pt] = *(const s16x4*)(vptr0 + (size_t)dt * 32 * vstr + kk * krs + 8 * pt);
            f32x16 sa;
#pragma unroll
            for (int v = 0; v < 16; ++v) sa[v] = 0.f;
#pragma unroll
            for (int s = 0; s < 4; ++s) sa = __builtin_amdgcn_mfma_f32_32x32x16_bf16(kf[s], loc ? qr[s] : qp[s], sa, 0, 0, 0);
            float tmax;
            if (loc) {
                const float* bp = rph + (krow0 - row + 7) * 128 + (16 * blk + 4 * h - qc + 15 + 48);
#pragma unroll
                for (int v = 0; v < 16; ++v) sa[v] += bp[(v >> 3) * 128 + (v & 3) + 8 * ((v >> 2) & 1)];
            }
            tmax = sa[0];
#pragma unroll
            for (int v = 1; v < 16; ++v) tmax = fmaxf(tmax, sa[v]);
            tmax = fmaxf(tmax, __shfl_xor(tmax, 32));
            const float mn = fmaxf(m, tmax), alpha = __builtin_amdgcn_exp2f(m - mn);
            m = mn;
            float ps = 0.f;
            const int w0 = 16 * blk + 4 * h - cs;
#pragma unroll
            for (int v = 0; v < 16; ++v) {
                float e = __builtin_amdgcn_exp2f(sa[v] - mn);
                if (loc) e = ((unsigned)(w0 + (v & 3) + 8 * ((v >> 2) & 1)) < 16u) ? e : 0.f;
                sa[v] = e; ps += e;
            }
            lsum = lsum * alpha + ps;
#pragma unroll
            for (int v = 0; v < 16; ++v) { o0[v] *= alpha; o1[v] *= alpha; }
            bf16x8 pf[2];
#pragma unroll
            for (int kk = 0; kk < 2; ++kk) {
                const unsigned w0_ = cvt_pk_bf16(sa[8 * kk + 0], sa[8 * kk + 1]), w1_ = cvt_pk_bf16(sa[8 * kk + 2], sa[8 * kk + 3]);
                const unsigned w2_ = cvt_pk_bf16(sa[8 * kk + 4], sa[8 * kk + 5]), w3_ = cvt_pk_bf16(sa[8 * kk + 6], sa[8 * kk + 7]);
                const uint4 w = make_uint4(w0_, w1_, w2_, w3_);
                pf[kk] = __builtin_bit_cast(bf16x8, w);
            }
#pragma unroll
            for (int kk = 0; kk < 2; ++kk) {
                bf16x8 a0, a1;
#pragma unroll
                for (int j = 0; j < 4; ++j) { a0[j] = va[0][kk][0][j]; a0[4 + j] = va[0][kk][1][j]; a1[j] = va[1][kk][0][j]; a1[4 + j] = va[1][kk][1][j]; }
                o0 = __builtin_amdgcn_mfma_f32_32x32x16_bf16(a0, pf[kk], o0, 0, 0, 0);
                o1 = __builtin_amdgcn_mfma_f32_32x32x16_bf16(a1, pf[kk], o1, 0, 0, 0);
            }
        }
        lsum += __shfl_xor(lsum, 32);
        const float inv = 1.f / lsum;
        float* op = p.na + (size_t)((bh / NH) * SEQ + nq) * DNA + hh * HD + 4 * h;
#pragma unroll
        for (int q = 0; q < 4; ++q) {
            *(float4*)(op + 8 * q) = make_float4(o0[4 * q] * inv, o0[4 * q + 1] * inv, o0[4 * q + 2] * inv, o0[4 * q + 3] * inv);
            *(float4*)(op + 32 + 8 * q) = make_float4(o1[4 * q] * inv, o1[4 * q + 1] * inv, o1[4 * q + 2] * inv, o1[4 * q + 3] * inv);
        }
    }
}

__device__ void ph_a2rows(const Params& p, float* lds) {
    const int tid = threadIdx.x, wv = tid >> 6, lane = tid & 63;
    const int nw = gridDim.x * (NT / 64), gw = blockIdx.x * (NT / 64) + wv;
    for (int tok = gw; tok < NTOK; tok += nw) {
        float4 v[3]; float ss = 0.f;
#pragma unroll
        for (int i = 0; i < 3; ++i) { v[i] = *(const float4*)(p.na + (size_t)tok * DNA + 4 * lane + 256 * i); ss += v[i].x * v[i].x + v[i].y * v[i].y + v[i].z * v[i].z + v[i].w * v[i].w; }
        ss = wave_sum(ss);
        const float rn = rsqrtf(ss / (float)DNA + EPS);
#pragma unroll
        for (int i = 0; i < 3; ++i) { const float4 g = *(const float4*)(p.g_out + DF + 4 * lane + 256 * i);
            uint2 w; w.x = cvt_pk_bf16(v[i].x * rn * g.x, v[i].y * rn * g.y); w.y = cvt_pk_bf16(v[i].z * rn * g.z, v[i].w * rn * g.w);
            *(uint2*)(p.A2b + (size_t)tok * D + DF + 4 * lane + 256 * i) = w; }
    }
}

__device__ void ph_outproj(const Params& p, float* ldsf) {
    LAS unsigned char* lds = (LAS unsigned char*)ldsf;
    int tid = threadIdx.x; asm volatile("" : "+v"(tid));
    const int lane = tid & 63, wid = tid >> 6, wr = wid >> 2, wc = wid & 3, r = lane & 31, h = lane >> 5;
    const int srow = tid >> 3, sc = SCS(tid);
    for (int u = blockIdx.x; u < (NTOK / 256) * (D / 256); u += gridDim.x) {
        const int pm = u >> 2, pn = u & 3;
        unsigned po[4], qo[4];
#pragma unroll
        for (int i = 0; i < 4; ++i) { const int rt = srow + 64 * i; po[i] = (unsigned)(pm * 256 + rt) * (unsigned)(D * 2) + sc * 16; qo[i] = (unsigned)(pn * 256 + rt) * (unsigned)(D * 2) + sc * 16; }
        f32x16 acc[4][2];
        gemm256(lds, tid, (const char*)p.A2b, po, (const char*)p.WoutT, qo, D / 64, acc);
        const float* gt1 = p.mod + (pm >> 5) * NMOD * D + 2 * D;
        int opq = 0; asm volatile("" : "+v"(opq));
        const int r_ = r + opq, h_ = h + opq;
#pragma unroll
        for (int j = 0; j < 2; ++j) {
            const int feat = pn * 256 + wc * 64 + j * 32 + r_; const float g = gt1[feat];
#pragma unroll
            for (int i = 0; i < 4; ++i) {
                const unsigned base = (unsigned)((pm * 256 + wr * 128 + i * 32 + 4 * h_) * D + feat);
                const float* xp = p.x + base; float* op = p.x1 + base;
#pragma unroll
                for (int hf = 0; hf < 2; ++hf) {
                    float xv[8];
#pragma unroll
                    for (int v = 0; v < 8; ++v) xv[v] = xp[((v & 3) + 8 * (v >> 2) + 16 * hf) * D];
#pragma unroll
                    for (int v = 0; v < 8; ++v) op[((v & 3) + 8 * (v >> 2) + 16 * hf) * D] = xv[v] + g * acc[i][j][8 * hf + v];
                    asm volatile("" ::: "memory");
                }
            }
        }
    }
}

__device__ void ph_router(const Params& p, float* lds) {
    const int tid = threadIdx.x, wv = tid >> 6, lane = tid & 63;
    const int nw = gridDim.x * (NT / 64), gw = blockIdx.x * (NT / 64) + wv;
    for (int tok = gw; tok < NTOK; tok += nw) {
        const int b = tok / SEQ;
        const float* sh = p.mod + b * NMOD * D + 3 * D, * sc = sh + D;
        float hv[16]; float ss = 0.f;
#pragma unroll
        for (int i = 0; i < 16; ++i) { hv[i] = p.x1[(size_t)tok * D + lane + 64 * i]; ss = fmaf(hv[i], hv[i], ss); }
        ss = wave_sum(ss);
        const float r = rsqrtf(ss / (float)D + EPS);
#pragma unroll
        for (int i = 0; i < 16; ++i) { const int e = lane + 64 * i; hv[i] = hv[i] * r * p.g_norm2[e] * (1.f + sc[e]) + sh[e]; p.h2b[(size_t)tok * D + e] = f2bf(hv[i]); }
        float lg[4];
#pragma unroll
        for (int o = 0; o < 4; ++o) { float a = 0.f;
#pragma unroll
            for (int i = 0; i < 16; ++i) a = fmaf(hv[i], p.w_rg[(size_t)(lane + 64 * i) * 4 + o], a);
            lg[o] = wave_sum(a); }
        int gs = 0; float gm = lg[0];
#pragma unroll
        for (int o = 1; o < 4; ++o) if (lg[o] > gm) { gm = lg[o]; gs = o; }
        float gz = 0.f;
#pragma unroll
        for (int o = 0; o < 4; ++o) gz += expf(lg[o] - gm);
        const float pg = 1.f / gz;
        float le[8];
#pragma unroll
        for (int o = 0; o < 8; ++o) { float a = 0.f;
#pragma unroll
            for (int i = 0; i < 16; ++i) a = fmaf(hv[i], p.w_re[(size_t)(lane + 64 * i) * NEXP + gs * 8 + o], a);
            le[o] = wave_sum(a); }
        int i0 = 0; float m0 = le[0];
#pragma unroll
        for (int o = 1; o < 8; ++o) if (le[o] > m0) { m0 = le[o]; i0 = o; }
        int i1 = -1; float m1 = -3.0e38f;
#pragma unroll
        for (int o = 0; o < 8; ++o) if (o != i0 && le[o] > m1) { m1 = le[o]; i1 = o; }
        const float e1 = expf(m1 - m0);
        const float g0 = pg / (1.f + e1), g1 = pg * e1 / (1.f + e1);
        if (lane == 0) {
            const int ea = gs * 8 + i0, eb = gs * 8 + i1;
            const int sa = atomicAdd(&p.cnt[ea], 1); p.list[ea * NTOK + sa] = tok * 2;
            const int sb = atomicAdd(&p.cnt[eb], 1); p.list[eb * NTOK + sb] = tok * 2 + 1;
            p.tokgate[tok * 2] = g0; p.tokgate[tok * 2 + 1] = g1;
        }
    }
}

struct ETile { int e, s0, ns, sbase; };
__device__ __forceinline__ int moe_ntiles(const Params& p) { int t = 0; for (int e = 0; e < NEXP; ++e) t += (p.cnt[e] + 255) >> 8; return t; }
__device__ __forceinline__ ETile moe_tile(const Params& p, int tile) {
    int e = 0, base = 0, sb = 0;
    for (;;) { const int c = p.cnt[e], nc = (c + 255) >> 8; if (tile < base + nc) break; base += nc; sb += c; ++e; }
    ETile t; t.e = e; t.s0 = (tile - base) * 256; t.ns = min(256, p.cnt[e] - t.s0); t.sbase = sb; return t;
}

__device__ void ph_moe_gu(const Params& p, float* ldsf) {
    LAS unsigned char* lds = (LAS unsigned char*)ldsf;
    int tid = threadIdx.x; asm volatile("" : "+v"(tid));
    const int lane = tid & 63, wid = tid >> 6, wr = wid >> 2, wc = wid & 3, r = lane & 31, h = lane >> 5;
    const int srow = tid >> 3, sc = SCS(tid);
    const int nunits = moe_ntiles(p) * 4;
    for (int u = blockIdx.x; u < nunits; u += gridDim.x) {
        const ETile t = moe_tile(p, u >> 2); const int fc = u & 3;
        unsigned po[4], qo[4];
#pragma unroll
        for (int i = 0; i < 4; ++i) {
            const int rt = srow + 64 * i;
            const int ent = rt < t.ns ? p.list[t.e * NTOK + t.s0 + rt] : 0;
            po[i] = (unsigned)(ent >> 1) * (unsigned)(D * 2) + sc * 16;
            const int f = fc * 128 + (rt >> 6) * 32 + (rt & 31), up = (rt >> 5) & 1;
            qo[i] = (unsigned)((up * NEXP + t.e) * DEXP + f) * (unsigned)(D * 2) + sc * 16;
        }
        f32x16 acc[4][2];
        gemm256(lds, tid, (const char*)p.h2b, po, (const char*)p.WgT, qo, D / 64, acc);
        int opq = 0; asm volatile("" : "+v"(opq));
        const int r_ = r + opq, h_ = h + opq;
        const int f = fc * 128 + wc * 32 + r_;
#pragma unroll
        for (int i = 0; i < 4; ++i) {
            const int s = wr * 128 + i * 32 + 4 * h_;
#pragma unroll
            for (int v = 0; v < 16; ++v) {
                const int sv = s + (v & 3) + 8 * (v >> 2);
                const float g = acc[i][0][v], uu = acc[i][1][v];
                if (sv < t.ns) p.act[(unsigned)((t.sbase + t.s0 + sv) * DEXP + f)] = f2bf(g / (1.f + __expf(-g)) * uu);
            }
            asm volatile("" ::: "memory");
        }
    }
}

__device__ void ph_moe_down(const Params& p, float* ldsf) {
    LAS unsigned char* lds = (LAS unsigned char*)ldsf;
    int tid = threadIdx.x; asm volatile("" : "+v"(tid));
    const int lane = tid & 63, wid = tid >> 6, wr = wid >> 2, wc = wid & 3, r = lane & 31, h = lane >> 5;
    const int srow = tid >> 3, sc = SCS(tid);
    const int nunits = moe_ntiles(p) * 4;
    for (int u = blockIdx.x; u < nunits; u += gridDim.x) {
        const ETile t = moe_tile(p, u >> 2); const int pn = u & 3;
        unsigned po[4], qo[4];
#pragma unroll
        for (int i = 0; i < 4; ++i) {
            const int rt = srow + 64 * i;
            po[i] = (unsigned)(t.sbase + t.s0 + (rt < t.ns ? rt : 0)) * (unsigned)(DEXP * 2) + sc * 16;
            qo[i] = (unsigned)(t.e * D + pn * 256 + rt) * (unsigned)(DEXP * 2) + sc * 16;
        }
        f32x16 acc[4][2];
        gemm256(lds, tid, (const char*)p.act, po, (const char*)p.WdT, qo, DEXP / 64, acc);
        int opq = 0; asm volatile("" : "+v"(opq));
        const int r_ = r + opq, h_ = h + opq;
#pragma unroll
        for (int i = 0; i < 4; ++i) {
            const int s = wr * 128 + i * 32 + 4 * h_;
#pragma unroll
            for (int v = 0; v < 16; ++v) {
                const int sv = s + (v & 3) + 8 * (v >> 2);
                if (sv < t.ns) {
                    const int ent = p.list[t.e * NTOK + t.s0 + sv]; const float g = p.tokgate[ent];
                    const unsigned base = (unsigned)ent * D + pn * 256 + wc * 64 + r_;
                    p.ybuf[base] = f2bf(g * acc[i][0][v]); p.ybuf[base + 32] = f2bf(g * acc[i][1][v]);
                }
            }
            asm volatile("" ::: "memory");
        }
    }
}

__device__ void ph_final(const Params& p, float* lds) {
    const int tid = threadIdx.x;
    for (int tok = blockIdx.x; tok < NTOK; tok += gridDim.x) {
        const float* gt2 = p.mod + (tok / SEQ) * NMOD * D + 5 * D;
        const unsigned ya = *(const unsigned*)(p.ybuf + (size_t)(2 * tok) * D + 2 * tid), yb = *(const unsigned*)(p.ybuf + (size_t)(2 * tok + 1) * D + 2 * tid);
        const float2 xv = *(const float2*)(p.x1 + (size_t)tok * D + 2 * tid);
        const float m0 = __uint_as_float(ya << 16) + __uint_as_float(yb << 16), m1 = __uint_as_float(ya & 0xffff0000u) + __uint_as_float(yb & 0xffff0000u);
        const float v0 = xv.x + gt2[2 * tid] * m0, v1 = xv.y + gt2[2 * tid + 1] * m1;
        const float ss = block_sum(v0 * v0 + v1 * v1, lds);
        const float rr = rsqrtf(ss / (float)D + EPS);
        *(float2*)(p.out + (size_t)tok * D + 2 * tid) = make_float2(v0 * rr * p.g_final[2 * tid], v1 * rr * p.g_final[2 * tid + 1]);
    }
}

extern __shared__ __attribute__((aligned(16))) float smem[];

constexpr int LDS_BAR_OFF = 128 * 1024 + 512;
__global__ void __launch_bounds__(NT) mega(Params p) {
    volatile LAS unsigned* st = (volatile LAS unsigned*)((LAS unsigned char*)smem + LDS_BAR_OFF);
    if (threadIdx.x == 0) { st[0] = 0u; st[1] = 0u; }
    __syncthreads();
    const XcdBarrier bar = xcd_barrier_post(p.bar, st);
    ph_adaln_tables(p, smem); xcd_barrier(bar);
    ph_hrows(p, smem); xcd_barrier(bar);
    ph_inproj(p, smem); xcd_barrier(bar);
    ph_four1(p, smem); xcd_barrier(bar);
    ph_four2(p, smem); xcd_barrier(bar);
    ph_attn(p, smem); xcd_barrier(bar);
    ph_fmix(p, smem); ph_a2rows(p, smem); xcd_barrier(bar);
    ph_outproj(p, smem); xcd_barrier(bar);
    ph_router(p, smem); xcd_barrier(bar);
    ph_moe_gu(p, smem); xcd_barrier(bar);
    ph_moe_down(p, smem); xcd_barrier(bar);
    ph_final(p, smem);
}

extern "C" void kernel_launch(void* const* d_in, const int* in_sizes, int n_in, void* d_out, int out_size, void* d_ws, size_t ws_size, hipStream_t stream) {
    constexpr size_t kDynLds = 128 * 1024 + 1024;
    static int grid_blocks = 0;
    if (!grid_blocks) {
        int dev = 0, cus = 0, per_cu = 0;
        (void)hipGetDevice(&dev);
        (void)hipDeviceGetAttribute(&cus, hipDeviceAttributeMultiprocessorCount, dev);
        (void)hipFuncSetAttribute((const void*)mega, hipFuncAttributeMaxDynamicSharedMemorySize, (int)kDynLds);
        (void)hipOccupancyMaxActiveBlocksPerMultiprocessor(&per_cu, (const void*)mega, NT, kDynLds);
        if (per_cu > 1) per_cu = 1;
        grid_blocks = cus * per_cu;
    }
    Params p{};
    p.x = (const float*)d_in[0]; p.c = (const float*)d_in[1]; p.ctx = (const float*)d_in[2]; p.c_ctx = (const float*)d_in[3];
    p.w_ada = (const float*)d_in[4]; p.b_ada = (const float*)d_in[5]; p.g_norm1 = (const float*)d_in[6]; p.w_in = (const float*)d_in[7];
    p.w_fmix = (const float*)d_in[8]; p.rpb = (const float*)d_in[9]; p.g_out = (const float*)d_in[10]; p.w_out = (const float*)d_in[11];
    p.g_norm2 = (const float*)d_in[12]; p.w_rg = (const float*)d_in[13]; p.w_re = (const float*)d_in[14]; p.w_gate = (const float*)d_in[15];
    p.w_up = (const float*)d_in[16]; p.w_down = (const float*)d_in[17]; p.g_final = (const float*)d_in[18];
    p.out = (float*)d_out;
    char* w = (char*)d_ws; size_t o = 0;
    auto take = [&](size_t bytes) { char* r = w + o; o += (bytes + 255) & ~(size_t)255; return r; };
    p.mod = (float*)take(3 * NMOD * D * 4); p.cosN = (float*)take(SEQ * 4); p.sinN = (float*)take(SEQ * 4); p.ropeR = (float*)take(GROWS * 32 * 4); p.ropeC = (float*)take(GW * 32 * 4);
    p.bar = (unsigned*)take(XCD_BAR_WORDS * 4); p.cnt = (int*)take(256); p.list = (int*)take((size_t)NEXP * NTOK * 4); p.tokgate = (float*)take(2 * NTOK * 4);
    p.WinT = (bf16_t*)take((size_t)DIN * D * 2); p.WoutT = (bf16_t*)take((size_t)D * D * 2);
    p.W64cs = (bf16_t*)take(256 * 64 * 2); p.G128 = (bf16_t*)take(256 * 256 * 2); p.WmixT = (bf16_t*)take(256 * 512 * 2);
    p.WgT = (bf16_t*)take((size_t)NEXP * DEXP * D * 2); p.WuT = (bf16_t*)take((size_t)NEXP * DEXP * D * 2); p.WdT = (bf16_t*)take((size_t)NEXP * DEXP * D * 2);
    char* R1 = take((size_t)NTOK * D * 4 + 256);
    p.hb = (bf16_t*)R1; p.Zb = (bf16_t*)R1; p.na = (float*)R1; p.P2 = (bf16_t*)(R1 + (size_t)NTOK * DNA * 4); p.h2b = (bf16_t*)R1; p.act = p.h2b + (size_t)NTOK * D;
    const size_t qkv = (size_t)NTOK * DNA * 2;
    char* R2 = take((size_t)NTOK * DF * 2 + 4 * qkv + 2 * (size_t)NCTX * DNA * 2 + 4096);
    p.fX = (bf16_t*)R2; p.Qr = (bf16_t*)(R2 + (size_t)NTOK * DF * 2); p.Qp = p.Qr + (size_t)NTOK * DNA; p.Kr = p.Qp + (size_t)NTOK * DNA; p.Vt = p.Kr + (size_t)NTOK * DNA;
    p.Kc = p.Vt + (size_t)NTOK * DNA; p.Vct = p.Kc + (size_t)NCTX * DNA;
    p.A2b = (bf16_t*)R2; p.x1 = (float*)(R2 + (size_t)NTOK * DF * 2 + 4 * qkv + 2 * (size_t)NCTX * DNA * 2 - (size_t)NTOK * D * 4);
    p.ybuf = (bf16_t*)p.out;
    void* args[] = {&p};
    (void)hipMemsetAsync(p.bar, 0, XCD_BAR_WORDS * 4, stream);
    hipError_t e = hipLaunchCooperativeKernel((const void*)mega, dim3(grid_blocks), dim3(NT), args, kDynLds, stream);
    if (e != hipSuccess) fprintf(stderr, "cooperative launch failed: %s (grid %d)\n", hipGetErrorString(e), grid_blocks);
}
```

```cpp
#include <hip/hip_runtime.h>
#include <cstdio>
#include <cstdint>

constexpr int D = 1024, NBATCH = 2, SEQ = 8192, NTOK = NBATCH * SEQ, LCTX = 256, NCTX = NBATCH * LCTX, NROWS = NTOK + NCTX;
constexpr int DIN = 2560, DF = 256, NH = 12, HD = 64, DNA = 768, QOFF = 256, KOFF = 1024, VOFF = 1792;
constexpr int GW = 64, GROWS = 128, NEXP = 32, DEXP = 512, NMOD = 6;
constexpr float EPS = 1e-6f;
constexpr int NT = 512;
constexpr float QSCALE = 0.125f * 1.4426950408889634f;
typedef unsigned short bf16_t;
typedef short bf16x8 __attribute__((ext_vector_type(8)));
typedef float f32x16 __attribute__((ext_vector_type(16)));
typedef float f32x4 __attribute__((ext_vector_type(4)));
__device__ __forceinline__ unsigned cvt_pk_bf16(float lo, float hi) { unsigned r; asm volatile("v_cvt_pk_bf16_f32 %0, %1, %2" : "=v"(r) : "v"(lo), "v"(hi)); return r; }
__device__ __forceinline__ bf16_t f2bf(float v) { return (bf16_t)(cvt_pk_bf16(v, 0.f) & 0xffffu); }
__device__ __forceinline__ float bf2f(bf16_t v) { return __uint_as_float((unsigned)v << 16); }

struct Params {
    const float *x, *c, *ctx, *c_ctx, *w_ada, *b_ada, *g_norm1, *w_in, *w_fmix, *rpb, *g_out, *w_out, *g_norm2, *w_rg, *w_re, *w_gate, *w_up, *w_down, *g_final;
    float* out;
    float *mod, *cosN, *sinN, *ropeR, *ropeC;
    float *na;
    float *x1;
    int *cnt, *list; float* tokgate; unsigned* bar; float* WrT;
    bf16_t *WinT, *WoutT, *WgT, *WuT, *WdT;
    bf16_t *hb, *A2b;
    bf16_t *h2b, *act, *ybuf;
    bf16_t *fX, *Qr, *Qp, *Kr, *Vt, *Kc, *Vct;
    bf16_t *W64cs, *G128, *WmixT;
    bf16_t *Zb, *P2;
};

__device__ __forceinline__ float wave_sum(float v) {
#pragma unroll
    for (int o = 32; o > 0; o >>= 1) v += __shfl_xor(v, o);
    return v;
}
__device__ __forceinline__ float wave_max(float v) {
#pragma unroll
    for (int o = 32; o > 0; o >>= 1) v = fmaxf(v, __shfl_xor(v, o));
    return v;
}
__device__ __forceinline__ float block_sum(float v, float* red) {
    v = wave_sum(v);
    const int w = threadIdx.x >> 6, l = threadIdx.x & 63;
    __syncthreads();
    if (l == 0) red[w] = v;
    __syncthreads();
    float s = 0.f;
#pragma unroll
    for (int i = 0; i < NT / 64; ++i) s += red[i];
    return s;
}

template <class AF, class BF, class EF>
__device__ void ngemm(float* lds, int M, int N, int K, AF af, BF bf, EF ef) {
    float* As = lds;
    float* Bs = lds + 16 * 132;
    const int tid = threadIdx.x, ty = tid >> 4, tx = tid & 15;
    const int tn = N / 128, nt = (M / 128) * tn;
    for (int t = blockIdx.x; t < nt; t += gridDim.x) {
        const int m0 = (t / tn) * 128, n0 = (t % tn) * 128;
        float acc[4][8];
#pragma unroll
        for (int i = 0; i < 4; ++i)
#pragma unroll
            for (int j = 0; j < 8; ++j) acc[i][j] = 0.f;
        for (int k0 = 0; k0 < K; k0 += 16) {
#pragma unroll
            for (int i = 0; i < 4; ++i) { const int idx = tid + NT * i, kk = idx & 15, m = idx >> 4; As[kk * 132 + m] = af(m0 + m, k0 + kk); }
#pragma unroll
            for (int i = 0; i < 4; ++i) { const int idx = tid + NT * i, n = idx & 127, kk = idx >> 7; Bs[kk * 128 + n] = bf(m0, k0 + kk, n0 + n); }
            __syncthreads();
#pragma unroll
            for (int kk = 0; kk < 16; ++kk) {
                const float4 a = *(const float4*)(As + kk * 132 + ty * 4);
                const float4 b0 = *(const float4*)(Bs + kk * 128 + tx * 8), b1 = *(const float4*)(Bs + kk * 128 + tx * 8 + 4);
                const float av[4] = {a.x, a.y, a.z, a.w}, bv[8] = {b0.x, b0.y, b0.z, b0.w, b1.x, b1.y, b1.z, b1.w};
#pragma unroll
                for (int i = 0; i < 4; ++i)
#pragma unroll
                    for (int j = 0; j < 8; ++j) acc[i][j] = fmaf(av[i], bv[j], acc[i][j]);
            }
            __syncthreads();
        }
#pragma unroll
        for (int i = 0; i < 4; ++i)
#pragma unroll
            for (int j = 0; j < 8; ++j) ef(m0 + ty * 4 + i, n0 + tx * 8 + j, acc[i][j]);
    }
}

#define LAS __attribute__((address_space(3)))
#define SCS(tid) (((tid) & 7) ^ ((((tid) >> 3) >> 1) & 7))
__device__ __forceinline__ void gemm256(LAS unsigned char* lds, const int tid, const char* Pb, const unsigned (&po)[4], const char* Qb, const unsigned (&qo)[4], int nk, f32x16 (&acc)[4][2]) {
    const int lane = tid & 63, wid = __builtin_amdgcn_readfirstlane(tid >> 6), wr = wid >> 2, wc = wid & 3;
    const int r = lane & 31, h = lane >> 5, swz = (r >> 1) & 7;
    const unsigned ldsw = (unsigned)wid * 1024u;
#pragma unroll
    for (int i = 0; i < 4; ++i)
#pragma unroll
        for (int j = 0; j < 2; ++j)
#pragma unroll
            for (int v = 0; v < 16; ++v) acc[i][j][v] = 0.f;
    __syncthreads();
#pragma unroll
    for (int i = 0; i < 4; ++i) {
        __builtin_amdgcn_global_load_lds((const unsigned*)(Pb + po[i]), (LAS unsigned*)(lds + ldsw + i * 8192), 16, 0, 0);
        __builtin_amdgcn_global_load_lds((const unsigned*)(Qb + qo[i]), (LAS unsigned*)(lds + 32768 + ldsw + i * 8192), 16, 0, 0);
    }
    __syncthreads();
    const int prd = (wr * 128 + r) * 128, qrd = 32768 + (wc * 64 + r) * 128;
    const int ko0 = ((0 + h) ^ swz) << 4, ko1 = ((2 + h) ^ swz) << 4, ko2 = ((4 + h) ^ swz) << 4, ko3 = ((6 + h) ^ swz) << 4;
#define G256_LD(pf, qf, ko) do { _Pragma("unroll") for (int i = 0; i < 4; ++i) pf[i] = *(const LAS bf16x8*)(lds + cb + prd + i * 4096 + (ko)); \
                                 _Pragma("unroll") for (int j = 0; j < 2; ++j) qf[j] = *(const LAS bf16x8*)(lds + cb + qrd + j * 4096 + (ko)); } while (0)
#define G256_MM(pf, qf) do { _Pragma("unroll") for (int i = 0; i < 4; ++i) _Pragma("unroll") for (int j = 0; j < 2; ++j) \
                                 acc[i][j] = __builtin_amdgcn_mfma_f32_32x32x16_bf16(pf[i], qf[j], acc[i][j], 0, 0, 0); } while (0)
#pragma unroll 1
    for (int kt = 0; kt < nk; ++kt) {
        const int cb = (kt & 1) * 65536, nb = 65536 - cb;
        {
            const unsigned koff = (unsigned)min(kt + 1, nk - 1) * 128u;
#pragma unroll
            for (int i = 0; i < 4; ++i) {
                __builtin_amdgcn_global_load_lds((const unsigned*)(Pb + (size_t)(po[i] + koff)), (LAS unsigned*)(lds + nb + ldsw + i * 8192), 16, 0, 0);
                __builtin_amdgcn_global_load_lds((const unsigned*)(Qb + (size_t)(qo[i] + koff)), (LAS unsigned*)(lds + nb + 32768 + ldsw + i * 8192), 16, 0, 0);
            }
        }
        bf16x8 pa[4], qa[2], pb[4], qb[2];
        G256_LD(pa, qa, ko0);
        G256_LD(pb, qb, ko1);
        G256_MM(pa, qa);
        G256_LD(pa, qa, ko2);
        G256_MM(pb, qb);
        G256_LD(pb, qb, ko3);
        G256_MM(pa, qa);
        G256_MM(pb, qb);
        __syncthreads();
    }
    asm volatile("" ::: "memory");
}

#define XB_TMO      128
#define XB_XCNT(j)  (256  + 64 * (j))
#define XB_XSUB(j)  (1280 + 64 * (j))
#define XB_XGEN(j)  (2304 + 64 * (j))
#define XB_TOP      3328
#define XB_TOPGEN   3392
#define XCD_BAR_WORDS 3456
#define XB_SPIN_CAP (1u << 18)
__device__ __forceinline__ unsigned xb_ld(unsigned* p)              { return __hip_atomic_load(p, __ATOMIC_RELAXED, __HIP_MEMORY_SCOPE_AGENT); }
__device__ __forceinline__ unsigned xb_add(unsigned* p, unsigned v) { return __hip_atomic_fetch_add(p, v, __ATOMIC_RELAXED, __HIP_MEMORY_SCOPE_AGENT); }
__device__ __forceinline__ unsigned xb_xcc_id() { return (unsigned)__builtin_amdgcn_s_getreg((3 << 11) | 20) & 0xFu; }
#define XB_SPIN(cond, bar) do { unsigned _sp = 0; while (cond) { __builtin_amdgcn_s_sleep(1); \
    if ((++_sp & 255u) == 0u) { if (xb_ld(&(bar)[XB_TMO])) break; if (_sp > XB_SPIN_CAP) { atomicAdd(&(bar)[XB_TMO], 1u); break; } } } } while (0)
struct XcdBarrier { unsigned* bar; unsigned x; volatile LAS unsigned* st; };
__device__ __forceinline__ XcdBarrier xcd_barrier_post(unsigned* bar, volatile LAS unsigned* st) {
    XcdBarrier b; b.bar = bar; b.x = xb_xcc_id(); b.st = st;
    if (threadIdx.x == 0) (void)xb_add(&bar[XB_XCNT(b.x)], 1u);
    return b;
}
__device__ __forceinline__ void xcd_barrier_complete(unsigned* bar, unsigned x, unsigned& nloc, unsigned& nx) {
    const unsigned G = gridDim.x * gridDim.y * gridDim.z;
    unsigned sum, cnt, mine, sp = 0u;
    for (;;) {
        sum = 0u; cnt = 0u; mine = 0u;
#pragma unroll
        for (unsigned j = 0; j < 16; ++j) { const unsigned c = xb_ld(&bar[XB_XCNT(j)]); sum += c; cnt += (c > 0u) ? 1u : 0u; mine = (j == x) ? c : mine; }
        if (sum == G) break;
        __builtin_amdgcn_s_sleep(1);
        if ((++sp & 255u) == 0u) { if (xb_ld(&bar[XB_TMO])) break; if (sp > XB_SPIN_CAP) { atomicAdd(&bar[XB_TMO], 1u); break; } }
    }
    nloc = mine > 0u ? mine : 1u; nx = cnt > 0u ? cnt : 1u;
}
__device__ __forceinline__ void xcd_barrier(const XcdBarrier& b) {
    asm volatile("s_waitcnt vmcnt(0)" ::: "memory");
    __syncthreads();
    if (threadIdx.x == 0) {
        unsigned* bar = b.bar;
        __builtin_amdgcn_s_waitcnt(0);
        unsigned nloc = b.st[0], nx = b.st[1];
        if (nloc == 0u) { xcd_barrier_complete(bar, b.x, nloc, nx); b.st[0] = nloc; b.st[1] = nx; }
        const unsigned old = xb_add(&bar[XB_XSUB(b.x)], 1u);
        const unsigned gen = old / nloc;
        if (old + 1u == (gen + 1u) * nloc) {
            __builtin_amdgcn_fence(__ATOMIC_RELEASE, "agent");
            asm volatile("s_waitcnt vmcnt(0)" ::: "memory");
            const unsigned og = xb_add(&bar[XB_TOP], 1u);
            const unsigned tg = og / nx;
            if (og + 1u == (tg + 1u) * nx) xb_add(&bar[XB_TOPGEN], 1u);
            else XB_SPIN(xb_ld(&bar[XB_TOPGEN]) == tg, bar);
            __builtin_amdgcn_fence(__ATOMIC_ACQUIRE, "agent");
            xb_add(&bar[XB_XGEN(b.x)], 1u);
            asm volatile("s_waitcnt vmcnt(0)" ::: "memory");
        } else {
            XB_SPIN(xb_ld(&bar[XB_XGEN(b.x)]) == gen, bar);
            __builtin_amdgcn_fence(__ATOMIC_ACQUIRE, "agent");
            asm volatile("s_waitcnt vmcnt(0)" ::: "memory");
        }
    }
    __syncthreads();
}

__device__ void transpose_job(float* lds, const float* src, bf16_t* dst, int R, int C, int batch, int& tbase, int gstride, int& next) {
    const int tid = threadIdx.x;
    const int tr = R / 64, tc = C / 256, ntile = batch * tr * tc;
    while (next < tbase + ntile) {
        const int t = next - tbase; next += gstride;
        const int bb = t / (tr * tc), rem = t % (tr * tc), r0 = (rem / tc) * 64, c0 = (rem % tc) * 256;
        const float* s = src + (size_t)bb * R * C + (size_t)r0 * C + c0; bf16_t* d = dst + (size_t)bb * R * C + (size_t)c0 * R + r0;
        float4 v[8];
#pragma unroll
        for (int i = 0; i < 8; ++i) { const int rr = (tid >> 6) + 8 * i, c4 = (tid & 63) * 4; v[i] = *(const float4*)(s + (size_t)rr * C + c4); }
        __syncthreads();
#pragma unroll
        for (int i = 0; i < 8; ++i) { const int rr = (tid >> 6) + 8 * i, c4 = (tid & 63) * 4; float* q = lds + rr * 257 + c4; q[0] = v[i].x; q[1] = v[i].y; q[2] = v[i].z; q[3] = v[i].w; }
        __syncthreads();
#pragma unroll
        for (int i = 0; i < 4; ++i) { const int cc = (tid >> 3) + 64 * i, r8 = (tid & 7) * 8; const float* q = lds + r8 * 257 + cc;
            uint4 w; w.x = cvt_pk_bf16(q[0], q[257]); w.y = cvt_pk_bf16(q[2 * 257], q[3 * 257]); w.z = cvt_pk_bf16(q[4 * 257], q[5 * 257]); w.w = cvt_pk_bf16(q[6 * 257], q[7 * 257]);
            *(uint4*)(d + (size_t)cc * R + r8) = w; }
    }
    tbase += ntile;
}

__device__ void ph_adaln_tables(const Params& p, float* lds) {
    const int tid = threadIdx.x, gid = blockIdx.x * NT + tid, gsz = gridDim.x * NT;
    if (blockIdx.x < NMOD * D / 32) {
        for (int i = tid; i < 3 * D; i += NT) { const int r = i / D, k = i % D; const float v = r < 2 ? p.c[r * D + k] : p.c_ctx[k]; lds[i] = v / (1.f + expf(-v)); }
        __syncthreads();
        const int col = blockIdx.x * 32 + (tid & 31), kg = tid >> 5;
        float a0 = 0.f, a1 = 0.f, a2 = 0.f;
#pragma unroll 8
        for (int kk = 0; kk < 64; ++kk) { const int k = kg * 64 + kk; const float w = p.w_ada[(size_t)k * (NMOD * D) + col]; a0 = fmaf(lds[k], w, a0); a1 = fmaf(lds[D + k], w, a1); a2 = fmaf(lds[2 * D + k], w, a2); }
        float* red = lds + 3 * D;
        red[(0 * 16 + kg) * 32 + (tid & 31)] = a0; red[(1 * 16 + kg) * 32 + (tid & 31)] = a1; red[(2 * 16 + kg) * 32 + (tid & 31)] = a2;
        __syncthreads();
        if (tid < 96) { const int rr = tid >> 5, cc = tid & 31; float s = 0.f;
#pragma unroll
            for (int g = 0; g < 16; ++g) s += red[(rr * 16 + g) * 32 + cc];
            p.mod[rr * NMOD * D + blockIdx.x * 32 + cc] = s + p.b_ada[blockIdx.x * 32 + cc]; }
        __syncthreads();
    }
    for (int i = gid; i < 36 * D; i += gsz) { const int o = i / D, k = i % D; p.WrT[i] = o < 4 ? p.w_rg[k * 4 + o] : p.w_re[k * NEXP + o - 4]; }
    for (int i = gid; i < SEQ; i += gsz) { p.cosN[i] = cospif(2.f * (float)i / (float)SEQ); p.sinN[i] = sinpif(2.f * (float)i / (float)SEQ); }
    for (int i = gid; i < (GROWS + GW) * 16; i += gsz) {
        const int pos = i / 16, f = i % 16; const float inv = powf(10000.f, -(float)f / 16.f);
        if (pos < GROWS) { const float a = (float)pos * inv; p.ropeR[2 * i] = cosf(a); p.ropeR[2 * i + 1] = sinf(a); }
        else { const int pc = pos - GROWS; const float a = (float)pc * inv; p.ropeC[2 * (pc * 16 + f)] = cosf(a); p.ropeC[2 * (pc * 16 + f) + 1] = sinf(a); }
    }
    if (gid < NEXP) p.cnt[gid] = 0;
    for (int i = gid; i < 256 * 64; i += gsz) {
        const int rho = i >> 6, n1 = i & 63, blk = rho >> 5, k1 = (blk >> 1) * 32 + (rho & 31);
        float v = 0.f;
        if (blk < 4) { const float a = 2.f * (float)((k1 * n1) & 63) / 64.f; v = (blk & 1) ? -sinpif(a) : cospif(a); }
        p.W64cs[i] = f2bf(v);
    }
    for (int i = gid; i < 256 * 256; i += gsz) {
        const int rho = i >> 8, kap = i & 255, ro = rho >> 7, k2 = rho & 127, ri = kap >> 7, n2 = kap & 127;
        const float a = 2.f * (float)((k2 * n2) & 127) / 128.f; const float c = cospif(a), s = sinpif(a);
        p.G128[i] = f2bf(ro == ri ? c : (ro == 0 ? s : -s));
    }
    for (int i = gid; i < 256 * 512; i += gsz) {
        const int j = i >> 9, kap = i & 511, ro = kap >> 8, ch = kap & 255, g = ch >> 6, c = ch & 63;
        float acc = 0.f;
        for (int l = 0; l < 64; ++l) { const float a = 2.f * (float)((l * c) & 63) / 64.f; acc = fmaf(ro ? sinpif(a) : cospif(a), p.w_fmix[(size_t)(64 * g + l) * DF + j], acc); }
        p.WmixT[i] = f2bf(acc * (1.0f / 724.0773439350247f));
    }
    __syncthreads();
    int tbase = 0, next = blockIdx.x;
    transpose_job(lds, p.w_in, p.WinT, D, DIN, 1, tbase, gridDim.x, next);
    transpose_job(lds, p.w_out, p.WoutT, D, D, 1, tbase, gridDim.x, next);
    transpose_job(lds, p.w_gate, p.WgT, D, DEXP, NEXP, tbase, gridDim.x, next);
    transpose_job(lds, p.w_up, p.WuT, D, DEXP, NEXP, tbase, gridDim.x, next);
    transpose_job(lds, p.w_down, p.WdT, DEXP, D, NEXP, tbase, gridDim.x, next);
}

__device__ void ph_hrows(const Params& p, float* lds) {
    const int tid = threadIdx.x;
    for (int row = blockIdx.x; row < NROWS; row += gridDim.x) {
        const float* src = row < NTOK ? p.x + (size_t)row * D : p.ctx + (size_t)(row - NTOK) * D;
        const int mr = row < NTOK ? row / SEQ : 2;
        const float* sh = p.mod + mr * NMOD * D, * sc = sh + D;
        const float2 v = *(const float2*)(src + 2 * tid);
        const float ss = block_sum(v.x * v.x + v.y * v.y, lds);
        const float r = rsqrtf(ss / (float)D + EPS);
        const float o0 = v.x * r * p.g_norm1[2 * tid] * (1.f + sc[2 * tid]) + sh[2 * tid];
        const float o1 = v.y * r * p.g_norm1[2 * tid + 1] * (1.f + sc[2 * tid + 1]) + sh[2 * tid + 1];
        *(unsigned*)(p.hb + (size_t)row * D + 2 * tid) = cvt_pk_bf16(o0, o1);
    }
}

__device__ void ph_inproj(const Params& p, float* ldsf) {
    LAS unsigned char* lds = (LAS unsigned char*)ldsf;
    int tid = threadIdx.x; asm volatile("" : "+v"(tid));
    const int lane = tid & 63, wid = tid >> 6, wr = wid >> 2, wc = wid & 3, r = lane & 31, h = lane >> 5;
    const int srow = tid >> 3, sc = SCS(tid);
    constexpr int NPM = NROWS / 256, NPN = DIN / 256;
    for (int u = blockIdx.x; u < NPM * NPN; u += gridDim.x) {
        const int pm = u / NPN, pn = u % NPN;
        if (pm >= 64 && pn < 4) continue;
        unsigned po[4], qo[4];
#pragma unroll
        for (int i = 0; i < 4; ++i) {
            const int rt = srow + 64 * i;
            po[i] = (unsigned)((pn * 256 + rt) * D * 2 + sc * 16);
            int rowidx;
            if (pn == 0) rowidx = (pm >> 5) * SEQ + 128 * (rt & 63) + 4 * (pm & 31) + (rt >> 6);
            else rowidx = pm * 256 + rt;
            qo[i] = (unsigned)rowidx * (unsigned)(D * 2) + sc * 16;
        }
        f32x16 acc[4][2];
        gemm256(lds, tid, (const char*)p.WinT, po, (const char*)p.hb, qo, D / 64, acc);
        int opq = 0; asm volatile("" : "+v"(opq));
        const int r_ = r + opq, h_ = h + opq;
        if (pn == 0) {
            const int b = pm >> 5, n2 = 4 * (pm & 31) + wc;
#pragma unroll
            for (int i = 0; i < 4; ++i) {
#pragma unroll
                for (int j = 0; j < 2; ++j) {
                    const unsigned base = (unsigned)(((b * DF + wr * 128 + i * 32 + 4 * h_) * 128 + n2) * 64 + j * 32 + r_);
#pragma unroll
                    for (int v = 0; v < 16; ++v) p.fX[base + (unsigned)(((v & 3) + 8 * (v >> 2)) * 128 * 64)] = f2bf(acc[i][j][v]);
                }
                asm volatile("" ::: "memory");
            }
        } else if (pn < 7) {
            const bool isq = pn < 4; const int hg = ((pn - 1) % 3) * 4 + wr * 2;
            const bool isctx = pm >= 64;
            const int b = isctx ? pm - 64 : (pm >> 5);
#pragma unroll
            for (int j = 0; j < 2; ++j) {
                const int n = (isctx ? 0 : (pm & 31) * 256) + wc * 64 + j * 32 + r_;
                const int grow = n >> 6, gcol = n & 63;
#pragma unroll
                for (int i = 0; i < 4; ++i) {
                    const int hh = hg + (i >> 1), blk = i & 1;
                    if (isctx) {
                        const unsigned base = (unsigned)(((b * NH + hh) * LCTX + n) * HD + blk * 32 + 4 * h_);
#pragma unroll
                        for (int q = 0; q < 4; ++q) {
                            uint2 w;
                            w.x = cvt_pk_bf16(acc[i][j][4 * q], acc[i][j][4 * q + 1]); w.y = cvt_pk_bf16(acc[i][j][4 * q + 2], acc[i][j][4 * q + 3]);
                            *(uint2*)(p.Kc + base + 8 * q) = w;
                        }
                    } else {
                        const float* tb = (blk == 0 ? p.ropeR + 32 * grow : p.ropeC + 32 * gcol) + 8 * h_;
                        float o1[8], o2[8];
#pragma unroll
                        for (int v = 0; v < 8; ++v) {
                            const float2 cs = *(const float2*)(tb + 2 * ((v & 3) + 8 * (v >> 2)));
                            const float x1 = acc[i][j][v], x2 = acc[i][j][v + 8];
                            o1[v] = x1 * cs.x - x2 * cs.y; o2[v] = x1 * cs.y + x2 * cs.x;
                        }
                        const unsigned base = (unsigned)(((b * NH + hh) * SEQ + n) * HD + blk * 32 + 4 * h_);
                        if (isq) {
#pragma unroll
                            for (int q = 0; q < 2; ++q) {
                                uint2 w;
                                w.x = cvt_pk_bf16(o1[4 * q] * QSCALE, o1[4 * q + 1] * QSCALE); w.y = cvt_pk_bf16(o1[4 * q + 2] * QSCALE, o1[4 * q + 3] * QSCALE);
                                *(uint2*)(p.Qr + base + 8 * q) = w;
                                w.x = cvt_pk_bf16(o2[4 * q] * QSCALE, o2[4 * q + 1] * QSCALE); w.y = cvt_pk_bf16(o2[4 * q + 2] * QSCALE, o2[4 * q + 3] * QSCALE);
                                *(uint2*)(p.Qr + base + 16 + 8 * q) = w;
                            }
#pragma unroll
                            for (int q = 0; q < 4; ++q) {
                                uint2 w;
                                w.x = cvt_pk_bf16(acc[i][j][4 * q] * QSCALE, acc[i][j][4 * q + 1] * QSCALE); w.y = cvt_pk_bf16(acc[i][j][4 * q + 2] * QSCALE, acc[i][j][4 * q + 3] * QSCALE);
                                *(uint2*)(p.Qp + base + 8 * q) = w;
                            }
                        } else {
#pragma unroll
                            for (int q = 0; q < 2; ++q) {
                                uint2 w;
                                w.x = cvt_pk_bf16(o1[4 * q], o1[4 * q + 1]); w.y = cvt_pk_bf16(o1[4 * q + 2], o1[4 * q + 3]);
                                *(uint2*)(p.Kr + base + 8 * q) = w;
                                w.x = cvt_pk_bf16(o2[4 * q], o2[4 * q + 1]); w.y = cvt_pk_bf16(o2[4 * q + 2], o2[4 * q + 3]);
                                *(uint2*)(p.Kr + base + 16 + 8 * q) = w;
                            }
                        }
                    }
                    asm volatile("" ::: "memory");
                }
            }
        } else {
            const int hg = (pn - 7) * 4 + wr * 2;
            const bool isctx = pm >= 64;
            const int b = isctx ? pm - 64 : (pm >> 5);
            const int ld = isctx ? LCTX : SEQ; bf16_t* vb = isctx ? p.Vct : p.Vt;
#pragma unroll
            for (int j = 0; j < 2; ++j) {
                const int n = (isctx ? 0 : (pm & 31) * 256) + wc * 64 + j * 32 + r_;
#pragma unroll
                for (int i = 0; i < 4; ++i) {
                    const unsigned base = (unsigned)(((b * NH + hg + (i >> 1)) * HD + (i & 1) * 32 + 4 * h_) * ld + n);
#pragma unroll
                    for (int v = 0; v < 16; ++v) vb[base + (unsigned)(((v & 3) + 8 * (v >> 2)) * ld)] = f2bf(acc[i][j][v]);
                    asm volatile("" ::: "memory");
                }
            }
        }
    }
}

__device__ void ph_four1(const Params& p, float* ldsf) {
    LAS unsigned char* lds = (LAS unsigned char*)ldsf;
    int tid = threadIdx.x; asm volatile("" : "+v"(tid));
    const int lane = tid & 63, wid = tid >> 6, wr = wid >> 2, wc = wid & 3, r = lane & 31, h = lane >> 5;
    const int srow = tid >> 3, sc = SCS(tid);
    for (int u = blockIdx.x; u < NBATCH * DF * 128 / 256; u += gridDim.x) {
        unsigned po[4], qo[4];
#pragma unroll
        for (int i = 0; i < 4; ++i) { const int rt = srow + 64 * i; po[i] = (unsigned)rt * 128u + sc * 16; qo[i] = (unsigned)(u * 256 + rt) * 128u + sc * 16; }
        f32x16 acc[4][2];
        gemm256(lds, tid, (const char*)p.W64cs, po, (const char*)p.fX, qo, 1, acc);
        if (wr == 0) {
            int opq = 0; asm volatile("" : "+v"(opq));
            const int r_ = r + opq, h_ = h + opq;
#pragma unroll
            for (int j = 0; j < 2; ++j) {
                const int qrow = u * 256 + wc * 64 + j * 32 + r_;
                const int n2 = qrow & 127, bc = qrow >> 7;
#pragma unroll
                for (int a = 0; a < 2; ++a) {
#pragma unroll
                    for (int v = 0; v < 16; ++v) {
                        const int k1 = a * 32 + (v & 3) + 8 * (v >> 2) + 4 * h_;
                        const int idx = n2 * k1;
                        const float cs = p.cosN[idx], sn = p.sinN[idx];
                        const float yr = acc[2 * a][j][v], yi = acc[2 * a + 1][j][v];
                        const unsigned base = (unsigned)((bc * 64 + k1) * 256 + n2);
                        p.Zb[base] = f2bf(yr * cs + yi * sn); p.Zb[base + 128] = f2bf(yi * cs - yr * sn);
                    }
                    asm volatile("" ::: "memory");
                }
            }
        }
    }
}

__device__ void ph_four2(const Params& p, float* ldsf) {
    LAS unsigned char* lds = (LAS unsigned char*)ldsf;
    int tid = threadIdx.x; asm volatile("" : "+v"(tid));
    const int lane = tid & 63, wid = tid >> 6, wr = wid >> 2, wc = wid & 3, r = lane & 31, h = lane >> 5;
    const int srow = tid >> 3, sc = SCS(tid);
    for (int u = blockIdx.x; u < NBATCH * 64; u += gridDim.x) {
        const int b = u >> 6, k1 = u & 63;
        unsigned po[4], qo[4];
#pragma unroll
        for (int i = 0; i < 4; ++i) { const int rt = srow + 64 * i; po[i] = (unsigned)rt * 512u + sc * 16; qo[i] = (unsigned)(((b * DF + rt) * 64 + k1) * 512) + sc * 16; }
        f32x16 acc[4][2];
        gemm256(lds, tid, (const char*)p.G128, po, (const char*)p.Zb, qo, 4, acc);
        int opq = 0; asm volatile("" : "+v"(opq));
        const int r_ = r + opq, h_ = h + opq;
#pragma unroll
        for (int i = 0; i < 4; ++i) {
#pragma unroll
            for (int j = 0; j < 2; ++j) {
                bf16_t* dst = p.P2 + (unsigned)((b * SEQ + k1 + 64 * (i * 32 + 4 * h_)) * 512 + wr * 256 + wc * 64 + j * 32 + r_);
#pragma unroll
                for (int v = 0; v < 16; ++v) dst[((v & 3) + 8 * (v >> 2)) * 64 * 512] = f2bf(acc[i][j][v]);
                asm volatile("" ::: "memory");
            }
        }
    }
}

__device__ void ph_fmix(const Params& p, float* ldsf) {
    LAS unsigned char* lds = (LAS unsigned char*)ldsf;
    int tid = threadIdx.x; asm volatile("" : "+v"(tid));
    const int lane = tid & 63, wid = tid >> 6, wr = wid >> 2, wc = wid & 3, r = lane & 31, h = lane >> 5;
    const int srow = tid >> 3, sc = SCS(tid);
    for (int u = blockIdx.x; u < NTOK / 256; u += gridDim.x) {
        unsigned po[4], qo[4];
#pragma unroll
        for (int i = 0; i < 4; ++i) { const int rt = srow + 64 * i; po[i] = (unsigned)rt * 1024u + sc * 16; qo[i] = (unsigned)(u * 256 + rt) * 1024u + sc * 16; }
        f32x16 acc[4][2];
        gemm256(lds, tid, (const char*)p.WmixT, po, (const char*)p.P2, qo, 8, acc);
        float ss[2];
#pragma unroll
        for (int j = 0; j < 2; ++j) { float s = 0.f;
#pragma unroll
            for (int i = 0; i < 4; ++i)
#pragma unroll
                for (int v = 0; v < 16; ++v) s = fmaf(acc[i][j][v], acc[i][j][v], s);
            ss[j] = s + __shfl_xor(s, 32); }
        float* red = ldsf;
        if (h == 0) { red[wr * 256 + wc * 64 + r] = ss[0]; red[wr * 256 + wc * 64 + 32 + r] = ss[1]; }
        __syncthreads();
        int opq = 0; asm volatile("" : "+v"(opq));
        const int r_ = r + opq, h_ = h + opq;
#pragma unroll
        for (int j = 0; j < 2; ++j) {
            const int tl = wc * 64 + j * 32 + r_;
            const float rstd = rsqrtf((red[tl] + red[256 + tl]) / (float)DF + EPS);
            bf16_t* dst = p.A2b + (unsigned)((u * 256 + tl) * D + wr * 128 + 4 * h_);
            const float* gp = p.g_out + wr * 128 + 4 * h_;
#pragma unroll
            for (int i = 0; i < 4; ++i) {
#pragma unroll
                for (int q = 0; q < 4; ++q) {
                    const float4 g = *(const float4*)(gp + i * 32 + 8 * q);
                    uint2 w; w.x = cvt_pk_bf16(acc[i][j][4 * q] * rstd * g.x, acc[i][j][4 * q + 1] * rstd * g.y); w.y = cvt_pk_bf16(acc[i][j][4 * q + 2] * rstd * g.z, acc[i][j][4 * q + 3] * rstd * g.w);
                    *(uint2*)(dst + i * 32 + 8 * q) = w;
                }
                asm volatile("" ::: "memory");
            }
        }
    }
}

typedef short s16x4 __attribute__((ext_vector_type(4)));
constexpr float LOG2E = 1.4426950408889634f;
__device__ void ph_attn(const Params& p, float* ldsf) {
    int tid = threadIdx.x; asm volatile("" : "+v"(tid));
    const int lane = tid & 63, wv = tid >> 6, l31 = lane & 31, h = lane >> 5;
    __syncthreads();
    for (int i = tid; i < NH * 15 * 128; i += NT) { const int dcx = (i & 127) - 48, dr = (i >> 7) % 15, hh = i / (15 * 128);
        ldsf[i] = (dcx >= 0 && dcx <= 30) ? p.rpb[(hh * 15 + dr) * 31 + dcx] * LOG2E : 0.f; }
    __syncthreads();
    const int half = wv & 1;
    for (int g = blockIdx.x; g < NBATCH * NH * (GROWS / 4); g += gridDim.x) {
        const int bh = g / (GROWS / 4), row = (g % (GROWS / 4)) * 4 + (wv >> 1), hh = bh % NH;
        const int rs = min(max(row - 4, 0), GROWS - 8);
        const int qc = 32 * half + l31, cs = min(max(qc - 8, 0), GW - 16);
        const int nq = row * GW + qc;
        const bf16_t* Kh = p.Kr + (size_t)bh * SEQ * HD; const bf16_t* Vh = p.Vt + (size_t)bh * HD * SEQ;
        const bf16_t* Kch = p.Kc + (size_t)bh * LCTX * HD; const bf16_t* Vch = p.Vct + (size_t)bh * HD * LCTX;
        bf16x8 qr[4], qp[4];
#pragma unroll
        for (int s = 0; s < 4; ++s) { qr[s] = *(const bf16x8*)(p.Qr + ((size_t)bh * SEQ + nq) * HD + 16 * s + 8 * h); qp[s] = *(const bf16x8*)(p.Qp + ((size_t)bh * SEQ + nq) * HD + 16 * s + 8 * h); }
        f32x16 o0, o1;
#pragma unroll
        for (int v = 0; v < 16; ++v) { o0[v] = 0.f; o1[v] = 0.f; }
        float m = -1e30f, lsum = 0.f;
        const float* rph = ldsf + hh * 15 * 128;
        for (int t = 0; t < 20; ++t) {
            const bool loc = t < 12;
            const bf16_t* kptr; const bf16_t* vptr0; int vstr;
            int krow0 = 0, blk = 0;
            if (loc) { const int pr = t / 3; blk = half + (t - 3 * pr); krow0 = rs + 2 * pr;
                kptr = Kh + (size_t)((krow0 + (l31 >> 4)) * GW + 16 * blk + (l31 & 15)) * HD + 8 * h;
                vptr0 = Vh + (size_t)l31 * SEQ + krow0 * GW + 16 * blk + 4 * h; vstr = SEQ;
            } else { const int m0 = 32 * (t - 12);
                kptr = Kch + (size_t)(m0 + l31) * HD + 8 * h;
                vptr0 = Vch + (size_t)l31 * LCTX + m0 + 4 * h; vstr = LCTX; }
            const int krs = loc ? GW : 16;
            bf16x8 kf[4];
#pragma unroll
            for (int s = 0; s < 4; ++s) kf[s] = *(const bf16x8*)(kptr + 16 * s);
            s16x4 va[2][2][2];
#pragma unroll
            for (int dt = 0; dt < 2; ++dt)
#pragma unroll
                for (int kk = 0; kk < 2; ++kk)
#pragma unroll
                    for (int pt = 0; pt < 2; ++pt) va[dt][kk][pt] = *(const s16x4*)(vptr0 + (size_t)dt * 32 * vstr + kk * krs + 8 * pt);
            f32x16 sa;
#pragma unroll
            for (int v = 0; v < 16; ++v) sa[v] = 0.f;
#pragma unroll
            for (int s = 0; s < 4; ++s) sa = __builtin_amdgcn_mfma_f32_32x32x16_bf16(kf[s], loc ? qr[s] : qp[s], sa, 0, 0, 0);
            float tmax;
            if (loc) {
                const float* bp = rph + (krow0 - row + 7) * 128 + (16 * blk + 4 * h - qc + 15 + 48);
#pragma unroll
                for (int v = 0; v < 16; ++v) sa[v] += bp[(v >> 3) * 128 + (v & 3) + 8 * ((v >> 2) & 1)];
            }
            tmax = sa[0];
#pragma unroll
            for (int v = 1; v < 16; ++v) tmax = fmaxf(tmax, sa[v]);
            tmax = fmaxf(tmax, __shfl_xor(tmax, 32));
            const float mn = fmaxf(m, tmax), alpha = __builtin_amdgcn_exp2f(m - mn);
            m = mn;
            float ps = 0.f;
            const int w0 = 16 * blk + 4 * h - cs;
#pragma unroll
            for (int v = 0; v < 16; ++v) {
                float e = __builtin_amdgcn_exp2f(sa[v] - mn);
                if (loc) e = ((unsigned)(w0 + (v & 3) + 8 * ((v >> 2) & 1)) < 16u) ? e : 0.f;
                sa[v] = e; ps += e;
            }
            lsum = lsum * alpha + ps;
#pragma unroll
            for (int v = 0; v < 16; ++v) { o0[v] *= alpha; o1[v] *= alpha; }
            bf16x8 pf[2];
#pragma unroll
            for (int kk = 0; kk < 2; ++kk) {
                const unsigned w0_ = cvt_pk_bf16(sa[8 * kk + 0], sa[8 * kk + 1]), w1_ = cvt_pk_bf16(sa[8 * kk + 2], sa[8 * kk + 3]);
                const unsigned w2_ = cvt_pk_bf16(sa[8 * kk + 4], sa[8 * kk + 5]), w3_ = cvt_pk_bf16(sa[8 * kk + 6], sa[8 * kk + 7]);
                const uint4 w = make_uint4(w0_, w1_, w2_, w3_);
                pf[kk] = __builtin_bit_cast(bf16x8, w);
            }
#pragma unroll
            for (int kk = 0; kk < 2; ++kk) {
                bf16x8 a0, a1;
#pragma unroll
                for (int j = 0; j < 4; ++j) { a0[j] = va[0][kk][0][j]; a0[4 + j] = va[0][kk][1][j]; a1[j] = va[1][kk][0][j]; a1[4 + j] = va[1][kk][1][j]; }
                o0 = __builtin_amdgcn_mfma_f32_32x32x16_bf16(a0, pf[kk], o0, 0, 0, 0);
                o1 = __builtin_amdgcn_mfma_f32_32x32x16_bf16(a1, pf[kk], o1, 0, 0, 0);
            }
        }
        lsum += __shfl_xor(lsum, 32);
        const float inv = 1.f / lsum;
        float* op = p.na + (size_t)((bh / NH) * SEQ + nq) * DNA + hh * HD + 4 * h;
#pragma unroll
        for (int q = 0; q < 4; ++q) {
            *(float4*)(op + 8 * q) = make_float4(o0[4 * q] * inv, o0[4 * q + 1] * inv, o0[4 * q + 2] * inv, o0[4 * q + 3] * inv);
            *(float4*)(op + 32 + 8 * q) = make_float4(o1[4 * q] * inv, o1[4 * q + 1] * inv, o1[4 * q + 2] * inv, o1[4 * q + 3] * inv);
        }
    }
}

__device__ void ph_a2rows(const Params& p, float* lds) {
    const int tid = threadIdx.x, wv = tid >> 6, lane = tid & 63;
    const int nw = gridDim.x * (NT / 64), gw = blockIdx.x * (NT / 64) + wv;
    for (int tok = gw; tok < NTOK; tok += nw) {
        float4 v[3]; float ss = 0.f;
#pragma unroll
        for (int i = 0; i < 3; ++i) { v[i] = *(const float4*)(p.na + (size_t)tok * DNA + 4 * lane + 256 * i); ss += v[i].x * v[i].x + v[i].y * v[i].y + v[i].z * v[i].z + v[i].w * v[i].w; }
        ss = wave_sum(ss);
        const float rn = rsqrtf(ss / (float)DNA + EPS);
#pragma unroll
        for (int i = 0; i < 3; ++i) { const float4 g = *(const float4*)(p.g_out + DF + 4 * lane + 256 * i);
            uint2 w; w.x = cvt_pk_bf16(v[i].x * rn * g.x, v[i].y * rn * g.y); w.y = cvt_pk_bf16(v[i].z * rn * g.z, v[i].w * rn * g.w);
            *(uint2*)(p.A2b + (size_t)tok * D + DF + 4 * lane + 256 * i) = w; }
    }
}

__device__ void ph_outproj(const Params& p, float* ldsf) {
    LAS unsigned char* lds = (LAS unsigned char*)ldsf;
    int tid = threadIdx.x; asm volatile("" : "+v"(tid));
    const int lane = tid & 63, wid = tid >> 6, wr = wid >> 2, wc = wid & 3, r = lane & 31, h = lane >> 5;
    const int srow = tid >> 3, sc = SCS(tid);
    for (int u = blockIdx.x; u < (NTOK / 256) * (D / 256); u += gridDim.x) {
        const int pm = u >> 2, pn = u & 3;
        unsigned po[4], qo[4];
#pragma unroll
        for (int i = 0; i < 4; ++i) { const int rt = srow + 64 * i; po[i] = (unsigned)(pm * 256 + rt) * (unsigned)(D * 2) + sc * 16; qo[i] = (unsigned)(pn * 256 + rt) * (unsigned)(D * 2) + sc * 16; }
        f32x16 acc[4][2];
        gemm256(lds, tid, (const char*)p.A2b, po, (const char*)p.WoutT, qo, D / 64, acc);
        const float* gt1 = p.mod + (pm >> 5) * NMOD * D + 2 * D;
        int opq = 0; asm volatile("" : "+v"(opq));
        const int r_ = r + opq, h_ = h + opq;
#pragma unroll
        for (int j = 0; j < 2; ++j) {
            const int feat = pn * 256 + wc * 64 + j * 32 + r_; const float g = gt1[feat];
#pragma unroll
            for (int i = 0; i < 4; ++i) {
                const unsigned base = (unsigned)((pm * 256 + wr * 128 + i * 32 + 4 * h_) * D + feat);
                const float* xp = p.x + base; float* op = p.x1 + base;
#pragma unroll
                for (int hf = 0; hf < 2; ++hf) {
                    float xv[8];
#pragma unroll
                    for (int v = 0; v < 8; ++v) xv[v] = xp[((v & 3) + 8 * (v >> 2) + 16 * hf) * D];
#pragma unroll
                    for (int v = 0; v < 8; ++v) op[((v & 3) + 8 * (v >> 2) + 16 * hf) * D] = xv[v] + g * acc[i][j][8 * hf + v];
                    asm volatile("" ::: "memory");
                }
            }
        }
    }
}

__device__ void ph_router(const Params& p, float* lds, bool commit = true) {
    const int tid = threadIdx.x, wv = tid >> 6, lane = tid & 63;
    const int nw = gridDim.x * (NT / 64), gw = blockIdx.x * (NT / 64) + wv;
    for (int tok = gw; tok < NTOK; tok += nw) {
        const int b = tok / SEQ;
        const float* sh = p.mod + b * NMOD * D + 3 * D, * sc = sh + D;
        float hv[16]; float ss = 0.f;
#pragma unroll
        for (int i = 0; i < 16; ++i) { hv[i] = p.x1[(size_t)tok * D + lane + 64 * i]; ss = fmaf(hv[i], hv[i], ss); }
        ss = wave_sum(ss);
        const float r = rsqrtf(ss / (float)D + EPS);
#pragma unroll
        for (int i = 0; i < 16; ++i) { const int e = lane + 64 * i; hv[i] = hv[i] * r * p.g_norm2[e] * (1.f + sc[e]) + sh[e]; p.h2b[(size_t)tok * D + e] = f2bf(hv[i]); }
        float lg[4];
#pragma unroll
        for (int o = 0; o < 4; ++o) { float a = 0.f;
#pragma unroll
            for (int i = 0; i < 16; ++i) a = fmaf(hv[i], p.WrT[o * D + lane + 64 * i], a);
            lg[o] = wave_sum(a); }
        int gs = 0; float gm = lg[0];
#pragma unroll
        for (int o = 1; o < 4; ++o) if (lg[o] > gm) { gm = lg[o]; gs = o; }
        float gz = 0.f;
#pragma unroll
        for (int o = 0; o < 4; ++o) gz += expf(lg[o] - gm);
        const float pg = 1.f / gz;
        float le[8];
#pragma unroll
        for (int o = 0; o < 8; ++o) { float a = 0.f;
#pragma unroll
            for (int i = 0; i < 16; ++i) a = fmaf(hv[i], p.WrT[(4 + gs * 8 + o) * D + lane + 64 * i], a);
            le[o] = wave_sum(a); }
        int i0 = 0; float m0 = le[0];
#pragma unroll
        for (int o = 1; o < 8; ++o) if (le[o] > m0) { m0 = le[o]; i0 = o; }
        int i1 = -1; float m1 = -3.0e38f;
#pragma unroll
        for (int o = 0; o < 8; ++o) if (o != i0 && le[o] > m1) { m1 = le[o]; i1 = o; }
        const float e1 = expf(m1 - m0);
        const float g0 = pg / (1.f + e1), g1 = pg * e1 / (1.f + e1);
        if (lane == 0 && commit) {
            const int ea = gs * 8 + i0, eb = gs * 8 + i1;
            const int sa = atomicAdd(&p.cnt[ea], 1); p.list[ea * NTOK + sa] = tok * 2;
            const int sb = atomicAdd(&p.cnt[eb], 1); p.list[eb * NTOK + sb] = tok * 2 + 1;
            p.tokgate[tok * 2] = g0; p.tokgate[tok * 2 + 1] = g1;
        }
    }
}

struct ETile { int e, s0, ns, sbase; };
__device__ __forceinline__ int moe_ntiles(const Params& p) { int t = 0; for (int e = 0; e < NEXP; ++e) t += (p.cnt[e] + 255) >> 8; return t; }
__device__ __forceinline__ ETile moe_tile(const Params& p, int tile) {
    int e = 0, base = 0, sb = 0;
    for (;;) { const int c = p.cnt[e], nc = (c + 255) >> 8; if (tile < base + nc) break; base += nc; sb += c; ++e; }
    ETile t; t.e = e; t.s0 = (tile - base) * 256; t.ns = min(256, p.cnt[e] - t.s0); t.sbase = sb; return t;
}

__device__ void ph_moe_gu(const Params& p, float* ldsf) {
    LAS unsigned char* lds = (LAS unsigned char*)ldsf;
    int tid = threadIdx.x; asm volatile("" : "+v"(tid));
    const int lane = tid & 63, wid = tid >> 6, wr = wid >> 2, wc = wid & 3, r = lane & 31, h = lane >> 5;
    const int srow = tid >> 3, sc = SCS(tid);
    const int nunits = moe_ntiles(p) * 4;
    for (int u = blockIdx.x; u < nunits; u += gridDim.x) {
        const ETile t = moe_tile(p, u >> 2); const int fc = u & 3;
        unsigned po[4], qo[4];
#pragma unroll
        for (int i = 0; i < 4; ++i) {
            const int rt = srow + 64 * i;
            const int ent = rt < t.ns ? p.list[t.e * NTOK + t.s0 + rt] : 0;
            po[i] = (unsigned)(ent >> 1) * (unsigned)(D * 2) + sc * 16;
            const int f = fc * 128 + (rt >> 6) * 32 + (rt & 31), up = (rt >> 5) & 1;
            qo[i] = (unsigned)((up * NEXP + t.e) * DEXP + f) * (unsigned)(D * 2) + sc * 16;
        }
        f32x16 acc[4][2];
        gemm256(lds, tid, (const char*)p.h2b, po, (const char*)p.WgT, qo, D / 64, acc);
        int opq = 0; asm volatile("" : "+v"(opq));
        const int r_ = r + opq, h_ = h + opq;
        const int f = fc * 128 + wc * 32 + r_;
#pragma unroll
        for (int i = 0; i < 4; ++i) {
            const int s = wr * 128 + i * 32 + 4 * h_;
#pragma unroll
            for (int v = 0; v < 16; ++v) {
                const int sv = s + (v & 3) + 8 * (v >> 2);
                const float g = acc[i][0][v], uu = acc[i][1][v];
                if (sv < t.ns) p.act[(unsigned)((t.sbase + t.s0 + sv) * DEXP + f)] = f2bf(g / (1.f + __expf(-g)) * uu);
            }
            asm volatile("" ::: "memory");
        }
    }
}

__device__ void ph_moe_down(const Params& p, float* ldsf) {
    LAS unsigned char* lds = (LAS unsigned char*)ldsf;
    int tid = threadIdx.x; asm volatile("" : "+v"(tid));
    const int lane = tid & 63, wid = tid >> 6, wr = wid >> 2, wc = wid & 3, r = lane & 31, h = lane >> 5;
    const int srow = tid >> 3, sc = SCS(tid);
    const int nunits = moe_ntiles(p) * 4;
    for (int u = blockIdx.x; u < nunits; u += gridDim.x) {
        const ETile t = moe_tile(p, u >> 2); const int pn = u & 3;
        unsigned po[4], qo[4];
#pragma unroll
        for (int i = 0; i < 4; ++i) {
            const int rt = srow + 64 * i;
            po[i] = (unsigned)(t.sbase + t.s0 + (rt < t.ns ? rt : 0)) * (unsigned)(DEXP * 2) + sc * 16;
            qo[i] = (unsigned)(t.e * D + pn * 256 + rt) * (unsigned)(DEXP * 2) + sc * 16;
        }
        f32x16 acc[4][2];
        gemm256(lds, tid, (const char*)p.act, po, (const char*)p.WdT, qo, DEXP / 64, acc);
        int opq = 0; asm volatile("" : "+v"(opq));
        const int r_ = r + opq, h_ = h + opq;
#pragma unroll
        for (int i = 0; i < 4; ++i) {
            const int s = wr * 128 + i * 32 + 4 * h_;
#pragma unroll
            for (int v = 0; v < 16; ++v) {
                const int sv = s + (v & 3) + 8 * (v >> 2);
                if (sv < t.ns) {
                    const int ent = p.list[t.e * NTOK + t.s0 + sv]; const float g = p.tokgate[ent];
                    const unsigned base = (unsigned)ent * D + pn * 256 + wc * 64 + r_;
                    p.ybuf[base] = f2bf(g * acc[i][0][v]); p.ybuf[base + 32] = f2bf(g * acc[i][1][v]);
                }
            }
            asm volatile("" ::: "memory");
        }
    }
}

__device__ void ph_final(const Params& p, float* lds, float* outp) {
    const int tid = threadIdx.x;
    for (int tok = blockIdx.x; tok < NTOK; tok += gridDim.x) {
        const float* gt2 = p.mod + (tok / SEQ) * NMOD * D + 5 * D;
        const unsigned ya = *(const unsigned*)(p.ybuf + (size_t)(2 * tok) * D + 2 * tid), yb = *(const unsigned*)(p.ybuf + (size_t)(2 * tok + 1) * D + 2 * tid);
        const float2 xv = *(const float2*)(p.x1 + (size_t)tok * D + 2 * tid);
        const float m0 = __uint_as_float(ya << 16) + __uint_as_float(yb << 16), m1 = __uint_as_float(ya & 0xffff0000u) + __uint_as_float(yb & 0xffff0000u);
        const float v0 = xv.x + gt2[2 * tid] * m0, v1 = xv.y + gt2[2 * tid + 1] * m1;
        const float ss = block_sum(v0 * v0 + v1 * v1, lds);
        const float rr = rsqrtf(ss / (float)D + EPS);
        *(float2*)(outp + (size_t)tok * D + 2 * tid) = make_float2(v0 * rr * p.g_final[2 * tid], v1 * rr * p.g_final[2 * tid + 1]);
    }
}

extern __shared__ __attribute__((aligned(16))) float smem[];

constexpr int R_P0 = 1, R_INP = 1, R_FOUR = 1, R_ATT = 1, R_OUT = 1, R_MOE = 1, R_RT = 1, R_FIN = 1, R_BAR = 1;
constexpr int LDS_BAR_OFF = 128 * 1024 + 512;
__global__ void __launch_bounds__(NT) mega(Params p) {
    volatile LAS unsigned* st = (volatile LAS unsigned*)((LAS unsigned char*)smem + LDS_BAR_OFF);
    if (threadIdx.x == 0) { st[0] = 0u; st[1] = 0u; }
    __syncthreads();
    const XcdBarrier bar = xcd_barrier_post(p.bar, st);
#define REP(n, call) for (int _r = 0; _r < (n); ++_r) { call; }
    REP(R_P0, ph_adaln_tables(p, smem)) REP(R_BAR, xcd_barrier(bar))
    REP(R_P0, ph_hrows(p, smem)) REP(R_BAR, xcd_barrier(bar))
    REP(R_INP, ph_inproj(p, smem)) REP(R_BAR, xcd_barrier(bar))
    REP(R_FOUR, ph_four1(p, smem)) REP(R_BAR, xcd_barrier(bar))
    REP(R_FOUR, ph_four2(p, smem)) REP(R_BAR, xcd_barrier(bar))
    REP(R_ATT, ph_attn(p, smem)) REP(R_BAR, xcd_barrier(bar))
    REP(R_FOUR, ph_fmix(p, smem); ph_a2rows(p, smem)) REP(R_BAR, xcd_barrier(bar))
    REP(R_OUT, ph_outproj(p, smem)) REP(R_BAR, xcd_barrier(bar))
    REP(R_RT - 1, ph_router(p, smem, false)) ph_router(p, smem); REP(R_BAR, xcd_barrier(bar))
    REP(R_MOE, ph_moe_gu(p, smem)) REP(R_BAR, xcd_barrier(bar))
    REP(R_MOE, ph_moe_down(p, smem)) REP(R_BAR, xcd_barrier(bar))
    REP(R_FIN - 1, ph_final(p, smem, (float*)p.h2b)) ph_final(p, smem, p.out);
}

extern "C" void kernel_launch(void* const* d_in, const int* in_sizes, int n_in, void* d_out, int out_size, void* d_ws, size_t ws_size, hipStream_t stream) {
    constexpr size_t kDynLds = 128 * 1024 + 1024;
    static int grid_blocks = 0;
    if (!grid_blocks) {
        int dev = 0, cus = 0, per_cu = 0;
        (void)hipGetDevice(&dev);
        (void)hipDeviceGetAttribute(&cus, hipDeviceAttributeMultiprocessorCount, dev);
        (void)hipFuncSetAttribute((const void*)mega, hipFuncAttributeMaxDynamicSharedMemorySize, (int)kDynLds);
        (void)hipOccupancyMaxActiveBlocksPerMultiprocessor(&per_cu, (const void*)mega, NT, kDynLds);
        if (per_cu > 1) per_cu = 1;
        grid_blocks = cus * per_cu;
    }
    Params p{};
    p.x = (const float*)d_in[0]; p.c = (const float*)d_in[1]; p.ctx = (const float*)d_in[2]; p.c_ctx = (const float*)d_in[3];
    p.w_ada = (const float*)d_in[4]; p.b_ada = (const float*)d_in[5]; p.g_norm1 = (const float*)d_in[6]; p.w_in = (const float*)d_in[7];
    p.w_fmix = (const float*)d_in[8]; p.rpb = (const float*)d_in[9]; p.g_out = (const float*)d_in[10]; p.w_out = (const float*)d_in[11];
    p.g_norm2 = (const float*)d_in[12]; p.w_rg = (const float*)d_in[13]; p.w_re = (const float*)d_in[14]; p.w_gate = (const float*)d_in[15];
    p.w_up = (const float*)d_in[16]; p.w_down = (const float*)d_in[17]; p.g_final = (const float*)d_in[18];
    p.out = (float*)d_out;
    char* w = (char*)d_ws; size_t o = 0;
    auto take = [&](size_t bytes) { char* r = w + o; o += (bytes + 255) & ~(size_t)255; return r; };
    p.mod = (float*)take(3 * NMOD * D * 4); p.cosN = (float*)take(SEQ * 4); p.sinN = (float*)take(SEQ * 4); p.ropeR = (float*)take(GROWS * 32 * 4); p.ropeC = (float*)take(GW * 32 * 4);
    p.bar = (unsigned*)take(XCD_BAR_WORDS * 4); p.WrT = (float*)take(36 * D * 4); p.cnt = (int*)take(256); p.list = (int*)take((size_t)NEXP * NTOK * 4); p.tokgate = (float*)take(2 * NTOK * 4);
    p.WinT = (bf16_t*)take((size_t)DIN * D * 2); p.WoutT = (bf16_t*)take((size_t)D * D * 2);
    p.W64cs = (bf16_t*)take(256 * 64 * 2); p.G128 = (bf16_t*)take(256 * 256 * 2); p.WmixT = (bf16_t*)take(256 * 512 * 2);
    p.WgT = (bf16_t*)take((size_t)NEXP * DEXP * D * 2); p.WuT = (bf16_t*)take((size_t)NEXP * DEXP * D * 2); p.WdT = (bf16_t*)take((size_t)NEXP * DEXP * D * 2);
    char* R1 = take((size_t)NTOK * D * 4 + 256);
    p.hb = (bf16_t*)R1; p.Zb = (bf16_t*)R1; p.na = (float*)R1; p.P2 = (bf16_t*)(R1 + (size_t)NTOK * DNA * 4); p.h2b = (bf16_t*)R1; p.act = p.h2b + (size_t)NTOK * D;
    const size_t qkv = (size_t)NTOK * DNA * 2;
    char* R2 = take((size_t)NTOK * DF * 2 + 4 * qkv + 2 * (size_t)NCTX * DNA * 2 + 4096);
    p.fX = (bf16_t*)R2; p.Qr = (bf16_t*)(R2 + (size_t)NTOK * DF * 2); p.Qp = p.Qr + (size_t)NTOK * DNA; p.Kr = p.Qp + (size_t)NTOK * DNA; p.Vt = p.Kr + (size_t)NTOK * DNA;
    p.Kc = p.Vt + (size_t)NTOK * DNA; p.Vct = p.Kc + (size_t)NCTX * DNA;
    p.A2b = (bf16_t*)R2; p.x1 = (float*)(R2 + (size_t)NTOK * DF * 2 + 4 * qkv + 2 * (size_t)NCTX * DNA * 2 - (size_t)NTOK * D * 4);
    p.ybuf = (bf16_t*)p.out;
    void* args[] = {&p};
    (void)hipMemsetAsync(p.bar, 0, XCD_BAR_WORDS * 4, stream);
    hipError_t e = hipLaunchCooperativeKernel((const void*)mega, dim3(grid_blocks), dim3(NT), args, kDynLds, stream);
    if (e != hipSuccess) fprintf(stderr, "cooperative launch failed: %s (grid %d)\n", hipGetErrorString(e), grid_blocks);
}
```

```cpp
#include <hip/hip_runtime.h>
#include <cstdio>
#include <cstdint>

constexpr int D = 1024, NBATCH = 2, SEQ = 8192, NTOK = NBATCH * SEQ, LCTX = 256, NCTX = NBATCH * LCTX, NROWS = NTOK + NCTX;
constexpr int DIN = 2560, DF = 256, NH = 12, HD = 64, DNA = 768, QOFF = 256, KOFF = 1024, VOFF = 1792;
constexpr int GW = 64, GROWS = 128, NEXP = 32, DEXP = 512, NMOD = 6;
constexpr float EPS = 1e-6f;
constexpr int NT = 512;
constexpr float QSCALE = 0.125f * 1.4426950408889634f;
typedef unsigned short bf16_t;
typedef short bf16x8 __attribute__((ext_vector_type(8)));
typedef float f32x16 __attribute__((ext_vector_type(16)));
typedef float f32x4 __attribute__((ext_vector_type(4)));
__device__ __forceinline__ unsigned cvt_pk_bf16(float lo, float hi) { unsigned r; asm volatile("v_cvt_pk_bf16_f32 %0, %1, %2" : "=v"(r) : "v"(lo), "v"(hi)); return r; }
__device__ __forceinline__ bf16_t f2bf(float v) { return (bf16_t)(cvt_pk_bf16(v, 0.f) & 0xffffu); }
__device__ __forceinline__ float bf2f(bf16_t v) { return __uint_as_float((unsigned)v << 16); }

struct Params {
    const float *x, *c, *ctx, *c_ctx, *w_ada, *b_ada, *g_norm1, *w_in, *w_fmix, *rpb, *g_out, *w_out, *g_norm2, *w_rg, *w_re, *w_gate, *w_up, *w_down, *g_final;
    float* out;
    float *mod, *cosN, *sinN, *ropeR, *ropeC;
    float *na;
    float *x1;
    int *cnt, *list; float* tokgate; unsigned* bar; float* WrT;
    bf16_t *WinT, *WoutT, *WgT, *WuT, *WdT;
    bf16_t *hb, *A2b;
    bf16_t *h2b, *act, *ybuf;
    bf16_t *fX, *Qr, *Qp, *Kr, *Vt, *Kc, *Vct;
    bf16_t *W64cs, *G128, *WmixT;
    bf16_t *Zb, *P2;
};

__device__ __forceinline__ float wave_sum(float v) {
#pragma unroll
    for (int o = 32; o > 0; o >>= 1) v += __shfl_xor(v, o);
    return v;
}
__device__ __forceinline__ float wave_max(float v) {
#pragma unroll
    for (int o = 32; o > 0; o >>= 1) v = fmaxf(v, __shfl_xor(v, o));
    return v;
}
__device__ __forceinline__ float block_sum(float v, float* red) {
    v = wave_sum(v);
    const int w = threadIdx.x >> 6, l = threadIdx.x & 63;
    __syncthreads();
    if (l == 0) red[w] = v;
    __syncthreads();
    float s = 0.f;
#pragma unroll
    for (int i = 0; i < NT / 64; ++i) s += red[i];
    return s;
}

template <class AF, class BF, class EF>
__device__ void ngemm(float* lds, int M, int N, int K, AF af, BF bf, EF ef) {
    float* As = lds;
    float* Bs = lds + 16 * 132;
    int tid = threadIdx.x; asm volatile("" : "+v"(tid));
    const int ty = tid >> 4, tx = tid & 15;
    const int tn = N / 128, nt = (M / 128) * tn;
    for (int t = blockIdx.x; t < nt; t += gridDim.x) {
        const int m0 = (t / tn) * 128, n0 = (t % tn) * 128;
        float acc[4][8];
#pragma unroll
        for (int i = 0; i < 4; ++i)
#pragma unroll
            for (int j = 0; j < 8; ++j) acc[i][j] = 0.f;
        for (int k0 = 0; k0 < K; k0 += 16) {
#pragma unroll
            for (int i = 0; i < 4; ++i) { const int idx = tid + NT * i, kk = idx & 15, m = idx >> 4; As[kk * 132 + m] = af(m0 + m, k0 + kk); }
#pragma unroll
            for (int i = 0; i < 4; ++i) { const int idx = tid + NT * i, n = idx & 127, kk = idx >> 7; Bs[kk * 128 + n] = bf(m0, k0 + kk, n0 + n); }
            __syncthreads();
#pragma unroll
            for (int kk = 0; kk < 16; ++kk) {
                const float4 a = *(const float4*)(As + kk * 132 + ty * 4);
                const float4 b0 = *(const float4*)(Bs + kk * 128 + tx * 8), b1 = *(const float4*)(Bs + kk * 128 + tx * 8 + 4);
                const float av[4] = {a.x, a.y, a.z, a.w}, bv[8] = {b0.x, b0.y, b0.z, b0.w, b1.x, b1.y, b1.z, b1.w};
#pragma unroll
                for (int i = 0; i < 4; ++i)
#pragma unroll
                    for (int j = 0; j < 8; ++j) acc[i][j] = fmaf(av[i], bv[j], acc[i][j]);
            }
            __syncthreads();
        }
#pragma unroll
        for (int i = 0; i < 4; ++i)
#pragma unroll
            for (int j = 0; j < 8; ++j) ef(m0 + ty * 4 + i, n0 + tx * 8 + j, acc[i][j]);
    }
}

#define LAS __attribute__((address_space(3)))
#define SCS(tid) (((tid) & 7) ^ ((((tid) >> 3) >> 1) & 7))
__device__ __forceinline__ void gemm256(LAS unsigned char* lds, const int tid, const char* Pb, const unsigned (&po)[4], const char* Qb, const unsigned (&qo)[4], int nk, f32x16 (&acc)[4][2]) {
    const int lane = tid & 63, wid = __builtin_amdgcn_readfirstlane(tid >> 6), wr = wid >> 2, wc = wid & 3;
    const int r = lane & 31, h = lane >> 5, swz = (r >> 1) & 7;
    const unsigned ldsw = (unsigned)wid * 1024u;
#pragma unroll
    for (int i = 0; i < 4; ++i)
#pragma unroll
        for (int j = 0; j < 2; ++j)
#pragma unroll
            for (int v = 0; v < 16; ++v) acc[i][j][v] = 0.f;
    __syncthreads();
#pragma unroll
    for (int i = 0; i < 4; ++i) {
        __builtin_amdgcn_global_load_lds((const unsigned*)(Pb + po[i]), (LAS unsigned*)(lds + ldsw + i * 8192), 16, 0, 0);
        __builtin_amdgcn_global_load_lds((const unsigned*)(Qb + qo[i]), (LAS unsigned*)(lds + 32768 + ldsw + i * 8192), 16, 0, 0);
    }
    __syncthreads();
    const int prd = (wr * 128 + r) * 128, qrd = 32768 + (wc * 64 + r) * 128;
    const int ko0 = ((0 + h) ^ swz) << 4, ko1 = ((2 + h) ^ swz) << 4, ko2 = ((4 + h) ^ swz) << 4, ko3 = ((6 + h) ^ swz) << 4;
#define G256_LD(pf, qf, ko) do { _Pragma("unroll") for (int i = 0; i < 4; ++i) pf[i] = *(const LAS bf16x8*)(lds + cb + prd + i * 4096 + (ko)); \
                                 _Pragma("unroll") for (int j = 0; j < 2; ++j) qf[j] = *(const LAS bf16x8*)(lds + cb + qrd + j * 4096 + (ko)); } while (0)
#define G256_MM(pf, qf) do { _Pragma("unroll") for (int i = 0; i < 4; ++i) _Pragma("unroll") for (int j = 0; j < 2; ++j) \
                                 acc[i][j] = __builtin_amdgcn_mfma_f32_32x32x16_bf16(pf[i], qf[j], acc[i][j], 0, 0, 0); } while (0)
#pragma unroll 1
    for (int kt = 0; kt < nk; ++kt) {
        const int cb = (kt & 1) * 65536, nb = 65536 - cb;
        {
            const unsigned koff = (unsigned)min(kt + 1, nk - 1) * 128u;
#pragma unroll
            for (int i = 0; i < 4; ++i) {
                __builtin_amdgcn_global_load_lds((const unsigned*)(Pb + (size_t)(po[i] + koff)), (LAS unsigned*)(lds + nb + ldsw + i * 8192), 16, 0, 0);
                __builtin_amdgcn_global_load_lds((const unsigned*)(Qb + (size_t)(qo[i] + koff)), (LAS unsigned*)(lds + nb + 32768 + ldsw + i * 8192), 16, 0, 0);
            }
        }
        bf16x8 pa[4], qa[2], pb[4], qb[2];
        G256_LD(pa, qa, ko0);
        G256_LD(pb, qb, ko1);
        G256_MM(pa, qa);
        G256_LD(pa, qa, ko2);
        G256_MM(pb, qb);
        G256_LD(pb, qb, ko3);
        G256_MM(pa, qa);
        G256_MM(pb, qb);
        __syncthreads();
    }
    asm volatile("" ::: "memory");
}

#define XB_TMO      128
#define XB_XCNT(j)  (256  + 64 * (j))
#define XB_XSUB(j)  (1280 + 64 * (j))
#define XB_XGEN(j)  (2304 + 64 * (j))
#define XB_TOP      3328
#define XB_TOPGEN   3392
#define XCD_BAR_WORDS 3456
#define XB_SPIN_CAP (1u << 18)
__device__ __forceinline__ unsigned xb_ld(unsigned* p)              { return __hip_atomic_load(p, __ATOMIC_RELAXED, __HIP_MEMORY_SCOPE_AGENT); }
__device__ __forceinline__ unsigned xb_add(unsigned* p, unsigned v) { return __hip_atomic_fetch_add(p, v, __ATOMIC_RELAXED, __HIP_MEMORY_SCOPE_AGENT); }
__device__ __forceinline__ unsigned xb_xcc_id() { return (unsigned)__builtin_amdgcn_s_getreg((3 << 11) | 20) & 0xFu; }
#define XB_SPIN(cond, bar) do { unsigned _sp = 0; while (cond) { __builtin_amdgcn_s_sleep(1); \
    if ((++_sp & 255u) == 0u) { if (xb_ld(&(bar)[XB_TMO])) break; if (_sp > XB_SPIN_CAP) { atomicAdd(&(bar)[XB_TMO], 1u); break; } } } } while (0)
struct XcdBarrier { unsigned* bar; unsigned x; volatile LAS unsigned* st; };
__device__ __forceinline__ XcdBarrier xcd_barrier_post(unsigned* bar, volatile LAS unsigned* st) {
    XcdBarrier b; b.bar = bar; b.x = xb_xcc_id(); b.st = st;
    if (threadIdx.x == 0) (void)xb_add(&bar[XB_XCNT(b.x)], 1u);
    return b;
}
__device__ __forceinline__ void xcd_barrier_complete(unsigned* bar, unsigned x, unsigned& nloc, unsigned& nx) {
    const unsigned G = gridDim.x * gridDim.y * gridDim.z;
    unsigned sum, cnt, mine, sp = 0u;
    for (;;) {
        sum = 0u; cnt = 0u; mine = 0u;
#pragma unroll
        for (unsigned j = 0; j < 16; ++j) { const unsigned c = xb_ld(&bar[XB_XCNT(j)]); sum += c; cnt += (c > 0u) ? 1u : 0u; mine = (j == x) ? c : mine; }
        if (sum == G) break;
        __builtin_amdgcn_s_sleep(1);
        if ((++sp & 255u) == 0u) { if (xb_ld(&bar[XB_TMO])) break; if (sp > XB_SPIN_CAP) { atomicAdd(&bar[XB_TMO], 1u); break; } }
    }
    nloc = mine > 0u ? mine : 1u; nx = cnt > 0u ? cnt : 1u;
}
__device__ __forceinline__ void xcd_barrier(const XcdBarrier& b) {
    asm volatile("s_waitcnt vmcnt(0)" ::: "memory");
    __syncthreads();
    if (threadIdx.x == 0) {
        unsigned* bar = b.bar;
        __builtin_amdgcn_s_waitcnt(0);
        unsigned nloc = b.st[0], nx = b.st[1];
        if (nloc == 0u) { xcd_barrier_complete(bar, b.x, nloc, nx); b.st[0] = nloc; b.st[1] = nx; }
        const unsigned old = xb_add(&bar[XB_XSUB(b.x)], 1u);
        const unsigned gen = old / nloc;
        if (old + 1u == (gen + 1u) * nloc) {
            __builtin_amdgcn_fence(__ATOMIC_RELEASE, "agent");
            asm volatile("s_waitcnt vmcnt(0)" ::: "memory");
            const unsigned og = xb_add(&bar[XB_TOP], 1u);
            const unsigned tg = og / nx;
            if (og + 1u == (tg + 1u) * nx) xb_add(&bar[XB_TOPGEN], 1u);
            else XB_SPIN(xb_ld(&bar[XB_TOPGEN]) == tg, bar);
            __builtin_amdgcn_fence(__ATOMIC_ACQUIRE, "agent");
            xb_add(&bar[XB_XGEN(b.x)], 1u);
            asm volatile("s_waitcnt vmcnt(0)" ::: "memory");
        } else {
            XB_SPIN(xb_ld(&bar[XB_XGEN(b.x)]) == gen, bar);
            __builtin_amdgcn_fence(__ATOMIC_ACQUIRE, "agent");
            asm volatile("s_waitcnt vmcnt(0)" ::: "memory");
        }
    }
    __syncthreads();
}

__device__ void transpose_job(float* lds, const float* src, bf16_t* dst, int R, int C, int batch, int& tbase, int gstride, int& next) {
    int tid = threadIdx.x; asm volatile("" : "+v"(tid));
    const int tr = R / 64, tc = C / 256, ntile = batch * tr * tc;
    while (next < tbase + ntile) {
        const int t = next - tbase; next += gstride;
        const int bb = t / (tr * tc), rem = t % (tr * tc), r0 = (rem / tc) * 64, c0 = (rem % tc) * 256;
        const float* s = src + (size_t)bb * R * C + (size_t)r0 * C + c0; bf16_t* d = dst + (size_t)bb * R * C + (size_t)c0 * R + r0;
        float4 v[8];
#pragma unroll
        for (int i = 0; i < 8; ++i) { const int rr = (tid >> 6) + 8 * i, c4 = (tid & 63) * 4; v[i] = *(const float4*)(s + (size_t)rr * C + c4); }
        __syncthreads();
#pragma unroll
        for (int i = 0; i < 8; ++i) { const int rr = (tid >> 6) + 8 * i, c4 = (tid & 63) * 4; float* q = lds + rr * 257 + c4; q[0] = v[i].x; q[1] = v[i].y; q[2] = v[i].z; q[3] = v[i].w; }
        __syncthreads();
#pragma unroll
        for (int i = 0; i < 4; ++i) { const int cc = (tid >> 3) + 64 * i, r8 = (tid & 7) * 8; const float* q = lds + r8 * 257 + cc;
            uint4 w; w.x = cvt_pk_bf16(q[0], q[257]); w.y = cvt_pk_bf16(q[2 * 257], q[3 * 257]); w.z = cvt_pk_bf16(q[4 * 257], q[5 * 257]); w.w = cvt_pk_bf16(q[6 * 257], q[7 * 257]);
            *(uint4*)(d + (size_t)cc * R + r8) = w; }
    }
    tbase += ntile;
}

__device__ void ph_adaln_tables(const Params& p, float* lds) {
    int tid = threadIdx.x; asm volatile("" : "+v"(tid));
    const int gid = blockIdx.x * NT + tid, gsz = gridDim.x * NT;
    if (blockIdx.x < NMOD * D / 32) {
        for (int i = tid; i < 3 * D; i += NT) { const int r = i / D, k = i % D; const float v = r < 2 ? p.c[r * D + k] : p.c_ctx[k]; lds[i] = v / (1.f + expf(-v)); }
        __syncthreads();
        const int col = blockIdx.x * 32 + (tid & 31), kg = tid >> 5;
        float a0 = 0.f, a1 = 0.f, a2 = 0.f;
#pragma unroll 8
        for (int kk = 0; kk < 64; ++kk) { const int k = kg * 64 + kk; const float w = p.w_ada[(size_t)k * (NMOD * D) + col]; a0 = fmaf(lds[k], w, a0); a1 = fmaf(lds[D + k], w, a1); a2 = fmaf(lds[2 * D + k], w, a2); }
        float* red = lds + 3 * D;
        red[(0 * 16 + kg) * 32 + (tid & 31)] = a0; red[(1 * 16 + kg) * 32 + (tid & 31)] = a1; red[(2 * 16 + kg) * 32 + (tid & 31)] = a2;
        __syncthreads();
        if (tid < 96) { const int rr = tid >> 5, cc = tid & 31; float s = 0.f;
#pragma unroll
            for (int g = 0; g < 16; ++g) s += red[(rr * 16 + g) * 32 + cc];
            p.mod[rr * NMOD * D + blockIdx.x * 32 + cc] = s + p.b_ada[blockIdx.x * 32 + cc]; }
        __syncthreads();
    }
    for (int i = gid; i < 36 * D; i += gsz) { const int o = i / D, k = i % D; p.WrT[i] = o < 4 ? p.w_rg[k * 4 + o] : p.w_re[k * NEXP + o - 4]; }
    for (int i = gid; i < SEQ; i += gsz) { p.cosN[i] = cospif(2.f * (float)i / (float)SEQ); p.sinN[i] = sinpif(2.f * (float)i / (float)SEQ); }
    for (int i = gid; i < (GROWS + GW) * 16; i += gsz) {
        const int pos = i / 16, f = i % 16; const float inv = powf(10000.f, -(float)f / 16.f);
        if (pos < GROWS) { const float a = (float)pos * inv; p.ropeR[2 * i] = cosf(a); p.ropeR[2 * i + 1] = sinf(a); }
        else { const int pc = pos - GROWS; const float a = (float)pc * inv; p.ropeC[2 * (pc * 16 + f)] = cosf(a); p.ropeC[2 * (pc * 16 + f) + 1] = sinf(a); }
    }
    if (gid < NEXP) p.cnt[gid * 64] = 0;
    for (int i = gid; i < 256 * 64; i += gsz) {
        const int rho = i >> 6, n1 = i & 63, blk = rho >> 5, k1 = (blk >> 1) * 32 + (rho & 31);
        float v = 0.f;
        if (blk < 4) { const float a = 2.f * (float)((k1 * n1) & 63) / 64.f; v = (blk & 1) ? -sinpif(a) : cospif(a); }
        p.W64cs[i] = f2bf(v);
    }
    for (int i = gid; i < 256 * 256; i += gsz) {
        const int rho = i >> 8, kap = i & 255, ro = rho >> 7, k2 = rho & 127, ri = kap >> 7, n2 = kap & 127;
        const float a = 2.f * (float)((k2 * n2) & 127) / 128.f; const float c = cospif(a), s = sinpif(a);
        p.G128[i] = f2bf(ro == ri ? c : (ro == 0 ? s : -s));
    }
    for (int i = gid; i < 256 * 512; i += gsz) {
        const int j = i >> 9, kap = i & 511, ro = kap >> 8, ch = kap & 255, g = ch >> 6, c = ch & 63;
        float acc = 0.f;
        for (int l = 0; l < 64; ++l) { const float a = 2.f * (float)((l * c) & 63) / 64.f; acc = fmaf(ro ? sinpif(a) : cospif(a), p.w_fmix[(size_t)(64 * g + l) * DF + j], acc); }
        p.WmixT[i] = f2bf(acc * (1.0f / 724.0773439350247f));
    }
    __syncthreads();
    int tbase = 0, next = blockIdx.x;
    transpose_job(lds, p.w_in, p.WinT, D, DIN, 1, tbase, gridDim.x, next);
    transpose_job(lds, p.w_out, p.WoutT, D, D, 1, tbase, gridDim.x, next);
    transpose_job(lds, p.w_gate, p.WgT, D, DEXP, NEXP, tbase, gridDim.x, next);
    transpose_job(lds, p.w_up, p.WuT, D, DEXP, NEXP, tbase, gridDim.x, next);
    transpose_job(lds, p.w_down, p.WdT, DEXP, D, NEXP, tbase, gridDim.x, next);
}

__device__ void ph_hrows(const Params& p, float* lds) {
    int tid = threadIdx.x; asm volatile("" : "+v"(tid));
    for (int row = blockIdx.x; row < NROWS; row += gridDim.x) {
        const float* src = row < NTOK ? p.x + (size_t)row * D : p.ctx + (size_t)(row - NTOK) * D;
        const int mr = row < NTOK ? row / SEQ : 2;
        const float* sh = p.mod + mr * NMOD * D, * sc = sh + D;
        const float2 v = *(const float2*)(src + 2 * tid);
        const float ss = block_sum(v.x * v.x + v.y * v.y, lds);
        const float r = rsqrtf(ss / (float)D + EPS);
        const float o0 = v.x * r * p.g_norm1[2 * tid] * (1.f + sc[2 * tid]) + sh[2 * tid];
        const float o1 = v.y * r * p.g_norm1[2 * tid + 1] * (1.f + sc[2 * tid + 1]) + sh[2 * tid + 1];
        *(unsigned*)(p.hb + (size_t)row * D + 2 * tid) = cvt_pk_bf16(o0, o1);
    }
}

__device__ void ph_inproj(const Params& p, float* ldsf) {
    LAS unsigned char* lds = (LAS unsigned char*)ldsf;
    int tid = threadIdx.x; asm volatile("" : "+v"(tid));
    const int lane = tid & 63, wid = tid >> 6, wr = wid >> 2, wc = wid & 3, r = lane & 31, h = lane >> 5;
    const int srow = tid >> 3, sc = SCS(tid);
    constexpr int NPM = NROWS / 256, NPN = DIN / 256;
    for (int u = blockIdx.x; u < NPM * NPN; u += gridDim.x) {
        const int pm = u / NPN, pn = u % NPN;
        if (pm >= 64 && pn < 4) continue;
        unsigned po[4], qo[4];
#pragma unroll
        for (int i = 0; i < 4; ++i) {
            const int rt = srow + 64 * i;
            po[i] = (unsigned)((pn * 256 + rt) * D * 2 + sc * 16);
            int rowidx;
            if (pn == 0) rowidx = (pm >> 5) * SEQ + 128 * (rt & 63) + 4 * (pm & 31) + (rt >> 6);
            else rowidx = pm * 256 + rt;
            qo[i] = (unsigned)rowidx * (unsigned)(D * 2) + sc * 16;
        }
        f32x16 acc[4][2];
        gemm256(lds, tid, (const char*)p.WinT, po, (const char*)p.hb, qo, D / 64, acc);
        int opq = 0; asm volatile("" : "+v"(opq));
        const int r_ = r + opq, h_ = h + opq;
        if (pn == 0) {
            const int b = pm >> 5, n2 = 4 * (pm & 31) + wc;
#pragma unroll
            for (int i = 0; i < 4; ++i) {
#pragma unroll
                for (int j = 0; j < 2; ++j) {
                    const unsigned base = (unsigned)(((b * DF + wr * 128 + i * 32 + 4 * h_) * 128 + n2) * 64 + j * 32 + r_);
#pragma unroll
                    for (int v = 0; v < 16; ++v) p.fX[base + (unsigned)(((v & 3) + 8 * (v >> 2)) * 128 * 64)] = f2bf(acc[i][j][v]);
                }
                asm volatile("" ::: "memory");
            }
        } else if (pn < 7) {
            const bool isq = pn < 4; const int hg = ((pn - 1) % 3) * 4 + wr * 2;
            const bool isctx = pm >= 64;
            const int b = isctx ? pm - 64 : (pm >> 5);
#pragma unroll
            for (int j = 0; j < 2; ++j) {
                const int n = (isctx ? 0 : (pm & 31) * 256) + wc * 64 + j * 32 + r_;
                const int grow = n >> 6, gcol = n & 63;
#pragma unroll
                for (int i = 0; i < 4; ++i) {
                    const int hh = hg + (i >> 1), blk = i & 1;
                    if (isctx) {
                        const unsigned base = (unsigned)(((b * NH + hh) * LCTX + n) * HD + blk * 32 + 4 * h_);
#pragma unroll
                        for (int q = 0; q < 4; ++q) {
                            uint2 w;
                            w.x = cvt_pk_bf16(acc[i][j][4 * q], acc[i][j][4 * q + 1]); w.y = cvt_pk_bf16(acc[i][j][4 * q + 2], acc[i][j][4 * q + 3]);
                            *(uint2*)(p.Kc + base + 8 * q) = w;
                        }
                    } else {
                        const float* tb = (blk == 0 ? p.ropeR + 32 * grow : p.ropeC + 32 * gcol) + 8 * h_;
                        float o1[8], o2[8];
#pragma unroll
                        for (int v = 0; v < 8; ++v) {
                            const float2 cs = *(const float2*)(tb + 2 * ((v & 3) + 8 * (v >> 2)));
                            const float x1 = acc[i][j][v], x2 = acc[i][j][v + 8];
                            o1[v] = x1 * cs.x - x2 * cs.y; o2[v] = x1 * cs.y + x2 * cs.x;
                        }
                        const unsigned base = (unsigned)(((b * NH + hh) * SEQ + n) * HD + blk * 32 + 4 * h_);
                        if (isq) {
#pragma unroll
                            for (int q = 0; q < 2; ++q) {
                                uint2 w;
                                w.x = cvt_pk_bf16(o1[4 * q] * QSCALE, o1[4 * q + 1] * QSCALE); w.y = cvt_pk_bf16(o1[4 * q + 2] * QSCALE, o1[4 * q + 3] * QSCALE);
                                *(uint2*)(p.Qr + base + 8 * q) = w;
                                w.x = cvt_pk_bf16(o2[4 * q] * QSCALE, o2[4 * q + 1] * QSCALE); w.y = cvt_pk_bf16(o2[4 * q + 2] * QSCALE, o2[4 * q + 3] * QSCALE);
                                *(uint2*)(p.Qr + base + 16 + 8 * q) = w;
                            }
#pragma unroll
                            for (int q = 0; q < 4; ++q) {
                                uint2 w;
                                w.x = cvt_pk_bf16(acc[i][j][4 * q] * QSCALE, acc[i][j][4 * q + 1] * QSCALE); w.y = cvt_pk_bf16(acc[i][j][4 * q + 2] * QSCALE, acc[i][j][4 * q + 3] * QSCALE);
                                *(uint2*)(p.Qp + base + 8 * q) = w;
                            }
                        } else {
#pragma unroll
                            for (int q = 0; q < 2; ++q) {
                                uint2 w;
                                w.x = cvt_pk_bf16(o1[4 * q], o1[4 * q + 1]); w.y = cvt_pk_bf16(o1[4 * q + 2], o1[4 * q + 3]);
                                *(uint2*)(p.Kr + base + 8 * q) = w;
                                w.x = cvt_pk_bf16(o2[4 * q], o2[4 * q + 1]); w.y = cvt_pk_bf16(o2[4 * q + 2], o2[4 * q + 3]);
                                *(uint2*)(p.Kr + base + 16 + 8 * q) = w;
                            }
                        }
                    }
                    asm volatile("" ::: "memory");
                }
            }
        } else {
            const int hg = (pn - 7) * 4 + wr * 2;
            const bool isctx = pm >= 64;
            const int b = isctx ? pm - 64 : (pm >> 5);
            const int ld = isctx ? LCTX : SEQ; bf16_t* vb = isctx ? p.Vct : p.Vt;
#pragma unroll
            for (int j = 0; j < 2; ++j) {
                const int n = (isctx ? 0 : (pm & 31) * 256) + wc * 64 + j * 32 + r_;
#pragma unroll
                for (int i = 0; i < 4; ++i) {
                    const unsigned base = (unsigned)(((b * NH + hg + (i >> 1)) * HD + (i & 1) * 32 + 4 * h_) * ld + n);
#pragma unroll
                    for (int v = 0; v < 16; ++v) vb[base + (unsigned)(((v & 3) + 8 * (v >> 2)) * ld)] = f2bf(acc[i][j][v]);
                    asm volatile("" ::: "memory");
                }
            }
        }
    }
}

__device__ void ph_four1(const Params& p, float* ldsf) {
    LAS unsigned char* lds = (LAS unsigned char*)ldsf;
    int tid = threadIdx.x; asm volatile("" : "+v"(tid));
    const int lane = tid & 63, wid = tid >> 6, wr = wid >> 2, wc = wid & 3, r = lane & 31, h = lane >> 5;
    const int srow = tid >> 3, sc = SCS(tid);
    for (int u = blockIdx.x; u < NBATCH * DF * 128 / 256; u += gridDim.x) {
        unsigned po[4], qo[4];
#pragma unroll
        for (int i = 0; i < 4; ++i) { const int rt = srow + 64 * i; po[i] = (unsigned)rt * 128u + sc * 16; qo[i] = (unsigned)(u * 256 + rt) * 128u + sc * 16; }
        f32x16 acc[4][2];
        gemm256(lds, tid, (const char*)p.W64cs, po, (const char*)p.fX, qo, 1, acc);
        if (wr == 0) {
            int opq = 0; asm volatile("" : "+v"(opq));
            const int r_ = r + opq, h_ = h + opq;
#pragma unroll
            for (int j = 0; j < 2; ++j) {
                const int qrow = u * 256 + wc * 64 + j * 32 + r_;
                const int n2 = qrow & 127, bc = qrow >> 7;
#pragma unroll
                for (int a = 0; a < 2; ++a) {
#pragma unroll
                    for (int v = 0; v < 16; ++v) {
                        const int k1 = a * 32 + (v & 3) + 8 * (v >> 2) + 4 * h_;
                        const int idx = n2 * k1;
                        const float cs = p.cosN[idx], sn = p.sinN[idx];
                        const float yr = acc[2 * a][j][v], yi = acc[2 * a + 1][j][v];
                        const unsigned base = (unsigned)((bc * 64 + k1) * 256 + n2);
                        p.Zb[base] = f2bf(yr * cs + yi * sn); p.Zb[base + 128] = f2bf(yi * cs - yr * sn);
                    }
                    asm volatile("" ::: "memory");
                }
            }
        }
    }
}

__device__ void ph_four2(const Params& p, float* ldsf) {
    LAS unsigned char* lds = (LAS unsigned char*)ldsf;
    int tid = threadIdx.x; asm volatile("" : "+v"(tid));
    const int lane = tid & 63, wid = tid >> 6, wr = wid >> 2, wc = wid & 3, r = lane & 31, h = lane >> 5;
    const int srow = tid >> 3, sc = SCS(tid);
    for (int u = blockIdx.x; u < NBATCH * 64; u += gridDim.x) {
        const int b = u >> 6, k1 = u & 63;
        unsigned po[4], qo[4];
#pragma unroll
        for (int i = 0; i < 4; ++i) { const int rt = srow + 64 * i; po[i] = (unsigned)rt * 512u + sc * 16; qo[i] = (unsigned)(((b * DF + rt) * 64 + k1) * 512) + sc * 16; }
        f32x16 acc[4][2];
        gemm256(lds, tid, (const char*)p.G128, po, (const char*)p.Zb, qo, 4, acc);
        int opq = 0; asm volatile("" : "+v"(opq));
        const int r_ = r + opq, h_ = h + opq;
#pragma unroll
        for (int i = 0; i < 4; ++i) {
#pragma unroll
            for (int j = 0; j < 2; ++j) {
                bf16_t* dst = p.P2 + (unsigned)((b * SEQ + k1 + 64 * (i * 32 + 4 * h_)) * 512 + wr * 256 + wc * 64 + j * 32 + r_);
#pragma unroll
                for (int v = 0; v < 16; ++v) dst[((v & 3) + 8 * (v >> 2)) * 64 * 512] = f2bf(acc[i][j][v]);
                asm volatile("" ::: "memory");
            }
        }
    }
}

__device__ void ph_fmix(const Params& p, float* ldsf) {
    LAS unsigned char* lds = (LAS unsigned char*)ldsf;
    int tid = threadIdx.x; asm volatile("" : "+v"(tid));
    const int lane = tid & 63, wid = tid >> 6, wr = wid >> 2, wc = wid & 3, r = lane & 31, h = lane >> 5;
    const int srow = tid >> 3, sc = SCS(tid);
    for (int u = blockIdx.x; u < NTOK / 256; u += gridDim.x) {
        unsigned po[4], qo[4];
#pragma unroll
        for (int i = 0; i < 4; ++i) { const int rt = srow + 64 * i; po[i] = (unsigned)rt * 1024u + sc * 16; qo[i] = (unsigned)(u * 256 + rt) * 1024u + sc * 16; }
        f32x16 acc[4][2];
        gemm256(lds, tid, (const char*)p.WmixT, po, (const char*)p.P2, qo, 8, acc);
        float ss[2];
#pragma unroll
        for (int j = 0; j < 2; ++j) { float s = 0.f;
#pragma unroll
            for (int i = 0; i < 4; ++i)
#pragma unroll
                for (int v = 0; v < 16; ++v) s = fmaf(acc[i][j][v], acc[i][j][v], s);
            ss[j] = s + __shfl_xor(s, 32); }
        float* red = ldsf;
        if (h == 0) { red[wr * 256 + wc * 64 + r] = ss[0]; red[wr * 256 + wc * 64 + 32 + r] = ss[1]; }
        __syncthreads();
        int opq = 0; asm volatile("" : "+v"(opq));
        const int r_ = r + opq, h_ = h + opq;
#pragma unroll
        for (int j = 0; j < 2; ++j) {
            const int tl = wc * 64 + j * 32 + r_;
            const float rstd = rsqrtf((red[tl] + red[256 + tl]) / (float)DF + EPS);
            bf16_t* dst = p.A2b + (unsigned)((u * 256 + tl) * D + wr * 128 + 4 * h_);
            const float* gp = p.g_out + wr * 128 + 4 * h_;
#pragma unroll
            for (int i = 0; i < 4; ++i) {
#pragma unroll
                for (int q = 0; q < 4; ++q) {
                    const float4 g = *(const float4*)(gp + i * 32 + 8 * q);
                    uint2 w; w.x = cvt_pk_bf16(acc[i][j][4 * q] * rstd * g.x, acc[i][j][4 * q + 1] * rstd * g.y); w.y = cvt_pk_bf16(acc[i][j][4 * q + 2] * rstd * g.z, acc[i][j][4 * q + 3] * rstd * g.w);
                    *(uint2*)(dst + i * 32 + 8 * q) = w;
                }
                asm volatile("" ::: "memory");
            }
        }
    }
}

typedef short s16x4 __attribute__((ext_vector_type(4)));
constexpr float LOG2E = 1.4426950408889634f;
__device__ void ph_attn(const Params& p, float* ldsf) {
    int tid = threadIdx.x; asm volatile("" : "+v"(tid));
    const int lane = tid & 63, wv = tid >> 6, l31 = lane & 31, h = lane >> 5;
    __syncthreads();
    for (int i = tid; i < NH * 15 * 128; i += NT) { const int dcx = (i & 127) - 48, dr = (i >> 7) % 15, hh = i / (15 * 128);
        ldsf[i] = (dcx >= 0 && dcx <= 30) ? p.rpb[(hh * 15 + dr) * 31 + dcx] * LOG2E : 0.f; }
    __syncthreads();
    const int half = wv & 1;
    for (int g = blockIdx.x; g < NBATCH * NH * (GROWS / 4); g += gridDim.x) {
        const int bh = g / (GROWS / 4), row = (g % (GROWS / 4)) * 4 + (wv >> 1), hh = bh % NH;
        const int rs = min(max(row - 4, 0), GROWS - 8);
        const int qc = 32 * half + l31, cs = min(max(qc - 8, 0), GW - 16);
        const int nq = row * GW + qc;
        const bf16_t* Kh = p.Kr + (size_t)bh * SEQ * HD; const bf16_t* Vh = p.Vt + (size_t)bh * HD * SEQ;
        const bf16_t* Kch = p.Kc + (size_t)bh * LCTX * HD; const bf16_t* Vch = p.Vct + (size_t)bh * HD * LCTX;
        bf16x8 qr[4], qp[4];
#pragma unroll
        for (int s = 0; s < 4; ++s) { qr[s] = *(const bf16x8*)(p.Qr + ((size_t)bh * SEQ + nq) * HD + 16 * s + 8 * h); qp[s] = *(const bf16x8*)(p.Qp + ((size_t)bh * SEQ + nq) * HD + 16 * s + 8 * h); }
        f32x16 o0, o1;
#pragma unroll
        for (int v = 0; v < 16; ++v) { o0[v] = 0.f; o1[v] = 0.f; }
        float m = -1e30f, lsum = 0.f;
        const float* rph = ldsf + hh * 15 * 128;
        for (int t = 0; t < 20; ++t) {
            const bool loc = t < 12;
            const bf16_t* kptr; const bf16_t* vptr0; int vstr;
            int krow0 = 0, blk = 0;
            if (loc) { const int pr = t / 3; blk = half + (t - 3 * pr); krow0 = rs + 2 * pr;
                kptr = Kh + (size_t)((krow0 + (l31 >> 4)) * GW + 16 * blk + (l31 & 15)) * HD + 8 * h;
                vptr0 = Vh + (size_t)l31 * SEQ + krow0 * GW + 16 * blk + 4 * h; vstr = SEQ;
            } else { const int m0 = 32 * (t - 12);
                kptr = Kch + (size_t)(m0 + l31) * HD + 8 * h;
                vptr0 = Vch + (size_t)l31 * LCTX + m0 + 4 * h; vstr = LCTX; }
            const int krs = loc ? GW : 16;
            bf16x8 kf[4];
#pragma unroll
            for (int s = 0; s < 4; ++s) kf[s] = *(const bf16x8*)(kptr + 16 * s);
            s16x4 va[2][2][2];
#pragma unroll
            for (int dt = 0; dt < 2; ++dt)
#pragma unroll
                for (int kk = 0; kk < 2; ++kk)
#pragma unroll
                    for (int pt = 0; pt < 2; ++pt) va[dt][kk][pt] = *(const s16x4*)(vptr0 + (size_t)dt * 32 * vstr + kk * krs + 8 * pt);
            f32x16 sa;
#pragma unroll
            for (int v = 0; v < 16; ++v) sa[v] = 0.f;
#pragma unroll
            for (int s = 0; s < 4; ++s) sa = __builtin_amdgcn_mfma_f32_32x32x16_bf16(kf[s], loc ? qr[s] : qp[s], sa, 0, 0, 0);
            float tmax;
            if (loc) {
                const float* bp = rph + (krow0 - row + 7) * 128 + (16 * blk + 4 * h - qc + 15 + 48);
#pragma unroll
                for (int v = 0; v < 16; ++v) sa[v] += bp[(v >> 3) * 128 + (v & 3) + 8 * ((v >> 2) & 1)];
            }
            tmax = sa[0];
#pragma unroll
            for (int v = 1; v < 16; ++v) tmax = fmaxf(tmax, sa[v]);
            tmax = fmaxf(tmax, __shfl_xor(tmax, 32));
            const float mn = fmaxf(m, tmax), alpha = __builtin_amdgcn_exp2f(m - mn);
            m = mn;
            float ps = 0.f;
            const int w0 = 16 * blk + 4 * h - cs;
#pragma unroll
            for (int v = 0; v < 16; ++v) {
                float e = __builtin_amdgcn_exp2f(sa[v] - mn);
                if (loc) e = ((unsigned)(w0 + (v & 3) + 8 * ((v >> 2) & 1)) < 16u) ? e : 0.f;
                sa[v] = e; ps += e;
            }
            lsum = lsum * alpha + ps;
#pragma unroll
            for (int v = 0; v < 16; ++v) { o0[v] *= alpha; o1[v] *= alpha; }
            bf16x8 pf[2];
#pragma unroll
            for (int kk = 0; kk < 2; ++kk) {
                const unsigned w0_ = cvt_pk_bf16(sa[8 * kk + 0], sa[8 * kk + 1]), w1_ = cvt_pk_bf16(sa[8 * kk + 2], sa[8 * kk + 3]);
                const unsigned w2_ = cvt_pk_bf16(sa[8 * kk + 4], sa[8 * kk + 5]), w3_ = cvt_pk_bf16(sa[8 * kk + 6], sa[8 * kk + 7]);
                const uint4 w = make_uint4(w0_, w1_, w2_, w3_);
                pf[kk] = __builtin_bit_cast(bf16x8, w);
            }
#pragma unroll
            for (int kk = 0; kk < 2; ++kk) {
                bf16x8 a0, a1;
#pragma unroll
                for (int j = 0; j < 4; ++j) { a0[j] = va[0][kk][0][j]; a0[4 + j] = va[0][kk][1][j]; a1[j] = va[1][kk][0][j]; a1[4 + j] = va[1][kk][1][j]; }
                o0 = __builtin_amdgcn_mfma_f32_32x32x16_bf16(a0, pf[kk], o0, 0, 0, 0);
                o1 = __builtin_amdgcn_mfma_f32_32x32x16_bf16(a1, pf[kk], o1, 0, 0, 0);
            }
        }
        lsum += __shfl_xor(lsum, 32);
        const float inv = 1.f / lsum;
        float* op = p.na + (size_t)((bh / NH) * SEQ + nq) * DNA + hh * HD + 4 * h;
#pragma unroll
        for (int q = 0; q < 4; ++q) {
            *(float4*)(op + 8 * q) = make_float4(o0[4 * q] * inv, o0[4 * q + 1] * inv, o0[4 * q + 2] * inv, o0[4 * q + 3] * inv);
            *(float4*)(op + 32 + 8 * q) = make_float4(o1[4 * q] * inv, o1[4 * q + 1] * inv, o1[4 * q + 2] * inv, o1[4 * q + 3] * inv);
        }
    }
}

__device__ void ph_a2rows(const Params& p, float* lds) {
    int tid = threadIdx.x; asm volatile("" : "+v"(tid));
    const int wv = tid >> 6, lane = tid & 63;
    const int nw = gridDim.x * (NT / 64), gw = blockIdx.x * (NT / 64) + wv;
    for (int tok = gw; tok < NTOK; tok += nw) {
        float4 v[3]; float ss = 0.f;
#pragma unroll
        for (int i = 0; i < 3; ++i) { v[i] = *(const float4*)(p.na + (size_t)tok * DNA + 4 * lane + 256 * i); ss += v[i].x * v[i].x + v[i].y * v[i].y + v[i].z * v[i].z + v[i].w * v[i].w; }
        ss = wave_sum(ss);
        const float rn = rsqrtf(ss / (float)DNA + EPS);
#pragma unroll
        for (int i = 0; i < 3; ++i) { const float4 g = *(const float4*)(p.g_out + DF + 4 * lane + 256 * i);
            uint2 w; w.x = cvt_pk_bf16(v[i].x * rn * g.x, v[i].y * rn * g.y); w.y = cvt_pk_bf16(v[i].z * rn * g.z, v[i].w * rn * g.w);
            *(uint2*)(p.A2b + (size_t)tok * D + DF + 4 * lane + 256 * i) = w; }
    }
}

__device__ void ph_outproj(const Params& p, float* ldsf) {
    LAS unsigned char* lds = (LAS unsigned char*)ldsf;
    int tid = threadIdx.x; asm volatile("" : "+v"(tid));
    const int lane = tid & 63, wid = tid >> 6, wr = wid >> 2, wc = wid & 3, r = lane & 31, h = lane >> 5;
    const int srow = tid >> 3, sc = SCS(tid);
    for (int u = blockIdx.x; u < (NTOK / 256) * (D / 256); u += gridDim.x) {
        const int pm = u >> 2, pn = u & 3;
        unsigned po[4], qo[4];
#pragma unroll
        for (int i = 0; i < 4; ++i) { const int rt = srow + 64 * i; po[i] = (unsigned)(pm * 256 + rt) * (unsigned)(D * 2) + sc * 16; qo[i] = (unsigned)(pn * 256 + rt) * (unsigned)(D * 2) + sc * 16; }
        f32x16 acc[4][2];
        gemm256(lds, tid, (const char*)p.A2b, po, (const char*)p.WoutT, qo, D / 64, acc);
        const float* gt1 = p.mod + (pm >> 5) * NMOD * D + 2 * D;
        int opq = 0; asm volatile("" : "+v"(opq));
        const int r_ = r + opq, h_ = h + opq;
#pragma unroll
        for (int j = 0; j < 2; ++j) {
            const int feat = pn * 256 + wc * 64 + j * 32 + r_; const float g = gt1[feat];
#pragma unroll
            for (int i = 0; i < 4; ++i) {
                const unsigned base = (unsigned)((pm * 256 + wr * 128 + i * 32 + 4 * h_) * D + feat);
                const float* xp = p.x + base; float* op = p.x1 + base;
#pragma unroll
                for (int hf = 0; hf < 2; ++hf) {
                    float xv[8];
#pragma unroll
                    for (int v = 0; v < 8; ++v) xv[v] = xp[((v & 3) + 8 * (v >> 2) + 16 * hf) * D];
#pragma unroll
                    for (int v = 0; v < 8; ++v) op[((v & 3) + 8 * (v >> 2) + 16 * hf) * D] = xv[v] + g * acc[i][j][8 * hf + v];
                    asm volatile("" ::: "memory");
                }
            }
        }
    }
}

__device__ void ph_router(const Params& p, float* lds, bool commit = true) {
    int tid = threadIdx.x; asm volatile("" : "+v"(tid));
    const int wv = tid >> 6, lane = tid & 63;
    int* sel = (int*)lds; int* cntl = sel + 128; int* basel = cntl + 32; int* posl = basel + 32;
    for (int blk = blockIdx.x; blk < NTOK / 64; blk += gridDim.x) {
        __syncthreads();
        if (tid < 32) cntl[tid] = 0;
        for (int ti = 0; ti < 8; ++ti) {
            const int tok = blk * 64 + wv * 8 + ti;
            const int b = tok / SEQ;
            const float* sh = p.mod + b * NMOD * D + 3 * D, * sc = sh + D;
            float hv[16]; float ss = 0.f;
#pragma unroll
            for (int i = 0; i < 16; ++i) { hv[i] = p.x1[(size_t)tok * D + lane + 64 * i]; ss = fmaf(hv[i], hv[i], ss); }
            ss = wave_sum(ss);
            const float r = rsqrtf(ss / (float)D + EPS);
#pragma unroll
            for (int i = 0; i < 16; ++i) { const int e = lane + 64 * i; hv[i] = hv[i] * r * p.g_norm2[e] * (1.f + sc[e]) + sh[e]; p.h2b[(size_t)tok * D + e] = f2bf(hv[i]); }
            float lg[4];
#pragma unroll
            for (int o = 0; o < 4; ++o) { float a = 0.f;
#pragma unroll
                for (int i = 0; i < 16; ++i) a = fmaf(hv[i], p.WrT[o * D + lane + 64 * i], a);
                lg[o] = wave_sum(a); }
            int gs = 0; float gm = lg[0];
#pragma unroll
            for (int o = 1; o < 4; ++o) if (lg[o] > gm) { gm = lg[o]; gs = o; }
            float gz = 0.f;
#pragma unroll
            for (int o = 0; o < 4; ++o) gz += expf(lg[o] - gm);
            const float pg = 1.f / gz;
            gs = __builtin_amdgcn_readfirstlane(gs);
            const float* wre = p.WrT + (4 + gs * 8) * D + lane;
            float le[8];
#pragma unroll
            for (int o = 0; o < 8; ++o) { float a = 0.f;
#pragma unroll
                for (int i = 0; i < 16; ++i) a = fmaf(hv[i], wre[o * D + 64 * i], a);
                le[o] = wave_sum(a); }
            int i0 = 0; float m0 = le[0];
#pragma unroll
            for (int o = 1; o < 8; ++o) if (le[o] > m0) { m0 = le[o]; i0 = o; }
            int i1 = -1; float m1 = -3.0e38f;
#pragma unroll
            for (int o = 0; o < 8; ++o) if (o != i0 && le[o] > m1) { m1 = le[o]; i1 = o; }
            const float e1 = expf(m1 - m0);
            const float g0 = pg / (1.f + e1), g1 = pg * e1 / (1.f + e1);
            if (lane == 0) {
                sel[(wv * 8 + ti) * 2] = gs * 8 + i0; sel[(wv * 8 + ti) * 2 + 1] = gs * 8 + i1;
                p.tokgate[tok * 2] = g0; p.tokgate[tok * 2 + 1] = g1;
            }
        }
        __syncthreads();
        int e = 0;
        if (tid < 128) { e = sel[tid]; posl[tid] = atomicAdd(&cntl[e], 1); }
        __syncthreads();
        if (tid < 32 && commit) basel[tid] = atomicAdd(&p.cnt[tid * 64], cntl[tid]);
        __syncthreads();
        if (tid < 128 && commit) p.list[e * NTOK + basel[e] + posl[tid]] = (blk * 64 + (tid >> 1)) * 2 + (tid & 1);
    }
}

struct ETile { int e, s0, ns, sbase; };
__device__ __forceinline__ int moe_ntiles(const Params& p) { int t = 0; for (int e = 0; e < NEXP; ++e) t += (p.cnt[e * 64] + 255) >> 8; return t; }
__device__ __forceinline__ ETile moe_tile(const Params& p, int tile) {
    int e = 0, base = 0, sb = 0;
    for (;;) { const int c = p.cnt[e * 64], nc = (c + 255) >> 8; if (tile < base + nc) break; base += nc; sb += c; ++e; }
    ETile t; t.e = e; t.s0 = (tile - base) * 256; t.ns = min(256, p.cnt[e * 64] - t.s0); t.sbase = sb; return t;
}

__device__ void ph_moe_gu(const Params& p, float* ldsf) {
    LAS unsigned char* lds = (LAS unsigned char*)ldsf;
    int tid = threadIdx.x; asm volatile("" : "+v"(tid));
    const int lane = tid & 63, wid = tid >> 6, wr = wid >> 2, wc = wid & 3, r = lane & 31, h = lane >> 5;
    const int srow = tid >> 3, sc = SCS(tid);
    const int nunits = moe_ntiles(p) * 4;
    for (int u = blockIdx.x; u < nunits; u += gridDim.x) {
        const ETile t = moe_tile(p, u >> 2); const int fc = u & 3;
        unsigned po[4], qo[4];
#pragma unroll
        for (int i = 0; i < 4; ++i) {
            const int rt = srow + 64 * i;
            const int ent = rt < t.ns ? p.list[t.e * NTOK + t.s0 + rt] : 0;
            po[i] = (unsigned)(ent >> 1) * (unsigned)(D * 2) + sc * 16;
            const int f = fc * 128 + (rt >> 6) * 32 + (rt & 31), up = (rt >> 5) & 1;
            qo[i] = (unsigned)((up * NEXP + t.e) * DEXP + f) * (unsigned)(D * 2) + sc * 16;
        }
        f32x16 acc[4][2];
        gemm256(lds, tid, (const char*)p.h2b, po, (const char*)p.WgT, qo, D / 64, acc);
        int opq = 0; asm volatile("" : "+v"(opq));
        const int r_ = r + opq, h_ = h + opq;
        const int f = fc * 128 + wc * 32 + r_;
#pragma unroll
        for (int i = 0; i < 4; ++i) {
            const int s = wr * 128 + i * 32 + 4 * h_;
#pragma unroll
            for (int v = 0; v < 16; ++v) {
                const int sv = s + (v & 3) + 8 * (v >> 2);
                const float g = acc[i][0][v], uu = acc[i][1][v];
                if (sv < t.ns) p.act[(unsigned)((t.sbase + t.s0 + sv) * DEXP + f)] = f2bf(g / (1.f + __expf(-g)) * uu);
            }
            asm volatile("" ::: "memory");
        }
    }
}

__device__ void ph_moe_down(const Params& p, float* ldsf) {
    LAS unsigned char* lds = (LAS unsigned char*)ldsf;
    int tid = threadIdx.x; asm volatile("" : "+v"(tid));
    const int lane = tid & 63, wid = tid >> 6, wr = wid >> 2, wc = wid & 3, r = lane & 31, h = lane >> 5;
    const int srow = tid >> 3, sc = SCS(tid);
    const int nunits = moe_ntiles(p) * 4;
    for (int u = blockIdx.x; u < nunits; u += gridDim.x) {
        const ETile t = moe_tile(p, u >> 2); const int pn = u & 3;
        unsigned po[4], qo[4];
#pragma unroll
        for (int i = 0; i < 4; ++i) {
            const int rt = srow + 64 * i;
            po[i] = (unsigned)(t.sbase + t.s0 + (rt < t.ns ? rt : 0)) * (unsigned)(DEXP * 2) + sc * 16;
            qo[i] = (unsigned)(t.e * D + pn * 256 + rt) * (unsigned)(DEXP * 2) + sc * 16;
        }
        f32x16 acc[4][2];
        gemm256(lds, tid, (const char*)p.act, po, (const char*)p.WdT, qo, DEXP / 64, acc);
        int opq = 0; asm volatile("" : "+v"(opq));
        const int r_ = r + opq, h_ = h + opq;
#pragma unroll
        for (int i = 0; i < 4; ++i) {
            const int s = wr * 128 + i * 32 + 4 * h_;
#pragma unroll
            for (int v = 0; v < 16; ++v) {
                const int sv = s + (v & 3) + 8 * (v >> 2);
                if (sv < t.ns) {
                    const int ent = p.list[t.e * NTOK + t.s0 + sv]; const float g = p.tokgate[ent];
                    const unsigned base = (unsigned)ent * D + pn * 256 + wc * 64 + r_;
                    p.ybuf[base] = f2bf(g * acc[i][0][v]); p.ybuf[base + 32] = f2bf(g * acc[i][1][v]);
                }
            }
            asm volatile("" ::: "memory");
        }
    }
}

__device__ void ph_final(const Params& p, float* lds, float* outp) {
    int tid = threadIdx.x; asm volatile("" : "+v"(tid));
    for (int tok = blockIdx.x; tok < NTOK; tok += gridDim.x) {
        const float* gt2 = p.mod + (tok / SEQ) * NMOD * D + 5 * D;
        const unsigned ya = *(const unsigned*)(p.ybuf + (size_t)(2 * tok) * D + 2 * tid), yb = *(const unsigned*)(p.ybuf + (size_t)(2 * tok + 1) * D + 2 * tid);
        const float2 xv = *(const float2*)(p.x1 + (size_t)tok * D + 2 * tid);
        const float m0 = __uint_as_float(ya << 16) + __uint_as_float(yb << 16), m1 = __uint_as_float(ya & 0xffff0000u) + __uint_as_float(yb & 0xffff0000u);
        const float v0 = xv.x + gt2[2 * tid] * m0, v1 = xv.y + gt2[2 * tid + 1] * m1;
        const float ss = block_sum(v0 * v0 + v1 * v1, lds);
        const float rr = rsqrtf(ss / (float)D + EPS);
        *(float2*)(outp + (size_t)tok * D + 2 * tid) = make_float2(v0 * rr * p.g_final[2 * tid], v1 * rr * p.g_final[2 * tid + 1]);
    }
}

extern __shared__ __attribute__((aligned(16))) float smem[];

constexpr int R_P0 = 1, R_INP = 1, R_FOUR = 1, R_ATT = 1, R_OUT = 1, R_MOE = 1, R_RT = 1, R_FIN = 1, R_BAR = 1;
constexpr int LDS_BAR_OFF = 128 * 1024 + 512;
__global__ void __launch_bounds__(NT) mega(Params p) {
    volatile LAS unsigned* st = (volatile LAS unsigned*)((LAS unsigned char*)smem + LDS_BAR_OFF);
    if (threadIdx.x == 0) { st[0] = 0u; st[1] = 0u; }
    __syncthreads();
    const XcdBarrier bar = xcd_barrier_post(p.bar, st);
#define REP(n, call) for (int _r = 0; _r < (n); ++_r) { call; }
    REP(R_P0, ph_adaln_tables(p, smem)) REP(R_BAR, xcd_barrier(bar))
    REP(R_P0, ph_hrows(p, smem)) REP(R_BAR, xcd_barrier(bar))
    REP(R_INP, ph_inproj(p, smem)) REP(R_BAR, xcd_barrier(bar))
    REP(R_FOUR, ph_four1(p, smem)) REP(R_BAR, xcd_barrier(bar))
    REP(R_FOUR, ph_four2(p, smem)) REP(R_BAR, xcd_barrier(bar))
    REP(R_ATT, ph_attn(p, smem)) REP(R_BAR, xcd_barrier(bar))
    REP(R_FOUR, ph_fmix(p, smem); ph_a2rows(p, smem)) REP(R_BAR, xcd_barrier(bar))
    REP(R_OUT, ph_outproj(p, smem)) REP(R_BAR, xcd_barrier(bar))
    REP(R_RT - 1, ph_router(p, smem, false)) ph_router(p, smem); REP(R_BAR, xcd_barrier(bar))
    REP(R_MOE, ph_moe_gu(p, smem)) REP(R_BAR, xcd_barrier(bar))
    REP(R_MOE, ph_moe_down(p, smem)) REP(R_BAR, xcd_barrier(bar))
    REP(R_FIN - 1, ph_final(p, smem, (float*)p.h2b)) ph_final(p, smem, p.out);
}

extern "C" void kernel_launch(void* const* d_in, const int* in_sizes, int n_in, void* d_out, int out_size, void* d_ws, size_t ws_size, hipStream_t stream) {
    constexpr size_t kDynLds = 128 * 1024 + 1024;
    static int grid_blocks = 0;
    if (!grid_blocks) {
        int dev = 0, cus = 0, per_cu = 0;
        (void)hipGetDevice(&dev);
        (void)hipDeviceGetAttribute(&cus, hipDeviceAttributeMultiprocessorCount, dev);
        (void)hipFuncSetAttribute((const void*)mega, hipFuncAttributeMaxDynamicSharedMemorySize, (int)kDynLds);
        (void)hipOccupancyMaxActiveBlocksPerMultiprocessor(&per_cu, (const void*)mega, NT, kDynLds);
        if (per_cu > 1) per_cu = 1;
        grid_blocks = cus * per_cu;
    }
    Params p{};
    p.x = (const float*)d_in[0]; p.c = (const float*)d_in[1]; p.ctx = (const float*)d_in[2]; p.c_ctx = (const float*)d_in[3];
    p.w_ada = (const float*)d_in[4]; p.b_ada = (const float*)d_in[5]; p.g_norm1 = (const float*)d_in[6]; p.w_in = (const float*)d_in[7];
    p.w_fmix = (const float*)d_in[8]; p.rpb = (const float*)d_in[9]; p.g_out = (const float*)d_in[10]; p.w_out = (const float*)d_in[11];
    p.g_norm2 = (const float*)d_in[12]; p.w_rg = (const float*)d_in[13]; p.w_re = (const float*)d_in[14]; p.w_gate = (const float*)d_in[15];
    p.w_up = (const float*)d_in[16]; p.w_down = (const float*)d_in[17]; p.g_final = (const float*)d_in[18];
    p.out = (float*)d_out;
    char* w = (char*)d_ws; size_t o = 0;
    auto take = [&](size_t bytes) { char* r = w + o; o += (bytes + 255) & ~(size_t)255; return r; };
    p.mod = (float*)take(3 * NMOD * D * 4); p.cosN = (float*)take(SEQ * 4); p.sinN = (float*)take(SEQ * 4); p.ropeR = (float*)take(GROWS * 32 * 4); p.ropeC = (float*)take(GW * 32 * 4);
    p.bar = (unsigned*)take(XCD_BAR_WORDS * 4); p.WrT = (float*)take(36 * D * 4); p.cnt = (int*)take(NEXP * 256); p.list = (int*)take((size_t)NEXP * NTOK * 4); p.tokgate = (float*)take(2 * NTOK * 4);
    p.WinT = (bf16_t*)take((size_t)DIN * D * 2); p.WoutT = (bf16_t*)take((size_t)D * D * 2);
    p.W64cs = (bf16_t*)take(256 * 64 * 2); p.G128 = (bf16_t*)take(256 * 256 * 2); p.WmixT = (bf16_t*)take(256 * 512 * 2);
    p.WgT = (bf16_t*)take((size_t)NEXP * DEXP * D * 2); p.WuT = (bf16_t*)take((size_t)NEXP * DEXP * D * 2); p.WdT = (bf16_t*)take((size_t)NEXP * DEXP * D * 2);
    char* R1 = take((size_t)NTOK * D * 4 + 256);
    p.hb = (bf16_t*)R1; p.Zb = (bf16_t*)R1; p.na = (float*)R1; p.P2 = (bf16_t*)(R1 + (size_t)NTOK * DNA * 4); p.h2b = (bf16_t*)R1; p.act = p.h2b + (size_t)NTOK * D;
    const size_t qkv = (size_t)NTOK * DNA * 2;
    char* R2 = take((size_t)NTOK * DF * 2 + 4 * qkv + 2 * (size_t)NCTX * DNA * 2 + 4096);
    p.fX = (bf16_t*)R2; p.Qr = (bf16_t*)(R2 + (size_t)NTOK * DF * 2); p.Qp = p.Qr + (size_t)NTOK * DNA; p.Kr = p.Qp + (size_t)NTOK * DNA; p.Vt = p.Kr + (size_t)NTOK * DNA;
    p.Kc = p.Vt + (size_t)NTOK * DNA; p.Vct = p.Kc + (size_t)NCTX * DNA;
    p.A2b = (bf16_t*)R2; p.x1 = (float*)(R2 + (size_t)NTOK * DF * 2 + 4 * qkv + 2 * (size_t)NCTX * DNA * 2 - (size_t)NTOK * D * 4);
    p.ybuf = (bf16_t*)p.out;
    void* args[] = {&p};
    (void)hipMemsetAsync(p.bar, 0, XCD_BAR_WORDS * 4, stream);
    hipError_t e = hipLaunchCooperativeKernel((const void*)mega, dim3(grid_blocks), dim3(NT), args, kDynLds, stream);
    if (e != hipSuccess) fprintf(stderr, "cooperative launch failed: %s (grid %d)\n", hipGetErrorString(e), grid_blocks);
}
```

```cpp
#include <hip/hip_runtime.h>
#include <cstdio>
#include <cstdint>

constexpr int D = 1024, NBATCH = 2, SEQ = 8192, NTOK = NBATCH * SEQ, LCTX = 256, NCTX = NBATCH * LCTX, NROWS = NTOK + NCTX;
constexpr int DIN = 2560, DF = 256, NH = 12, HD = 64, DNA = 768, QOFF = 256, KOFF = 1024, VOFF = 1792;
constexpr int GW = 64, GROWS = 128, NEXP = 32, DEXP = 512, NMOD = 6;
constexpr float EPS = 1e-6f;
constexpr int NT = 512;
constexpr float QSCALE = 0.125f * 1.4426950408889634f;
typedef unsigned short bf16_t;
typedef short bf16x8 __attribute__((ext_vector_type(8)));
typedef float f32x16 __attribute__((ext_vector_type(16)));
typedef float f32x4 __attribute__((ext_vector_type(4)));
__device__ __forceinline__ unsigned cvt_pk_bf16(float lo, float hi) { unsigned r; asm volatile("v_cvt_pk_bf16_f32 %0, %1, %2" : "=v"(r) : "v"(lo), "v"(hi)); return r; }
__device__ __forceinline__ bf16_t f2bf(float v) { return (bf16_t)(cvt_pk_bf16(v, 0.f) & 0xffffu); }
__device__ __forceinline__ float bf2f(bf16_t v) { return __uint_as_float((unsigned)v << 16); }

struct Params {
    const float *x, *c, *ctx, *c_ctx, *w_ada, *b_ada, *g_norm1, *w_in, *w_fmix, *rpb, *g_out, *w_out, *g_norm2, *w_rg, *w_re, *w_gate, *w_up, *w_down, *g_final;
    float* out;
    float *mod, *cosN, *sinN, *ropeR, *ropeC;
    float *na;
    float *x1;
    int *cnt, *list; float* tokgate; unsigned* bar; float* WrT;
    bf16_t *WinT, *WoutT, *WgT, *WuT, *WdT;
    bf16_t *hb, *A2b;
    bf16_t *h2b, *act, *ybuf;
    bf16_t *fX, *Qr, *Qp, *Kr, *Vt, *Kc, *Vct;
    bf16_t *W64cs, *G128, *WmixT;
    bf16_t *Zb, *P2;
};

template <int CTRL> __device__ __forceinline__ float dpp(float x) { return __builtin_bit_cast(float, __builtin_amdgcn_mov_dpp(__builtin_bit_cast(int, x), CTRL, 0xf, 0xf, true)); }
__device__ __forceinline__ float xhalf_sum(float x) { auto t = __builtin_amdgcn_permlane32_swap(__float_as_uint(x), __float_as_uint(x), false, false); return __uint_as_float(t[0]) + __uint_as_float(t[1]); }
__device__ __forceinline__ float xhalf_max(float x) { auto t = __builtin_amdgcn_permlane32_swap(__float_as_uint(x), __float_as_uint(x), false, false); return fmaxf(__uint_as_float(t[0]), __uint_as_float(t[1])); }
__device__ __forceinline__ float wave_sum(float x) {
    x += dpp<0xB1>(x); x += dpp<0x4E>(x); x += dpp<0x141>(x); x += dpp<0x128>(x);
    auto s = __builtin_amdgcn_permlane16_swap(__float_as_uint(x), __float_as_uint(x), false, false);
    x = __uint_as_float(s[0]) + __uint_as_float(s[1]);
    return xhalf_sum(x);
}
__device__ __forceinline__ float wave_max(float x) {
    x = fmaxf(x, dpp<0xB1>(x)); x = fmaxf(x, dpp<0x4E>(x)); x = fmaxf(x, dpp<0x141>(x)); x = fmaxf(x, dpp<0x128>(x));
    auto s = __builtin_amdgcn_permlane16_swap(__float_as_uint(x), __float_as_uint(x), false, false);
    x = fmaxf(__uint_as_float(s[0]), __uint_as_float(s[1]));
    return xhalf_max(x);
}
__device__ __forceinline__ float block_sum(float v, float* red) {
    v = wave_sum(v);
    const int w = threadIdx.x >> 6, l = threadIdx.x & 63;
    __syncthreads();
    if (l == 0) red[w] = v;
    __syncthreads();
    float s = 0.f;
#pragma unroll
    for (int i = 0; i < NT / 64; ++i) s += red[i];
    return s;
}

template <class AF, class BF, class EF>
__device__ void ngemm(float* lds, int M, int N, int K, AF af, BF bf, EF ef) {
    float* As = lds;
    float* Bs = lds + 16 * 132;
    int tid = threadIdx.x; asm volatile("" : "+v"(tid));
    const int ty = tid >> 4, tx = tid & 15;
    const int tn = N / 128, nt = (M / 128) * tn;
    for (int t = blockIdx.x; t < nt; t += gridDim.x) {
        const int m0 = (t / tn) * 128, n0 = (t % tn) * 128;
        float acc[4][8];
#pragma unroll
        for (int i = 0; i < 4; ++i)
#pragma unroll
            for (int j = 0; j < 8; ++j) acc[i][j] = 0.f;
        for (int k0 = 0; k0 < K; k0 += 16) {
#pragma unroll
            for (int i = 0; i < 4; ++i) { const int idx = tid + NT * i, kk = idx & 15, m = idx >> 4; As[kk * 132 + m] = af(m0 + m, k0 + kk); }
#pragma unroll
            for (int i = 0; i < 4; ++i) { const int idx = tid + NT * i, n = idx & 127, kk = idx >> 7; Bs[kk * 128 + n] = bf(m0, k0 + kk, n0 + n); }
            __syncthreads();
#pragma unroll
            for (int kk = 0; kk < 16; ++kk) {
                const float4 a = *(const float4*)(As + kk * 132 + ty * 4);
                const float4 b0 = *(const float4*)(Bs + kk * 128 + tx * 8), b1 = *(const float4*)(Bs + kk * 128 + tx * 8 + 4);
                const float av[4] = {a.x, a.y, a.z, a.w}, bv[8] = {b0.x, b0.y, b0.z, b0.w, b1.x, b1.y, b1.z, b1.w};
#pragma unroll
                for (int i = 0; i < 4; ++i)
#pragma unroll
                    for (int j = 0; j < 8; ++j) acc[i][j] = fmaf(av[i], bv[j], acc[i][j]);
            }
            __syncthreads();
        }
#pragma unroll
        for (int i = 0; i < 4; ++i)
#pragma unroll
            for (int j = 0; j < 8; ++j) ef(m0 + ty * 4 + i, n0 + tx * 8 + j, acc[i][j]);
    }
}

#define LAS __attribute__((address_space(3)))
#define SCS(tid) (((tid) & 7) ^ ((((tid) >> 3) >> 1) & 7))
__device__ __forceinline__ void gemm256(LAS unsigned char* lds, const int tid, const char* Pb, const unsigned (&po)[4], const char* Qb, const unsigned (&qo)[4], int nk, f32x16 (&acc)[4][2]) {
    const int lane = tid & 63, wid = __builtin_amdgcn_readfirstlane(tid >> 6), wr = wid >> 2, wc = wid & 3;
    const int r = lane & 31, h = lane >> 5, swz = (r >> 1) & 7;
    const unsigned ldsw = (unsigned)wid * 1024u;
#pragma unroll
    for (int i = 0; i < 4; ++i)
#pragma unroll
        for (int j = 0; j < 2; ++j)
#pragma unroll
            for (int v = 0; v < 16; ++v) acc[i][j][v] = 0.f;
    __syncthreads();
#pragma unroll
    for (int i = 0; i < 4; ++i) {
        __builtin_amdgcn_global_load_lds((const unsigned*)(Pb + po[i]), (LAS unsigned*)(lds + ldsw + i * 8192), 16, 0, 0);
        __builtin_amdgcn_global_load_lds((const unsigned*)(Qb + qo[i]), (LAS unsigned*)(lds + 32768 + ldsw + i * 8192), 16, 0, 0);
    }
    __syncthreads();
    const int prd = (wr * 128 + r) * 128, qrd = 32768 + (wc * 64 + r) * 128;
    const int ko0 = ((0 + h) ^ swz) << 4, ko1 = ((2 + h) ^ swz) << 4, ko2 = ((4 + h) ^ swz) << 4, ko3 = ((6 + h) ^ swz) << 4;
#define G256_LD(pf, qf, ko) do { _Pragma("unroll") for (int i = 0; i < 4; ++i) pf[i] = *(const LAS bf16x8*)(lds + cb + prd + i * 4096 + (ko)); \
                                 _Pragma("unroll") for (int j = 0; j < 2; ++j) qf[j] = *(const LAS bf16x8*)(lds + cb + qrd + j * 4096 + (ko)); } while (0)
#define G256_MM(pf, qf) do { _Pragma("unroll") for (int i = 0; i < 4; ++i) _Pragma("unroll") for (int j = 0; j < 2; ++j) \
                                 acc[i][j] = __builtin_amdgcn_mfma_f32_32x32x16_bf16(pf[i], qf[j], acc[i][j], 0, 0, 0); } while (0)
#pragma unroll 1
    for (int kt = 0; kt < nk; ++kt) {
        const int cb = (kt & 1) * 65536, nb = 65536 - cb;
        {
            const unsigned koff = (unsigned)min(kt + 1, nk - 1) * 128u;
#pragma unroll
            for (int i = 0; i < 4; ++i) {
                __builtin_amdgcn_global_load_lds((const unsigned*)(Pb + (size_t)(po[i] + koff)), (LAS unsigned*)(lds + nb + ldsw + i * 8192), 16, 0, 0);
                __builtin_amdgcn_global_load_lds((const unsigned*)(Qb + (size_t)(qo[i] + koff)), (LAS unsigned*)(lds + nb + 32768 + ldsw + i * 8192), 16, 0, 0);
            }
        }
        bf16x8 pa[4], qa[2], pb[4], qb[2];
        G256_LD(pa, qa, ko0);
        G256_LD(pb, qb, ko1);
        G256_MM(pa, qa);
        G256_LD(pa, qa, ko2);
        G256_MM(pb, qb);
        G256_LD(pb, qb, ko3);
        G256_MM(pa, qa);
        G256_MM(pb, qb);
        __syncthreads();
    }
    asm volatile("" ::: "memory");
}

#define XB_TMO      128
#define XB_XCNT(j)  (256  + 64 * (j))
#define XB_XSUB(j)  (1280 + 64 * (j))
#define XB_XGEN(j)  (2304 + 64 * (j))
#define XB_TOP      3328
#define XB_TOPGEN   3392
#define XCD_BAR_WORDS 3456
#define XB_SPIN_CAP (1u << 18)
__device__ __forceinline__ unsigned xb_ld(unsigned* p)              { return __hip_atomic_load(p, __ATOMIC_RELAXED, __HIP_MEMORY_SCOPE_AGENT); }
__device__ __forceinline__ unsigned xb_add(unsigned* p, unsigned v) { return __hip_atomic_fetch_add(p, v, __ATOMIC_RELAXED, __HIP_MEMORY_SCOPE_AGENT); }
__device__ __forceinline__ unsigned xb_xcc_id() { return (unsigned)__builtin_amdgcn_s_getreg((3 << 11) | 20) & 0xFu; }
#define XB_SPIN(cond, bar) do { unsigned _sp = 0; while (cond) { __builtin_amdgcn_s_sleep(1); \
    if ((++_sp & 255u) == 0u) { if (xb_ld(&(bar)[XB_TMO])) break; if (_sp > XB_SPIN_CAP) { atomicAdd(&(bar)[XB_TMO], 1u); break; } } } } while (0)
struct XcdBarrier { unsigned* bar; unsigned x; volatile LAS unsigned* st; };
__device__ __forceinline__ XcdBarrier xcd_barrier_post(unsigned* bar, volatile LAS unsigned* st) {
    XcdBarrier b; b.bar = bar; b.x = xb_xcc_id(); b.st = st;
    if (threadIdx.x == 0) (void)xb_add(&bar[XB_XCNT(b.x)], 1u);
    return b;
}
__device__ __forceinline__ void xcd_barrier_complete(unsigned* bar, unsigned x, unsigned& nloc, unsigned& nx) {
    const unsigned G = gridDim.x * gridDim.y * gridDim.z;
    unsigned sum, cnt, mine, sp = 0u;
    for (;;) {
        sum = 0u; cnt = 0u; mine = 0u;
#pragma unroll
        for (unsigned j = 0; j < 16; ++j) { const unsigned c = xb_ld(&bar[XB_XCNT(j)]); sum += c; cnt += (c > 0u) ? 1u : 0u; mine = (j == x) ? c : mine; }
        if (sum == G) break;
        __builtin_amdgcn_s_sleep(1);
        if ((++sp & 255u) == 0u) { if (xb_ld(&bar[XB_TMO])) break; if (sp > XB_SPIN_CAP) { atomicAdd(&bar[XB_TMO], 1u); break; } }
    }
    nloc = mine > 0u ? mine : 1u; nx = cnt > 0u ? cnt : 1u;
}
__device__ __forceinline__ void xcd_barrier(const XcdBarrier& b) {
    asm volatile("s_waitcnt vmcnt(0)" ::: "memory");
    __syncthreads();
    if (threadIdx.x == 0) {
        unsigned* bar = b.bar;
        __builtin_amdgcn_s_waitcnt(0);
        unsigned nloc = b.st[0], nx = b.st[1];
        if (nloc == 0u) { xcd_barrier_complete(bar, b.x, nloc, nx); b.st[0] = nloc; b.st[1] = nx; }
        const unsigned old = xb_add(&bar[XB_XSUB(b.x)], 1u);
        const unsigned gen = old / nloc;
        if (old + 1u == (gen + 1u) * nloc) {
            __builtin_amdgcn_fence(__ATOMIC_RELEASE, "agent");
            asm volatile("s_waitcnt vmcnt(0)" ::: "memory");
            const unsigned og = xb_add(&bar[XB_TOP], 1u);
            const unsigned tg = og / nx;
            if (og + 1u == (tg + 1u) * nx) xb_add(&bar[XB_TOPGEN], 1u);
            else XB_SPIN(xb_ld(&bar[XB_TOPGEN]) == tg, bar);
            __builtin_amdgcn_fence(__ATOMIC_ACQUIRE, "agent");
            xb_add(&bar[XB_XGEN(b.x)], 1u);
            asm volatile("s_waitcnt vmcnt(0)" ::: "memory");
        } else {
            XB_SPIN(xb_ld(&bar[XB_XGEN(b.x)]) == gen, bar);
            __builtin_amdgcn_fence(__ATOMIC_ACQUIRE, "agent");
            asm volatile("s_waitcnt vmcnt(0)" ::: "memory");
        }
    }
    __syncthreads();
}

__device__ void transpose_job(float* lds, const float* src, bf16_t* dst, int R, int C, int batch, int& tbase, int gstride, int& next) {
    int tid = threadIdx.x; asm volatile("" : "+v"(tid));
    const int tr = R / 64, tc = C / 256, ntile = batch * tr * tc;
    while (next < tbase + ntile) {
        const int t = next - tbase; next += gstride;
        const int bb = t / (tr * tc), rem = t % (tr * tc), r0 = (rem / tc) * 64, c0 = (rem % tc) * 256;
        const float* s = src + (size_t)bb * R * C + (size_t)r0 * C + c0; bf16_t* d = dst + (size_t)bb * R * C + (size_t)c0 * R + r0;
        float4 v[8];
#pragma unroll
        for (int i = 0; i < 8; ++i) { const int rr = (tid >> 6) + 8 * i, c4 = (tid & 63) * 4; v[i] = *(const float4*)(s + (size_t)rr * C + c4); }
        __syncthreads();
#pragma unroll
        for (int i = 0; i < 8; ++i) { const int rr = (tid >> 6) + 8 * i, c4 = (tid & 63) * 4; float* q = lds + rr * 257 + c4; q[0] = v[i].x; q[1] = v[i].y; q[2] = v[i].z; q[3] = v[i].w; }
        __syncthreads();
#pragma unroll
        for (int i = 0; i < 4; ++i) { const int cc = (tid >> 3) + 64 * i, r8 = (tid & 7) * 8; const float* q = lds + r8 * 257 + cc;
            uint4 w; w.x = cvt_pk_bf16(q[0], q[257]); w.y = cvt_pk_bf16(q[2 * 257], q[3 * 257]); w.z = cvt_pk_bf16(q[4 * 257], q[5 * 257]); w.w = cvt_pk_bf16(q[6 * 257], q[7 * 257]);
            *(uint4*)(d + (size_t)cc * R + r8) = w; }
    }
    tbase += ntile;
}

__device__ void ph_adaln_tables(const Params& p, float* lds) {
    int tid = threadIdx.x; asm volatile("" : "+v"(tid));
    const int gid = blockIdx.x * NT + tid, gsz = gridDim.x * NT;
    if (blockIdx.x < NMOD * D / 32) {
        for (int i = tid; i < 3 * D; i += NT) { const int r = i / D, k = i % D; const float v = r < 2 ? p.c[r * D + k] : p.c_ctx[k]; lds[i] = v / (1.f + expf(-v)); }
        __syncthreads();
        const int col = blockIdx.x * 32 + (tid & 31), kg = tid >> 5;
        float a0 = 0.f, a1 = 0.f, a2 = 0.f;
#pragma unroll 8
        for (int kk = 0; kk < 64; ++kk) { const int k = kg * 64 + kk; const float w = p.w_ada[(size_t)k * (NMOD * D) + col]; a0 = fmaf(lds[k], w, a0); a1 = fmaf(lds[D + k], w, a1); a2 = fmaf(lds[2 * D + k], w, a2); }
        float* red = lds + 3 * D;
        red[(0 * 16 + kg) * 32 + (tid & 31)] = a0; red[(1 * 16 + kg) * 32 + (tid & 31)] = a1; red[(2 * 16 + kg) * 32 + (tid & 31)] = a2;
        __syncthreads();
        if (tid < 96) { const int rr = tid >> 5, cc = tid & 31; float s = 0.f;
#pragma unroll
            for (int g = 0; g < 16; ++g) s += red[(rr * 16 + g) * 32 + cc];
            p.mod[rr * NMOD * D + blockIdx.x * 32 + cc] = s + p.b_ada[blockIdx.x * 32 + cc]; }
        __syncthreads();
    }
    for (int i = gid; i < 36 * D; i += gsz) { const int o = i / D, k = i % D; p.WrT[i] = o < 4 ? p.w_rg[k * 4 + o] : p.w_re[k * NEXP + o - 4]; }
    for (int i = gid; i < SEQ; i += gsz) { p.cosN[i] = cospif(2.f * (float)i / (float)SEQ); p.sinN[i] = sinpif(2.f * (float)i / (float)SEQ); }
    for (int i = gid; i < (GROWS + GW) * 16; i += gsz) {
        const int pos = i / 16, f = i % 16; const float inv = powf(10000.f, -(float)f / 16.f);
        if (pos < GROWS) { const float a = (float)pos * inv; p.ropeR[2 * i] = cosf(a); p.ropeR[2 * i + 1] = sinf(a); }
        else { const int pc = pos - GROWS; const float a = (float)pc * inv; p.ropeC[2 * (pc * 16 + f)] = cosf(a); p.ropeC[2 * (pc * 16 + f) + 1] = sinf(a); }
    }
    if (gid < NEXP) p.cnt[gid * 64] = 0;
    for (int i = gid; i < 256 * 64; i += gsz) {
        const int rho = i >> 6, n1 = i & 63, blk = rho >> 5, k1 = (blk >> 1) * 32 + (rho & 31);
        float v = 0.f;
        if (blk < 4) { const float a = 2.f * (float)((k1 * n1) & 63) / 64.f; v = (blk & 1) ? -sinpif(a) : cospif(a); }
        p.W64cs[i] = f2bf(v);
    }
    for (int i = gid; i < 256 * 256; i += gsz) {
        const int rho = i >> 8, kap = i & 255, ro = rho >> 7, k2 = rho & 127, ri = kap >> 7, n2 = kap & 127;
        const float a = 2.f * (float)((k2 * n2) & 127) / 128.f; const float c = cospif(a), s = sinpif(a);
        p.G128[i] = f2bf(ro == ri ? c : (ro == 0 ? s : -s));
    }
    for (int i = gid; i < 256 * 512; i += gsz) {
        const int j = i >> 9, kap = i & 511, ro = kap >> 8, ch = kap & 255, g = ch >> 6, c = ch & 63;
        float acc = 0.f;
        for (int l = 0; l < 64; ++l) { const float a = 2.f * (float)((l * c) & 63) / 64.f; acc = fmaf(ro ? sinpif(a) : cospif(a), p.w_fmix[(size_t)(64 * g + l) * DF + j], acc); }
        p.WmixT[i] = f2bf(acc * (1.0f / 724.0773439350247f));
    }
    __syncthreads();
    int tbase = 0, next = blockIdx.x;
    transpose_job(lds, p.w_in, p.WinT, D, DIN, 1, tbase, gridDim.x, next);
    transpose_job(lds, p.w_out, p.WoutT, D, D, 1, tbase, gridDim.x, next);
    transpose_job(lds, p.w_gate, p.WgT, D, DEXP, NEXP, tbase, gridDim.x, next);
    transpose_job(lds, p.w_up, p.WuT, D, DEXP, NEXP, tbase, gridDim.x, next);
    transpose_job(lds, p.w_down, p.WdT, DEXP, D, NEXP, tbase, gridDim.x, next);
}

__device__ void ph_hrows(const Params& p, float* lds) {
    int tid = threadIdx.x; asm volatile("" : "+v"(tid));
    for (int row = blockIdx.x; row < NROWS; row += gridDim.x) {
        const float* src = row < NTOK ? p.x + (size_t)row * D : p.ctx + (size_t)(row - NTOK) * D;
        const int mr = row < NTOK ? row / SEQ : 2;
        const float* sh = p.mod + mr * NMOD * D, * sc = sh + D;
        const float2 v = *(const float2*)(src + 2 * tid);
        const float ss = block_sum(v.x * v.x + v.y * v.y, lds);
        const float r = rsqrtf(ss / (float)D + EPS);
        const float o0 = v.x * r * p.g_norm1[2 * tid] * (1.f + sc[2 * tid]) + sh[2 * tid];
        const float o1 = v.y * r * p.g_norm1[2 * tid + 1] * (1.f + sc[2 * tid + 1]) + sh[2 * tid + 1];
        *(unsigned*)(p.hb + (size_t)row * D + 2 * tid) = cvt_pk_bf16(o0, o1);
    }
}

__device__ void ph_inproj(const Params& p, float* ldsf) {
    LAS unsigned char* lds = (LAS unsigned char*)ldsf;
    int tid = threadIdx.x; asm volatile("" : "+v"(tid));
    const int lane = tid & 63, wid = tid >> 6, wr = wid >> 2, wc = wid & 3, r = lane & 31, h = lane >> 5;
    const int srow = tid >> 3, sc = SCS(tid);
    constexpr int NPM = NROWS / 256, NPN = DIN / 256;
    for (int u = blockIdx.x; u < NPM * NPN; u += gridDim.x) {
        const int pm = u / NPN, pn = u % NPN;
        if (pm >= 64 && pn < 4) continue;
        unsigned po[4], qo[4];
#pragma unroll
        for (int i = 0; i < 4; ++i) {
            const int rt = srow + 64 * i;
            po[i] = (unsigned)((pn * 256 + rt) * D * 2 + sc * 16);
            int rowidx;
            if (pn == 0) rowidx = (pm >> 5) * SEQ + 128 * (rt & 63) + 4 * (pm & 31) + (rt >> 6);
            else rowidx = pm * 256 + rt;
            qo[i] = (unsigned)rowidx * (unsigned)(D * 2) + sc * 16;
        }
        f32x16 acc[4][2];
        gemm256(lds, tid, (const char*)p.WinT, po, (const char*)p.hb, qo, D / 64, acc);
        int opq = 0; asm volatile("" : "+v"(opq));
        const int r_ = r + opq, h_ = h + opq;
        if (pn == 0) {
            const int b = pm >> 5, n2 = 4 * (pm & 31) + wc;
#pragma unroll
            for (int i = 0; i < 4; ++i) {
#pragma unroll
                for (int j = 0; j < 2; ++j) {
                    const unsigned base = (unsigned)(((b * DF + wr * 128 + i * 32 + 4 * h_) * 128 + n2) * 64 + j * 32 + r_);
#pragma unroll
                    for (int v = 0; v < 16; ++v) p.fX[base + (unsigned)(((v & 3) + 8 * (v >> 2)) * 128 * 64)] = f2bf(acc[i][j][v]);
                }
                asm volatile("" ::: "memory");
            }
        } else if (pn < 7) {
            const bool isq = pn < 4; const int hg = ((pn - 1) % 3) * 4 + wr * 2;
            const bool isctx = pm >= 64;
            const int b = isctx ? pm - 64 : (pm >> 5);
#pragma unroll
            for (int j = 0; j < 2; ++j) {
                const int n = (isctx ? 0 : (pm & 31) * 256) + wc * 64 + j * 32 + r_;
                const int grow = n >> 6, gcol = n & 63;
#pragma unroll
                for (int i = 0; i < 4; ++i) {
                    const int hh = hg + (i >> 1), blk = i & 1;
                    if (isctx) {
                        const unsigned base = (unsigned)(((b * NH + hh) * LCTX + n) * HD + blk * 32 + 4 * h_);
#pragma unroll
                        for (int q = 0; q < 4; ++q) {
                            uint2 w;
                            w.x = cvt_pk_bf16(acc[i][j][4 * q], acc[i][j][4 * q + 1]); w.y = cvt_pk_bf16(acc[i][j][4 * q + 2], acc[i][j][4 * q + 3]);
                            *(uint2*)(p.Kc + base + 8 * q) = w;
                        }
                    } else {
                        const float* tb = (blk == 0 ? p.ropeR + 32 * grow : p.ropeC + 32 * gcol) + 8 * h_;
                        float o1[8], o2[8];
#pragma unroll
                        for (int v = 0; v < 8; ++v) {
                            const float2 cs = *(const float2*)(tb + 2 * ((v & 3) + 8 * (v >> 2)));
                            const float x1 = acc[i][j][v], x2 = acc[i][j][v + 8];
                            o1[v] = x1 * cs.x - x2 * cs.y; o2[v] = x1 * cs.y + x2 * cs.x;
                        }
                        const unsigned base = (unsigned)(((b * NH + hh) * SEQ + n) * HD + blk * 32 + 4 * h_);
                        if (isq) {
#pragma unroll
                            for (int q = 0; q < 2; ++q) {
                                uint2 w;
                                w.x = cvt_pk_bf16(o1[4 * q] * QSCALE, o1[4 * q + 1] * QSCALE); w.y = cvt_pk_bf16(o1[4 * q + 2] * QSCALE, o1[4 * q + 3] * QSCALE);
                                *(uint2*)(p.Qr + base + 8 * q) = w;
                                w.x = cvt_pk_bf16(o2[4 * q] * QSCALE, o2[4 * q + 1] * QSCALE); w.y = cvt_pk_bf16(o2[4 * q + 2] * QSCALE, o2[4 * q + 3] * QSCALE);
                                *(uint2*)(p.Qr + base + 16 + 8 * q) = w;
                            }
#pragma unroll
                            for (int q = 0; q < 4; ++q) {
                                uint2 w;
                                w.x = cvt_pk_bf16(acc[i][j][4 * q] * QSCALE, acc[i][j][4 * q + 1] * QSCALE); w.y = cvt_pk_bf16(acc[i][j][4 * q + 2] * QSCALE, acc[i][j][4 * q + 3] * QSCALE);
                                *(uint2*)(p.Qp + base + 8 * q) = w;
                            }
                        } else {
#pragma unroll
                            for (int q = 0; q < 2; ++q) {
                                uint2 w;
                                w.x = cvt_pk_bf16(o1[4 * q], o1[4 * q + 1]); w.y = cvt_pk_bf16(o1[4 * q + 2], o1[4 * q + 3]);
                                *(uint2*)(p.Kr + base + 8 * q) = w;
                                w.x = cvt_pk_bf16(o2[4 * q], o2[4 * q + 1]); w.y = cvt_pk_bf16(o2[4 * q + 2], o2[4 * q + 3]);
                                *(uint2*)(p.Kr + base + 16 + 8 * q) = w;
                            }
                        }
                    }
                    asm volatile("" ::: "memory");
                }
            }
        } else {
            const int hg = (pn - 7) * 4 + wr * 2;
            const bool isctx = pm >= 64;
            const int b = isctx ? pm - 64 : (pm >> 5);
            const int ntb = isctx ? LCTX / 8 : SEQ / 8; bf16_t* vb = isctx ? p.Vct : p.Vt;
#pragma unroll
            for (int j = 0; j < 2; ++j) {
                const int n = (isctx ? 0 : (pm & 31) * 256) + wc * 64 + j * 32 + r_;
#pragma unroll
                for (int i = 0; i < 4; ++i) {
                    const unsigned base = (unsigned)((((b * NH + hg + (i >> 1)) * ntb + (n >> 3)) * HD + (i & 1) * 32 + 4 * h_) * 8 + (n & 7));
#pragma unroll
                    for (int v = 0; v < 16; ++v) vb[base + (unsigned)(((v & 3) + 8 * (v >> 2)) * 8)] = f2bf(acc[i][j][v]);
                    asm volatile("" ::: "memory");
                }
            }
        }
    }
}

__device__ void ph_four1(const Params& p, float* ldsf) {
    LAS unsigned char* lds = (LAS unsigned char*)ldsf;
    int tid = threadIdx.x; asm volatile("" : "+v"(tid));
    const int lane = tid & 63, wid = tid >> 6, wr = wid >> 2, wc = wid & 3, r = lane & 31, h = lane >> 5;
    const int srow = tid >> 3, sc = SCS(tid);
    for (int u = blockIdx.x; u < NBATCH * DF * 128 / 256; u += gridDim.x) {
        unsigned po[4], qo[4];
#pragma unroll
        for (int i = 0; i < 4; ++i) { const int rt = srow + 64 * i; po[i] = (unsigned)rt * 128u + sc * 16; qo[i] = (unsigned)(u * 256 + rt) * 128u + sc * 16; }
        f32x16 acc[4][2];
        gemm256(lds, tid, (const char*)p.W64cs, po, (const char*)p.fX, qo, 1, acc);
        if (wr == 0) {
            int opq = 0; asm volatile("" : "+v"(opq));
            const int r_ = r + opq, h_ = h + opq;
#pragma unroll
            for (int j = 0; j < 2; ++j) {
                const int qrow = u * 256 + wc * 64 + j * 32 + r_;
                const int n2 = qrow & 127, bc = qrow >> 7;
#pragma unroll
                for (int a = 0; a < 2; ++a) {
#pragma unroll
                    for (int v = 0; v < 16; ++v) {
                        const int k1 = a * 32 + (v & 3) + 8 * (v >> 2) + 4 * h_;
                        const int idx = n2 * k1;
                        const float cs = p.cosN[idx], sn = p.sinN[idx];
                        const float yr = acc[2 * a][j][v], yi = acc[2 * a + 1][j][v];
                        const unsigned base = (unsigned)((bc * 64 + k1) * 256 + n2);
                        p.Zb[base] = f2bf(yr * cs + yi * sn); p.Zb[base + 128] = f2bf(yi * cs - yr * sn);
                    }
                    asm volatile("" ::: "memory");
                }
            }
        }
    }
}

__device__ void ph_four2(const Params& p, float* ldsf) {
    LAS unsigned char* lds = (LAS unsigned char*)ldsf;
    int tid = threadIdx.x; asm volatile("" : "+v"(tid));
    const int lane = tid & 63, wid = tid >> 6, wr = wid >> 2, wc = wid & 3, r = lane & 31, h = lane >> 5;
    const int srow = tid >> 3, sc = SCS(tid);
    for (int u = blockIdx.x; u < NBATCH * 64; u += gridDim.x) {
        const int b = u >> 6, k1 = u & 63;
        unsigned po[4], qo[4];
#pragma unroll
        for (int i = 0; i < 4; ++i) { const int rt = srow + 64 * i; po[i] = (unsigned)rt * 512u + sc * 16; qo[i] = (unsigned)(((b * DF + rt) * 64 + k1) * 512) + sc * 16; }
        f32x16 acc[4][2];
        gemm256(lds, tid, (const char*)p.G128, po, (const char*)p.Zb, qo, 4, acc);
        int opq = 0; asm volatile("" : "+v"(opq));
        const int r_ = r + opq, h_ = h + opq;
#pragma unroll
        for (int i = 0; i < 4; ++i) {
#pragma unroll
            for (int j = 0; j < 2; ++j) {
                bf16_t* dst = p.P2 + (unsigned)((b * SEQ + k1 + 64 * (i * 32 + 4 * h_)) * 512 + wr * 256 + wc * 64 + j * 32 + r_);
#pragma unroll
                for (int v = 0; v < 16; ++v) dst[((v & 3) + 8 * (v >> 2)) * 64 * 512] = f2bf(acc[i][j][v]);
                asm volatile("" ::: "memory");
            }
        }
    }
}

__device__ void ph_fmix(const Params& p, float* ldsf) {
    LAS unsigned char* lds = (LAS unsigned char*)ldsf;
    int tid = threadIdx.x; asm volatile("" : "+v"(tid));
    const int lane = tid & 63, wid = tid >> 6, wr = wid >> 2, wc = wid & 3, r = lane & 31, h = lane >> 5;
    const int srow = tid >> 3, sc = SCS(tid);
    for (int u = blockIdx.x; u < NTOK / 256; u += gridDim.x) {
        unsigned po[4], qo[4];
#pragma unroll
        for (int i = 0; i < 4; ++i) { const int rt = srow + 64 * i; po[i] = (unsigned)rt * 1024u + sc * 16; qo[i] = (unsigned)(u * 256 + rt) * 1024u + sc * 16; }
        f32x16 acc[4][2];
        gemm256(lds, tid, (const char*)p.WmixT, po, (const char*)p.P2, qo, 8, acc);
        float ss[2];
#pragma unroll
        for (int j = 0; j < 2; ++j) { float s = 0.f;
#pragma unroll
            for (int i = 0; i < 4; ++i)
#pragma unroll
                for (int v = 0; v < 16; ++v) s = fmaf(acc[i][j][v], acc[i][j][v], s);
            ss[j] = xhalf_sum(s); }
        float* red = ldsf;
        if (h == 0) { red[wr * 256 + wc * 64 + r] = ss[0]; red[wr * 256 + wc * 64 + 32 + r] = ss[1]; }
        __syncthreads();
        int opq = 0; asm volatile("" : "+v"(opq));
        const int r_ = r + opq, h_ = h + opq;
#pragma unroll
        for (int j = 0; j < 2; ++j) {
            const int tl = wc * 64 + j * 32 + r_;
            const float rstd = rsqrtf((red[tl] + red[256 + tl]) / (float)DF + EPS);
            bf16_t* dst = p.A2b + (unsigned)((u * 256 + tl) * D + wr * 128 + 4 * h_);
            const float* gp = p.g_out + wr * 128 + 4 * h_;
#pragma unroll
            for (int i = 0; i < 4; ++i) {
#pragma unroll
                for (int q = 0; q < 4; ++q) {
                    const float4 g = *(const float4*)(gp + i * 32 + 8 * q);
                    uint2 w; w.x = cvt_pk_bf16(acc[i][j][4 * q] * rstd * g.x, acc[i][j][4 * q + 1] * rstd * g.y); w.y = cvt_pk_bf16(acc[i][j][4 * q + 2] * rstd * g.z, acc[i][j][4 * q + 3] * rstd * g.w);
                    *(uint2*)(dst + i * 32 + 8 * q) = w;
                }
                asm volatile("" ::: "memory");
            }
        }
    }
}

constexpr float LOG2E = 1.4426950408889634f;
struct AttnTile { bf16x8 kf[4]; bf16x8 vf[2][2]; };
__device__ void ph_attn(const Params& p, float* ldsf) {
    int tid = threadIdx.x; asm volatile("" : "+v"(tid));
    const int lane = tid & 63, wv = tid >> 6, l31 = lane & 31, h = lane >> 5;
    __syncthreads();
    for (int i = tid; i < NH * 15 * 128; i += NT) { const int dcx = (i & 127) - 48, dr = (i >> 7) % 15, hh = i / (15 * 128);
        ldsf[i] = (dcx >= 0 && dcx <= 30) ? p.rpb[(hh * 15 + dr) * 31 + dcx] * LOG2E : 0.f; }
    __syncthreads();
    const int half = wv & 1;
    const int kcol = (l31 & 3) + 4 * ((l31 >> 3) & 1) + 8 * ((l31 >> 2) & 1), krow = l31 >> 4;
    for (int g = blockIdx.x; g < NBATCH * NH * (GROWS / 4); g += gridDim.x) {
        const int bh = g / (GROWS / 4), row = (g % (GROWS / 4)) * 4 + (wv >> 1), hh = bh % NH;
        const int rs = min(max(row - 4, 0), GROWS - 8);
        const int qc = 32 * half + l31, cs = min(max(qc - 8, 0), GW - 16);
        const int nq = row * GW + qc;
        const bf16_t* Kh = p.Kr + (size_t)bh * SEQ * HD; const bf16_t* Vh = p.Vt + (size_t)bh * HD * SEQ;
        const bf16_t* Kch = p.Kc + (size_t)bh * LCTX * HD; const bf16_t* Vch = p.Vct + (size_t)bh * HD * LCTX;
        bf16x8 qr[4], qp[4];
#pragma unroll
        for (int s = 0; s < 4; ++s) { qr[s] = *(const bf16x8*)(p.Qr + ((size_t)bh * SEQ + nq) * HD + 16 * s + 8 * h); qp[s] = *(const bf16x8*)(p.Qp + ((size_t)bh * SEQ + nq) * HD + 16 * s + 8 * h); }
        f32x16 o0, o1;
#pragma unroll
        for (int v = 0; v < 16; ++v) { o0[v] = 0.f; o1[v] = 0.f; }
        float m = -1e30f, lsum = 0.f;
        const float* rph = ldsf + hh * 15 * 128;
        auto load_tile = [&](int t, AttnTile& T) {
            const bf16_t* kptr; const bf16_t* vptr;
            if (t < 12) { const int pr = t / 3, blk = half + (t - 3 * pr), kr0 = rs + 2 * pr;
                kptr = Kh + (size_t)((kr0 + krow) * GW + 16 * blk + kcol) * HD + 8 * h;
                vptr = Vh + ((size_t)((kr0 * GW + 16 * blk) >> 3) + h) * (HD * 8) + l31 * 8;
#pragma unroll
                for (int kk = 0; kk < 2; ++kk)
#pragma unroll
                    for (int dt = 0; dt < 2; ++dt) T.vf[dt][kk] = *(const bf16x8*)(vptr + (size_t)kk * 8 * (HD * 8) + dt * 32 * 8);
            } else { const int m0 = 32 * (t - 12);
                kptr = Kch + (size_t)(m0 + 16 * krow + kcol) * HD + 8 * h;
                vptr = Vch + ((size_t)(m0 >> 3) + h) * (HD * 8) + l31 * 8;
#pragma unroll
                for (int kk = 0; kk < 2; ++kk)
#pragma unroll
                    for (int dt = 0; dt < 2; ++dt) T.vf[dt][kk] = *(const bf16x8*)(vptr + (size_t)kk * 2 * (HD * 8) + dt * 32 * 8);
            }
#pragma unroll
            for (int s = 0; s < 4; ++s) T.kf[s] = *(const bf16x8*)(kptr + 16 * s);
        };
        auto compute_tile = [&](int t, const AttnTile& T) {
            const bool loc = t < 12;
            f32x16 sa;
#pragma unroll
            for (int v = 0; v < 16; ++v) sa[v] = 0.f;
#pragma unroll
            for (int s = 0; s < 4; ++s) sa = __builtin_amdgcn_mfma_f32_32x32x16_bf16(T.kf[s], loc ? qr[s] : qp[s], sa, 0, 0, 0);
            int w0 = 0;
            if (loc) {
                const int pr = t / 3, blk = half + (t - 3 * pr), kr0 = rs + 2 * pr;
                const float* bp = rph + (kr0 - row + 7) * 128 + (16 * blk + 8 * h - qc + 15 + 48);
#pragma unroll
                for (int v = 0; v < 16; ++v) sa[v] += bp[(v >> 3) * 128 + (v & 3) + 4 * ((v >> 2) & 1)];
                w0 = 16 * blk + 8 * h - cs;
            }
            float tmax = sa[0];
#pragma unroll
            for (int v = 1; v < 16; ++v) tmax = fmaxf(tmax, sa[v]);
            tmax = xhalf_max(tmax);
            if (__any(tmax > m + 10.f)) {
                const float mn = fmaxf(m, tmax), alpha = __builtin_amdgcn_exp2f(m - mn);
                m = mn; lsum *= alpha;
#pragma unroll
                for (int v = 0; v < 16; ++v) { o0[v] *= alpha; o1[v] *= alpha; }
            }
            float ps = 0.f;
#pragma unroll
            for (int v = 0; v < 16; ++v) {
                float e = __builtin_amdgcn_exp2f(sa[v] - m);
                if (loc) e = ((unsigned)(w0 + (v & 3) + 4 * ((v >> 2) & 1)) < 16u) ? e : 0.f;
                sa[v] = e; ps += e;
            }
            lsum += ps;
#pragma unroll
            for (int kk = 0; kk < 2; ++kk) {
                const uint4 w = make_uint4(cvt_pk_bf16(sa[8 * kk + 0], sa[8 * kk + 1]), cvt_pk_bf16(sa[8 * kk + 2], sa[8 * kk + 3]), cvt_pk_bf16(sa[8 * kk + 4], sa[8 * kk + 5]), cvt_pk_bf16(sa[8 * kk + 6], sa[8 * kk + 7]));
                const bf16x8 pf = __builtin_bit_cast(bf16x8, w);
                o0 = __builtin_amdgcn_mfma_f32_32x32x16_bf16(T.vf[0][kk], pf, o0, 0, 0, 0);
                o1 = __builtin_amdgcn_mfma_f32_32x32x16_bf16(T.vf[1][kk], pf, o1, 0, 0, 0);
            }
        };
        AttnTile TA, TB;
        load_tile(0, TA);
#pragma unroll 1
        for (int t = 0; t < 20; t += 2) {
            load_tile(t + 1, TB);
            compute_tile(t, TA);
            if (t + 2 < 20) load_tile(t + 2, TA);
            compute_tile(t + 1, TB);
        }
        lsum = xhalf_sum(lsum);
        const float inv = 1.f / lsum;
        float* op = p.na + (size_t)((bh / NH) * SEQ + nq) * DNA + hh * HD + 4 * h;
#pragma unroll
        for (int q = 0; q < 4; ++q) {
            *(float4*)(op + 8 * q) = make_float4(o0[4 * q] * inv, o0[4 * q + 1] * inv, o0[4 * q + 2] * inv, o0[4 * q + 3] * inv);
            *(float4*)(op + 32 + 8 * q) = make_float4(o1[4 * q] * inv, o1[4 * q + 1] * inv, o1[4 * q + 2] * inv, o1[4 * q + 3] * inv);
        }
    }
}

__device__ void ph_a2rows(const Params& p, float* lds) {
    int tid = threadIdx.x; asm volatile("" : "+v"(tid));
    const int wv = tid >> 6, lane = tid & 63;
    const int nw = gridDim.x * (NT / 64), gw = blockIdx.x * (NT / 64) + wv;
    for (int tok = gw; tok < NTOK; tok += nw) {
        float4 v[3]; float ss = 0.f;
#pragma unroll
        for (int i = 0; i < 3; ++i) { v[i] = *(const float4*)(p.na + (size_t)tok * DNA + 4 * lane + 256 * i); ss += v[i].x * v[i].x + v[i].y * v[i].y + v[i].z * v[i].z + v[i].w * v[i].w; }
        ss = wave_sum(ss);
        const float rn = rsqrtf(ss / (float)DNA + EPS);
#pragma unroll
        for (int i = 0; i < 3; ++i) { const float4 g = *(const float4*)(p.g_out + DF + 4 * lane + 256 * i);
            uint2 w; w.x = cvt_pk_bf16(v[i].x * rn * g.x, v[i].y * rn * g.y); w.y = cvt_pk_bf16(v[i].z * rn * g.z, v[i].w * rn * g.w);
            *(uint2*)(p.A2b + (size_t)tok * D + DF + 4 * lane + 256 * i) = w; }
    }
}

__device__ void ph_outproj(const Params& p, float* ldsf) {
    LAS unsigned char* lds = (LAS unsigned char*)ldsf;
    int tid = threadIdx.x; asm volatile("" : "+v"(tid));
    const int lane = tid & 63, wid = tid >> 6, wr = wid >> 2, wc = wid & 3, r = lane & 31, h = lane >> 5;
    const int srow = tid >> 3, sc = SCS(tid);
    for (int u = blockIdx.x; u < (NTOK / 256) * (D / 256); u += gridDim.x) {
        const int pm = u >> 2, pn = u & 3;
        unsigned po[4], qo[4];
#pragma unroll
        for (int i = 0; i < 4; ++i) { const int rt = srow + 64 * i; po[i] = (unsigned)(pm * 256 + rt) * (unsigned)(D * 2) + sc * 16; qo[i] = (unsigned)(pn * 256 + rt) * (unsigned)(D * 2) + sc * 16; }
        f32x16 acc[4][2];
        gemm256(lds, tid, (const char*)p.A2b, po, (const char*)p.WoutT, qo, D / 64, acc);
        const float* gt1 = p.mod + (pm >> 5) * NMOD * D + 2 * D;
        int opq = 0; asm volatile("" : "+v"(opq));
        const int r_ = r + opq, h_ = h + opq;
#pragma unroll
        for (int j = 0; j < 2; ++j) {
            const int feat = pn * 256 + wc * 64 + j * 32 + r_; const float g = gt1[feat];
#pragma unroll
            for (int i = 0; i < 4; ++i) {
                const unsigned base = (unsigned)((pm * 256 + wr * 128 + i * 32 + 4 * h_) * D + feat);
                const float* xp = p.x + base; float* op = p.x1 + base;
#pragma unroll
                for (int hf = 0; hf < 2; ++hf) {
                    float xv[8];
#pragma unroll
                    for (int v = 0; v < 8; ++v) xv[v] = xp[((v & 3) + 8 * (v >> 2) + 16 * hf) * D];
#pragma unroll
                    for (int v = 0; v < 8; ++v) op[((v & 3) + 8 * (v >> 2) + 16 * hf) * D] = xv[v] + g * acc[i][j][8 * hf + v];
                    asm volatile("" ::: "memory");
                }
            }
        }
    }
}

__device__ void ph_router(const Params& p, float* lds, bool commit = true) {
    int tid = threadIdx.x; asm volatile("" : "+v"(tid));
    const int wv = tid >> 6, lane = tid & 63;
    int* sel = (int*)lds; int* cntl = sel + 128; int* basel = cntl + 32; int* posl = basel + 32;
    for (int blk = blockIdx.x; blk < NTOK / 64; blk += gridDim.x) {
        __syncthreads();
        if (tid < 32) cntl[tid] = 0;
        for (int ti = 0; ti < 8; ++ti) {
            const int tok = blk * 64 + wv * 8 + ti;
            const int b = tok / SEQ;
            const float* sh = p.mod + b * NMOD * D + 3 * D, * sc = sh + D;
            float hv[16]; float ss = 0.f;
#pragma unroll
            for (int i = 0; i < 16; ++i) { hv[i] = p.x1[(size_t)tok * D + lane + 64 * i]; ss = fmaf(hv[i], hv[i], ss); }
            ss = wave_sum(ss);
            const float r = rsqrtf(ss / (float)D + EPS);
#pragma unroll
            for (int i = 0; i < 16; ++i) { const int e = lane + 64 * i; hv[i] = hv[i] * r * p.g_norm2[e] * (1.f + sc[e]) + sh[e]; p.h2b[(size_t)tok * D + e] = f2bf(hv[i]); }
            float lg[4];
#pragma unroll
            for (int o = 0; o < 4; ++o) { float a = 0.f;
#pragma unroll
                for (int i = 0; i < 16; ++i) a = fmaf(hv[i], p.WrT[o * D + lane + 64 * i], a);
                lg[o] = wave_sum(a); }
            int gs = 0; float gm = lg[0];
#pragma unroll
            for (int o = 1; o < 4; ++o) if (lg[o] > gm) { gm = lg[o]; gs = o; }
            float gz = 0.f;
#pragma unroll
            for (int o = 0; o < 4; ++o) gz += expf(lg[o] - gm);
            const float pg = 1.f / gz;
            gs = __builtin_amdgcn_readfirstlane(gs);
            const float* wre = p.WrT + (4 + gs * 8) * D + lane;
            float le[8];
#pragma unroll
            for (int o = 0; o < 8; ++o) { float a = 0.f;
#pragma unroll
                for (int i = 0; i < 16; ++i) a = fmaf(hv[i], wre[o * D + 64 * i], a);
                le[o] = wave_sum(a); }
            int i0 = 0; float m0 = le[0];
#pragma unroll
            for (int o = 1; o < 8; ++o) if (le[o] > m0) { m0 = le[o]; i0 = o; }
            int i1 = -1; float m1 = -3.0e38f;
#pragma unroll
            for (int o = 0; o < 8; ++o) if (o != i0 && le[o] > m1) { m1 = le[o]; i1 = o; }
            const float e1 = expf(m1 - m0);
            const float g0 = pg / (1.f + e1), g1 = pg * e1 / (1.f + e1);
            if (lane == 0) {
                sel[(wv * 8 + ti) * 2] = gs * 8 + i0; sel[(wv * 8 + ti) * 2 + 1] = gs * 8 + i1;
                p.tokgate[tok * 2] = g0; p.tokgate[tok * 2 + 1] = g1;
            }
        }
        __syncthreads();
        int e = 0;
        if (tid < 128) { e = sel[tid]; posl[tid] = atomicAdd(&cntl[e], 1); }
        __syncthreads();
        if (tid < 32 && commit) basel[tid] = atomicAdd(&p.cnt[tid * 64], cntl[tid]);
        __syncthreads();
        if (tid < 128 && commit) p.list[e * NTOK + basel[e] + posl[tid]] = (blk * 64 + (tid >> 1)) * 2 + (tid & 1);
    }
}

struct ETile { int e, s0, ns, sbase; };
__device__ __forceinline__ int moe_ntiles(const Params& p) { int t = 0; for (int e = 0; e < NEXP; ++e) t += (p.cnt[e * 64] + 255) >> 8; return t; }
__device__ __forceinline__ ETile moe_tile(const Params& p, int tile) {
    int e = 0, base = 0, sb = 0;
    for (;;) { const int c = p.cnt[e * 64], nc = (c + 255) >> 8; if (tile < base + nc) break; base += nc; sb += c; ++e; }
    ETile t; t.e = e; t.s0 = (tile - base) * 256; t.ns = min(256, p.cnt[e * 64] - t.s0); t.sbase = sb; return t;
}

__device__ void ph_moe_gu(const Params& p, float* ldsf) {
    LAS unsigned char* lds = (LAS unsigned char*)ldsf;
    int tid = threadIdx.x; asm volatile("" : "+v"(tid));
    const int lane = tid & 63, wid = tid >> 6, wr = wid >> 2, wc = wid & 3, r = lane & 31, h = lane >> 5;
    const int srow = tid >> 3, sc = SCS(tid);
    const int nunits = moe_ntiles(p) * 4;
    for (int u = blockIdx.x; u < nunits; u += gridDim.x) {
        const ETile t = moe_tile(p, u >> 2); const int fc = u & 3;
        unsigned po[4], qo[4];
#pragma unroll
        for (int i = 0; i < 4; ++i) {
            const int rt = srow + 64 * i;
            const int ent = rt < t.ns ? p.list[t.e * NTOK + t.s0 + rt] : 0;
            po[i] = (unsigned)(ent >> 1) * (unsigned)(D * 2) + sc * 16;
            const int f = fc * 128 + (rt >> 6) * 32 + (rt & 31), up = (rt >> 5) & 1;
            qo[i] = (unsigned)((up * NEXP + t.e) * DEXP + f) * (unsigned)(D * 2) + sc * 16;
        }
        f32x16 acc[4][2];
        gemm256(lds, tid, (const char*)p.h2b, po, (const char*)p.WgT, qo, D / 64, acc);
        int opq = 0; asm volatile("" : "+v"(opq));
        const int r_ = r + opq, h_ = h + opq;
        const int f = fc * 128 + wc * 32 + r_;
#pragma unroll
        for (int i = 0; i < 4; ++i) {
            const int s = wr * 128 + i * 32 + 4 * h_;
#pragma unroll
            for (int v = 0; v < 16; ++v) {
                const int sv = s + (v & 3) + 8 * (v >> 2);
                const float g = acc[i][0][v], uu = acc[i][1][v];
                if (sv < t.ns) p.act[(unsigned)((t.sbase + t.s0 + sv) * DEXP + f)] = f2bf(g / (1.f + __expf(-g)) * uu);
            }
            asm volatile("" ::: "memory");
        }
    }
}

__device__ void ph_moe_down(const Params& p, float* ldsf) {
    LAS unsigned char* lds = (LAS unsigned char*)ldsf;
    int tid = threadIdx.x; asm volatile("" : "+v"(tid));
    const int lane = tid & 63, wid = tid >> 6, wr = wid >> 2, wc = wid & 3, r = lane & 31, h = lane >> 5;
    const int srow = tid >> 3, sc = SCS(tid);
    const int nunits = moe_ntiles(p) * 4;
    for (int u = blockIdx.x; u < nunits; u += gridDim.x) {
        const ETile t = moe_tile(p, u >> 2); const int pn = u & 3;
        unsigned po[4], qo[4];
#pragma unroll
        for (int i = 0; i < 4; ++i) {
            const int rt = srow + 64 * i;
            po[i] = (unsigned)(t.sbase + t.s0 + (rt < t.ns ? rt : 0)) * (unsigned)(DEXP * 2) + sc * 16;
            qo[i] = (unsigned)(t.e * D + pn * 256 + rt) * (unsigned)(DEXP * 2) + sc * 16;
        }
        f32x16 acc[4][2];
        gemm256(lds, tid, (const char*)p.act, po, (const char*)p.WdT, qo, DEXP / 64, acc);
        int opq = 0; asm volatile("" : "+v"(opq));
        const int r_ = r + opq, h_ = h + opq;
#pragma unroll
        for (int i = 0; i < 4; ++i) {
            const int s = wr * 128 + i * 32 + 4 * h_;
#pragma unroll
            for (int v = 0; v < 16; ++v) {
                const int sv = s + (v & 3) + 8 * (v >> 2);
                if (sv < t.ns) {
                    const int ent = p.list[t.e * NTOK + t.s0 + sv]; const float g = p.tokgate[ent];
                    const unsigned base = (unsigned)ent * D + pn * 256 + wc * 64 + r_;
                    p.ybuf[base] = f2bf(g * acc[i][0][v]); p.ybuf[base + 32] = f2bf(g * acc[i][1][v]);
                }
            }
            asm volatile("" ::: "memory");
        }
    }
}

__device__ void ph_final(const Params& p, float* lds, float* outp) {
    int tid = threadIdx.x; asm volatile("" : "+v"(tid));
    for (int tok = blockIdx.x; tok < NTOK; tok += gridDim.x) {
        const float* gt2 = p.mod + (tok / SEQ) * NMOD * D + 5 * D;
        const unsigned ya = *(const unsigned*)(p.ybuf + (size_t)(2 * tok) * D + 2 * tid), yb = *(const unsigned*)(p.ybuf + (size_t)(2 * tok + 1) * D + 2 * tid);
        const float2 xv = *(const float2*)(p.x1 + (size_t)tok * D + 2 * tid);
        const float m0 = __uint_as_float(ya << 16) + __uint_as_float(yb << 16), m1 = __uint_as_float(ya & 0xffff0000u) + __uint_as_float(yb & 0xffff0000u);
        const float v0 = xv.x + gt2[2 * tid] * m0, v1 = xv.y + gt2[2 * tid + 1] * m1;
        const float ss = block_sum(v0 * v0 + v1 * v1, lds);
        const float rr = rsqrtf(ss / (float)D + EPS);
        *(float2*)(outp + (size_t)tok * D + 2 * tid) = make_float2(v0 * rr * p.g_final[2 * tid], v1 * rr * p.g_final[2 * tid + 1]);
    }
}

extern __shared__ __attribute__((aligned(16))) float smem[];

constexpr int R_P0 = 1, R_INP = 1, R_FOUR = 1, R_ATT = 1, R_OUT = 1, R_MOE = 1, R_RT = 1, R_FIN = 1, R_BAR = 1;
constexpr int LDS_BAR_OFF = 128 * 1024 + 512;
__global__ void __launch_bounds__(NT) mega(Params p) {
    volatile LAS unsigned* st = (volatile LAS unsigned*)((LAS unsigned char*)smem + LDS_BAR_OFF);
    if (threadIdx.x == 0) { st[0] = 0u; st[1] = 0u; }
    __syncthreads();
    const XcdBarrier bar = xcd_barrier_post(p.bar, st);
#define REP(n, call) for (int _r = 0; _r < (n); ++_r) { call; }
    REP(R_P0, ph_adaln_tables(p, smem)) REP(R_BAR, xcd_barrier(bar))
    REP(R_P0, ph_hrows(p, smem)) REP(R_BAR, xcd_barrier(bar))
    REP(R_INP, ph_inproj(p, smem)) REP(R_BAR, xcd_barrier(bar))
    REP(R_FOUR, ph_four1(p, smem)) REP(R_BAR, xcd_barrier(bar))
    REP(R_FOUR, ph_four2(p, smem)) REP(R_BAR, xcd_barrier(bar))
    REP(R_ATT, ph_attn(p, smem)) REP(R_BAR, xcd_barrier(bar))
    REP(R_FOUR, ph_fmix(p, smem); ph_a2rows(p, smem)) REP(R_BAR, xcd_barrier(bar))
    REP(R_OUT, ph_outproj(p, smem)) REP(R_BAR, xcd_barrier(bar))
    REP(R_RT - 1, ph_router(p, smem, false)) ph_router(p, smem); REP(R_BAR, xcd_barrier(bar))
    REP(R_MOE, ph_moe_gu(p, smem)) REP(R_BAR, xcd_barrier(bar))
    REP(R_MOE, ph_moe_down(p, smem)) REP(R_BAR, xcd_barrier(bar))
    REP(R_FIN - 1, ph_final(p, smem, (float*)p.h2b)) ph_final(p, smem, p.out);
}

extern "C" void kernel_launch(void* const* d_in, const int* in_sizes, int n_in, void* d_out, int out_size, void* d_ws, size_t ws_size, hipStream_t stream) {
    constexpr size_t kDynLds = 128 * 1024 + 1024;
    static int grid_blocks = 0;
    if (!grid_blocks) {
        int dev = 0, cus = 0, per_cu = 0;
        (void)hipGetDevice(&dev);
        (void)hipDeviceGetAttribute(&cus, hipDeviceAttributeMultiprocessorCount, dev);
        (void)hipFuncSetAttribute((const void*)mega, hipFuncAttributeMaxDynamicSharedMemorySize, (int)kDynLds);
        (void)hipOccupancyMaxActiveBlocksPerMultiprocessor(&per_cu, (const void*)mega, NT, kDynLds);
        if (per_cu > 1) per_cu = 1;
        grid_blocks = cus * per_cu;
    }
    Params p{};
    p.x = (const float*)d_in[0]; p.c = (const float*)d_in[1]; p.ctx = (const float*)d_in[2]; p.c_ctx = (const float*)d_in[3];
    p.w_ada = (const float*)d_in[4]; p.b_ada = (const float*)d_in[5]; p.g_norm1 = (const float*)d_in[6]; p.w_in = (const float*)d_in[7];
    p.w_fmix = (const float*)d_in[8]; p.rpb = (const float*)d_in[9]; p.g_out = (const float*)d_in[10]; p.w_out = (const float*)d_in[11];
    p.g_norm2 = (const float*)d_in[12]; p.w_rg = (const float*)d_in[13]; p.w_re = (const float*)d_in[14]; p.w_gate = (const float*)d_in[15];
    p.w_up = (const float*)d_in[16]; p.w_down = (const float*)d_in[17]; p.g_final = (const float*)d_in[18];
    p.out = (float*)d_out;
    char* w = (char*)d_ws; size_t o = 0;
    auto take = [&](size_t bytes) { char* r = w + o; o += (bytes + 255) & ~(size_t)255; return r; };
    p.mod = (float*)take(3 * NMOD * D * 4); p.cosN = (float*)take(SEQ * 4); p.sinN = (float*)take(SEQ * 4); p.ropeR = (float*)take(GROWS * 32 * 4); p.ropeC = (float*)take(GW * 32 * 4);
    p.bar = (unsigned*)take(XCD_BAR_WORDS * 4); p.WrT = (float*)take(36 * D * 4); p.cnt = (int*)take(NEXP * 256); p.list = (int*)take((size_t)NEXP * NTOK * 4); p.tokgate = (float*)take(2 * NTOK * 4);
    p.WinT = (bf16_t*)take((size_t)DIN * D * 2); p.WoutT = (bf16_t*)take((size_t)D * D * 2);
    p.W64cs = (bf16_t*)take(256 * 64 * 2); p.G128 = (bf16_t*)take(256 * 256 * 2); p.WmixT = (bf16_t*)take(256 * 512 * 2);
    p.WgT = (bf16_t*)take((size_t)NEXP * DEXP * D * 2); p.WuT = (bf16_t*)take((size_t)NEXP * DEXP * D * 2); p.WdT = (bf16_t*)take((size_t)NEXP * DEXP * D * 2);
    char* R1 = take((size_t)NTOK * D * 4 + 256);
    p.hb = (bf16_t*)R1; p.Zb = (bf16_t*)R1; p.na = (float*)R1; p.P2 = (bf16_t*)(R1 + (size_t)NTOK * DNA * 4); p.h2b = (bf16_t*)R1; p.act = p.h2b + (size_t)NTOK * D;
    const size_t qkv = (size_t)NTOK * DNA * 2;
    char* R2 = take((size_t)NTOK * DF * 2 + 4 * qkv + 2 * (size_t)NCTX * DNA * 2 + 4096);
    p.fX = (bf16_t*)R2; p.Qr = (bf16_t*)(R2 + (size_t)NTOK * DF * 2); p.Qp = p.Qr + (size_t)NTOK * DNA; p.Kr = p.Qp + (size_t)NTOK * DNA; p.Vt = p.Kr + (size_t)NTOK * DNA;
    p.Kc = p.Vt + (size_t)NTOK * DNA; p.Vct = p.Kc + (size_t)NCTX * DNA;
    p.A2b = (bf16_t*)R2; p.x1 = (float*)(R2 + (size_t)NTOK * DF * 2 + 4 * qkv + 2 * (size_t)NCTX * DNA * 2 - (size_t)NTOK * D * 4);
    p.ybuf = (bf16_t*)p.out;
    void* args[] = {&p};
    (void)hipMemsetAsync(p.bar, 0, XCD_BAR_WORDS * 4, stream);
    hipError_t e = hipLaunchCooperativeKernel((const void*)mega, dim3(grid_blocks), dim3(NT), args, kDynLds, stream);
    if (e != hipSuccess) fprintf(stderr, "cooperative launch failed: %s (grid %d)\n", hipGetErrorString(e), grid_blocks);
}
```

```cpp
#include <hip/hip_runtime.h>
#include <cstdio>
#include <cstdint>

constexpr int D = 1024, NBATCH = 2, SEQ = 8192, NTOK = NBATCH * SEQ, LCTX = 256, NCTX = NBATCH * LCTX, NROWS = NTOK + NCTX;
constexpr int DIN = 2560, DF = 256, NH = 12, HD = 64, DNA = 768, QOFF = 256, KOFF = 1024, VOFF = 1792;
constexpr int GW = 64, GROWS = 128, NEXP = 32, DEXP = 512, NMOD = 6;
constexpr float EPS = 1e-6f;
constexpr int NT = 512;
constexpr float QSCALE = 0.125f * 1.4426950408889634f;
typedef unsigned short bf16_t;
typedef short bf16x8 __attribute__((ext_vector_type(8)));
typedef float f32x16 __attribute__((ext_vector_type(16)));
typedef float f32x4 __attribute__((ext_vector_type(4)));
__device__ __forceinline__ unsigned cvt_pk_bf16(float lo, float hi) { unsigned r; asm volatile("v_cvt_pk_bf16_f32 %0, %1, %2" : "=v"(r) : "v"(lo), "v"(hi)); return r; }
__device__ __forceinline__ bf16_t f2bf(float v) { return (bf16_t)(cvt_pk_bf16(v, 0.f) & 0xffffu); }
__device__ __forceinline__ float bf2f(bf16_t v) { return __uint_as_float((unsigned)v << 16); }

struct Params {
    const float *x, *c, *ctx, *c_ctx, *w_ada, *b_ada, *g_norm1, *w_in, *w_fmix, *rpb, *g_out, *w_out, *g_norm2, *w_rg, *w_re, *w_gate, *w_up, *w_down, *g_final;
    float* out;
    float *mod, *cosN, *sinN, *ropeR, *ropeC;
    float *na;
    float *x1;
    int *cnt, *list; float* tokgate; unsigned* bar; float* WrT;
    bf16_t *WinT, *WoutT, *WgT, *WuT, *WdT;
    bf16_t *hb, *A2b;
    bf16_t *h2b, *act, *ybuf;
    bf16_t *fX, *Qr, *Qp, *Kr, *Vt, *Kc, *Vct;
    bf16_t *W64cs, *G128, *WmixT;
    bf16_t *Zb, *P2;
};

template <int CTRL> __device__ __forceinline__ float dpp(float x) { return __builtin_bit_cast(float, __builtin_amdgcn_mov_dpp(__builtin_bit_cast(int, x), CTRL, 0xf, 0xf, true)); }
__device__ __forceinline__ float xhalf_sum(float x) { auto t = __builtin_amdgcn_permlane32_swap(__float_as_uint(x), __float_as_uint(x), false, false); return __uint_as_float(t[0]) + __uint_as_float(t[1]); }
__device__ __forceinline__ float xhalf_max(float x) { auto t = __builtin_amdgcn_permlane32_swap(__float_as_uint(x), __float_as_uint(x), false, false); return fmaxf(__uint_as_float(t[0]), __uint_as_float(t[1])); }
__device__ __forceinline__ float wave_sum(float x) {
    x += dpp<0xB1>(x); x += dpp<0x4E>(x); x += dpp<0x141>(x); x += dpp<0x128>(x);
    x += __shfl_xor(x, 16);
    return x + __shfl_xor(x, 32);
}
__device__ __forceinline__ float wave_max(float x) {
    x = fmaxf(x, dpp<0xB1>(x)); x = fmaxf(x, dpp<0x4E>(x)); x = fmaxf(x, dpp<0x141>(x)); x = fmaxf(x, dpp<0x128>(x));
    x = fmaxf(x, __shfl_xor(x, 16));
    return fmaxf(x, __shfl_xor(x, 32));
}
__device__ __forceinline__ float block_sum(float v, float* red) {
    v = wave_sum(v);
    const int w = threadIdx.x >> 6, l = threadIdx.x & 63;
    __syncthreads();
    if (l == 0) red[w] = v;
    __syncthreads();
    float s = 0.f;
#pragma unroll
    for (int i = 0; i < NT / 64; ++i) s += red[i];
    return s;
}

template <class AF, class BF, class EF>
__device__ void ngemm(float* lds, int M, int N, int K, AF af, BF bf, EF ef) {
    float* As = lds;
    float* Bs = lds + 16 * 132;
    int tid = threadIdx.x; asm volatile("" : "+v"(tid));
    const int ty = tid >> 4, tx = tid & 15;
    const int tn = N / 128, nt = (M / 128) * tn;
    for (int t = blockIdx.x; t < nt; t += gridDim.x) {
        const int m0 = (t / tn) * 128, n0 = (t % tn) * 128;
        float acc[4][8];
#pragma unroll
        for (int i = 0; i < 4; ++i)
#pragma unroll
            for (int j = 0; j < 8; ++j) acc[i][j] = 0.f;
        for (int k0 = 0; k0 < K; k0 += 16) {
#pragma unroll
            for (int i = 0; i < 4; ++i) { const int idx = tid + NT * i, kk = idx & 15, m = idx >> 4; As[kk * 132 + m] = af(m0 + m, k0 + kk); }
#pragma unroll
            for (int i = 0; i < 4; ++i) { const int idx = tid + NT * i, n = idx & 127, kk = idx >> 7; Bs[kk * 128 + n] = bf(m0, k0 + kk, n0 + n); }
            __syncthreads();
#pragma unroll
            for (int kk = 0; kk < 16; ++kk) {
                const float4 a = *(const float4*)(As + kk * 132 + ty * 4);
                const float4 b0 = *(const float4*)(Bs + kk * 128 + tx * 8), b1 = *(const float4*)(Bs + kk * 128 + tx * 8 + 4);
                const float av[4] = {a.x, a.y, a.z, a.w}, bv[8] = {b0.x, b0.y, b0.z, b0.w, b1.x, b1.y, b1.z, b1.w};
#pragma unroll
                for (int i = 0; i < 4; ++i)
#pragma unroll
                    for (int j = 0; j < 8; ++j) acc[i][j] = fmaf(av[i], bv[j], acc[i][j]);
            }
            __syncthreads();
        }
#pragma unroll
        for (int i = 0; i < 4; ++i)
#pragma unroll
            for (int j = 0; j < 8; ++j) ef(m0 + ty * 4 + i, n0 + tx * 8 + j, acc[i][j]);
    }
}

#define LAS __attribute__((address_space(3)))
#define SCS(tid) (((tid) & 7) ^ ((((tid) >> 3) >> 1) & 7))
__device__ __forceinline__ void gemm256(LAS unsigned char* lds, const int tid, const char* Pb, const unsigned (&po)[4], const char* Qb, const unsigned (&qo)[4], int nk, f32x16 (&acc)[4][2]) {
    const int lane = tid & 63, wid = __builtin_amdgcn_readfirstlane(tid >> 6), wr = wid >> 2, wc = wid & 3;
    const int r = lane & 31, h = lane >> 5, swz = (r >> 1) & 7;
    const unsigned ldsw = (unsigned)wid * 1024u;
#pragma unroll
    for (int i = 0; i < 4; ++i)
#pragma unroll
        for (int j = 0; j < 2; ++j)
#pragma unroll
            for (int v = 0; v < 16; ++v) acc[i][j][v] = 0.f;
    __syncthreads();
#pragma unroll
    for (int i = 0; i < 4; ++i) {
        __builtin_amdgcn_global_load_lds((const unsigned*)(Pb + po[i]), (LAS unsigned*)(lds + ldsw + i * 8192), 16, 0, 0);
        __builtin_amdgcn_global_load_lds((const unsigned*)(Qb + qo[i]), (LAS unsigned*)(lds + 32768 + ldsw + i * 8192), 16, 0, 0);
    }
    __syncthreads();
    const int prd = (wr * 128 + r) * 128, qrd = 32768 + (wc * 64 + r) * 128;
    const int ko0 = ((0 + h) ^ swz) << 4, ko1 = ((2 + h) ^ swz) << 4, ko2 = ((4 + h) ^ swz) << 4, ko3 = ((6 + h) ^ swz) << 4;
#define G256_LD(pf, qf, ko) do { _Pragma("unroll") for (int i = 0; i < 4; ++i) pf[i] = *(const LAS bf16x8*)(lds + cb + prd + i * 4096 + (ko)); \
                                 _Pragma("unroll") for (int j = 0; j < 2; ++j) qf[j] = *(const LAS bf16x8*)(lds + cb + qrd + j * 4096 + (ko)); } while (0)
#define G256_MM(pf, qf) do { _Pragma("unroll") for (int i = 0; i < 4; ++i) _Pragma("unroll") for (int j = 0; j < 2; ++j) \
                                 acc[i][j] = __builtin_amdgcn_mfma_f32_32x32x16_bf16(pf[i], qf[j], acc[i][j], 0, 0, 0); } while (0)
#pragma unroll 1
    for (int kt = 0; kt < nk; ++kt) {
        const int cb = (kt & 1) * 65536, nb = 65536 - cb;
        {
            const unsigned koff = (unsigned)min(kt + 1, nk - 1) * 128u;
#pragma unroll
            for (int i = 0; i < 4; ++i) {
                __builtin_amdgcn_global_load_lds((const unsigned*)(Pb + (size_t)(po[i] + koff)), (LAS unsigned*)(lds + nb + ldsw + i * 8192), 16, 0, 0);
                __builtin_amdgcn_global_load_lds((const unsigned*)(Qb + (size_t)(qo[i] + koff)), (LAS unsigned*)(lds + nb + 32768 + ldsw + i * 8192), 16, 0, 0);
            }
        }
        bf16x8 pa[4], qa[2], pb[4], qb[2];
        G256_LD(pa, qa, ko0);
        G256_LD(pb, qb, ko1);
        G256_MM(pa, qa);
        G256_LD(pa, qa, ko2);
        G256_MM(pb, qb);
        G256_LD(pb, qb, ko3);
        G256_MM(pa, qa);
        G256_MM(pb, qb);
        __syncthreads();
    }
    asm volatile("" ::: "memory");
}

#define XB_TMO      128
#define XB_XCNT(j)  (256  + 64 * (j))
#define XB_XSUB(j)  (1280 + 64 * (j))
#define XB_XGEN(j)  (2304 + 64 * (j))
#define XB_TOP      3328
#define XB_TOPGEN   3392
#define XCD_BAR_WORDS 3456
#define XB_SPIN_CAP (1u << 18)
__device__ __forceinline__ unsigned xb_ld(unsigned* p)              { return __hip_atomic_load(p, __ATOMIC_RELAXED, __HIP_MEMORY_SCOPE_AGENT); }
__device__ __forceinline__ unsigned xb_add(unsigned* p, unsigned v) { return __hip_atomic_fetch_add(p, v, __ATOMIC_RELAXED, __HIP_MEMORY_SCOPE_AGENT); }
__device__ __forceinline__ unsigned xb_xcc_id() { return (unsigned)__builtin_amdgcn_s_getreg((3 << 11) | 20) & 0xFu; }
#define XB_SPIN(cond, bar) do { unsigned _sp = 0; while (cond) { __builtin_amdgcn_s_sleep(1); \
    if ((++_sp & 255u) == 0u) { if (xb_ld(&(bar)[XB_TMO])) break; if (_sp > XB_SPIN_CAP) { atomicAdd(&(bar)[XB_TMO], 1u); break; } } } } while (0)
struct XcdBarrier { unsigned* bar; unsigned x; volatile LAS unsigned* st; };
__device__ __forceinline__ XcdBarrier xcd_barrier_post(unsigned* bar, volatile LAS unsigned* st) {
    XcdBarrier b; b.bar = bar; b.x = xb_xcc_id(); b.st = st;
    if (threadIdx.x == 0) (void)xb_add(&bar[XB_XCNT(b.x)], 1u);
    return b;
}
__device__ __forceinline__ void xcd_barrier_complete(unsigned* bar, unsigned x, unsigned& nloc, unsigned& nx) {
    const unsigned G = gridDim.x * gridDim.y * gridDim.z;
    unsigned sum, cnt, mine, sp = 0u;
    for (;;) {
        sum = 0u; cnt = 0u; mine = 0u;
#pragma unroll
        for (unsigned j = 0; j < 16; ++j) { const unsigned c = xb_ld(&bar[XB_XCNT(j)]); sum += c; cnt += (c > 0u) ? 1u : 0u; mine = (j == x) ? c : mine; }
        if (sum == G) break;
        __builtin_amdgcn_s_sleep(1);
        if ((++sp & 255u) == 0u) { if (xb_ld(&bar[XB_TMO])) break; if (sp > XB_SPIN_CAP) { atomicAdd(&bar[XB_TMO], 1u); break; } }
    }
    nloc = mine > 0u ? mine : 1u; nx = cnt > 0u ? cnt : 1u;
}
__device__ __forceinline__ void xcd_barrier(const XcdBarrier& b) {
    asm volatile("s_waitcnt vmcnt(0)" ::: "memory");
    __syncthreads();
    if (threadIdx.x == 0) {
        unsigned* bar = b.bar;
        __builtin_amdgcn_s_waitcnt(0);
        unsigned nloc = b.st[0], nx = b.st[1];
        if (nloc == 0u) { xcd_barrier_complete(bar, b.x, nloc, nx); b.st[0] = nloc; b.st[1] = nx; }
        const unsigned old = xb_add(&bar[XB_XSUB(b.x)], 1u);
        const unsigned gen = old / nloc;
        if (old + 1u == (gen + 1u) * nloc) {
            __builtin_amdgcn_fence(__ATOMIC_RELEASE, "agent");
            asm volatile("s_waitcnt vmcnt(0)" ::: "memory");
            const unsigned og = xb_add(&bar[XB_TOP], 1u);
            const unsigned tg = og / nx;
            if (og + 1u == (tg + 1u) * nx) xb_add(&bar[XB_TOPGEN], 1u);
            else XB_SPIN(xb_ld(&bar[XB_TOPGEN]) == tg, bar);
            __builtin_amdgcn_fence(__ATOMIC_ACQUIRE, "agent");
            xb_add(&bar[XB_XGEN(b.x)], 1u);
            asm volatile("s_waitcnt vmcnt(0)" ::: "memory");
        } else {
            XB_SPIN(xb_ld(&bar[XB_XGEN(b.x)]) == gen, bar);
            __builtin_amdgcn_fence(__ATOMIC_ACQUIRE, "agent");
            asm volatile("s_waitcnt vmcnt(0)" ::: "memory");
        }
    }
    __syncthreads();
}

__device__ void transpose_job(float* lds, const float* src, bf16_t* dst, int R, int C, int batch, int& tbase, int gstride, int& next) {
    int tid = threadIdx.x; asm volatile("" : "+v"(tid));
    const int tr = R / 64, tc = C / 256, ntile = batch * tr * tc;
    while (next < tbase + ntile) {
        const int t = next - tbase; next += gstride;
        const int bb = t / (tr * tc), rem = t % (tr * tc), r0 = (rem / tc) * 64, c0 = (rem % tc) * 256;
        const float* s = src + (size_t)bb * R * C + (size_t)r0 * C + c0; bf16_t* d = dst + (size_t)bb * R * C + (size_t)c0 * R + r0;
        float4 v[8];
#pragma unroll
        for (int i = 0; i < 8; ++i) { const int rr = (tid >> 6) + 8 * i, c4 = (tid & 63) * 4; v[i] = *(const float4*)(s + (size_t)rr * C + c4); }
        __syncthreads();
#pragma unroll
        for (int i = 0; i < 8; ++i) { const int rr = (tid >> 6) + 8 * i, c4 = (tid & 63) * 4; float* q = lds + rr * 257 + c4; q[0] = v[i].x; q[1] = v[i].y; q[2] = v[i].z; q[3] = v[i].w; }
        __syncthreads();
#pragma unroll
        for (int i = 0; i < 4; ++i) { const int cc = (tid >> 3) + 64 * i, r8 = (tid & 7) * 8; const float* q = lds + r8 * 257 + cc;
            uint4 w; w.x = cvt_pk_bf16(q[0], q[257]); w.y = cvt_pk_bf16(q[2 * 257], q[3 * 257]); w.z = cvt_pk_bf16(q[4 * 257], q[5 * 257]); w.w = cvt_pk_bf16(q[6 * 257], q[7 * 257]);
            *(uint4*)(d + (size_t)cc * R + r8) = w; }
    }
    tbase += ntile;
}

__device__ void ph_adaln_tables(const Params& p, float* lds) {
    int tid = threadIdx.x; asm volatile("" : "+v"(tid));
    const int gid = blockIdx.x * NT + tid, gsz = gridDim.x * NT;
    if (blockIdx.x < NMOD * D / 32) {
        for (int i = tid; i < 3 * D; i += NT) { const int r = i / D, k = i % D; const float v = r < 2 ? p.c[r * D + k] : p.c_ctx[k]; lds[i] = v / (1.f + expf(-v)); }
        __syncthreads();
        const int col = blockIdx.x * 32 + (tid & 31), kg = tid >> 5;
        float a0 = 0.f, a1 = 0.f, a2 = 0.f;
#pragma unroll 8
        for (int kk = 0; kk < 64; ++kk) { const int k = kg * 64 + kk; const float w = p.w_ada[(size_t)k * (NMOD * D) + col]; a0 = fmaf(lds[k], w, a0); a1 = fmaf(lds[D + k], w, a1); a2 = fmaf(lds[2 * D + k], w, a2); }
        float* red = lds + 3 * D;
        red[(0 * 16 + kg) * 32 + (tid & 31)] = a0; red[(1 * 16 + kg) * 32 + (tid & 31)] = a1; red[(2 * 16 + kg) * 32 + (tid & 31)] = a2;
        __syncthreads();
        if (tid < 96) { const int rr = tid >> 5, cc = tid & 31; float s = 0.f;
#pragma unroll
            for (int g = 0; g < 16; ++g) s += red[(rr * 16 + g) * 32 + cc];
            p.mod[rr * NMOD * D + blockIdx.x * 32 + cc] = s + p.b_ada[blockIdx.x * 32 + cc]; }
        __syncthreads();
    }
    for (int i = gid; i < 36 * D; i += gsz) { const int o = i / D, k = i % D; p.WrT[i] = o < 4 ? p.w_rg[k * 4 + o] : p.w_re[k * NEXP + o - 4]; }
    for (int i = gid; i < SEQ; i += gsz) { p.cosN[i] = cospif(2.f * (float)i / (float)SEQ); p.sinN[i] = sinpif(2.f * (float)i / (float)SEQ); }
    for (int i = gid; i < (GROWS + GW) * 16; i += gsz) {
        const int pos = i / 16, f = i % 16; const float inv = powf(10000.f, -(float)f / 16.f);
        if (pos < GROWS) { const float a = (float)pos * inv; p.ropeR[2 * i] = cosf(a); p.ropeR[2 * i + 1] = sinf(a); }
        else { const int pc = pos - GROWS; const float a = (float)pc * inv; p.ropeC[2 * (pc * 16 + f)] = cosf(a); p.ropeC[2 * (pc * 16 + f) + 1] = sinf(a); }
    }
    if (gid < NEXP) p.cnt[gid * 64] = 0;
    for (int i = gid; i < 256 * 64; i += gsz) {
        const int rho = i >> 6, n1 = i & 63, blk = rho >> 5, k1 = (blk >> 1) * 32 + (rho & 31);
        float v = 0.f;
        if (blk < 4) { const float a = 2.f * (float)((k1 * n1) & 63) / 64.f; v = (blk & 1) ? -sinpif(a) : cospif(a); }
        p.W64cs[i] = f2bf(v);
    }
    for (int i = gid; i < 256 * 256; i += gsz) {
        const int rho = i >> 8, kap = i & 255, ro = rho >> 7, k2 = rho & 127, ri = kap >> 7, n2 = kap & 127;
        const float a = 2.f * (float)((k2 * n2) & 127) / 128.f; const float c = cospif(a), s = sinpif(a);
        p.G128[i] = f2bf(ro == ri ? c : (ro == 0 ? s : -s));
    }
    for (int i = gid; i < 256 * 512; i += gsz) {
        const int j = i >> 9, kap = i & 511, ro = kap >> 8, ch = kap & 255, g = ch >> 6, c = ch & 63;
        float acc = 0.f;
        for (int l = 0; l < 64; ++l) { const float a = 2.f * (float)((l * c) & 63) / 64.f; acc = fmaf(ro ? sinpif(a) : cospif(a), p.w_fmix[(size_t)(64 * g + l) * DF + j], acc); }
        p.WmixT[i] = f2bf(acc * (1.0f / 724.0773439350247f));
    }
    __syncthreads();
    int tbase = 0, next = blockIdx.x;
    transpose_job(lds, p.w_in, p.WinT, D, DIN, 1, tbase, gridDim.x, next);
    transpose_job(lds, p.w_out, p.WoutT, D, D, 1, tbase, gridDim.x, next);
    transpose_job(lds, p.w_gate, p.WgT, D, DEXP, NEXP, tbase, gridDim.x, next);
    transpose_job(lds, p.w_up, p.WuT, D, DEXP, NEXP, tbase, gridDim.x, next);
    transpose_job(lds, p.w_down, p.WdT, DEXP, D, NEXP, tbase, gridDim.x, next);
}

__device__ void ph_hrows(const Params& p, float* lds) {
    int tid = threadIdx.x; asm volatile("" : "+v"(tid));
    for (int row = blockIdx.x; row < NROWS; row += gridDim.x) {
        const float* src = row < NTOK ? p.x + (size_t)row * D : p.ctx + (size_t)(row - NTOK) * D;
        const int mr = row < NTOK ? row / SEQ : 2;
        const float* sh = p.mod + mr * NMOD * D, * sc = sh + D;
        const float2 v = *(const float2*)(src + 2 * tid);
        const float ss = block_sum(v.x * v.x + v.y * v.y, lds);
        const float r = rsqrtf(ss / (float)D + EPS);
        const float o0 = v.x * r * p.g_norm1[2 * tid] * (1.f + sc[2 * tid]) + sh[2 * tid];
        const float o1 = v.y * r * p.g_norm1[2 * tid + 1] * (1.f + sc[2 * tid + 1]) + sh[2 * tid + 1];
        *(unsigned*)(p.hb + (size_t)row * D + 2 * tid) = cvt_pk_bf16(o0, o1);
    }
}

__device__ void ph_inproj(const Params& p, float* ldsf) {
    LAS unsigned char* lds = (LAS unsigned char*)ldsf;
    int tid = threadIdx.x; asm volatile("" : "+v"(tid));
    const int lane = tid & 63, wid = tid >> 6, wr = wid >> 2, wc = wid & 3, r = lane & 31, h = lane >> 5;
    const int srow = tid >> 3, sc = SCS(tid);
    constexpr int NPM = NROWS / 256, NPN = DIN / 256;
    for (int u = blockIdx.x; u < NPM * NPN; u += gridDim.x) {
        const int pm = u / NPN, pn = u % NPN;
        if (pm >= 64 && pn < 4) continue;
        unsigned po[4], qo[4];
#pragma unroll
        for (int i = 0; i < 4; ++i) {
            const int rt = srow + 64 * i;
            po[i] = (unsigned)((pn * 256 + rt) * D * 2 + sc * 16);
            int rowidx;
            if (pn == 0) rowidx = (pm >> 5) * SEQ + 128 * (rt & 63) + 4 * (pm & 31) + (rt >> 6);
            else rowidx = pm * 256 + rt;
            qo[i] = (unsigned)rowidx * (unsigned)(D * 2) + sc * 16;
        }
        f32x16 acc[4][2];
        gemm256(lds, tid, (const char*)p.WinT, po, (const char*)p.hb, qo, D / 64, acc);
        int opq = 0; asm volatile("" : "+v"(opq));
        const int r_ = r + opq, h_ = h + opq;
        if (pn == 0) {
            const int b = pm >> 5, n2 = 4 * (pm & 31) + wc;
#pragma unroll
            for (int i = 0; i < 4; ++i) {
#pragma unroll
                for (int j = 0; j < 2; ++j) {
                    const unsigned base = (unsigned)(((b * DF + wr * 128 + i * 32 + 4 * h_) * 128 + n2) * 64 + j * 32 + r_);
#pragma unroll
                    for (int v = 0; v < 16; ++v) p.fX[base + (unsigned)(((v & 3) + 8 * (v >> 2)) * 128 * 64)] = f2bf(acc[i][j][v]);
                }
                asm volatile("" ::: "memory");
            }
        } else if (pn < 7) {
            const bool isq = pn < 4; const int hg = ((pn - 1) % 3) * 4 + wr * 2;
            const bool isctx = pm >= 64;
            const int b = isctx ? pm - 64 : (pm >> 5);
#pragma unroll
            for (int j = 0; j < 2; ++j) {
                const int n = (isctx ? 0 : (pm & 31) * 256) + wc * 64 + j * 32 + r_;
                const int grow = n >> 6, gcol = n & 63;
#pragma unroll
                for (int i = 0; i < 4; ++i) {
                    const int hh = hg + (i >> 1), blk = i & 1;
                    if (isctx) {
                        const unsigned base = (unsigned)(((b * NH + hh) * LCTX + n) * HD + blk * 32 + 4 * h_);
#pragma unroll
                        for (int q = 0; q < 4; ++q) {
                            uint2 w;
                            w.x = cvt_pk_bf16(acc[i][j][4 * q], acc[i][j][4 * q + 1]); w.y = cvt_pk_bf16(acc[i][j][4 * q + 2], acc[i][j][4 * q + 3]);
                            *(uint2*)(p.Kc + base + 8 * q) = w;
                        }
                    } else {
                        const float* tb = (blk == 0 ? p.ropeR + 32 * grow : p.ropeC + 32 * gcol) + 8 * h_;
                        float o1[8], o2[8];
#pragma unroll
                        for (int v = 0; v < 8; ++v) {
                            const float2 cs = *(const float2*)(tb + 2 * ((v & 3) + 8 * (v >> 2)));
                            const float x1 = acc[i][j][v], x2 = acc[i][j][v + 8];
                            o1[v] = x1 * cs.x - x2 * cs.y; o2[v] = x1 * cs.y + x2 * cs.x;
                        }
                        const unsigned base = (unsigned)(((b * NH + hh) * SEQ + n) * HD + blk * 32 + 4 * h_);
                        if (isq) {
#pragma unroll
                            for (int q = 0; q < 2; ++q) {
                                uint2 w;
                                w.x = cvt_pk_bf16(o1[4 * q] * QSCALE, o1[4 * q + 1] * QSCALE); w.y = cvt_pk_bf16(o1[4 * q + 2] * QSCALE, o1[4 * q + 3] * QSCALE);
                                *(uint2*)(p.Qr + base + 8 * q) = w;
                                w.x = cvt_pk_bf16(o2[4 * q] * QSCALE, o2[4 * q + 1] * QSCALE); w.y = cvt_pk_bf16(o2[4 * q + 2] * QSCALE, o2[4 * q + 3] * QSCALE);
                                *(uint2*)(p.Qr + base + 16 + 8 * q) = w;
                            }
#pragma unroll
                            for (int q = 0; q < 4; ++q) {
                                uint2 w;
                                w.x = cvt_pk_bf16(acc[i][j][4 * q] * QSCALE, acc[i][j][4 * q + 1] * QSCALE); w.y = cvt_pk_bf16(acc[i][j][4 * q + 2] * QSCALE, acc[i][j][4 * q + 3] * QSCALE);
                                *(uint2*)(p.Qp + base + 8 * q) = w;
                            }
                        } else {
#pragma unroll
                            for (int q = 0; q < 2; ++q) {
                                uint2 w;
                                w.x = cvt_pk_bf16(o1[4 * q], o1[4 * q + 1]); w.y = cvt_pk_bf16(o1[4 * q + 2], o1[4 * q + 3]);
                                *(uint2*)(p.Kr + base + 8 * q) = w;
                                w.x = cvt_pk_bf16(o2[4 * q], o2[4 * q + 1]); w.y = cvt_pk_bf16(o2[4 * q + 2], o2[4 * q + 3]);
                                *(uint2*)(p.Kr + base + 16 + 8 * q) = w;
                            }
                        }
                    }
                    asm volatile("" ::: "memory");
                }
            }
        } else {
            const int hg = (pn - 7) * 4 + wr * 2;
            const bool isctx = pm >= 64;
            const int b = isctx ? pm - 64 : (pm >> 5);
            const int ntb = isctx ? LCTX / 8 : SEQ / 8; bf16_t* vb = isctx ? p.Vct : p.Vt;
#pragma unroll
            for (int j = 0; j < 2; ++j) {
                const int n = (isctx ? 0 : (pm & 31) * 256) + wc * 64 + j * 32 + r_;
#pragma unroll
                for (int i = 0; i < 4; ++i) {
                    const unsigned base = (unsigned)((((b * NH + hg + (i >> 1)) * ntb + (n >> 3)) * HD + (i & 1) * 32 + 4 * h_) * 8 + (n & 7));
#pragma unroll
                    for (int v = 0; v < 16; ++v) vb[base + (unsigned)(((v & 3) + 8 * (v >> 2)) * 8)] = f2bf(acc[i][j][v]);
                    asm volatile("" ::: "memory");
                }
            }
        }
    }
}

__device__ void ph_four1(const Params& p, float* ldsf) {
    LAS unsigned char* lds = (LAS unsigned char*)ldsf;
    int tid = threadIdx.x; asm volatile("" : "+v"(tid));
    const int lane = tid & 63, wid = tid >> 6, wr = wid >> 2, wc = wid & 3, r = lane & 31, h = lane >> 5;
    const int srow = tid >> 3, sc = SCS(tid);
    for (int u = blockIdx.x; u < NBATCH * DF * 128 / 256; u += gridDim.x) {
        unsigned po[4], qo[4];
#pragma unroll
        for (int i = 0; i < 4; ++i) { const int rt = srow + 64 * i; po[i] = (unsigned)rt * 128u + sc * 16; qo[i] = (unsigned)(u * 256 + rt) * 128u + sc * 16; }
        f32x16 acc[4][2];
        gemm256(lds, tid, (const char*)p.W64cs, po, (const char*)p.fX, qo, 1, acc);
        if (wr == 0) {
            int opq = 0; asm volatile("" : "+v"(opq));
            const int r_ = r + opq, h_ = h + opq;
#pragma unroll
            for (int j = 0; j < 2; ++j) {
                const int qrow = u * 256 + wc * 64 + j * 32 + r_;
                const int n2 = qrow & 127, bc = qrow >> 7;
#pragma unroll
                for (int a = 0; a < 2; ++a) {
#pragma unroll
                    for (int v = 0; v < 16; ++v) {
                        const int k1 = a * 32 + (v & 3) + 8 * (v >> 2) + 4 * h_;
                        const int idx = n2 * k1;
                        const float cs = p.cosN[idx], sn = p.sinN[idx];
                        const float yr = acc[2 * a][j][v], yi = acc[2 * a + 1][j][v];
                        const unsigned base = (unsigned)((bc * 64 + k1) * 256 + n2);
                        p.Zb[base] = f2bf(yr * cs + yi * sn); p.Zb[base + 128] = f2bf(yi * cs - yr * sn);
                    }
                    asm volatile("" ::: "memory");
                }
            }
        }
    }
}

__device__ void ph_four2(const Params& p, float* ldsf) {
    LAS unsigned char* lds = (LAS unsigned char*)ldsf;
    int tid = threadIdx.x; asm volatile("" : "+v"(tid));
    const int lane = tid & 63, wid = tid >> 6, wr = wid >> 2, wc = wid & 3, r = lane & 31, h = lane >> 5;
    const int srow = tid >> 3, sc = SCS(tid);
    for (int u = blockIdx.x; u < NBATCH * 64; u += gridDim.x) {
        const int b = u >> 6, k1 = u & 63;
        unsigned po[4], qo[4];
#pragma unroll
        for (int i = 0; i < 4; ++i) { const int rt = srow + 64 * i; po[i] = (unsigned)rt * 512u + sc * 16; qo[i] = (unsigned)(((b * DF + rt) * 64 + k1) * 512) + sc * 16; }
        f32x16 acc[4][2];
        gemm256(lds, tid, (const char*)p.G128, po, (const char*)p.Zb, qo, 4, acc);
        int opq = 0; asm volatile("" : "+v"(opq));
        const int r_ = r + opq, h_ = h + opq;
#pragma unroll
        for (int i = 0; i < 4; ++i) {
#pragma unroll
            for (int j = 0; j < 2; ++j) {
                bf16_t* dst = p.P2 + (unsigned)((b * SEQ + k1 + 64 * (i * 32 + 4 * h_)) * 512 + wr * 256 + wc * 64 + j * 32 + r_);
#pragma unroll
                for (int v = 0; v < 16; ++v) dst[((v & 3) + 8 * (v >> 2)) * 64 * 512] = f2bf(acc[i][j][v]);
                asm volatile("" ::: "memory");
            }
        }
    }
}

__device__ void ph_fmix(const Params& p, float* ldsf) {
    LAS unsigned char* lds = (LAS unsigned char*)ldsf;
    int tid = threadIdx.x; asm volatile("" : "+v"(tid));
    const int lane = tid & 63, wid = tid >> 6, wr = wid >> 2, wc = wid & 3, r = lane & 31, h = lane >> 5;
    const int srow = tid >> 3, sc = SCS(tid);
    for (int u = blockIdx.x; u < NTOK / 256; u += gridDim.x) {
        unsigned po[4], qo[4];
#pragma unroll
        for (int i = 0; i < 4; ++i) { const int rt = srow + 64 * i; po[i] = (unsigned)rt * 1024u + sc * 16; qo[i] = (unsigned)(u * 256 + rt) * 1024u + sc * 16; }
        f32x16 acc[4][2];
        gemm256(lds, tid, (const char*)p.WmixT, po, (const char*)p.P2, qo, 8, acc);
        float ss[2];
#pragma unroll
        for (int j = 0; j < 2; ++j) { float s = 0.f;
#pragma unroll
            for (int i = 0; i < 4; ++i)
#pragma unroll
                for (int v = 0; v < 16; ++v) s = fmaf(acc[i][j][v], acc[i][j][v], s);
            ss[j] = xhalf_sum(s); }
        float* red = ldsf;
        if (h == 0) { red[wr * 256 + wc * 64 + r] = ss[0]; red[wr * 256 + wc * 64 + 32 + r] = ss[1]; }
        __syncthreads();
        int opq = 0; asm volatile("" : "+v"(opq));
        const int r_ = r + opq, h_ = h + opq;
#pragma unroll
        for (int j = 0; j < 2; ++j) {
            const int tl = wc * 64 + j * 32 + r_;
            const float rstd = rsqrtf((red[tl] + red[256 + tl]) / (float)DF + EPS);
            bf16_t* dst = p.A2b + (unsigned)((u * 256 + tl) * D + wr * 128 + 4 * h_);
            const float* gp = p.g_out + wr * 128 + 4 * h_;
#pragma unroll
            for (int i = 0; i < 4; ++i) {
#pragma unroll
                for (int q = 0; q < 4; ++q) {
                    const float4 g = *(const float4*)(gp + i * 32 + 8 * q);
                    uint2 w; w.x = cvt_pk_bf16(acc[i][j][4 * q] * rstd * g.x, acc[i][j][4 * q + 1] * rstd * g.y); w.y = cvt_pk_bf16(acc[i][j][4 * q + 2] * rstd * g.z, acc[i][j][4 * q + 3] * rstd * g.w);
                    *(uint2*)(dst + i * 32 + 8 * q) = w;
                }
                asm volatile("" ::: "memory");
            }
        }
    }
}

constexpr float LOG2E = 1.4426950408889634f;
struct AttnTile { bf16x8 kf[4]; bf16x8 vf[2][2]; };
__device__ void ph_attn(const Params& p, float* ldsf) {
    int tid = threadIdx.x; asm volatile("" : "+v"(tid));
    const int lane = tid & 63, wv = tid >> 6, l31 = lane & 31, h = lane >> 5;
    __syncthreads();
    for (int i = tid; i < NH * 15 * 128; i += NT) { const int dcx = (i & 127) - 48, dr = (i >> 7) % 15, hh = i / (15 * 128);
        ldsf[i] = (dcx >= 0 && dcx <= 30) ? p.rpb[(hh * 15 + dr) * 31 + dcx] * LOG2E : 0.f; }
    __syncthreads();
    const int half = wv & 1;
    const int kcol = (l31 & 3) + 4 * ((l31 >> 3) & 1) + 8 * ((l31 >> 2) & 1), krow = l31 >> 4;
    for (int g = blockIdx.x; g < NBATCH * NH * (GROWS / 4); g += gridDim.x) {
        const int bh = g / (GROWS / 4), row = (g % (GROWS / 4)) * 4 + (wv >> 1), hh = bh % NH;
        const int rs = min(max(row - 4, 0), GROWS - 8);
        const int qc = 32 * half + l31, cs = min(max(qc - 8, 0), GW - 16);
        const int nq = row * GW + qc;
        const bf16_t* Kh = p.Kr + (size_t)bh * SEQ * HD; const bf16_t* Vh = p.Vt + (size_t)bh * HD * SEQ;
        const bf16_t* Kch = p.Kc + (size_t)bh * LCTX * HD; const bf16_t* Vch = p.Vct + (size_t)bh * HD * LCTX;
        bf16x8 qr[4], qp[4];
#pragma unroll
        for (int s = 0; s < 4; ++s) { qr[s] = *(const bf16x8*)(p.Qr + ((size_t)bh * SEQ + nq) * HD + 16 * s + 8 * h); qp[s] = *(const bf16x8*)(p.Qp + ((size_t)bh * SEQ + nq) * HD + 16 * s + 8 * h); }
        f32x16 o0, o1;
#pragma unroll
        for (int v = 0; v < 16; ++v) { o0[v] = 0.f; o1[v] = 0.f; }
        float m = -1e30f, lsum = 0.f;
        const float* rph = ldsf + hh * 15 * 128;
        auto load_tile = [&](int t, AttnTile& T) {
            const bf16_t* kptr; const bf16_t* vptr;
            if (t < 12) { const int pr = t / 3, blk = half + (t - 3 * pr), kr0 = rs + 2 * pr;
                kptr = Kh + (size_t)((kr0 + krow) * GW + 16 * blk + kcol) * HD + 8 * h;
                vptr = Vh + ((size_t)((kr0 * GW + 16 * blk) >> 3) + h) * (HD * 8) + l31 * 8;
#pragma unroll
                for (int kk = 0; kk < 2; ++kk)
#pragma unroll
                    for (int dt = 0; dt < 2; ++dt) T.vf[dt][kk] = *(const bf16x8*)(vptr + (size_t)kk * 8 * (HD * 8) + dt * 32 * 8);
            } else { const int m0 = 32 * (t - 12);
                kptr = Kch + (size_t)(m0 + 16 * krow + kcol) * HD + 8 * h;
                vptr = Vch + ((size_t)(m0 >> 3) + h) * (HD * 8) + l31 * 8;
#pragma unroll
                for (int kk = 0; kk < 2; ++kk)
#pragma unroll
                    for (int dt = 0; dt < 2; ++dt) T.vf[dt][kk] = *(const bf16x8*)(vptr + (size_t)kk * 2 * (HD * 8) + dt * 32 * 8);
            }
#pragma unroll
            for (int s = 0; s < 4; ++s) T.kf[s] = *(const bf16x8*)(kptr + 16 * s);
        };
        auto compute_tile = [&](int t, const AttnTile& T) {
            const bool loc = t < 12;
            f32x16 sa;
#pragma unroll
            for (int v = 0; v < 16; ++v) sa[v] = 0.f;
#pragma unroll
            for (int s = 0; s < 4; ++s) sa = __builtin_amdgcn_mfma_f32_32x32x16_bf16(T.kf[s], loc ? qr[s] : qp[s], sa, 0, 0, 0);
            int w0 = 0;
            if (loc) {
                const int pr = t / 3, blk = half + (t - 3 * pr), kr0 = rs + 2 * pr;
                const float* bp = rph + (kr0 - row + 7) * 128 + (16 * blk + 8 * h - qc + 15 + 48);
#pragma unroll
                for (int v = 0; v < 16; ++v) sa[v] += bp[(v >> 3) * 128 + (v & 3) + 4 * ((v >> 2) & 1)];
                w0 = 16 * blk + 8 * h - cs;
            }
            float tmax = sa[0];
#pragma unroll
            for (int v = 1; v < 16; ++v) tmax = fmaxf(tmax, sa[v]);
            tmax = xhalf_max(tmax);
            if (__any(tmax > m + 10.f)) {
                const float mn = fmaxf(m, tmax), alpha = __builtin_amdgcn_exp2f(m - mn);
                m = mn; lsum *= alpha;
#pragma unroll
                for (int v = 0; v < 16; ++v) { o0[v] *= alpha; o1[v] *= alpha; }
            }
            float ps = 0.f;
#pragma unroll
            for (int v = 0; v < 16; ++v) {
                float e = __builtin_amdgcn_exp2f(sa[v] - m);
                if (loc) e = ((unsigned)(w0 + (v & 3) + 4 * ((v >> 2) & 1)) < 16u) ? e : 0.f;
                sa[v] = e; ps += e;
            }
            lsum += ps;
#pragma unroll
            for (int kk = 0; kk < 2; ++kk) {
                const uint4 w = make_uint4(cvt_pk_bf16(sa[8 * kk + 0], sa[8 * kk + 1]), cvt_pk_bf16(sa[8 * kk + 2], sa[8 * kk + 3]), cvt_pk_bf16(sa[8 * kk + 4], sa[8 * kk + 5]), cvt_pk_bf16(sa[8 * kk + 6], sa[8 * kk + 7]));
                const bf16x8 pf = __builtin_bit_cast(bf16x8, w);
                o0 = __builtin_amdgcn_mfma_f32_32x32x16_bf16(T.vf[0][kk], pf, o0, 0, 0, 0);
                o1 = __builtin_amdgcn_mfma_f32_32x32x16_bf16(T.vf[1][kk], pf, o1, 0, 0, 0);
            }
        };
        AttnTile TA, TB;
        load_tile(0, TA);
#pragma unroll 1
        for (int t = 0; t < 20; t += 2) {
            load_tile(t + 1, TB);
            compute_tile(t, TA);
            if (t + 2 < 20) load_tile(t + 2, TA);
            compute_tile(t + 1, TB);
        }
        lsum = xhalf_sum(lsum);
        const float inv = 1.f / lsum;
        float* op = p.na + (size_t)((bh / NH) * SEQ + nq) * DNA + hh * HD + 4 * h;
#pragma unroll
        for (int q = 0; q < 4; ++q) {
            *(float4*)(op + 8 * q) = make_float4(o0[4 * q] * inv, o0[4 * q + 1] * inv, o0[4 * q + 2] * inv, o0[4 * q + 3] * inv);
            *(float4*)(op + 32 + 8 * q) = make_float4(o1[4 * q] * inv, o1[4 * q + 1] * inv, o1[4 * q + 2] * inv, o1[4 * q + 3] * inv);
        }
    }
}

__device__ void ph_a2rows(const Params& p, float* lds) {
    int tid = threadIdx.x; asm volatile("" : "+v"(tid));
    const int wv = tid >> 6, lane = tid & 63;
    const int nw = gridDim.x * (NT / 64), gw = blockIdx.x * (NT / 64) + wv;
    for (int tok = gw; tok < NTOK; tok += nw) {
        float4 v[3]; float ss = 0.f;
#pragma unroll
        for (int i = 0; i < 3; ++i) { v[i] = *(const float4*)(p.na + (size_t)tok * DNA + 4 * lane + 256 * i); ss += v[i].x * v[i].x + v[i].y * v[i].y + v[i].z * v[i].z + v[i].w * v[i].w; }
        ss = wave_sum(ss);
        const float rn = rsqrtf(ss / (float)DNA + EPS);
#pragma unroll
        for (int i = 0; i < 3; ++i) { const float4 g = *(const float4*)(p.g_out + DF + 4 * lane + 256 * i);
            uint2 w; w.x = cvt_pk_bf16(v[i].x * rn * g.x, v[i].y * rn * g.y); w.y = cvt_pk_bf16(v[i].z * rn * g.z, v[i].w * rn * g.w);
            *(uint2*)(p.A2b + (size_t)tok * D + DF + 4 * lane + 256 * i) = w; }
    }
}

__device__ void ph_outproj(const Params& p, float* ldsf) {
    LAS unsigned char* lds = (LAS unsigned char*)ldsf;
    int tid = threadIdx.x; asm volatile("" : "+v"(tid));
    const int lane = tid & 63, wid = tid >> 6, wr = wid >> 2, wc = wid & 3, r = lane & 31, h = lane >> 5;
    const int srow = tid >> 3, sc = SCS(tid);
    for (int u = blockIdx.x; u < (NTOK / 256) * (D / 256); u += gridDim.x) {
        const int pm = u >> 2, pn = u & 3;
        unsigned po[4], qo[4];
#pragma unroll
        for (int i = 0; i < 4; ++i) { const int rt = srow + 64 * i; po[i] = (unsigned)(pm * 256 + rt) * (unsigned)(D * 2) + sc * 16; qo[i] = (unsigned)(pn * 256 + rt) * (unsigned)(D * 2) + sc * 16; }
        f32x16 acc[4][2];
        gemm256(lds, tid, (const char*)p.A2b, po, (const char*)p.WoutT, qo, D / 64, acc);
        const float* gt1 = p.mod + (pm >> 5) * NMOD * D + 2 * D;
        int opq = 0; asm volatile("" : "+v"(opq));
        const int r_ = r + opq, h_ = h + opq;
#pragma unroll
        for (int j = 0; j < 2; ++j) {
            const int feat = pn * 256 + wc * 64 + j * 32 + r_; const float g = gt1[feat];
#pragma unroll
            for (int i = 0; i < 4; ++i) {
                const unsigned base = (unsigned)((pm * 256 + wr * 128 + i * 32 + 4 * h_) * D + feat);
                const float* xp = p.x + base; float* op = p.x1 + base;
#pragma unroll
                for (int hf = 0; hf < 2; ++hf) {
                    float xv[8];
#pragma unroll
                    for (int v = 0; v < 8; ++v) xv[v] = xp[((v & 3) + 8 * (v >> 2) + 16 * hf) * D];
#pragma unroll
                    for (int v = 0; v < 8; ++v) op[((v & 3) + 8 * (v >> 2) + 16 * hf) * D] = xv[v] + g * acc[i][j][8 * hf + v];
                    asm volatile("" ::: "memory");
                }
            }
        }
    }
}

__device__ void ph_router(const Params& p, float* lds, bool commit = true) {
    int tid = threadIdx.x; asm volatile("" : "+v"(tid));
    const int wv = tid >> 6, lane = tid & 63;
    int* sel = (int*)lds; int* cntl = sel + 128; int* basel = cntl + 32; int* posl = basel + 32;
    for (int blk = blockIdx.x; blk < NTOK / 64; blk += gridDim.x) {
        __syncthreads();
        if (tid < 32) cntl[tid] = 0;
        for (int ti = 0; ti < 8; ++ti) {
            const int tok = blk * 64 + wv * 8 + ti;
            const int b = tok / SEQ;
            const float* sh = p.mod + b * NMOD * D + 3 * D, * sc = sh + D;
            float hv[16]; float ss = 0.f;
#pragma unroll
            for (int i = 0; i < 16; ++i) { hv[i] = p.x1[(size_t)tok * D + lane + 64 * i]; ss = fmaf(hv[i], hv[i], ss); }
            ss = wave_sum(ss);
            const float r = rsqrtf(ss / (float)D + EPS);
#pragma unroll
            for (int i = 0; i < 16; ++i) { const int e = lane + 64 * i; hv[i] = hv[i] * r * p.g_norm2[e] * (1.f + sc[e]) + sh[e]; p.h2b[(size_t)tok * D + e] = f2bf(hv[i]); }
            float lg[4];
#pragma unroll
            for (int o = 0; o < 4; ++o) { float a = 0.f;
#pragma unroll
                for (int i = 0; i < 16; ++i) a = fmaf(hv[i], p.WrT[o * D + lane + 64 * i], a);
                lg[o] = wave_sum(a); }
            int gs = 0; float gm = lg[0];
#pragma unroll
            for (int o = 1; o < 4; ++o) if (lg[o] > gm) { gm = lg[o]; gs = o; }
            float gz = 0.f;
#pragma unroll
            for (int o = 0; o < 4; ++o) gz += expf(lg[o] - gm);
            const float pg = 1.f / gz;
            gs = __builtin_amdgcn_readfirstlane(gs);
            const float* wre = p.WrT + (4 + gs * 8) * D + lane;
            float le[8];
#pragma unroll
            for (int o = 0; o < 8; ++o) { float a = 0.f;
#pragma unroll
                for (int i = 0; i < 16; ++i) a = fmaf(hv[i], wre[o * D + 64 * i], a);
                le[o] = wave_sum(a); }
            int i0 = 0; float m0 = le[0];
#pragma unroll
            for (int o = 1; o < 8; ++o) if (le[o] > m0) { m0 = le[o]; i0 = o; }
            int i1 = -1; float m1 = -3.0e38f;
#pragma unroll
            for (int o = 0; o < 8; ++o) if (o != i0 && le[o] > m1) { m1 = le[o]; i1 = o; }
            const float e1 = expf(m1 - m0);
            const float g0 = pg / (1.f + e1), g1 = pg * e1 / (1.f + e1);
            if (lane == 0) {
                sel[(wv * 8 + ti) * 2] = gs * 8 + i0; sel[(wv * 8 + ti) * 2 + 1] = gs * 8 + i1;
                p.tokgate[tok * 2] = g0; p.tokgate[tok * 2 + 1] = g1;
            }
        }
        __syncthreads();
        int e = 0;
        if (tid < 128) { e = sel[tid]; posl[tid] = atomicAdd(&cntl[e], 1); }
        __syncthreads();
        if (tid < 32 && commit) basel[tid] = atomicAdd(&p.cnt[tid * 64], cntl[tid]);
        __syncthreads();
        if (tid < 128 && commit) p.list[e * NTOK + basel[e] + posl[tid]] = (blk * 64 + (tid >> 1)) * 2 + (tid & 1);
    }
}

struct ETile { int e, s0, ns, sbase; };
__device__ __forceinline__ int moe_ntiles(const Params& p) { int t = 0; for (int e = 0; e < NEXP; ++e) t += (p.cnt[e * 64] + 255) >> 8; return t; }
__device__ __forceinline__ ETile moe_tile(const Params& p, int tile) {
    int e = 0, base = 0, sb = 0;
    for (;;) { const int c = p.cnt[e * 64], nc = (c + 255) >> 8; if (tile < base + nc) break; base += nc; sb += c; ++e; }
    ETile t; t.e = e; t.s0 = (tile - base) * 256; t.ns = min(256, p.cnt[e * 64] - t.s0); t.sbase = sb; return t;
}

__device__ void ph_moe_gu(const Params& p, float* ldsf) {
    LAS unsigned char* lds = (LAS unsigned char*)ldsf;
    int tid = threadIdx.x; asm volatile("" : "+v"(tid));
    const int lane = tid & 63, wid = tid >> 6, wr = wid >> 2, wc = wid & 3, r = lane & 31, h = lane >> 5;
    const int srow = tid >> 3, sc = SCS(tid);
    const int nunits = moe_ntiles(p) * 4;
    for (int u = blockIdx.x; u < nunits; u += gridDim.x) {
        const ETile t = moe_tile(p, u >> 2); const int fc = u & 3;
        unsigned po[4], qo[4];
#pragma unroll
        for (int i = 0; i < 4; ++i) {
            const int rt = srow + 64 * i;
            const int ent = rt < t.ns ? p.list[t.e * NTOK + t.s0 + rt] : 0;
            po[i] = (unsigned)(ent >> 1) * (unsigned)(D * 2) + sc * 16;
            const int f = fc * 128 + (rt >> 6) * 32 + (rt & 31), up = (rt >> 5) & 1;
            qo[i] = (unsigned)((up * NEXP + t.e) * DEXP + f) * (unsigned)(D * 2) + sc * 16;
        }
        f32x16 acc[4][2];
        gemm256(lds, tid, (const char*)p.h2b, po, (const char*)p.WgT, qo, D / 64, acc);
        int opq = 0; asm volatile("" : "+v"(opq));
        const int r_ = r + opq, h_ = h + opq;
        const int f = fc * 128 + wc * 32 + r_;
#pragma unroll
        for (int i = 0; i < 4; ++i) {
            const int s = wr * 128 + i * 32 + 4 * h_;
#pragma unroll
            for (int v = 0; v < 16; ++v) {
                const int sv = s + (v & 3) + 8 * (v >> 2);
                const float g = acc[i][0][v], uu = acc[i][1][v];
                if (sv < t.ns) p.act[(unsigned)((t.sbase + t.s0 + sv) * DEXP + f)] = f2bf(g / (1.f + __expf(-g)) * uu);
            }
            asm volatile("" ::: "memory");
        }
    }
}

__device__ void ph_moe_down(const Params& p, float* ldsf) {
    LAS unsigned char* lds = (LAS unsigned char*)ldsf;
    int tid = threadIdx.x; asm volatile("" : "+v"(tid));
    const int lane = tid & 63, wid = tid >> 6, wr = wid >> 2, wc = wid & 3, r = lane & 31, h = lane >> 5;
    const int srow = tid >> 3, sc = SCS(tid);
    const int nunits = moe_ntiles(p) * 4;
    for (int u = blockIdx.x; u < nunits; u += gridDim.x) {
        const ETile t = moe_tile(p, u >> 2); const int pn = u & 3;
        unsigned po[4], qo[4];
#pragma unroll
        for (int i = 0; i < 4; ++i) {
            const int rt = srow + 64 * i;
            po[i] = (unsigned)(t.sbase + t.s0 + (rt < t.ns ? rt : 0)) * (unsigned)(DEXP * 2) + sc * 16;
            qo[i] = (unsigned)(t.e * D + pn * 256 + rt) * (unsigned)(DEXP * 2) + sc * 16;
        }
        f32x16 acc[4][2];
        gemm256(lds, tid, (const char*)p.act, po, (const char*)p.WdT, qo, DEXP / 64, acc);
        int opq = 0; asm volatile("" : "+v"(opq));
        const int r_ = r + opq, h_ = h + opq;
#pragma unroll
        for (int i = 0; i < 4; ++i) {
            const int s = wr * 128 + i * 32 + 4 * h_;
#pragma unroll
            for (int v = 0; v < 16; ++v) {
                const int sv = s + (v & 3) + 8 * (v >> 2);
                if (sv < t.ns) {
                    const int ent = p.list[t.e * NTOK + t.s0 + sv]; const float g = p.tokgate[ent];
                    const unsigned base = (unsigned)ent * D + pn * 256 + wc * 64 + r_;
                    p.ybuf[base] = f2bf(g * acc[i][0][v]); p.ybuf[base + 32] = f2bf(g * acc[i][1][v]);
                }
            }
            asm volatile("" ::: "memory");
        }
    }
}

__device__ void ph_final(const Params& p, float* lds, float* outp) {
    int tid = threadIdx.x; asm volatile("" : "+v"(tid));
    for (int tok = blockIdx.x; tok < NTOK; tok += gridDim.x) {
        const float* gt2 = p.mod + (tok / SEQ) * NMOD * D + 5 * D;
        const unsigned ya = *(const unsigned*)(p.ybuf + (size_t)(2 * tok) * D + 2 * tid), yb = *(const unsigned*)(p.ybuf + (size_t)(2 * tok + 1) * D + 2 * tid);
        const float2 xv = *(const float2*)(p.x1 + (size_t)tok * D + 2 * tid);
        const float m0 = __uint_as_float(ya << 16) + __uint_as_float(yb << 16), m1 = __uint_as_float(ya & 0xffff0000u) + __uint_as_float(yb & 0xffff0000u);
        const float v0 = xv.x + gt2[2 * tid] * m0, v1 = xv.y + gt2[2 * tid + 1] * m1;
        const float ss = block_sum(v0 * v0 + v1 * v1, lds);
        const float rr = rsqrtf(ss / (float)D + EPS);
        *(float2*)(outp + (size_t)tok * D + 2 * tid) = make_float2(v0 * rr * p.g_final[2 * tid], v1 * rr * p.g_final[2 * tid + 1]);
    }
}

extern __shared__ __attribute__((aligned(16))) float smem[];

constexpr int R_P0 = 1, R_INP = 1, R_FOUR = 1, R_ATT = 1, R_OUT = 1, R_MOE = 1, R_RT = 1, R_FIN = 1, R_BAR = 1;
constexpr int LDS_BAR_OFF = 128 * 1024 + 512;
__global__ void __launch_bounds__(NT) mega(Params p) {
    volatile LAS unsigned* st = (volatile LAS unsigned*)((LAS unsigned char*)smem + LDS_BAR_OFF);
    if (threadIdx.x == 0) { st[0] = 0u; st[1] = 0u; }
    __syncthreads();
    const XcdBarrier bar = xcd_barrier_post(p.bar, st);
#define REP(n, call) for (int _r = 0; _r < (n); ++_r) { call; }
    REP(R_P0, ph_adaln_tables(p, smem)) REP(R_BAR, xcd_barrier(bar))
    REP(R_P0, ph_hrows(p, smem)) REP(R_BAR, xcd_barrier(bar))
    REP(R_INP, ph_inproj(p, smem)) REP(R_BAR, xcd_barrier(bar))
    REP(R_FOUR, ph_four1(p, smem)) REP(R_BAR, xcd_barrier(bar))
    REP(R_FOUR, ph_four2(p, smem)) REP(R_BAR, xcd_barrier(bar))
    REP(R_ATT, ph_attn(p, smem)) REP(R_BAR, xcd_barrier(bar))
    REP(R_FOUR, ph_fmix(p, smem); ph_a2rows(p, smem)) REP(R_BAR, xcd_barrier(bar))
    REP(R_OUT, ph_outproj(p, smem)) REP(R_BAR, xcd_barrier(bar))
    REP(R_RT - 1, ph_router(p, smem, false)) ph_router(p, smem); REP(R_BAR, xcd_barrier(bar))
    REP(R_MOE, ph_moe_gu(p, smem)) REP(R_BAR, xcd_barrier(bar))
    REP(R_MOE, ph_moe_down(p, smem)) REP(R_BAR, xcd_barrier(bar))
    REP(R_FIN - 1, ph_final(p, smem, (float*)p.h2b)) ph_final(p, smem, p.out);
}

extern "C" void kernel_launch(void* const* d_in, const int* in_sizes, int n_in, void* d_out, int out_size, void* d_ws, size_t ws_size, hipStream_t stream) {
    constexpr size_t kDynLds = 128 * 1024 + 1024;
    static int grid_blocks = 0;
    if (!grid_blocks) {
        int dev = 0, cus = 0, per_cu = 0;
        (void)hipGetDevice(&dev);
        (void)hipDeviceGetAttribute(&cus, hipDeviceAttributeMultiprocessorCount, dev);
        (void)hipFuncSetAttribute((const void*)mega, hipFuncAttributeMaxDynamicSharedMemorySize, (int)kDynLds);
        (void)hipOccupancyMaxActiveBlocksPerMultiprocessor(&per_cu, (const void*)mega, NT, kDynLds);
        if (per_cu > 1) per_cu = 1;
        grid_blocks = cus * per_cu;
    }
    Params p{};
    p.x = (const float*)d_in[0]; p.c = (const float*)d_in[1]; p.ctx = (const float*)d_in[2]; p.c_ctx = (const float*)d_in[3];
    p.w_ada = (const float*)d_in[4]; p.b_ada = (const float*)d_in[5]; p.g_norm1 = (const float*)d_in[6]; p.w_in = (const float*)d_in[7];
    p.w_fmix = (const float*)d_in[8]; p.rpb = (const float*)d_in[9]; p.g_out = (const float*)d_in[10]; p.w_out = (const float*)d_in[11];
    p.g_norm2 = (const float*)d_in[12]; p.w_rg = (const float*)d_in[13]; p.w_re = (const float*)d_in[14]; p.w_gate = (const float*)d_in[15];
    p.w_up = (const float*)d_in[16]; p.w_down = (const float*)d_in[17]; p.g_final = (const float*)d_in[18];
    p.out = (float*)d_out;
    char* w = (char*)d_ws; size_t o = 0;
    auto take = [&](size_t bytes) { char* r = w + o; o += (bytes + 255) & ~(size_t)255; return r; };
    p.mod = (float*)take(3 * NMOD * D * 4); p.cosN = (float*)take(SEQ * 4); p.sinN = (float*)take(SEQ * 4); p.ropeR = (float*)take(GROWS * 32 * 4); p.ropeC = (float*)take(GW * 32 * 4);
    p.bar = (unsigned*)take(XCD_BAR_WORDS * 4); p.WrT = (float*)take(36 * D * 4); p.cnt = (int*)take(NEXP * 256); p.list = (int*)take((size_t)NEXP * NTOK * 4); p.tokgate = (float*)take(2 * NTOK * 4);
    p.WinT = (bf16_t*)take((size_t)DIN * D * 2); p.WoutT = (bf16_t*)take((size_t)D * D * 2);
    p.W64cs = (bf16_t*)take(256 * 64 * 2); p.G128 = (bf16_t*)take(256 * 256 * 2); p.WmixT = (bf16_t*)take(256 * 512 * 2);
    p.WgT = (bf16_t*)take((size_t)NEXP * DEXP * D * 2); p.WuT = (bf16_t*)take((size_t)NEXP * DEXP * D * 2); p.WdT = (bf16_t*)take((size_t)NEXP * DEXP * D * 2);
    char* R1 = take((size_t)NTOK * D * 4 + 256);
    p.hb = (bf16_t*)R1; p.Zb = (bf16_t*)R1; p.na = (float*)R1; p.P2 = (bf16_t*)(R1 + (size_t)NTOK * DNA * 4); p.h2b = (bf16_t*)R1; p.act = p.h2b + (size_t)NTOK * D;
    const size_t qkv = (size_t)NTOK * DNA * 2;
    char* R2 = take((size_t)NTOK * DF * 2 + 4 * qkv + 2 * (size_t)NCTX * DNA * 2 + 4096);
    p.fX = (bf16_t*)R2; p.Qr = (bf16_t*)(R2 + (size_t)NTOK * DF * 2); p.Qp = p.Qr + (size_t)NTOK * DNA; p.Kr = p.Qp + (size_t)NTOK * DNA; p.Vt = p.Kr + (size_t)NTOK * DNA;
    p.Kc = p.Vt + (size_t)NTOK * DNA; p.Vct = p.Kc + (size_t)NCTX * DNA;
    p.A2b = (bf16_t*)R2; p.x1 = (float*)(R2 + (size_t)NTOK * DF * 2 + 4 * qkv + 2 * (size_t)NCTX * DNA * 2 - (size_t)NTOK * D * 4);
    p.ybuf = (bf16_t*)p.out;
    void* args[] = {&p};
    (void)hipMemsetAsync(p.bar, 0, XCD_BAR_WORDS * 4, stream);
    hipError_t e = hipLaunchCooperativeKernel((const void*)mega, dim3(grid_blocks), dim3(NT), args, kDynLds, stream);
    if (e != hipSuccess) fprintf(stderr, "cooperative launch failed: %s (grid %d)\n", hipGetErrorString(e), grid_blocks);
}
```

```cpp
#include <hip/hip_runtime.h>
#include <cstdio>
#include <cstdint>

constexpr int D = 1024, NBATCH = 2, SEQ = 8192, NTOK = NBATCH * SEQ, LCTX = 256, NCTX = NBATCH * LCTX, NROWS = NTOK + NCTX;
constexpr int DIN = 2560, DF = 256, NH = 12, HD = 64, DNA = 768, QOFF = 256, KOFF = 1024, VOFF = 1792;
constexpr int GW = 64, GROWS = 128, NEXP = 32, DEXP = 512, NMOD = 6;
constexpr float EPS = 1e-6f;
constexpr int NT = 512;
constexpr float QSCALE = 0.125f * 1.4426950408889634f;
typedef unsigned short bf16_t;
typedef short bf16x8 __attribute__((ext_vector_type(8)));
typedef float f32x16 __attribute__((ext_vector_type(16)));
typedef float f32x4 __attribute__((ext_vector_type(4)));
__device__ __forceinline__ unsigned cvt_pk_bf16(float lo, float hi) { unsigned r; asm volatile("v_cvt_pk_bf16_f32 %0, %1, %2" : "=v"(r) : "v"(lo), "v"(hi)); return r; }
__device__ __forceinline__ bf16_t f2bf(float v) { return (bf16_t)(cvt_pk_bf16(v, 0.f) & 0xffffu); }
__device__ __forceinline__ float bf2f(bf16_t v) { return __uint_as_float((unsigned)v << 16); }

struct Params {
    const float *x, *c, *ctx, *c_ctx, *w_ada, *b_ada, *g_norm1, *w_in, *w_fmix, *rpb, *g_out, *w_out, *g_norm2, *w_rg, *w_re, *w_gate, *w_up, *w_down, *g_final;
    float* out;
    float *mod, *cosN, *sinN, *ropeR, *ropeC;
    float *x1;
    int *cnt, *list; float* tokgate; unsigned* bar; float* WrT; float* ssq; unsigned* tilecnt;
    bf16_t *WinT, *WoutT, *WgT, *WuT, *WdT;
    bf16_t *hb, *A2b;
    bf16_t *h2b, *act, *ybuf;
    bf16_t *fX, *Qr, *Qp, *Kr, *Vt, *Kc, *Vct;
    bf16_t *W64cs, *G128, *WmixT;
    bf16_t *Zb, *P2;
};

template <int CTRL> __device__ __forceinline__ float dpp(float x) { return __builtin_bit_cast(float, __builtin_amdgcn_mov_dpp(__builtin_bit_cast(int, x), CTRL, 0xf, 0xf, true)); }
__device__ __forceinline__ float xhalf_sum(float x) { auto t = __builtin_amdgcn_permlane32_swap(__float_as_uint(x), __float_as_uint(x), false, false); return __uint_as_float(t[0]) + __uint_as_float(t[1]); }
__device__ __forceinline__ float xhalf_max(float x) { auto t = __builtin_amdgcn_permlane32_swap(__float_as_uint(x), __float_as_uint(x), false, false); return fmaxf(__uint_as_float(t[0]), __uint_as_float(t[1])); }
__device__ __forceinline__ float wave_sum(float x) {
    x += dpp<0xB1>(x); x += dpp<0x4E>(x); x += dpp<0x141>(x); x += dpp<0x128>(x);
    x += __shfl_xor(x, 16);
    return x + __shfl_xor(x, 32);
}
__device__ __forceinline__ float wave_max(float x) {
    x = fmaxf(x, dpp<0xB1>(x)); x = fmaxf(x, dpp<0x4E>(x)); x = fmaxf(x, dpp<0x141>(x)); x = fmaxf(x, dpp<0x128>(x));
    x = fmaxf(x, __shfl_xor(x, 16));
    return fmaxf(x, __shfl_xor(x, 32));
}
__device__ __forceinline__ float block_sum(float v, float* red) {
    v = wave_sum(v);
    const int w = threadIdx.x >> 6, l = threadIdx.x & 63;
    __syncthreads();
    if (l == 0) red[w] = v;
    __syncthreads();
    float s = 0.f;
#pragma unroll
    for (int i = 0; i < NT / 64; ++i) s += red[i];
    return s;
}

template <class AF, class BF, class EF>
__device__ void ngemm(float* lds, int M, int N, int K, AF af, BF bf, EF ef) {
    float* As = lds;
    float* Bs = lds + 16 * 132;
    int tid = threadIdx.x; asm volatile("" : "+v"(tid));
    const int ty = tid >> 4, tx = tid & 15;
    const int tn = N / 128, nt = (M / 128) * tn;
    for (int t = blockIdx.x; t < nt; t += gridDim.x) {
        const int m0 = (t / tn) * 128, n0 = (t % tn) * 128;
        float acc[4][8];
#pragma unroll
        for (int i = 0; i < 4; ++i)
#pragma unroll
            for (int j = 0; j < 8; ++j) acc[i][j] = 0.f;
        for (int k0 = 0; k0 < K; k0 += 16) {
#pragma unroll
            for (int i = 0; i < 4; ++i) { const int idx = tid + NT * i, kk = idx & 15, m = idx >> 4; As[kk * 132 + m] = af(m0 + m, k0 + kk); }
#pragma unroll
            for (int i = 0; i < 4; ++i) { const int idx = tid + NT * i, n = idx & 127, kk = idx >> 7; Bs[kk * 128 + n] = bf(m0, k0 + kk, n0 + n); }
            __syncthreads();
#pragma unroll
            for (int kk = 0; kk < 16; ++kk) {
                const float4 a = *(const float4*)(As + kk * 132 + ty * 4);
                const float4 b0 = *(const float4*)(Bs + kk * 128 + tx * 8), b1 = *(const float4*)(Bs + kk * 128 + tx * 8 + 4);
                const float av[4] = {a.x, a.y, a.z, a.w}, bv[8] = {b0.x, b0.y, b0.z, b0.w, b1.x, b1.y, b1.z, b1.w};
#pragma unroll
                for (int i = 0; i < 4; ++i)
#pragma unroll
                    for (int j = 0; j < 8; ++j) acc[i][j] = fmaf(av[i], bv[j], acc[i][j]);
            }
            __syncthreads();
        }
#pragma unroll
        for (int i = 0; i < 4; ++i)
#pragma unroll
            for (int j = 0; j < 8; ++j) ef(m0 + ty * 4 + i, n0 + tx * 8 + j, acc[i][j]);
    }
}

#define LAS __attribute__((address_space(3)))
#define SCS(tid) (((tid) & 7) ^ ((((tid) >> 3) >> 1) & 7))
__device__ __forceinline__ void gemm256(LAS unsigned char* lds, const int tid, const char* Pb, const unsigned (&po)[4], const char* Qb, const unsigned (&qo)[4], int nk, f32x16 (&acc)[4][2], const bool zero = true) {
    const int lane = tid & 63, wid = __builtin_amdgcn_readfirstlane(tid >> 6), wr = wid >> 2, wc = wid & 3;
    const int r = lane & 31, h = lane >> 5, swz = (r >> 1) & 7;
    const unsigned ldsw = (unsigned)wid * 1024u;
    if (zero) {
#pragma unroll
        for (int i = 0; i < 4; ++i)
#pragma unroll
            for (int j = 0; j < 2; ++j)
#pragma unroll
                for (int v = 0; v < 16; ++v) acc[i][j][v] = 0.f;
    }
    __syncthreads();
#pragma unroll
    for (int i = 0; i < 4; ++i) {
        __builtin_amdgcn_global_load_lds((const unsigned*)(Pb + po[i]), (LAS unsigned*)(lds + ldsw + i * 8192), 16, 0, 0);
        __builtin_amdgcn_global_load_lds((const unsigned*)(Qb + qo[i]), (LAS unsigned*)(lds + 32768 + ldsw + i * 8192), 16, 0, 0);
    }
    __syncthreads();
    const int prd = (wr * 128 + r) * 128, qrd = 32768 + (wc * 64 + r) * 128;
    const int ko0 = ((0 + h) ^ swz) << 4, ko1 = ((2 + h) ^ swz) << 4, ko2 = ((4 + h) ^ swz) << 4, ko3 = ((6 + h) ^ swz) << 4;
#define G256_LD(pf, qf, ko) do { _Pragma("unroll") for (int i = 0; i < 4; ++i) pf[i] = *(const LAS bf16x8*)(lds + cb + prd + i * 4096 + (ko)); \
                                 _Pragma("unroll") for (int j = 0; j < 2; ++j) qf[j] = *(const LAS bf16x8*)(lds + cb + qrd + j * 4096 + (ko)); } while (0)
#define G256_MM(pf, qf) do { _Pragma("unroll") for (int i = 0; i < 4; ++i) _Pragma("unroll") for (int j = 0; j < 2; ++j) \
                                 acc[i][j] = __builtin_amdgcn_mfma_f32_32x32x16_bf16(pf[i], qf[j], acc[i][j], 0, 0, 0); } while (0)
#pragma unroll 1
    for (int kt = 0; kt < nk; ++kt) {
        const int cb = (kt & 1) * 65536, nb = 65536 - cb;
        {
            const unsigned koff = (unsigned)min(kt + 1, nk - 1) * 128u;
#pragma unroll
            for (int i = 0; i < 4; ++i) {
                __builtin_amdgcn_global_load_lds((const unsigned*)(Pb + (size_t)(po[i] + koff)), (LAS unsigned*)(lds + nb + ldsw + i * 8192), 16, 0, 0);
                __builtin_amdgcn_global_load_lds((const unsigned*)(Qb + (size_t)(qo[i] + koff)), (LAS unsigned*)(lds + nb + 32768 + ldsw + i * 8192), 16, 0, 0);
            }
        }
        bf16x8 pa[4], qa[2], pb[4], qb[2];
        G256_LD(pa, qa, ko0);
        G256_LD(pb, qb, ko1);
        G256_MM(pa, qa);
        G256_LD(pa, qa, ko2);
        G256_MM(pb, qb);
        G256_LD(pb, qb, ko3);
        G256_MM(pa, qa);
        G256_MM(pb, qb);
        __syncthreads();
    }
    asm volatile("" ::: "memory");
}

#define XB_TMO      128
#define XB_XCNT(j)  (256  + 64 * (j))
#define XB_XSUB(j)  (1280 + 64 * (j))
#define XB_XGEN(j)  (2304 + 64 * (j))
#define XB_TOP      3328
#define XB_TOPGEN   3392
#define XCD_BAR_WORDS 3456
#define XB_SPIN_CAP (1u << 18)
__device__ __forceinline__ unsigned xb_ld(unsigned* p)              { return __hip_atomic_load(p, __ATOMIC_RELAXED, __HIP_MEMORY_SCOPE_AGENT); }
__device__ __forceinline__ unsigned xb_add(unsigned* p, unsigned v) { return __hip_atomic_fetch_add(p, v, __ATOMIC_RELAXED, __HIP_MEMORY_SCOPE_AGENT); }
__device__ __forceinline__ unsigned xb_xcc_id() { return (unsigned)__builtin_amdgcn_s_getreg((3 << 11) | 20) & 0xFu; }
#define XB_SPIN(cond, bar) do { unsigned _sp = 0; while (cond) { __builtin_amdgcn_s_sleep(1); \
    if ((++_sp & 255u) == 0u) { if (xb_ld(&(bar)[XB_TMO])) break; if (_sp > XB_SPIN_CAP) { atomicAdd(&(bar)[XB_TMO], 1u); break; } } } } while (0)
struct XcdBarrier { unsigned* bar; unsigned x; volatile LAS unsigned* st; };
__device__ __forceinline__ XcdBarrier xcd_barrier_post(unsigned* bar, volatile LAS unsigned* st) {
    XcdBarrier b; b.bar = bar; b.x = xb_xcc_id(); b.st = st;
    if (threadIdx.x == 0) (void)xb_add(&bar[XB_XCNT(b.x)], 1u);
    return b;
}
__device__ __forceinline__ void xcd_barrier_complete(unsigned* bar, unsigned x, unsigned& nloc, unsigned& nx) {
    const unsigned G = gridDim.x * gridDim.y * gridDim.z;
    unsigned sum, cnt, mine, sp = 0u;
    for (;;) {
        sum = 0u; cnt = 0u; mine = 0u;
#pragma unroll
        for (unsigned j = 0; j < 16; ++j) { const unsigned c = xb_ld(&bar[XB_XCNT(j)]); sum += c; cnt += (c > 0u) ? 1u : 0u; mine = (j == x) ? c : mine; }
        if (sum == G) break;
        __builtin_amdgcn_s_sleep(1);
        if ((++sp & 255u) == 0u) { if (xb_ld(&bar[XB_TMO])) break; if (sp > XB_SPIN_CAP) { atomicAdd(&bar[XB_TMO], 1u); break; } }
    }
    nloc = mine > 0u ? mine : 1u; nx = cnt > 0u ? cnt : 1u;
}
__device__ __forceinline__ void xcd_barrier(const XcdBarrier& b) {
    asm volatile("s_waitcnt vmcnt(0)" ::: "memory");
    __syncthreads();
    if (threadIdx.x == 0) {
        unsigned* bar = b.bar;
        __builtin_amdgcn_s_waitcnt(0);
        unsigned nloc = b.st[0], nx = b.st[1];
        if (nloc == 0u) { xcd_barrier_complete(bar, b.x, nloc, nx); b.st[0] = nloc; b.st[1] = nx; }
        const unsigned old = xb_add(&bar[XB_XSUB(b.x)], 1u);
        const unsigned gen = old / nloc;
        if (old + 1u == (gen + 1u) * nloc) {
            __builtin_amdgcn_fence(__ATOMIC_RELEASE, "agent");
            asm volatile("s_waitcnt vmcnt(0)" ::: "memory");
            const unsigned og = xb_add(&bar[XB_TOP], 1u);
            const unsigned tg = og / nx;
            if (og + 1u == (tg + 1u) * nx) xb_add(&bar[XB_TOPGEN], 1u);
            else XB_SPIN(xb_ld(&bar[XB_TOPGEN]) == tg, bar);
            __builtin_amdgcn_fence(__ATOMIC_ACQUIRE, "agent");
            xb_add(&bar[XB_XGEN(b.x)], 1u);
            asm volatile("s_waitcnt vmcnt(0)" ::: "memory");
        } else {
            XB_SPIN(xb_ld(&bar[XB_XGEN(b.x)]) == gen, bar);
            __builtin_amdgcn_fence(__ATOMIC_ACQUIRE, "agent");
            asm volatile("s_waitcnt vmcnt(0)" ::: "memory");
        }
    }
    __syncthreads();
}

__device__ void transpose_job(float* lds, const float* src, bf16_t* dst, int R, int C, int batch, int& tbase, int gstride, int& next, const float* rscale = nullptr, int smin = 0) {
    int tid = threadIdx.x; asm volatile("" : "+v"(tid));
    const int tr = R / 64, tc = C / 256, ntile = batch * tr * tc;
    while (next < tbase + ntile) {
        const int t = next - tbase; next += gstride;
        const int bb = t / (tr * tc), rem = t % (tr * tc), r0 = (rem / tc) * 64, c0 = (rem % tc) * 256;
        const float* s = src + (size_t)bb * R * C + (size_t)r0 * C + c0; bf16_t* d = dst + (size_t)bb * R * C + (size_t)c0 * R + r0;
        float4 v[8];
#pragma unroll
        for (int i = 0; i < 8; ++i) { const int rr = (tid >> 6) + 8 * i, c4 = (tid & 63) * 4; v[i] = *(const float4*)(s + (size_t)rr * C + c4);
            if (rscale && r0 + rr >= smin) { const float g = rscale[r0 + rr]; v[i].x *= g; v[i].y *= g; v[i].z *= g; v[i].w *= g; } }
        __syncthreads();
#pragma unroll
        for (int i = 0; i < 8; ++i) { const int rr = (tid >> 6) + 8 * i, c4 = (tid & 63) * 4; float* q = lds + rr * 257 + c4; q[0] = v[i].x; q[1] = v[i].y; q[2] = v[i].z; q[3] = v[i].w; }
        __syncthreads();
#pragma unroll
        for (int i = 0; i < 4; ++i) { const int cc = (tid >> 3) + 64 * i, r8 = (tid & 7) * 8; const float* q = lds + r8 * 257 + cc;
            uint4 w; w.x = cvt_pk_bf16(q[0], q[257]); w.y = cvt_pk_bf16(q[2 * 257], q[3 * 257]); w.z = cvt_pk_bf16(q[4 * 257], q[5 * 257]); w.w = cvt_pk_bf16(q[6 * 257], q[7 * 257]);
            *(uint4*)(d + (size_t)cc * R + r8) = w; }
    }
    tbase += ntile;
}

__device__ void ph_adaln_tables(const Params& p, float* lds) {
    int tid = threadIdx.x; asm volatile("" : "+v"(tid));
    const int gid = blockIdx.x * NT + tid, gsz = gridDim.x * NT;
    if (blockIdx.x < NMOD * D / 32) {
        for (int i = tid; i < 3 * D; i += NT) { const int r = i / D, k = i % D; const float v = r < 2 ? p.c[r * D + k] : p.c_ctx[k]; lds[i] = v / (1.f + expf(-v)); }
        __syncthreads();
        const int col = blockIdx.x * 32 + (tid & 31), kg = tid >> 5;
        float a0 = 0.f, a1 = 0.f, a2 = 0.f;
#pragma unroll 8
        for (int kk = 0; kk < 64; ++kk) { const int k = kg * 64 + kk; const float w = p.w_ada[(size_t)k * (NMOD * D) + col]; a0 = fmaf(lds[k], w, a0); a1 = fmaf(lds[D + k], w, a1); a2 = fmaf(lds[2 * D + k], w, a2); }
        float* red = lds + 3 * D;
        red[(0 * 16 + kg) * 32 + (tid & 31)] = a0; red[(1 * 16 + kg) * 32 + (tid & 31)] = a1; red[(2 * 16 + kg) * 32 + (tid & 31)] = a2;
        __syncthreads();
        if (tid < 96) { const int rr = tid >> 5, cc = tid & 31; float s = 0.f;
#pragma unroll
            for (int g = 0; g < 16; ++g) s += red[(rr * 16 + g) * 32 + cc];
            p.mod[rr * NMOD * D + blockIdx.x * 32 + cc] = s + p.b_ada[blockIdx.x * 32 + cc]; }
        __syncthreads();
    }
    for (int i = gid; i < 36 * D; i += gsz) { const int o = i / D, k = i % D; p.WrT[i] = o < 4 ? p.w_rg[k * 4 + o] : p.w_re[k * NEXP + o - 4]; }
    for (int i = gid; i < SEQ; i += gsz) { p.cosN[i] = cospif(2.f * (float)i / (float)SEQ); p.sinN[i] = sinpif(2.f * (float)i / (float)SEQ); }
    for (int i = gid; i < (GROWS + GW) * 16; i += gsz) {
        const int pos = i / 16, f = i % 16; const float inv = powf(10000.f, -(float)f / 16.f);
        if (pos < GROWS) { const float a = (float)pos * inv; p.ropeR[2 * i] = cosf(a); p.ropeR[2 * i + 1] = sinf(a); }
        else { const int pc = pos - GROWS; const float a = (float)pc * inv; p.ropeC[2 * (pc * 16 + f)] = cosf(a); p.ropeC[2 * (pc * 16 + f) + 1] = sinf(a); }
    }
    if (gid < NEXP) p.cnt[gid * 64] = 0;
    if (gid < 256) p.tilecnt[gid] = 0u;
    for (int i = gid; i < 256 * 64; i += gsz) {
        const int rho = i >> 6, n1 = i & 63, blk = rho >> 5, k1 = (blk >> 1) * 32 + (rho & 31);
        float v = 0.f;
        if (blk < 4) { const float a = 2.f * (float)((k1 * n1) & 63) / 64.f; v = (blk & 1) ? -sinpif(a) : cospif(a); }
        p.W64cs[i] = f2bf(v);
    }
    for (int i = gid; i < 256 * 256; i += gsz) {
        const int rho = i >> 8, kap = i & 255, ro = rho >> 7, k2 = rho & 127, ri = kap >> 7, n2 = kap & 127;
        const float a = 2.f * (float)((k2 * n2) & 127) / 128.f; const float c = cospif(a), s = sinpif(a);
        p.G128[i] = f2bf(ro == ri ? c : (ro == 0 ? s : -s));
    }
    for (int i = gid; i < 256 * 512; i += gsz) {
        const int j = i >> 9, kap = i & 511, ro = kap >> 8, ch = kap & 255, g = ch >> 6, c = ch & 63;
        float acc = 0.f;
        for (int l = 0; l < 64; ++l) { const float a = 2.f * (float)((l * c) & 63) / 64.f; acc = fmaf(ro ? sinpif(a) : cospif(a), p.w_fmix[(size_t)(64 * g + l) * DF + j], acc); }
        p.WmixT[i] = f2bf(acc * (1.0f / 724.0773439350247f));
    }
    __syncthreads();
    int tbase = 0, next = blockIdx.x;
    transpose_job(lds, p.w_in, p.WinT, D, DIN, 1, tbase, gridDim.x, next);
    transpose_job(lds, p.w_out, p.WoutT, D, D, 1, tbase, gridDim.x, next, p.g_out, DF);
    transpose_job(lds, p.w_gate, p.WgT, D, DEXP, NEXP, tbase, gridDim.x, next);
    transpose_job(lds, p.w_up, p.WuT, D, DEXP, NEXP, tbase, gridDim.x, next);
    transpose_job(lds, p.w_down, p.WdT, DEXP, D, NEXP, tbase, gridDim.x, next);
}

__device__ void ph_hrows(const Params& p, float* lds) {
    int tid = threadIdx.x; asm volatile("" : "+v"(tid));
    for (int row = blockIdx.x; row < NROWS; row += gridDim.x) {
        const float* src = row < NTOK ? p.x + (size_t)row * D : p.ctx + (size_t)(row - NTOK) * D;
        const int mr = row < NTOK ? row / SEQ : 2;
        const float* sh = p.mod + mr * NMOD * D, * sc = sh + D;
        const float2 v = *(const float2*)(src + 2 * tid);
        const float ss = block_sum(v.x * v.x + v.y * v.y, lds);
        const float r = rsqrtf(ss / (float)D + EPS);
        const float o0 = v.x * r * p.g_norm1[2 * tid] * (1.f + sc[2 * tid]) + sh[2 * tid];
        const float o1 = v.y * r * p.g_norm1[2 * tid + 1] * (1.f + sc[2 * tid + 1]) + sh[2 * tid + 1];
        *(unsigned*)(p.hb + (size_t)row * D + 2 * tid) = cvt_pk_bf16(o0, o1);
    }
}

__device__ void ph_inproj(const Params& p, float* ldsf) {
    LAS unsigned char* lds = (LAS unsigned char*)ldsf;
    int tid = threadIdx.x; asm volatile("" : "+v"(tid));
    const int lane = tid & 63, wid = tid >> 6, wr = wid >> 2, wc = wid & 3, r = lane & 31, h = lane >> 5;
    const int srow = tid >> 3, sc = SCS(tid);
    constexpr int NPM = NROWS / 256, NPN = DIN / 256;
    for (int u = blockIdx.x; u < NPM * NPN; u += gridDim.x) {
        const int pm = u / NPN, pn = u % NPN;
        if (pm >= 64 && pn < 4) continue;
        unsigned po[4], qo[4];
#pragma unroll
        for (int i = 0; i < 4; ++i) {
            const int rt = srow + 64 * i;
            po[i] = (unsigned)((pn * 256 + rt) * D * 2 + sc * 16);
            int rowidx;
            if (pn == 0) rowidx = (pm >> 5) * SEQ + 128 * (rt & 63) + 4 * (pm & 31) + (rt >> 6);
            else rowidx = pm * 256 + rt;
            qo[i] = (unsigned)rowidx * (unsigned)(D * 2) + sc * 16;
        }
        f32x16 acc[4][2];
        gemm256(lds, tid, (const char*)p.WinT, po, (const char*)p.hb, qo, D / 64, acc);
        int opq = 0; asm volatile("" : "+v"(opq));
        const int r_ = r + opq, h_ = h + opq;
        if (pn == 0) {
            const int b = pm >> 5, n2 = 4 * (pm & 31) + wc;
#pragma unroll
            for (int i = 0; i < 4; ++i) {
#pragma unroll
                for (int j = 0; j < 2; ++j) {
                    const unsigned base = (unsigned)(((b * DF + wr * 128 + i * 32 + 4 * h_) * 128 + n2) * 64 + j * 32 + r_);
#pragma unroll
                    for (int v = 0; v < 16; ++v) p.fX[base + (unsigned)(((v & 3) + 8 * (v >> 2)) * 128 * 64)] = f2bf(acc[i][j][v]);
                }
                asm volatile("" ::: "memory");
            }
        } else if (pn < 7) {
            const bool isq = pn < 4; const int hg = ((pn - 1) % 3) * 4 + wr * 2;
            const bool isctx = pm >= 64;
            const int b = isctx ? pm - 64 : (pm >> 5);
#pragma unroll
            for (int j = 0; j < 2; ++j) {
                const int n = (isctx ? 0 : (pm & 31) * 256) + wc * 64 + j * 32 + r_;
                const int grow = n >> 6, gcol = n & 63;
#pragma unroll
                for (int i = 0; i < 4; ++i) {
                    const int hh = hg + (i >> 1), blk = i & 1;
                    if (isctx) {
                        const unsigned base = (unsigned)(((b * NH + hh) * LCTX + n) * HD + blk * 32 + 4 * h_);
#pragma unroll
                        for (int q = 0; q < 4; ++q) {
                            uint2 w;
                            w.x = cvt_pk_bf16(acc[i][j][4 * q], acc[i][j][4 * q + 1]); w.y = cvt_pk_bf16(acc[i][j][4 * q + 2], acc[i][j][4 * q + 3]);
                            *(uint2*)(p.Kc + base + 8 * q) = w;
                        }
                    } else {
                        const float* tb = (blk == 0 ? p.ropeR + 32 * grow : p.ropeC + 32 * gcol) + 8 * h_;
                        float o1[8], o2[8];
#pragma unroll
                        for (int v = 0; v < 8; ++v) {
                            const float2 cs = *(const float2*)(tb + 2 * ((v & 3) + 8 * (v >> 2)));
                            const float x1 = acc[i][j][v], x2 = acc[i][j][v + 8];
                            o1[v] = x1 * cs.x - x2 * cs.y; o2[v] = x1 * cs.y + x2 * cs.x;
                        }
                        const unsigned base = (unsigned)(((b * NH + hh) * SEQ + n) * HD + blk * 32 + 4 * h_);
                        if (isq) {
#pragma unroll
                            for (int q = 0; q < 2; ++q) {
                                uint2 w;
                                w.x = cvt_pk_bf16(o1[4 * q] * QSCALE, o1[4 * q + 1] * QSCALE); w.y = cvt_pk_bf16(o1[4 * q + 2] * QSCALE, o1[4 * q + 3] * QSCALE);
                                *(uint2*)(p.Qr + base + 8 * q) = w;
                                w.x = cvt_pk_bf16(o2[4 * q] * QSCALE, o2[4 * q + 1] * QSCALE); w.y = cvt_pk_bf16(o2[4 * q + 2] * QSCALE, o2[4 * q + 3] * QSCALE);
                                *(uint2*)(p.Qr + base + 16 + 8 * q) = w;
                            }
#pragma unroll
                            for (int q = 0; q < 4; ++q) {
                                uint2 w;
                                w.x = cvt_pk_bf16(acc[i][j][4 * q] * QSCALE, acc[i][j][4 * q + 1] * QSCALE); w.y = cvt_pk_bf16(acc[i][j][4 * q + 2] * QSCALE, acc[i][j][4 * q + 3] * QSCALE);
                                *(uint2*)(p.Qp + base + 8 * q) = w;
                            }
                        } else {
#pragma unroll
                            for (int q = 0; q < 2; ++q) {
                                uint2 w;
                                w.x = cvt_pk_bf16(o1[4 * q], o1[4 * q + 1]); w.y = cvt_pk_bf16(o1[4 * q + 2], o1[4 * q + 3]);
                                *(uint2*)(p.Kr + base + 8 * q) = w;
                                w.x = cvt_pk_bf16(o2[4 * q], o2[4 * q + 1]); w.y = cvt_pk_bf16(o2[4 * q + 2], o2[4 * q + 3]);
                                *(uint2*)(p.Kr + base + 16 + 8 * q) = w;
                            }
                        }
                    }
                    asm volatile("" ::: "memory");
                }
            }
        } else {
            const int hg = (pn - 7) * 4 + wr * 2;
            const bool isctx = pm >= 64;
            const int b = isctx ? pm - 64 : (pm >> 5);
            const int ntb = isctx ? LCTX / 8 : SEQ / 8; bf16_t* vb = isctx ? p.Vct : p.Vt;
#pragma unroll
            for (int j = 0; j < 2; ++j) {
                const int n = (isctx ? 0 : (pm & 31) * 256) + wc * 64 + j * 32 + r_;
#pragma unroll
                for (int i = 0; i < 4; ++i) {
                    const unsigned base = (unsigned)((((b * NH + hg + (i >> 1)) * ntb + (n >> 3)) * HD + (i & 1) * 32 + 4 * h_) * 8 + (n & 7));
#pragma unroll
                    for (int v = 0; v < 16; ++v) vb[base + (unsigned)(((v & 3) + 8 * (v >> 2)) * 8)] = f2bf(acc[i][j][v]);
                    asm volatile("" ::: "memory");
                }
            }
        }
    }
}

__device__ void ph_four1(const Params& p, float* ldsf) {
    LAS unsigned char* lds = (LAS unsigned char*)ldsf;
    int tid = threadIdx.x; asm volatile("" : "+v"(tid));
    const int lane = tid & 63, wid = tid >> 6, wr = wid >> 2, wc = wid & 3, r = lane & 31, h = lane >> 5;
    const int srow = tid >> 3, sc = SCS(tid);
    for (int u = blockIdx.x; u < NBATCH * DF * 128 / 256; u += gridDim.x) {
        unsigned po[4], qo[4];
#pragma unroll
        for (int i = 0; i < 4; ++i) { const int rt = srow + 64 * i; po[i] = (unsigned)rt * 128u + sc * 16; qo[i] = (unsigned)(u * 256 + rt) * 128u + sc * 16; }
        f32x16 acc[4][2];
        gemm256(lds, tid, (const char*)p.W64cs, po, (const char*)p.fX, qo, 1, acc);
        if (wr == 0) {
            int opq = 0; asm volatile("" : "+v"(opq));
            const int r_ = r + opq, h_ = h + opq;
#pragma unroll
            for (int j = 0; j < 2; ++j) {
                const int qrow = u * 256 + wc * 64 + j * 32 + r_;
                const int n2 = qrow & 127, bc = qrow >> 7;
#pragma unroll
                for (int a = 0; a < 2; ++a) {
#pragma unroll
                    for (int v = 0; v < 16; ++v) {
                        const int k1 = a * 32 + (v & 3) + 8 * (v >> 2) + 4 * h_;
                        const int idx = n2 * k1;
                        const float cs = p.cosN[idx], sn = p.sinN[idx];
                        const float yr = acc[2 * a][j][v], yi = acc[2 * a + 1][j][v];
                        const unsigned base = (unsigned)((bc * 64 + k1) * 256 + n2);
                        p.Zb[base] = f2bf(yr * cs + yi * sn); p.Zb[base + 128] = f2bf(yi * cs - yr * sn);
                    }
                    asm volatile("" ::: "memory");
                }
            }
        }
    }
}

__device__ void ph_four2(const Params& p, float* ldsf) {
    LAS unsigned char* lds = (LAS unsigned char*)ldsf;
    int tid = threadIdx.x; asm volatile("" : "+v"(tid));
    const int lane = tid & 63, wid = tid >> 6, wr = wid >> 2, wc = wid & 3, r = lane & 31, h = lane >> 5;
    const int srow = tid >> 3, sc = SCS(tid);
    for (int u = blockIdx.x; u < NBATCH * 64; u += gridDim.x) {
        const int b = u >> 6, k1 = u & 63;
        unsigned po[4], qo[4];
#pragma unroll
        for (int i = 0; i < 4; ++i) { const int rt = srow + 64 * i; po[i] = (unsigned)rt * 512u + sc * 16; qo[i] = (unsigned)(((b * DF + rt) * 64 + k1) * 512) + sc * 16; }
        f32x16 acc[4][2];
        gemm256(lds, tid, (const char*)p.G128, po, (const char*)p.Zb, qo, 4, acc);
        int opq = 0; asm volatile("" : "+v"(opq));
        const int r_ = r + opq, h_ = h + opq;
#pragma unroll
        for (int i = 0; i < 4; ++i) {
#pragma unroll
            for (int j = 0; j < 2; ++j) {
                bf16_t* dst = p.P2 + (unsigned)((b * SEQ + k1 + 64 * (i * 32 + 4 * h_)) * 512 + wr * 256 + wc * 64 + j * 32 + r_);
#pragma unroll
                for (int v = 0; v < 16; ++v) dst[((v & 3) + 8 * (v >> 2)) * 64 * 512] = f2bf(acc[i][j][v]);
                asm volatile("" ::: "memory");
            }
        }
    }
}

__device__ void ph_fmix(const Params& p, float* ldsf) {
    LAS unsigned char* lds = (LAS unsigned char*)ldsf;
    int tid = threadIdx.x; asm volatile("" : "+v"(tid));
    const int lane = tid & 63, wid = tid >> 6, wr = wid >> 2, wc = wid & 3, r = lane & 31, h = lane >> 5;
    const int srow = tid >> 3, sc = SCS(tid);
    for (int u = blockIdx.x; u < NTOK / 256; u += gridDim.x) {
        unsigned po[4], qo[4];
#pragma unroll
        for (int i = 0; i < 4; ++i) { const int rt = srow + 64 * i; po[i] = (unsigned)rt * 1024u + sc * 16; qo[i] = (unsigned)(u * 256 + rt) * 1024u + sc * 16; }
        f32x16 acc[4][2];
        gemm256(lds, tid, (const char*)p.WmixT, po, (const char*)p.P2, qo, 8, acc);
        float ss[2];
#pragma unroll
        for (int j = 0; j < 2; ++j) { float s = 0.f;
#pragma unroll
            for (int i = 0; i < 4; ++i)
#pragma unroll
                for (int v = 0; v < 16; ++v) s = fmaf(acc[i][j][v], acc[i][j][v], s);
            ss[j] = xhalf_sum(s); }
        float* red = ldsf;
        if (h == 0) { red[wr * 256 + wc * 64 + r] = ss[0]; red[wr * 256 + wc * 64 + 32 + r] = ss[1]; }
        __syncthreads();
        int opq = 0; asm volatile("" : "+v"(opq));
        const int r_ = r + opq, h_ = h + opq;
#pragma unroll
        for (int j = 0; j < 2; ++j) {
            const int tl = wc * 64 + j * 32 + r_;
            const float rstd = rsqrtf((red[tl] + red[256 + tl]) / (float)DF + EPS);
            bf16_t* dst = p.A2b + (unsigned)((u * 256 + tl) * D + wr * 128 + 4 * h_);
            const float* gp = p.g_out + wr * 128 + 4 * h_;
#pragma unroll
            for (int i = 0; i < 4; ++i) {
#pragma unroll
                for (int q = 0; q < 4; ++q) {
                    const float4 g = *(const float4*)(gp + i * 32 + 8 * q);
                    uint2 w; w.x = cvt_pk_bf16(acc[i][j][4 * q] * rstd * g.x, acc[i][j][4 * q + 1] * rstd * g.y); w.y = cvt_pk_bf16(acc[i][j][4 * q + 2] * rstd * g.z, acc[i][j][4 * q + 3] * rstd * g.w);
                    *(uint2*)(dst + i * 32 + 8 * q) = w;
                }
                asm volatile("" ::: "memory");
            }
        }
    }
}

constexpr float LOG2E = 1.4426950408889634f;
struct AttnTile { bf16x8 kf[4]; bf16x8 vf[2][2]; };
__device__ void ph_attn(const Params& p, float* ldsf) {
    int tid = threadIdx.x; asm volatile("" : "+v"(tid));
    const int lane = tid & 63, wv = tid >> 6, l31 = lane & 31, h = lane >> 5;
    __syncthreads();
    for (int i = tid; i < NH * 15 * 128; i += NT) { const int dcx = (i & 127) - 48, dr = (i >> 7) % 15, hh = i / (15 * 128);
        ldsf[i] = (dcx >= 0 && dcx <= 30) ? p.rpb[(hh * 15 + dr) * 31 + dcx] * LOG2E : 0.f; }
    __syncthreads();
    const int half = wv & 1;
    const int kcol = (l31 & 3) + 4 * ((l31 >> 3) & 1) + 8 * ((l31 >> 2) & 1), krow = l31 >> 4;
    for (int g = blockIdx.x; g < NBATCH * NH * (GROWS / 4); g += gridDim.x) {
        const int bh = g / (GROWS / 4), row = (g % (GROWS / 4)) * 4 + (wv >> 1), hh = bh % NH;
        const int rs = min(max(row - 4, 0), GROWS - 8);
        const int qc = 32 * half + l31, cs = min(max(qc - 8, 0), GW - 16);
        const int nq = row * GW + qc;
        const bf16_t* Kh = p.Kr + (size_t)bh * SEQ * HD; const bf16_t* Vh = p.Vt + (size_t)bh * HD * SEQ;
        const bf16_t* Kch = p.Kc + (size_t)bh * LCTX * HD; const bf16_t* Vch = p.Vct + (size_t)bh * HD * LCTX;
        bf16x8 qr[4], qp[4];
#pragma unroll
        for (int s = 0; s < 4; ++s) { qr[s] = *(const bf16x8*)(p.Qr + ((size_t)bh * SEQ + nq) * HD + 16 * s + 8 * h); qp[s] = *(const bf16x8*)(p.Qp + ((size_t)bh * SEQ + nq) * HD + 16 * s + 8 * h); }
        f32x16 o0, o1;
#pragma unroll
        for (int v = 0; v < 16; ++v) { o0[v] = 0.f; o1[v] = 0.f; }
        float m = -1e30f, lsum = 0.f;
        const float* rph = ldsf + hh * 15 * 128;
        auto load_tile = [&](int t, AttnTile& T) {
            const bf16_t* kptr; const bf16_t* vptr;
            if (t < 12) { const int pr = t / 3, blk = half + (t - 3 * pr), kr0 = rs + 2 * pr;
                kptr = Kh + (size_t)((kr0 + krow) * GW + 16 * blk + kcol) * HD + 8 * h;
                vptr = Vh + ((size_t)((kr0 * GW + 16 * blk) >> 3) + h) * (HD * 8) + l31 * 8;
#pragma unroll
                for (int kk = 0; kk < 2; ++kk)
#pragma unroll
                    for (int dt = 0; dt < 2; ++dt) T.vf[dt][kk] = *(const bf16x8*)(vptr + (size_t)kk * 8 * (HD * 8) + dt * 32 * 8);
            } else { const int m0 = 32 * (t - 12);
                kptr = Kch + (size_t)(m0 + 16 * krow + kcol) * HD + 8 * h;
                vptr = Vch + ((size_t)(m0 >> 3) + h) * (HD * 8) + l31 * 8;
#pragma unroll
                for (int kk = 0; kk < 2; ++kk)
#pragma unroll
                    for (int dt = 0; dt < 2; ++dt) T.vf[dt][kk] = *(const bf16x8*)(vptr + (size_t)kk * 2 * (HD * 8) + dt * 32 * 8);
            }
#pragma unroll
            for (int s = 0; s < 4; ++s) T.kf[s] = *(const bf16x8*)(kptr + 16 * s);
        };
        auto compute_tile = [&](int t, const AttnTile& T) {
            const bool loc = t < 12;
            f32x16 sa;
#pragma unroll
            for (int v = 0; v < 16; ++v) sa[v] = 0.f;
#pragma unroll
            for (int s = 0; s < 4; ++s) sa = __builtin_amdgcn_mfma_f32_32x32x16_bf16(T.kf[s], loc ? qr[s] : qp[s], sa, 0, 0, 0);
            int w0 = 0;
            if (loc) {
                const int pr = t / 3, blk = half + (t - 3 * pr), kr0 = rs + 2 * pr;
                const float* bp = rph + (kr0 - row + 7) * 128 + (16 * blk + 8 * h - qc + 15 + 48);
#pragma unroll
                for (int v = 0; v < 16; ++v) sa[v] += bp[(v >> 3) * 128 + (v & 3) + 4 * ((v >> 2) & 1)];
                w0 = 16 * blk + 8 * h - cs;
            }
            float tmax = sa[0];
#pragma unroll
            for (int v = 1; v < 16; ++v) tmax = fmaxf(tmax, sa[v]);
            tmax = xhalf_max(tmax);
            if (__any(tmax > m + 10.f)) {
                const float mn = fmaxf(m, tmax), alpha = __builtin_amdgcn_exp2f(m - mn);
                m = mn; lsum *= alpha;
#pragma unroll
                for (int v = 0; v < 16; ++v) { o0[v] *= alpha; o1[v] *= alpha; }
            }
            float ps = 0.f;
#pragma unroll
            for (int v = 0; v < 16; ++v) {
                float e = __builtin_amdgcn_exp2f(sa[v] - m);
                if (loc) e = ((unsigned)(w0 + (v & 3) + 4 * ((v >> 2) & 1)) < 16u) ? e : 0.f;
                sa[v] = e; ps += e;
            }
            lsum += ps;
#pragma unroll
            for (int kk = 0; kk < 2; ++kk) {
                const uint4 w = make_uint4(cvt_pk_bf16(sa[8 * kk + 0], sa[8 * kk + 1]), cvt_pk_bf16(sa[8 * kk + 2], sa[8 * kk + 3]), cvt_pk_bf16(sa[8 * kk + 4], sa[8 * kk + 5]), cvt_pk_bf16(sa[8 * kk + 6], sa[8 * kk + 7]));
                const bf16x8 pf = __builtin_bit_cast(bf16x8, w);
                o0 = __builtin_amdgcn_mfma_f32_32x32x16_bf16(T.vf[0][kk], pf, o0, 0, 0, 0);
                o1 = __builtin_amdgcn_mfma_f32_32x32x16_bf16(T.vf[1][kk], pf, o1, 0, 0, 0);
            }
        };
        AttnTile TA, TB;
        load_tile(0, TA);
#pragma unroll 1
        for (int t = 0; t < 20; t += 2) {
            load_tile(t + 1, TB);
            compute_tile(t, TA);
            if (t + 2 < 20) load_tile(t + 2, TA);
            compute_tile(t + 1, TB);
        }
        lsum = xhalf_sum(lsum);
        const float inv = 1.f / lsum;
        bf16_t* op = p.A2b + (size_t)((bh / NH) * SEQ + nq) * D + DF + hh * HD + 4 * h;
        float sq = 0.f;
#pragma unroll
        for (int q = 0; q < 4; ++q) {
            const float a0 = o0[4 * q] * inv, a1 = o0[4 * q + 1] * inv, a2 = o0[4 * q + 2] * inv, a3 = o0[4 * q + 3] * inv;
            const float b0 = o1[4 * q] * inv, b1 = o1[4 * q + 1] * inv, b2 = o1[4 * q + 2] * inv, b3 = o1[4 * q + 3] * inv;
            sq += a0 * a0 + a1 * a1 + a2 * a2 + a3 * a3 + b0 * b0 + b1 * b1 + b2 * b2 + b3 * b3;
            *(uint2*)(op + 8 * q) = make_uint2(cvt_pk_bf16(a0, a1), cvt_pk_bf16(a2, a3));
            *(uint2*)(op + 32 + 8 * q) = make_uint2(cvt_pk_bf16(b0, b1), cvt_pk_bf16(b2, b3));
        }
        sq = xhalf_sum(sq);
        if (h == 0) p.ssq[((bh / NH) * SEQ + nq) * NH + hh] = sq;
    }
}

__device__ void ph_outproj(const Params& p, float* ldsf) {
    LAS unsigned char* lds = (LAS unsigned char*)ldsf;
    int tid = threadIdx.x; asm volatile("" : "+v"(tid));
    const int lane = tid & 63, wid = tid >> 6, wr = wid >> 2, wc = wid & 3, r = lane & 31, h = lane >> 5;
    const int srow = tid >> 3, sc = SCS(tid);
    for (int u = blockIdx.x; u < (NTOK / 256) * (D / 256); u += gridDim.x) {
        const int pm = u >> 2, pn = u & 3;
        unsigned po[4], qo[4];
#pragma unroll
        for (int i = 0; i < 4; ++i) { const int rt = srow + 64 * i; po[i] = (unsigned)(pm * 256 + rt) * (unsigned)(D * 2) + sc * 16; qo[i] = (unsigned)(pn * 256 + rt) * (unsigned)(D * 2) + sc * 16; }
        float* rtab = ldsf + (128 * 1024 + 1024) / 4;
        if (tid < 256) { const float4* sp = (const float4*)(p.ssq + (size_t)(pm * 256 + tid) * NH); const float4 a = sp[0], b = sp[1], c = sp[2];
            rtab[tid] = rsqrtf(((a.x + a.y) + (a.z + a.w) + (b.x + b.y) + (b.z + b.w) + (c.x + c.y) + (c.z + c.w)) / (float)DNA + EPS); }
        f32x16 acc[4][2];
        unsigned po2[4], qo2[4];
#pragma unroll
        for (int i = 0; i < 4; ++i) { po2[i] = po[i] + DF * 2; qo2[i] = qo[i] + DF * 2; }
        gemm256(lds, tid, (const char*)p.A2b, po2, (const char*)p.WoutT, qo2, DNA / 64, acc);
#pragma unroll
        for (int i = 0; i < 4; ++i)
#pragma unroll
            for (int v = 0; v < 16; ++v) { const float rs_ = rtab[wr * 128 + i * 32 + (v & 3) + 8 * (v >> 2) + 4 * h]; acc[i][0][v] *= rs_; acc[i][1][v] *= rs_; }
        gemm256(lds, tid, (const char*)p.A2b, po, (const char*)p.WoutT, qo, DF / 64, acc, false);
        const float* gt1 = p.mod + (pm >> 5) * NMOD * D + 2 * D;
        int opq = 0; asm volatile("" : "+v"(opq));
        const int r_ = r + opq, h_ = h + opq;
#pragma unroll
        for (int j = 0; j < 2; ++j) {
            const int feat = pn * 256 + wc * 64 + j * 32 + r_; const float g = gt1[feat];
#pragma unroll
            for (int i = 0; i < 4; ++i) {
                const unsigned base = (unsigned)((pm * 256 + wr * 128 + i * 32 + 4 * h_) * D + feat);
                const float* xp = p.x + base; float* op = p.x1 + base;
#pragma unroll
                for (int hf = 0; hf < 2; ++hf) {
                    float xv[8];
#pragma unroll
                    for (int v = 0; v < 8; ++v) xv[v] = xp[((v & 3) + 8 * (v >> 2) + 16 * hf) * D];
#pragma unroll
                    for (int v = 0; v < 8; ++v) op[((v & 3) + 8 * (v >> 2) + 16 * hf) * D] = xv[v] + g * acc[i][j][8 * hf + v];
                    asm volatile("" ::: "memory");
                }
            }
        }
    }
}

__device__ void ph_router(const Params& p, float* lds, bool commit = true) {
    int tid = threadIdx.x; asm volatile("" : "+v"(tid));
    const int wv = tid >> 6, lane = tid & 63;
    int* sel = (int*)lds; int* cntl = sel + 128; int* basel = cntl + 32; int* posl = basel + 32;
    for (int blk = blockIdx.x; blk < NTOK / 64; blk += gridDim.x) {
        __syncthreads();
        if (tid < 32) cntl[tid] = 0;
        for (int ti = 0; ti < 8; ++ti) {
            const int tok = blk * 64 + wv * 8 + ti;
            const int b = tok / SEQ;
            const float* sh = p.mod + b * NMOD * D + 3 * D, * sc = sh + D;
            float hv[16]; float ss = 0.f;
#pragma unroll
            for (int i = 0; i < 16; ++i) { hv[i] = p.x1[(size_t)tok * D + lane + 64 * i]; ss = fmaf(hv[i], hv[i], ss); }
            ss = wave_sum(ss);
            const float r = rsqrtf(ss / (float)D + EPS);
#pragma unroll
            for (int i = 0; i < 16; ++i) { const int e = lane + 64 * i; hv[i] = hv[i] * r * p.g_norm2[e] * (1.f + sc[e]) + sh[e]; p.h2b[(size_t)tok * D + e] = f2bf(hv[i]); }
            float lg[4];
#pragma unroll
            for (int o = 0; o < 4; ++o) { float a = 0.f;
#pragma unroll
                for (int i = 0; i < 16; ++i) a = fmaf(hv[i], p.WrT[o * D + lane + 64 * i], a);
                lg[o] = wave_sum(a); }
            int gs = 0; float gm = lg[0];
#pragma unroll
            for (int o = 1; o < 4; ++o) if (lg[o] > gm) { gm = lg[o]; gs = o; }
            float gz = 0.f;
#pragma unroll
            for (int o = 0; o < 4; ++o) gz += expf(lg[o] - gm);
            const float pg = 1.f / gz;
            gs = __builtin_amdgcn_readfirstlane(gs);
            const float* wre = p.WrT + (4 + gs * 8) * D + lane;
            float le[8];
#pragma unroll
            for (int o = 0; o < 8; ++o) { float a = 0.f;
#pragma unroll
                for (int i = 0; i < 16; ++i) a = fmaf(hv[i], wre[o * D + 64 * i], a);
                le[o] = wave_sum(a); }
            int i0 = 0; float m0 = le[0];
#pragma unroll
            for (int o = 1; o < 8; ++o) if (le[o] > m0) { m0 = le[o]; i0 = o; }
            int i1 = -1; float m1 = -3.0e38f;
#pragma unroll
            for (int o = 0; o < 8; ++o) if (o != i0 && le[o] > m1) { m1 = le[o]; i1 = o; }
            const float e1 = expf(m1 - m0);
            const float g0 = pg / (1.f + e1), g1 = pg * e1 / (1.f + e1);
            if (lane == 0) {
                sel[(wv * 8 + ti) * 2] = gs * 8 + i0; sel[(wv * 8 + ti) * 2 + 1] = gs * 8 + i1;
                p.tokgate[tok * 2] = g0; p.tokgate[tok * 2 + 1] = g1;
            }
        }
        __syncthreads();
        int e = 0;
        if (tid < 128) { e = sel[tid]; posl[tid] = atomicAdd(&cntl[e], 1); }
        __syncthreads();
        if (tid < 32 && commit) basel[tid] = atomicAdd(&p.cnt[tid * 64], cntl[tid]);
        __syncthreads();
        if (tid < 128 && commit) p.list[e * NTOK + basel[e] + posl[tid]] = (blk * 64 + (tid >> 1)) * 2 + (tid & 1);
    }
}

struct ETile { int e, s0, ns, sbase; };
__device__ __forceinline__ int moe_ntiles(const Params& p) { int t = 0; for (int e = 0; e < NEXP; ++e) t += (p.cnt[e * 64] + 255) >> 8; return t; }
__device__ __forceinline__ ETile moe_tile(const Params& p, int tile) {
    int e = 0, base = 0, sb = 0;
    for (;;) { const int c = p.cnt[e * 64], nc = (c + 255) >> 8; if (tile < base + nc) break; base += nc; sb += c; ++e; }
    ETile t; t.e = e; t.s0 = (tile - base) * 256; t.ns = min(256, p.cnt[e * 64] - t.s0); t.sbase = sb; return t;
}

__device__ void ph_moe(const Params& p, float* ldsf) {
    LAS unsigned char* lds = (LAS unsigned char*)ldsf;
    int tid = threadIdx.x; asm volatile("" : "+v"(tid));
    const int lane = tid & 63, wid = tid >> 6, wr = wid >> 2, wc = wid & 3, r = lane & 31, h = lane >> 5;
    const int srow = tid >> 3, sc = SCS(tid);
    const int nt4 = moe_ntiles(p) * 4;
    for (int u = blockIdx.x; u < 2 * nt4; u += gridDim.x) {
        const bool isdown = u >= nt4; const int uu = isdown ? u - nt4 : u;
        const int tile = uu >> 2;
        const ETile t = moe_tile(p, tile); const int fc = uu & 3;
        unsigned po[4], qo[4];
        f32x16 acc[4][2];
        if (!isdown) {
#pragma unroll
            for (int i = 0; i < 4; ++i) {
                const int rt = srow + 64 * i;
                const int ent = rt < t.ns ? p.list[t.e * NTOK + t.s0 + rt] : 0;
                po[i] = (unsigned)(ent >> 1) * (unsigned)(D * 2) + sc * 16;
                const int f = fc * 128 + (rt >> 6) * 32 + (rt & 31), up = (rt >> 5) & 1;
                qo[i] = (unsigned)((up * NEXP + t.e) * DEXP + f) * (unsigned)(D * 2) + sc * 16;
            }
            gemm256(lds, tid, (const char*)p.h2b, po, (const char*)p.WgT, qo, D / 64, acc);
            int opq = 0; asm volatile("" : "+v"(opq));
            const int r_ = r + opq, h_ = h + opq;
            const int f = fc * 128 + wc * 32 + r_;
#pragma unroll
            for (int i = 0; i < 4; ++i) {
                const int s = wr * 128 + i * 32 + 4 * h_;
#pragma unroll
                for (int v = 0; v < 16; ++v) {
                    const int sv = s + (v & 3) + 8 * (v >> 2);
                    const float g = acc[i][0][v], uu_ = acc[i][1][v];
                    if (sv < t.ns) p.act[(unsigned)((t.sbase + t.s0 + sv) * DEXP + f)] = f2bf(g / (1.f + __expf(-g)) * uu_);
                }
                asm volatile("" ::: "memory");
            }
            asm volatile("s_waitcnt vmcnt(0)" ::: "memory");
            __syncthreads();
            if (tid == 0) { __builtin_amdgcn_fence(__ATOMIC_RELEASE, "agent"); asm volatile("s_waitcnt vmcnt(0)" ::: "memory");
                __hip_atomic_fetch_add(p.tilecnt + tile, 1u, __ATOMIC_RELAXED, __HIP_MEMORY_SCOPE_AGENT); }
        } else {
            if (tid == 0) { unsigned sp = 0;
                while (__hip_atomic_load(p.tilecnt + tile, __ATOMIC_RELAXED, __HIP_MEMORY_SCOPE_AGENT) < 4u) { __builtin_amdgcn_s_sleep(2); if (++sp > (1u << 22)) break; }
                __builtin_amdgcn_fence(__ATOMIC_ACQUIRE, "agent"); asm volatile("s_waitcnt vmcnt(0)" ::: "memory"); }
            __syncthreads();
            const int pn = fc;
#pragma unroll
            for (int i = 0; i < 4; ++i) {
                const int rt = srow + 64 * i;
                po[i] = (unsigned)(t.sbase + t.s0 + (rt < t.ns ? rt : 0)) * (unsigned)(DEXP * 2) + sc * 16;
                qo[i] = (unsigned)(t.e * D + pn * 256 + rt) * (unsigned)(DEXP * 2) + sc * 16;
            }
            gemm256(lds, tid, (const char*)p.act, po, (const char*)p.WdT, qo, DEXP / 64, acc);
            int opq = 0; asm volatile("" : "+v"(opq));
            const int r_ = r + opq, h_ = h + opq;
#pragma unroll
            for (int i = 0; i < 4; ++i) {
                const int s = wr * 128 + i * 32 + 4 * h_;
#pragma unroll
                for (int v = 0; v < 16; ++v) {
                    const int sv = s + (v & 3) + 8 * (v >> 2);
                    if (sv < t.ns) {
                        const int ent = p.list[t.e * NTOK + t.s0 + sv]; const float g = p.tokgate[ent];
                        const unsigned base = (unsigned)ent * D + pn * 256 + wc * 64 + r_;
                        p.ybuf[base] = f2bf(g * acc[i][0][v]); p.ybuf[base + 32] = f2bf(g * acc[i][1][v]);
                    }
                }
                asm volatile("" ::: "memory");
            }
        }
    }
}

__device__ void ph_final(const Params& p, float* lds, float* outp) {
    int tid = threadIdx.x; asm volatile("" : "+v"(tid));
    for (int tok = blockIdx.x; tok < NTOK; tok += gridDim.x) {
        const float* gt2 = p.mod + (tok / SEQ) * NMOD * D + 5 * D;
        const unsigned ya = *(const unsigned*)(p.ybuf + (size_t)(2 * tok) * D + 2 * tid), yb = *(const unsigned*)(p.ybuf + (size_t)(2 * tok + 1) * D + 2 * tid);
        const float2 xv = *(const float2*)(p.x1 + (size_t)tok * D + 2 * tid);
        const float m0 = __uint_as_float(ya << 16) + __uint_as_float(yb << 16), m1 = __uint_as_float(ya & 0xffff0000u) + __uint_as_float(yb & 0xffff0000u);
        const float v0 = xv.x + gt2[2 * tid] * m0, v1 = xv.y + gt2[2 * tid + 1] * m1;
        const float ss = block_sum(v0 * v0 + v1 * v1, lds);
        const float rr = rsqrtf(ss / (float)D + EPS);
        *(float2*)(outp + (size_t)tok * D + 2 * tid) = make_float2(v0 * rr * p.g_final[2 * tid], v1 * rr * p.g_final[2 * tid + 1]);
    }
}

extern __shared__ __attribute__((aligned(16))) float smem[];

constexpr int R_P0 = 1, R_INP = 1, R_FOUR = 1, R_ATT = 1, R_OUT = 1, R_MOE = 1, R_RT = 1, R_FIN = 1, R_BAR = 1;
constexpr int LDS_BAR_OFF = 128 * 1024 + 512;
__global__ void __launch_bounds__(NT) mega(Params p) {
    volatile LAS unsigned* st = (volatile LAS unsigned*)((LAS unsigned char*)smem + LDS_BAR_OFF);
    if (threadIdx.x == 0) { st[0] = 0u; st[1] = 0u; }
    __syncthreads();
    const XcdBarrier bar = xcd_barrier_post(p.bar, st);
#define REP(n, call) for (int _r = 0; _r < (n); ++_r) { call; }
    REP(R_P0, ph_adaln_tables(p, smem)) REP(R_BAR, xcd_barrier(bar))
    REP(R_P0, ph_hrows(p, smem)) REP(R_BAR, xcd_barrier(bar))
    REP(R_INP, ph_inproj(p, smem)) REP(R_BAR, xcd_barrier(bar))
    REP(R_FOUR, ph_four1(p, smem)) REP(R_BAR, xcd_barrier(bar))
    REP(R_FOUR, ph_four2(p, smem)) REP(R_BAR, xcd_barrier(bar))
    REP(R_ATT, ph_attn(p, smem)) REP(R_BAR, xcd_barrier(bar))
    REP(R_FOUR, ph_fmix(p, smem)) REP(R_BAR, xcd_barrier(bar))
    REP(R_OUT, ph_outproj(p, smem)) REP(R_BAR, xcd_barrier(bar))
    REP(R_RT - 1, ph_router(p, smem, false)) ph_router(p, smem); REP(R_BAR, xcd_barrier(bar))
    ph_moe(p, smem); REP(R_BAR, xcd_barrier(bar))
    REP(R_FIN - 1, ph_final(p, smem, (float*)p.h2b)) ph_final(p, smem, p.out);
}

extern "C" void kernel_launch(void* const* d_in, const int* in_sizes, int n_in, void* d_out, int out_size, void* d_ws, size_t ws_size, hipStream_t stream) {
    constexpr size_t kDynLds = 128 * 1024 + 2048;
    static int grid_blocks = 0;
    if (!grid_blocks) {
        int dev = 0, cus = 0, per_cu = 0;
        (void)hipGetDevice(&dev);
        (void)hipDeviceGetAttribute(&cus, hipDeviceAttributeMultiprocessorCount, dev);
        (void)hipFuncSetAttribute((const void*)mega, hipFuncAttributeMaxDynamicSharedMemorySize, (int)kDynLds);
        (void)hipOccupancyMaxActiveBlocksPerMultiprocessor(&per_cu, (const void*)mega, NT, kDynLds);
        if (per_cu > 1) per_cu = 1;
        grid_blocks = cus * per_cu;
    }
    Params p{};
    p.x = (const float*)d_in[0]; p.c = (const float*)d_in[1]; p.ctx = (const float*)d_in[2]; p.c_ctx = (const float*)d_in[3];
    p.w_ada = (const float*)d_in[4]; p.b_ada = (const float*)d_in[5]; p.g_norm1 = (const float*)d_in[6]; p.w_in = (const float*)d_in[7];
    p.w_fmix = (const float*)d_in[8]; p.rpb = (const float*)d_in[9]; p.g_out = (const float*)d_in[10]; p.w_out = (const float*)d_in[11];
    p.g_norm2 = (const float*)d_in[12]; p.w_rg = (const float*)d_in[13]; p.w_re = (const float*)d_in[14]; p.w_gate = (const float*)d_in[15];
    p.w_up = (const float*)d_in[16]; p.w_down = (const float*)d_in[17]; p.g_final = (const float*)d_in[18];
    p.out = (float*)d_out;
    char* w = (char*)d_ws; size_t o = 0;
    auto take = [&](size_t bytes) { char* r = w + o; o += (bytes + 255) & ~(size_t)255; return r; };
    p.mod = (float*)take(3 * NMOD * D * 4); p.cosN = (float*)take(SEQ * 4); p.sinN = (float*)take(SEQ * 4); p.ropeR = (float*)take(GROWS * 32 * 4); p.ropeC = (float*)take(GW * 32 * 4);
    p.bar = (unsigned*)take(XCD_BAR_WORDS * 4); p.WrT = (float*)take(36 * D * 4); p.ssq = (float*)take((size_t)NTOK * NH * 4); p.tilecnt = (unsigned*)take(256 * 4); p.cnt = (int*)take(NEXP * 256); p.list = (int*)take((size_t)NEXP * NTOK * 4); p.tokgate = (float*)take(2 * NTOK * 4);
    p.WinT = (bf16_t*)take((size_t)DIN * D * 2); p.WoutT = (bf16_t*)take((size_t)D * D * 2);
    p.W64cs = (bf16_t*)take(256 * 64 * 2); p.G128 = (bf16_t*)take(256 * 256 * 2); p.WmixT = (bf16_t*)take(256 * 512 * 2);
    p.WgT = (bf16_t*)take((size_t)NEXP * DEXP * D * 2); p.WuT = (bf16_t*)take((size_t)NEXP * DEXP * D * 2); p.WdT = (bf16_t*)take((size_t)NEXP * DEXP * D * 2);
    char* R1 = take((size_t)NTOK * D * 4 + 256);
    p.hb = (bf16_t*)R1; p.Zb = (bf16_t*)R1; p.A2b = (bf16_t*)R1; p.P2 = (bf16_t*)(R1 + (size_t)NTOK * DNA * 4); p.h2b = (bf16_t*)R1; p.act = p.h2b + (size_t)NTOK * D;
    const size_t qkv = (size_t)NTOK * DNA * 2;
    char* R2 = take((size_t)NTOK * DF * 2 + 4 * qkv + 2 * (size_t)NCTX * DNA * 2 + 4096);
    p.fX = (bf16_t*)R2; p.Qr = (bf16_t*)(R2 + (size_t)NTOK * DF * 2); p.Qp = p.Qr + (size_t)NTOK * DNA; p.Kr = p.Qp + (size_t)NTOK * DNA; p.Vt = p.Kr + (size_t)NTOK * DNA;
    p.Kc = p.Vt + (size_t)NTOK * DNA; p.Vct = p.Kc + (size_t)NCTX * DNA;
    p.x1 = (float*)(R2 + (size_t)NTOK * DF * 2 + 4 * qkv + 2 * (size_t)NCTX * DNA * 2 - (size_t)NTOK * D * 4);
    p.ybuf = (bf16_t*)p.out;
    void* args[] = {&p};
    (void)hipMemsetAsync(p.bar, 0, XCD_BAR_WORDS * 4, stream);
    hipError_t e = hipLaunchCooperativeKernel((const void*)mega, dim3(grid_blocks), dim3(NT), args, kDynLds, stream);
    if (e != hipSuccess) fprintf(stderr, "cooperative launch failed: %s (grid %d)\n", hipGetErrorString(e), grid_blocks);
}
```

```cpp
#include <hip/hip_runtime.h>
#include <cstdio>
#include <cstdint>

constexpr int D = 1024, NBATCH = 2, SEQ = 8192, NTOK = NBATCH * SEQ, LCTX = 256, NCTX = NBATCH * LCTX, NROWS = NTOK + NCTX;
constexpr int DIN = 2560, DF = 256, NH = 12, HD = 64, DNA = 768, QOFF = 256, KOFF = 1024, VOFF = 1792;
constexpr int GW = 64, GROWS = 128, NEXP = 32, DEXP = 512, NMOD = 6;
constexpr float EPS = 1e-6f;
constexpr int NT = 512;
constexpr float QSCALE = 0.125f * 1.4426950408889634f;
typedef unsigned short bf16_t;
typedef short bf16x8 __attribute__((ext_vector_type(8)));
typedef float f32x16 __attribute__((ext_vector_type(16)));
typedef float f32x4 __attribute__((ext_vector_type(4)));
__device__ __forceinline__ unsigned cvt_pk_bf16(float lo, float hi) { unsigned r; asm volatile("v_cvt_pk_bf16_f32 %0, %1, %2" : "=v"(r) : "v"(lo), "v"(hi)); return r; }
__device__ __forceinline__ bf16_t f2bf(float v) { return (bf16_t)(cvt_pk_bf16(v, 0.f) & 0xffffu); }
__device__ __forceinline__ float bf2f(bf16_t v) { return __uint_as_float((unsigned)v << 16); }

struct Params {
    const float *x, *c, *ctx, *c_ctx, *w_ada, *b_ada, *g_norm1, *w_in, *w_fmix, *rpb, *g_out, *w_out, *g_norm2, *w_rg, *w_re, *w_gate, *w_up, *w_down, *g_final;
    float* out;
    float *mod, *cosN, *sinN, *ropeR, *ropeC;
    float *x1;
    int *cnt, *list; float* tokgate; unsigned* bar; float* WrT; float* ssq; unsigned* tilecnt; unsigned* qctl; bf16_t* F2;
    bf16_t *WinT, *WoutT, *WgT, *WuT, *WdT;
    bf16_t *hb, *A2b;
    bf16_t *h2b, *act, *ybuf;
    bf16_t *fX, *Qr, *Qp, *Kr, *Vt, *Kc, *Vct;
    bf16_t *W64cs, *G128, *WmixT;
    bf16_t *Zb, *P2;
};

template <int CTRL> __device__ __forceinline__ float dpp(float x) { return __builtin_bit_cast(float, __builtin_amdgcn_mov_dpp(__builtin_bit_cast(int, x), CTRL, 0xf, 0xf, true)); }
__device__ __forceinline__ float xhalf_sum(float x) { auto t = __builtin_amdgcn_permlane32_swap(__float_as_uint(x), __float_as_uint(x), false, false); return __uint_as_float(t[0]) + __uint_as_float(t[1]); }
__device__ __forceinline__ float xhalf_max(float x) { auto t = __builtin_amdgcn_permlane32_swap(__float_as_uint(x), __float_as_uint(x), false, false); return fmaxf(__uint_as_float(t[0]), __uint_as_float(t[1])); }
__device__ __forceinline__ float wave_sum(float x) {
    x += dpp<0xB1>(x); x += dpp<0x4E>(x); x += dpp<0x141>(x); x += dpp<0x128>(x);
    x += __shfl_xor(x, 16);
    return x + __shfl_xor(x, 32);
}
__device__ __forceinline__ float wave_max(float x) {
    x = fmaxf(x, dpp<0xB1>(x)); x = fmaxf(x, dpp<0x4E>(x)); x = fmaxf(x, dpp<0x141>(x)); x = fmaxf(x, dpp<0x128>(x));
    x = fmaxf(x, __shfl_xor(x, 16));
    return fmaxf(x, __shfl_xor(x, 32));
}
__device__ __forceinline__ float block_sum(float v, float* red) {
    v = wave_sum(v);
    const int w = threadIdx.x >> 6, l = threadIdx.x & 63;
    __syncthreads();
    if (l == 0) red[w] = v;
    __syncthreads();
    float s = 0.f;
#pragma unroll
    for (int i = 0; i < NT / 64; ++i) s += red[i];
    return s;
}

template <class AF, class BF, class EF>
__device__ void ngemm(float* lds, int M, int N, int K, AF af, BF bf, EF ef) {
    float* As = lds;
    float* Bs = lds + 16 * 132;
    int tid = threadIdx.x; asm volatile("" : "+v"(tid));
    const int ty = tid >> 4, tx = tid & 15;
    const int tn = N / 128, nt = (M / 128) * tn;
    for (int t = blockIdx.x; t < nt; t += gridDim.x) {
        const int m0 = (t / tn) * 128, n0 = (t % tn) * 128;
        float acc[4][8];
#pragma unroll
        for (int i = 0; i < 4; ++i)
#pragma unroll
            for (int j = 0; j < 8; ++j) acc[i][j] = 0.f;
        for (int k0 = 0; k0 < K; k0 += 16) {
#pragma unroll
            for (int i = 0; i < 4; ++i) { const int idx = tid + NT * i, kk = idx & 15, m = idx >> 4; As[kk * 132 + m] = af(m0 + m, k0 + kk); }
#pragma unroll
            for (int i = 0; i < 4; ++i) { const int idx = tid + NT * i, n = idx & 127, kk = idx >> 7; Bs[kk * 128 + n] = bf(m0, k0 + kk, n0 + n); }
            __syncthreads();
#pragma unroll
            for (int kk = 0; kk < 16; ++kk) {
                const float4 a = *(const float4*)(As + kk * 132 + ty * 4);
                const float4 b0 = *(const float4*)(Bs + kk * 128 + tx * 8), b1 = *(const float4*)(Bs + kk * 128 + tx * 8 + 4);
                const float av[4] = {a.x, a.y, a.z, a.w}, bv[8] = {b0.x, b0.y, b0.z, b0.w, b1.x, b1.y, b1.z, b1.w};
#pragma unroll
                for (int i = 0; i < 4; ++i)
#pragma unroll
                    for (int j = 0; j < 8; ++j) acc[i][j] = fmaf(av[i], bv[j], acc[i][j]);
            }
            __syncthreads();
        }
#pragma unroll
        for (int i = 0; i < 4; ++i)
#pragma unroll
            for (int j = 0; j < 8; ++j) ef(m0 + ty * 4 + i, n0 + tx * 8 + j, acc[i][j]);
    }
}

#define LAS __attribute__((address_space(3)))
#define SCS(tid) (((tid) & 7) ^ ((((tid) >> 3) >> 1) & 7))
__device__ __forceinline__ void gemm256(LAS unsigned char* lds, const int tid, const char* Pb, const unsigned (&po)[4], const char* Qb, const unsigned (&qo)[4], int nk, f32x16 (&acc)[4][2], const bool zero = true) {
    const int lane = tid & 63, wid = __builtin_amdgcn_readfirstlane(tid >> 6), wr = wid >> 2, wc = wid & 3;
    const int r = lane & 31, h = lane >> 5, swz = (r >> 1) & 7;
    const unsigned ldsw = (unsigned)wid * 1024u;
    if (zero) {
#pragma unroll
        for (int i = 0; i < 4; ++i)
#pragma unroll
            for (int j = 0; j < 2; ++j)
#pragma unroll
                for (int v = 0; v < 16; ++v) acc[i][j][v] = 0.f;
    }
    __syncthreads();
#pragma unroll
    for (int i = 0; i < 4; ++i) {
        __builtin_amdgcn_global_load_lds((const unsigned*)(Pb + po[i]), (LAS unsigned*)(lds + ldsw + i * 8192), 16, 0, 0);
        __builtin_amdgcn_global_load_lds((const unsigned*)(Qb + qo[i]), (LAS unsigned*)(lds + 32768 + ldsw + i * 8192), 16, 0, 0);
    }
    __syncthreads();
    const int prd = (wr * 128 + r) * 128, qrd = 32768 + (wc * 64 + r) * 128;
    const int ko0 = ((0 + h) ^ swz) << 4, ko1 = ((2 + h) ^ swz) << 4, ko2 = ((4 + h) ^ swz) << 4, ko3 = ((6 + h) ^ swz) << 4;
#define G256_LD(pf, qf, ko) do { _Pragma("unroll") for (int i = 0; i < 4; ++i) pf[i] = *(const LAS bf16x8*)(lds + cb + prd + i * 4096 + (ko)); \
                                 _Pragma("unroll") for (int j = 0; j < 2; ++j) qf[j] = *(const LAS bf16x8*)(lds + cb + qrd + j * 4096 + (ko)); } while (0)
#define G256_MM(pf, qf) do { _Pragma("unroll") for (int i = 0; i < 4; ++i) _Pragma("unroll") for (int j = 0; j < 2; ++j) \
                                 acc[i][j] = __builtin_amdgcn_mfma_f32_32x32x16_bf16(pf[i], qf[j], acc[i][j], 0, 0, 0); } while (0)
#pragma unroll 1
    for (int kt = 0; kt < nk; ++kt) {
        const int cb = (kt & 1) * 65536, nb = 65536 - cb;
        {
            const unsigned koff = (unsigned)min(kt + 1, nk - 1) * 128u;
#pragma unroll
            for (int i = 0; i < 4; ++i) {
                __builtin_amdgcn_global_load_lds((const unsigned*)(Pb + (size_t)(po[i] + koff)), (LAS unsigned*)(lds + nb + ldsw + i * 8192), 16, 0, 0);
                __builtin_amdgcn_global_load_lds((const unsigned*)(Qb + (size_t)(qo[i] + koff)), (LAS unsigned*)(lds + nb + 32768 + ldsw + i * 8192), 16, 0, 0);
            }
        }
        bf16x8 pa[4], qa[2], pb[4], qb[2];
        G256_LD(pa, qa, ko0);
        G256_LD(pb, qb, ko1);
        G256_MM(pa, qa);
        G256_LD(pa, qa, ko2);
        G256_MM(pb, qb);
        G256_LD(pb, qb, ko3);
        G256_MM(pa, qa);
        G256_MM(pb, qb);
        __syncthreads();
    }
    asm volatile("" ::: "memory");
}

#define XB_TMO      128
#define XB_XCNT(j)  (256  + 64 * (j))
#define XB_XSUB(j)  (1280 + 64 * (j))
#define XB_XGEN(j)  (2304 + 64 * (j))
#define XB_TOP      3328
#define XB_TOPGEN   3392
#define XCD_BAR_WORDS 3456
#define XB_SPIN_CAP (1u << 18)
__device__ __forceinline__ unsigned xb_ld(unsigned* p)              { return __hip_atomic_load(p, __ATOMIC_RELAXED, __HIP_MEMORY_SCOPE_AGENT); }
__device__ __forceinline__ unsigned xb_add(unsigned* p, unsigned v) { return __hip_atomic_fetch_add(p, v, __ATOMIC_RELAXED, __HIP_MEMORY_SCOPE_AGENT); }
__device__ __forceinline__ unsigned xb_xcc_id() { return (unsigned)__builtin_amdgcn_s_getreg((3 << 11) | 20) & 0xFu; }
#define XB_SPIN(cond, bar) do { unsigned _sp = 0; while (cond) { __builtin_amdgcn_s_sleep(1); \
    if ((++_sp & 255u) == 0u) { if (xb_ld(&(bar)[XB_TMO])) break; if (_sp > XB_SPIN_CAP) { atomicAdd(&(bar)[XB_TMO], 1u); break; } } } } while (0)
struct XcdBarrier { unsigned* bar; unsigned x; volatile LAS unsigned* st; };
__device__ __forceinline__ XcdBarrier xcd_barrier_post(unsigned* bar, volatile LAS unsigned* st) {
    XcdBarrier b; b.bar = bar; b.x = xb_xcc_id(); b.st = st;
    if (threadIdx.x == 0) (void)xb_add(&bar[XB_XCNT(b.x)], 1u);
    return b;
}
__device__ __forceinline__ void xcd_barrier_complete(unsigned* bar, unsigned x, unsigned& nloc, unsigned& nx) {
    const unsigned G = gridDim.x * gridDim.y * gridDim.z;
    unsigned sum, cnt, mine, sp = 0u;
    for (;;) {
        sum = 0u; cnt = 0u; mine = 0u;
#pragma unroll
        for (unsigned j = 0; j < 16; ++j) { const unsigned c = xb_ld(&bar[XB_XCNT(j)]); sum += c; cnt += (c > 0u) ? 1u : 0u; mine = (j == x) ? c : mine; }
        if (sum == G) break;
        __builtin_amdgcn_s_sleep(1);
        if ((++sp & 255u) == 0u) { if (xb_ld(&bar[XB_TMO])) break; if (sp > XB_SPIN_CAP) { atomicAdd(&bar[XB_TMO], 1u); break; } }
    }
    nloc = mine > 0u ? mine : 1u; nx = cnt > 0u ? cnt : 1u;
}
__device__ __forceinline__ void xcd_barrier(const XcdBarrier& b) {
    asm volatile("s_waitcnt vmcnt(0)" ::: "memory");
    __syncthreads();
    if (threadIdx.x == 0) {
        unsigned* bar = b.bar;
        __builtin_amdgcn_s_waitcnt(0);
        unsigned nloc = b.st[0], nx = b.st[1];
        if (nloc == 0u) { xcd_barrier_complete(bar, b.x, nloc, nx); b.st[0] = nloc; b.st[1] = nx; }
        const unsigned old = xb_add(&bar[XB_XSUB(b.x)], 1u);
        const unsigned gen = old / nloc;
        if (old + 1u == (gen + 1u) * nloc) {
            __builtin_amdgcn_fence(__ATOMIC_RELEASE, "agent");
            asm volatile("s_waitcnt vmcnt(0)" ::: "memory");
            const unsigned og = xb_add(&bar[XB_TOP], 1u);
            const unsigned tg = og / nx;
            if (og + 1u == (tg + 1u) * nx) xb_add(&bar[XB_TOPGEN], 1u);
            else XB_SPIN(xb_ld(&bar[XB_TOPGEN]) == tg, bar);
            __builtin_amdgcn_fence(__ATOMIC_ACQUIRE, "agent");
            xb_add(&bar[XB_XGEN(b.x)], 1u);
            asm volatile("s_waitcnt vmcnt(0)" ::: "memory");
        } else {
            XB_SPIN(xb_ld(&bar[XB_XGEN(b.x)]) == gen, bar);
            __builtin_amdgcn_fence(__ATOMIC_ACQUIRE, "agent");
            asm volatile("s_waitcnt vmcnt(0)" ::: "memory");
        }
    }
    __syncthreads();
}

__device__ __forceinline__ void publish_add(unsigned* ctr, int tid) {
    asm volatile("s_waitcnt vmcnt(0)" ::: "memory");
    __syncthreads();
    if (tid == 0) { __builtin_amdgcn_fence(__ATOMIC_RELEASE, "agent"); asm volatile("s_waitcnt vmcnt(0)" ::: "memory");
        __hip_atomic_fetch_add(ctr, 1u, __ATOMIC_RELAXED, __HIP_MEMORY_SCOPE_AGENT); }
}
__device__ __forceinline__ void wait_ge(unsigned* ctr, unsigned want, int tid) {
    if (tid == 0) { unsigned sp = 0;
        while (__hip_atomic_load(ctr, __ATOMIC_RELAXED, __HIP_MEMORY_SCOPE_AGENT) < want) { __builtin_amdgcn_s_sleep(2); if (++sp > (1u << 22)) break; }
        __builtin_amdgcn_fence(__ATOMIC_ACQUIRE, "agent"); asm volatile("s_waitcnt vmcnt(0)" ::: "memory"); }
    __syncthreads();
}
#define QW(i) ((i) * 64)

__device__ void transpose_job(float* lds, const float* src, bf16_t* dst, int R, int C, int batch, int& tbase, int gstride, int& next, const float* rscale = nullptr, int smin = 0) {
    int tid = threadIdx.x; asm volatile("" : "+v"(tid));
    const int tr = R / 64, tc = C / 256, ntile = batch * tr * tc;
    while (next < tbase + ntile) {
        const int t = next - tbase; next += gstride;
        const int bb = t / (tr * tc), rem = t % (tr * tc), r0 = (rem / tc) * 64, c0 = (rem % tc) * 256;
        const float* s = src + (size_t)bb * R * C + (size_t)r0 * C + c0; bf16_t* d = dst + (size_t)bb * R * C + (size_t)c0 * R + r0;
        float4 v[8];
#pragma unroll
        for (int i = 0; i < 8; ++i) { const int rr = (tid >> 6) + 8 * i, c4 = (tid & 63) * 4; v[i] = *(const float4*)(s + (size_t)rr * C + c4);
            if (rscale && r0 + rr >= smin) { const float g = rscale[r0 + rr]; v[i].x *= g; v[i].y *= g; v[i].z *= g; v[i].w *= g; } }
        __syncthreads();
#pragma unroll
        for (int i = 0; i < 8; ++i) { const int rr = (tid >> 6) + 8 * i, c4 = (tid & 63) * 4; float* q = lds + rr * 257 + c4; q[0] = v[i].x; q[1] = v[i].y; q[2] = v[i].z; q[3] = v[i].w; }
        __syncthreads();
#pragma unroll
        for (int i = 0; i < 4; ++i) { const int cc = (tid >> 3) + 64 * i, r8 = (tid & 7) * 8; const float* q = lds + r8 * 257 + cc;
            uint4 w; w.x = cvt_pk_bf16(q[0], q[257]); w.y = cvt_pk_bf16(q[2 * 257], q[3 * 257]); w.z = cvt_pk_bf16(q[4 * 257], q[5 * 257]); w.w = cvt_pk_bf16(q[6 * 257], q[7 * 257]);
            *(uint4*)(d + (size_t)cc * R + r8) = w; }
    }
    tbase += ntile;
}

__device__ void ph_adaln_tables(const Params& p, float* lds) {
    int tid = threadIdx.x; asm volatile("" : "+v"(tid));
    const int gid = blockIdx.x * NT + tid, gsz = gridDim.x * NT;
    if (blockIdx.x < NMOD * D / 32) {
        for (int i = tid; i < 3 * D; i += NT) { const int r = i / D, k = i % D; const float v = r < 2 ? p.c[r * D + k] : p.c_ctx[k]; lds[i] = v / (1.f + expf(-v)); }
        __syncthreads();
        const int col = blockIdx.x * 32 + (tid & 31), kg = tid >> 5;
        float a0 = 0.f, a1 = 0.f, a2 = 0.f;
#pragma unroll 8
        for (int kk = 0; kk < 64; ++kk) { const int k = kg * 64 + kk; const float w = p.w_ada[(size_t)k * (NMOD * D) + col]; a0 = fmaf(lds[k], w, a0); a1 = fmaf(lds[D + k], w, a1); a2 = fmaf(lds[2 * D + k], w, a2); }
        float* red = lds + 3 * D;
        red[(0 * 16 + kg) * 32 + (tid & 31)] = a0; red[(1 * 16 + kg) * 32 + (tid & 31)] = a1; red[(2 * 16 + kg) * 32 + (tid & 31)] = a2;
        __syncthreads();
        if (tid < 96) { const int rr = tid >> 5, cc = tid & 31; float s = 0.f;
#pragma unroll
            for (int g = 0; g < 16; ++g) s += red[(rr * 16 + g) * 32 + cc];
            p.mod[rr * NMOD * D + blockIdx.x * 32 + cc] = s + p.b_ada[blockIdx.x * 32 + cc]; }
        __syncthreads();
    }
    for (int i = gid; i < 36 * D; i += gsz) { const int o = i / D, k = i % D; p.WrT[i] = o < 4 ? p.w_rg[k * 4 + o] : p.w_re[k * NEXP + o - 4]; }
    for (int i = gid; i < SEQ; i += gsz) { p.cosN[i] = cospif(2.f * (float)i / (float)SEQ); p.sinN[i] = sinpif(2.f * (float)i / (float)SEQ); }
    for (int i = gid; i < (GROWS + GW) * 16; i += gsz) {
        const int pos = i / 16, f = i % 16; const float inv = powf(10000.f, -(float)f / 16.f);
        if (pos < GROWS) { const float a = (float)pos * inv; p.ropeR[2 * i] = cosf(a); p.ropeR[2 * i + 1] = sinf(a); }
        else { const int pc = pos - GROWS; const float a = (float)pc * inv; p.ropeC[2 * (pc * 16 + f)] = cosf(a); p.ropeC[2 * (pc * 16 + f) + 1] = sinf(a); }
    }
    if (gid < NEXP) p.cnt[gid * 64] = 0;
    if (gid < 256) p.tilecnt[gid] = 0u;
    if (gid < 8) p.qctl[QW(gid)] = 0u;
    for (int i = gid; i < 256 * 64; i += gsz) {
        const int rho = i >> 6, n1 = i & 63, blk = rho >> 5, k1 = (blk >> 1) * 32 + (rho & 31);
        float v = 0.f;
        if (blk < 4) { const float a = 2.f * (float)((k1 * n1) & 63) / 64.f; v = (blk & 1) ? -sinpif(a) : cospif(a); }
        p.W64cs[i] = f2bf(v);
    }
    for (int i = gid; i < 256 * 256; i += gsz) {
        const int rho = i >> 8, kap = i & 255, ro = rho >> 7, k2 = rho & 127, ri = kap >> 7, n2 = kap & 127;
        const float a = 2.f * (float)((k2 * n2) & 127) / 128.f; const float c = cospif(a), s = sinpif(a);
        p.G128[i] = f2bf(ro == ri ? c : (ro == 0 ? s : -s));
    }
    for (int i = gid; i < 256 * 512; i += gsz) {
        const int j = i >> 9, kap = i & 511, ro = kap >> 8, ch = kap & 255, g = ch >> 6, c = ch & 63;
        float acc = 0.f;
        for (int l = 0; l < 64; ++l) { const float a = 2.f * (float)((l * c) & 63) / 64.f; acc = fmaf(ro ? sinpif(a) : cospif(a), p.w_fmix[(size_t)(64 * g + l) * DF + j], acc); }
        p.WmixT[i] = f2bf(acc * (1.0f / 724.0773439350247f));
    }
    __syncthreads();
    int tbase = 0, next = blockIdx.x;
    transpose_job(lds, p.w_in, p.WinT, D, DIN, 1, tbase, gridDim.x, next);
    transpose_job(lds, p.w_out, p.WoutT, D, D, 1, tbase, gridDim.x, next, p.g_out, DF);
    transpose_job(lds, p.w_gate, p.WgT, D, DEXP, NEXP, tbase, gridDim.x, next);
    transpose_job(lds, p.w_up, p.WuT, D, DEXP, NEXP, tbase, gridDim.x, next);
    transpose_job(lds, p.w_down, p.WdT, DEXP, D, NEXP, tbase, gridDim.x, next);
}

__device__ void ph_hrows(const Params& p, float* lds) {
    int tid = threadIdx.x; asm volatile("" : "+v"(tid));
    for (int row = blockIdx.x; row < NROWS; row += gridDim.x) {
        const float* src = row < NTOK ? p.x + (size_t)row * D : p.ctx + (size_t)(row - NTOK) * D;
        const int mr = row < NTOK ? row / SEQ : 2;
        const float* sh = p.mod + mr * NMOD * D, * sc = sh + D;
        const float2 v = *(const float2*)(src + 2 * tid);
        const float ss = block_sum(v.x * v.x + v.y * v.y, lds);
        const float r = rsqrtf(ss / (float)D + EPS);
        const float o0 = v.x * r * p.g_norm1[2 * tid] * (1.f + sc[2 * tid]) + sh[2 * tid];
        const float o1 = v.y * r * p.g_norm1[2 * tid + 1] * (1.f + sc[2 * tid + 1]) + sh[2 * tid + 1];
        *(unsigned*)(p.hb + (size_t)row * D + 2 * tid) = cvt_pk_bf16(o0, o1);
    }
}

__device__ void ph_inproj(const Params& p, float* ldsf) {
    LAS unsigned char* lds = (LAS unsigned char*)ldsf;
    int tid = threadIdx.x; asm volatile("" : "+v"(tid));
    const int lane = tid & 63, wid = tid >> 6, wr = wid >> 2, wc = wid & 3, r = lane & 31, h = lane >> 5;
    const int srow = tid >> 3, sc = SCS(tid);
    for (int u = blockIdx.x; u < 64 + 64 * 9 + 12; u += gridDim.x) {
        int pm, pn;
        if (u < 64) { pm = u; pn = 0; } else if (u < 64 + 576) { pm = (u - 64) / 9; pn = 1 + (u - 64) % 9; } else { pm = 64 + (u - 640) / 6; pn = 4 + (u - 640) % 6; }
        unsigned po[4], qo[4];
#pragma unroll
        for (int i = 0; i < 4; ++i) {
            const int rt = srow + 64 * i;
            po[i] = (unsigned)((pn * 256 + rt) * D * 2 + sc * 16);
            int rowidx;
            if (pn == 0) rowidx = (pm >> 5) * SEQ + 128 * (rt & 63) + 4 * (pm & 31) + (rt >> 6);
            else rowidx = pm * 256 + rt;
            qo[i] = (unsigned)rowidx * (unsigned)(D * 2) + sc * 16;
        }
        f32x16 acc[4][2];
        gemm256(lds, tid, (const char*)p.WinT, po, (const char*)p.hb, qo, D / 64, acc);
        int opq = 0; asm volatile("" : "+v"(opq));
        const int r_ = r + opq, h_ = h + opq;
        if (pn == 0) {
            const int b = pm >> 5, n2 = 4 * (pm & 31) + wc;
#pragma unroll
            for (int i = 0; i < 4; ++i) {
#pragma unroll
                for (int j = 0; j < 2; ++j) {
                    const unsigned base = (unsigned)(((b * DF + wr * 128 + i * 32 + 4 * h_) * 128 + n2) * 64 + j * 32 + r_);
#pragma unroll
                    for (int v = 0; v < 16; ++v) p.fX[base + (unsigned)(((v & 3) + 8 * (v >> 2)) * 128 * 64)] = f2bf(acc[i][j][v]);
                }
                asm volatile("" ::: "memory");
            }
            publish_add(p.qctl + QW(1 + b), tid);
        } else if (pn < 7) {
            const bool isq = pn < 4; const int hg = ((pn - 1) % 3) * 4 + wr * 2;
            const bool isctx = pm >= 64;
            const int b = isctx ? pm - 64 : (pm >> 5);
#pragma unroll
            for (int j = 0; j < 2; ++j) {
                const int n = (isctx ? 0 : (pm & 31) * 256) + wc * 64 + j * 32 + r_;
                const int grow = n >> 6, gcol = n & 63;
#pragma unroll
                for (int i = 0; i < 4; ++i) {
                    const int hh = hg + (i >> 1), blk = i & 1;
                    if (isctx) {
                        const unsigned base = (unsigned)(((b * NH + hh) * LCTX + n) * HD + blk * 32 + 4 * h_);
#pragma unroll
                        for (int q = 0; q < 4; ++q) {
                            uint2 w;
                            w.x = cvt_pk_bf16(acc[i][j][4 * q], acc[i][j][4 * q + 1]); w.y = cvt_pk_bf16(acc[i][j][4 * q + 2], acc[i][j][4 * q + 3]);
                            *(uint2*)(p.Kc + base + 8 * q) = w;
                        }
                    } else {
                        const float* tb = (blk == 0 ? p.ropeR + 32 * grow : p.ropeC + 32 * gcol) + 8 * h_;
                        float o1[8], o2[8];
#pragma unroll
                        for (int v = 0; v < 8; ++v) {
                            const float2 cs = *(const float2*)(tb + 2 * ((v & 3) + 8 * (v >> 2)));
                            const float x1 = acc[i][j][v], x2 = acc[i][j][v + 8];
                            o1[v] = x1 * cs.x - x2 * cs.y; o2[v] = x1 * cs.y + x2 * cs.x;
                        }
                        const unsigned base = (unsigned)(((b * NH + hh) * SEQ + n) * HD + blk * 32 + 4 * h_);
                        if (isq) {
#pragma unroll
                            for (int q = 0; q < 2; ++q) {
                                uint2 w;
                                w.x = cvt_pk_bf16(o1[4 * q] * QSCALE, o1[4 * q + 1] * QSCALE); w.y = cvt_pk_bf16(o1[4 * q + 2] * QSCALE, o1[4 * q + 3] * QSCALE);
                                *(uint2*)(p.Qr + base + 8 * q) = w;
                                w.x = cvt_pk_bf16(o2[4 * q] * QSCALE, o2[4 * q + 1] * QSCALE); w.y = cvt_pk_bf16(o2[4 * q + 2] * QSCALE, o2[4 * q + 3] * QSCALE);
                                *(uint2*)(p.Qr + base + 16 + 8 * q) = w;
                            }
#pragma unroll
                            for (int q = 0; q < 4; ++q) {
                                uint2 w;
                                w.x = cvt_pk_bf16(acc[i][j][4 * q] * QSCALE, acc[i][j][4 * q + 1] * QSCALE); w.y = cvt_pk_bf16(acc[i][j][4 * q + 2] * QSCALE, acc[i][j][4 * q + 3] * QSCALE);
                                *(uint2*)(p.Qp + base + 8 * q) = w;
                            }
                        } else {
#pragma unroll
                            for (int q = 0; q < 2; ++q) {
                                uint2 w;
                                w.x = cvt_pk_bf16(o1[4 * q], o1[4 * q + 1]); w.y = cvt_pk_bf16(o1[4 * q + 2], o1[4 * q + 3]);
                                *(uint2*)(p.Kr + base + 8 * q) = w;
                                w.x = cvt_pk_bf16(o2[4 * q], o2[4 * q + 1]); w.y = cvt_pk_bf16(o2[4 * q + 2], o2[4 * q + 3]);
                                *(uint2*)(p.Kr + base + 16 + 8 * q) = w;
                            }
                        }
                    }
                    asm volatile("" ::: "memory");
                }
            }
        } else {
            const int hg = (pn - 7) * 4 + wr * 2;
            const bool isctx = pm >= 64;
            const int b = isctx ? pm - 64 : (pm >> 5);
            const int ntb = isctx ? LCTX / 8 : SEQ / 8; bf16_t* vb = isctx ? p.Vct : p.Vt;
#pragma unroll
            for (int j = 0; j < 2; ++j) {
                const int n = (isctx ? 0 : (pm & 31) * 256) + wc * 64 + j * 32 + r_;
#pragma unroll
                for (int i = 0; i < 4; ++i) {
                    const unsigned base = (unsigned)((((b * NH + hg + (i >> 1)) * ntb + (n >> 3)) * HD + (i & 1) * 32 + 4 * h_) * 8 + (n & 7));
#pragma unroll
                    for (int v = 0; v < 16; ++v) vb[base + (unsigned)(((v & 3) + 8 * (v >> 2)) * 8)] = f2bf(acc[i][j][v]);
                    asm volatile("" ::: "memory");
                }
            }
        }
    }
}

__device__ __forceinline__ void four1_unit(const Params& p, float* ldsf, const int u) {
    LAS unsigned char* lds = (LAS unsigned char*)ldsf;
    int tid = threadIdx.x; asm volatile("" : "+v"(tid));
    const int lane = tid & 63, wid = tid >> 6, wr = wid >> 2, wc = wid & 3, r = lane & 31, h = lane >> 5;
    const int srow = tid >> 3, sc = SCS(tid);
    {
        unsigned po[4], qo[4];
#pragma unroll
        for (int i = 0; i < 4; ++i) { const int rt = srow + 64 * i; po[i] = (unsigned)rt * 128u + sc * 16; qo[i] = (unsigned)(u * 256 + rt) * 128u + sc * 16; }
        f32x16 acc[4][2];
        gemm256(lds, tid, (const char*)p.W64cs, po, (const char*)p.fX, qo, 1, acc);
        if (wr == 0) {
            int opq = 0; asm volatile("" : "+v"(opq));
            const int r_ = r + opq, h_ = h + opq;
#pragma unroll
            for (int j = 0; j < 2; ++j) {
                const int qrow = u * 256 + wc * 64 + j * 32 + r_;
                const int n2 = qrow & 127, bc = qrow >> 7;
#pragma unroll
                for (int a = 0; a < 2; ++a) {
#pragma unroll
                    for (int v = 0; v < 16; ++v) {
                        const int k1 = a * 32 + (v & 3) + 8 * (v >> 2) + 4 * h_;
                        const int idx = n2 * k1;
                        const float cs = p.cosN[idx], sn = p.sinN[idx];
                        const float yr = acc[2 * a][j][v], yi = acc[2 * a + 1][j][v];
                        const unsigned base = (unsigned)((bc * 64 + k1) * 256 + n2);
                        p.Zb[base] = f2bf(yr * cs + yi * sn); p.Zb[base + 128] = f2bf(yi * cs - yr * sn);
                    }
                    asm volatile("" ::: "memory");
                }
            }
        }
    }
}

__device__ __forceinline__ void four2_unit(const Params& p, float* ldsf, const int u) {
    LAS unsigned char* lds = (LAS unsigned char*)ldsf;
    int tid = threadIdx.x; asm volatile("" : "+v"(tid));
    const int lane = tid & 63, wid = tid >> 6, wr = wid >> 2, wc = wid & 3, r = lane & 31, h = lane >> 5;
    const int srow = tid >> 3, sc = SCS(tid);
    {
        const int b = u >> 6, k1 = u & 63;
        unsigned po[4], qo[4];
#pragma unroll
        for (int i = 0; i < 4; ++i) { const int rt = srow + 64 * i; po[i] = (unsigned)rt * 512u + sc * 16; qo[i] = (unsigned)(((b * DF + rt) * 64 + k1) * 512) + sc * 16; }
        f32x16 acc[4][2];
        gemm256(lds, tid, (const char*)p.G128, po, (const char*)p.Zb, qo, 4, acc);
        int opq = 0; asm volatile("" : "+v"(opq));
        const int r_ = r + opq, h_ = h + opq;
#pragma unroll
        for (int i = 0; i < 4; ++i) {
#pragma unroll
            for (int j = 0; j < 2; ++j) {
                bf16_t* dst = p.P2 + (unsigned)((b * SEQ + k1 + 64 * (i * 32 + 4 * h_)) * 512 + wr * 256 + wc * 64 + j * 32 + r_);
#pragma unroll
                for (int v = 0; v < 16; ++v) dst[((v & 3) + 8 * (v >> 2)) * 64 * 512] = f2bf(acc[i][j][v]);
                asm volatile("" ::: "memory");
            }
        }
    }
}

__device__ __forceinline__ void fmix_unit(const Params& p, float* ldsf, const int u) {
    LAS unsigned char* lds = (LAS unsigned char*)ldsf;
    int tid = threadIdx.x; asm volatile("" : "+v"(tid));
    const int lane = tid & 63, wid = tid >> 6, wr = wid >> 2, wc = wid & 3, r = lane & 31, h = lane >> 5;
    const int srow = tid >> 3, sc = SCS(tid);
    {
        unsigned po[4], qo[4];
#pragma unroll
        for (int i = 0; i < 4; ++i) { const int rt = srow + 64 * i; po[i] = (unsigned)rt * 1024u + sc * 16; qo[i] = (unsigned)(u * 256 + rt) * 1024u + sc * 16; }
        f32x16 acc[4][2];
        gemm256(lds, tid, (const char*)p.WmixT, po, (const char*)p.P2, qo, 8, acc);
        float ss[2];
#pragma unroll
        for (int j = 0; j < 2; ++j) { float s = 0.f;
#pragma unroll
            for (int i = 0; i < 4; ++i)
#pragma unroll
                for (int v = 0; v < 16; ++v) s = fmaf(acc[i][j][v], acc[i][j][v], s);
            ss[j] = xhalf_sum(s); }
        float* red = ldsf;
        if (h == 0) { red[wr * 256 + wc * 64 + r] = ss[0]; red[wr * 256 + wc * 64 + 32 + r] = ss[1]; }
        __syncthreads();
        int opq = 0; asm volatile("" : "+v"(opq));
        const int r_ = r + opq, h_ = h + opq;
#pragma unroll
        for (int j = 0; j < 2; ++j) {
            const int tl = wc * 64 + j * 32 + r_;
            const float rstd = rsqrtf((red[tl] + red[256 + tl]) / (float)DF + EPS);
            bf16_t* dst = p.F2 + (unsigned)((u * 256 + tl) * DF + wr * 128 + 4 * h_);
            const float* gp = p.g_out + wr * 128 + 4 * h_;
#pragma unroll
            for (int i = 0; i < 4; ++i) {
#pragma unroll
                for (int q = 0; q < 4; ++q) {
                    const float4 g = *(const float4*)(gp + i * 32 + 8 * q);
                    uint2 w; w.x = cvt_pk_bf16(acc[i][j][4 * q] * rstd * g.x, acc[i][j][4 * q + 1] * rstd * g.y); w.y = cvt_pk_bf16(acc[i][j][4 * q + 2] * rstd * g.z, acc[i][j][4 * q + 3] * rstd * g.w);
                    *(uint2*)(dst + i * 32 + 8 * q) = w;
                }
                asm volatile("" ::: "memory");
            }
        }
    }
}

__device__ void ph_filler(const Params& p, float* ldsf) {
    int tid = threadIdx.x; asm volatile("" : "+v"(tid));
    volatile LAS unsigned* qw = (volatile LAS unsigned*)((LAS unsigned char*)ldsf + 128 * 1024 + 528);
    for (;;) {
        __syncthreads();
        if (tid == 0) qw[0] = __hip_atomic_fetch_add(p.qctl + QW(0), 1u, __ATOMIC_RELAXED, __HIP_MEMORY_SCOPE_AGENT);
        __syncthreads();
        const int item = (int)qw[0];
        if (item >= 448) break;
        if (item < 256) { const int b = item >> 7; wait_ge(p.qctl + QW(1 + b), 32u, tid); four1_unit(p, ldsf, item); publish_add(p.qctl + QW(3 + b), tid); }
        else if (item < 384) { const int u = item - 256, b = u >> 6; wait_ge(p.qctl + QW(3 + b), 128u, tid); four2_unit(p, ldsf, u); publish_add(p.qctl + QW(5 + b), tid); }
        else { const int u = item - 384, b = u >> 5; wait_ge(p.qctl + QW(5 + b), 64u, tid); fmix_unit(p, ldsf, u); }
    }
}

constexpr float LOG2E = 1.4426950408889634f;
struct AttnTile { bf16x8 kf[4]; bf16x8 vf[2][2]; };
__device__ void ph_attn(const Params& p, float* ldsf) {
    int tid = threadIdx.x; asm volatile("" : "+v"(tid));
    const int lane = tid & 63, wv = tid >> 6, l31 = lane & 31, h = lane >> 5;
    __syncthreads();
    for (int i = tid; i < NH * 15 * 128; i += NT) { const int dcx = (i & 127) - 48, dr = (i >> 7) % 15, hh = i / (15 * 128);
        ldsf[i] = (dcx >= 0 && dcx <= 30) ? p.rpb[(hh * 15 + dr) * 31 + dcx] * LOG2E : 0.f; }
    __syncthreads();
    const int half = wv & 1;
    const int kcol = (l31 & 3) + 4 * ((l31 >> 3) & 1) + 8 * ((l31 >> 2) & 1), krow = l31 >> 4;
    for (int g = blockIdx.x; g < NBATCH * NH * (GROWS / 4); g += gridDim.x) {
        const int bh = g / (GROWS / 4), row = (g % (GROWS / 4)) * 4 + (wv >> 1), hh = bh % NH;
        const int rs = min(max(row - 4, 0), GROWS - 8);
        const int qc = 32 * half + l31, cs = min(max(qc - 8, 0), GW - 16);
        const int nq = row * GW + qc;
        const bf16_t* Kh = p.Kr + (size_t)bh * SEQ * HD; const bf16_t* Vh = p.Vt + (size_t)bh * HD * SEQ;
        const bf16_t* Kch = p.Kc + (size_t)bh * LCTX * HD; const bf16_t* Vch = p.Vct + (size_t)bh * HD * LCTX;
        bf16x8 qr[4], qp[4];
#pragma unroll
        for (int s = 0; s < 4; ++s) { qr[s] = *(const bf16x8*)(p.Qr + ((size_t)bh * SEQ + nq) * HD + 16 * s + 8 * h); qp[s] = *(const bf16x8*)(p.Qp + ((size_t)bh * SEQ + nq) * HD + 16 * s + 8 * h); }
        f32x16 o0, o1;
#pragma unroll
        for (int v = 0; v < 16; ++v) { o0[v] = 0.f; o1[v] = 0.f; }
        float m = -1e30f, lsum = 0.f;
        const float* rph = ldsf + hh * 15 * 128;
        auto load_tile = [&](int t, AttnTile& T) {
            const bf16_t* kptr; const bf16_t* vptr;
            if (t < 12) { const int pr = t / 3, blk = half + (t - 3 * pr), kr0 = rs + 2 * pr;
                kptr = Kh + (size_t)((kr0 + krow) * GW + 16 * blk + kcol) * HD + 8 * h;
                vptr = Vh + ((size_t)((kr0 * GW + 16 * blk) >> 3) + h) * (HD * 8) + l31 * 8;
#pragma unroll
                for (int kk = 0; kk < 2; ++kk)
#pragma unroll
                    for (int dt = 0; dt < 2; ++dt) T.vf[dt][kk] = *(const bf16x8*)(vptr + (size_t)kk * 8 * (HD * 8) + dt * 32 * 8);
            } else { const int m0 = 32 * (t - 12);
                kptr = Kch + (size_t)(m0 + 16 * krow + kcol) * HD + 8 * h;
                vptr = Vch + ((size_t)(m0 >> 3) + h) * (HD * 8) + l31 * 8;
#pragma unroll
                for (int kk = 0; kk < 2; ++kk)
#pragma unroll
                    for (int dt = 0; dt < 2; ++dt) T.vf[dt][kk] = *(const bf16x8*)(vptr + (size_t)kk * 2 * (HD * 8) + dt * 32 * 8);
            }
#pragma unroll
            for (int s = 0; s < 4; ++s) T.kf[s] = *(const bf16x8*)(kptr + 16 * s);
        };
        auto compute_tile = [&](int t, const AttnTile& T) {
            const bool loc = t < 12;
            f32x16 sa;
#pragma unroll
            for (int v = 0; v < 16; ++v) sa[v] = 0.f;
#pragma unroll
            for (int s = 0; s < 4; ++s) sa = __builtin_amdgcn_mfma_f32_32x32x16_bf16(T.kf[s], loc ? qr[s] : qp[s], sa, 0, 0, 0);
            int w0 = 0;
            if (loc) {
                const int pr = t / 3, blk = half + (t - 3 * pr), kr0 = rs + 2 * pr;
                const float* bp = rph + (kr0 - row + 7) * 128 + (16 * blk + 8 * h - qc + 15 + 48);
#pragma unroll
                for (int v = 0; v < 16; ++v) sa[v] += bp[(v >> 3) * 128 + (v & 3) + 4 * ((v >> 2) & 1)];
                w0 = 16 * blk + 8 * h - cs;
            }
            float tmax = sa[0];
#pragma unroll
            for (int v = 1; v < 16; ++v) tmax = fmaxf(tmax, sa[v]);
            tmax = xhalf_max(tmax);
            if (__any(tmax > m + 10.f)) {
                const float mn = fmaxf(m, tmax), alpha = __builtin_amdgcn_exp2f(m - mn);
                m = mn; lsum *= alpha;
#pragma unroll
                for (int v = 0; v < 16; ++v) { o0[v] *= alpha; o1[v] *= alpha; }
            }
            float ps = 0.f;
#pragma unroll
            for (int v = 0; v < 16; ++v) {
                float e = __builtin_amdgcn_exp2f(sa[v] - m);
                if (loc) e = ((unsigned)(w0 + (v & 3) + 4 * ((v >> 2) & 1)) < 16u) ? e : 0.f;
                sa[v] = e; ps += e;
            }
            lsum += ps;
#pragma unroll
            for (int kk = 0; kk < 2; ++kk) {
                const uint4 w = make_uint4(cvt_pk_bf16(sa[8 * kk + 0], sa[8 * kk + 1]), cvt_pk_bf16(sa[8 * kk + 2], sa[8 * kk + 3]), cvt_pk_bf16(sa[8 * kk + 4], sa[8 * kk + 5]), cvt_pk_bf16(sa[8 * kk + 6], sa[8 * kk + 7]));
                const bf16x8 pf = __builtin_bit_cast(bf16x8, w);
                o0 = __builtin_amdgcn_mfma_f32_32x32x16_bf16(T.vf[0][kk], pf, o0, 0, 0, 0);
                o1 = __builtin_amdgcn_mfma_f32_32x32x16_bf16(T.vf[1][kk], pf, o1, 0, 0, 0);
            }
        };
        AttnTile TA, TB;
        load_tile(0, TA);
#pragma unroll 1
        for (int t = 0; t < 20; t += 2) {
            load_tile(t + 1, TB);
            compute_tile(t, TA);
            if (t + 2 < 20) load_tile(t + 2, TA);
            compute_tile(t + 1, TB);
        }
        lsum = xhalf_sum(lsum);
        const float inv = 1.f / lsum;
        bf16_t* op = p.A2b + (size_t)((bh / NH) * SEQ + nq) * D + DF + hh * HD + 4 * h;
        float sq = 0.f;
#pragma unroll
        for (int q = 0; q < 4; ++q) {
            const float a0 = o0[4 * q] * inv, a1 = o0[4 * q + 1] * inv, a2 = o0[4 * q + 2] * inv, a3 = o0[4 * q + 3] * inv;
            const float b0 = o1[4 * q] * inv, b1 = o1[4 * q + 1] * inv, b2 = o1[4 * q + 2] * inv, b3 = o1[4 * q + 3] * inv;
            sq += a0 * a0 + a1 * a1 + a2 * a2 + a3 * a3 + b0 * b0 + b1 * b1 + b2 * b2 + b3 * b3;
            *(uint2*)(op + 8 * q) = make_uint2(cvt_pk_bf16(a0, a1), cvt_pk_bf16(a2, a3));
            *(uint2*)(op + 32 + 8 * q) = make_uint2(cvt_pk_bf16(b0, b1), cvt_pk_bf16(b2, b3));
        }
        sq = xhalf_sum(sq);
        if (h == 0) p.ssq[((bh / NH) * SEQ + nq) * NH + hh] = sq;
    }
}

__device__ void ph_outproj(const Params& p, float* ldsf) {
    LAS unsigned char* lds = (LAS unsigned char*)ldsf;
    int tid = threadIdx.x; asm volatile("" : "+v"(tid));
    const int lane = tid & 63, wid = tid >> 6, wr = wid >> 2, wc = wid & 3, r = lane & 31, h = lane >> 5;
    const int srow = tid >> 3, sc = SCS(tid);
    for (int u = blockIdx.x; u < (NTOK / 256) * (D / 256); u += gridDim.x) {
        const int pm = u >> 2, pn = u & 3;
        unsigned po[4], qo[4];
#pragma unroll
        for (int i = 0; i < 4; ++i) { const int rt = srow + 64 * i; po[i] = (unsigned)(pm * 256 + rt) * (unsigned)(D * 2) + sc * 16; qo[i] = (unsigned)(pn * 256 + rt) * (unsigned)(D * 2) + sc * 16; }
        float* rtab = ldsf + (128 * 1024 + 1024) / 4;
        if (tid < 256) { const float4* sp = (const float4*)(p.ssq + (size_t)(pm * 256 + tid) * NH); const float4 a = sp[0], b = sp[1], c = sp[2];
            rtab[tid] = rsqrtf(((a.x + a.y) + (a.z + a.w) + (b.x + b.y) + (b.z + b.w) + (c.x + c.y) + (c.z + c.w)) / (float)DNA + EPS); }
        f32x16 acc[4][2];
        unsigned po2[4], qo2[4];
#pragma unroll
        for (int i = 0; i < 4; ++i) { po2[i] = po[i] + DF * 2; qo2[i] = qo[i] + DF * 2; }
        gemm256(lds, tid, (const char*)p.A2b, po2, (const char*)p.WoutT, qo2, DNA / 64, acc);
#pragma unroll
        for (int i = 0; i < 4; ++i)
#pragma unroll
            for (int v = 0; v < 16; ++v) { const float rs_ = rtab[wr * 128 + i * 32 + (v & 3) + 8 * (v >> 2) + 4 * h]; acc[i][0][v] *= rs_; acc[i][1][v] *= rs_; }
        unsigned po3[4];
#pragma unroll
        for (int i = 0; i < 4; ++i) po3[i] = (unsigned)(pm * 256 + srow + 64 * i) * (unsigned)(DF * 2) + sc * 16;
        gemm256(lds, tid, (const char*)p.F2, po3, (const char*)p.WoutT, qo, DF / 64, acc, false);
        const float* gt1 = p.mod + (pm >> 5) * NMOD * D + 2 * D;
        int opq = 0; asm volatile("" : "+v"(opq));
        const int r_ = r + opq, h_ = h + opq;
#pragma unroll
        for (int j = 0; j < 2; ++j) {
            const int feat = pn * 256 + wc * 64 + j * 32 + r_; const float g = gt1[feat];
#pragma unroll
            for (int i = 0; i < 4; ++i) {
                const unsigned base = (unsigned)((pm * 256 + wr * 128 + i * 32 + 4 * h_) * D + feat);
                const float* xp = p.x + base; float* op = p.x1 + base;
#pragma unroll
                for (int hf = 0; hf < 2; ++hf) {
                    float xv[8];
#pragma unroll
                    for (int v = 0; v < 8; ++v) xv[v] = xp[((v & 3) + 8 * (v >> 2) + 16 * hf) * D];
#pragma unroll
                    for (int v = 0; v < 8; ++v) op[((v & 3) + 8 * (v >> 2) + 16 * hf) * D] = xv[v] + g * acc[i][j][8 * hf + v];
                    asm volatile("" ::: "memory");
                }
            }
        }
    }
}

__device__ void ph_router(const Params& p, float* lds, bool commit = true) {
    int tid = threadIdx.x; asm volatile("" : "+v"(tid));
    const int wv = tid >> 6, lane = tid & 63;
    int* sel = (int*)lds; int* cntl = sel + 128; int* basel = cntl + 32; int* posl = basel + 32;
    for (int blk = blockIdx.x; blk < NTOK / 64; blk += gridDim.x) {
        __syncthreads();
        if (tid < 32) cntl[tid] = 0;
        for (int ti = 0; ti < 8; ++ti) {
            const int tok = blk * 64 + wv * 8 + ti;
            const int b = tok / SEQ;
            const float* sh = p.mod + b * NMOD * D + 3 * D, * sc = sh + D;
            float hv[16]; float ss = 0.f;
#pragma unroll
            for (int i = 0; i < 16; ++i) { hv[i] = p.x1[(size_t)tok * D + lane + 64 * i]; ss = fmaf(hv[i], hv[i], ss); }
            ss = wave_sum(ss);
            const float r = rsqrtf(ss / (float)D + EPS);
#pragma unroll
            for (int i = 0; i < 16; ++i) { const int e = lane + 64 * i; hv[i] = hv[i] * r * p.g_norm2[e] * (1.f + sc[e]) + sh[e]; p.h2b[(size_t)tok * D + e] = f2bf(hv[i]); }
            float lg[4];
#pragma unroll
            for (int o = 0; o < 4; ++o) { float a = 0.f;
#pragma unroll
                for (int i = 0; i < 16; ++i) a = fmaf(hv[i], p.WrT[o * D + lane + 64 * i], a);
                lg[o] = wave_sum(a); }
            int gs = 0; float gm = lg[0];
#pragma unroll
            for (int o = 1; o < 4; ++o) if (lg[o] > gm) { gm = lg[o]; gs = o; }
            float gz = 0.f;
#pragma unroll
            for (int o = 0; o < 4; ++o) gz += expf(lg[o] - gm);
            const float pg = 1.f / gz;
            gs = __builtin_amdgcn_readfirstlane(gs);
            const float* wre = p.WrT + (4 + gs * 8) * D + lane;
            float le[8];
#pragma unroll
            for (int o = 0; o < 8; ++o) { float a = 0.f;
#pragma unroll
                for (int i = 0; i < 16; ++i) a = fmaf(hv[i], wre[o * D + 64 * i], a);
                le[o] = wave_sum(a); }
            int i0 = 0; float m0 = le[0];
#pragma unroll
            for (int o = 1; o < 8; ++o) if (le[o] > m0) { m0 = le[o]; i0 = o; }
            int i1 = -1; float m1 = -3.0e38f;
#pragma unroll
            for (int o = 0; o < 8; ++o) if (o != i0 && le[o] > m1) { m1 = le[o]; i1 = o; }
            const float e1 = expf(m1 - m0);
            const float g0 = pg / (1.f + e1), g1 = pg * e1 / (1.f + e1);
            if (lane == 0) {
                sel[(wv * 8 + ti) * 2] = gs * 8 + i0; sel[(wv * 8 + ti) * 2 + 1] = gs * 8 + i1;
                p.tokgate[tok * 2] = g0; p.tokgate[tok * 2 + 1] = g1;
            }
        }
        __syncthreads();
        int e = 0;
        if (tid < 128) { e = sel[tid]; posl[tid] = atomicAdd(&cntl[e], 1); }
        __syncthreads();
        if (tid < 32 && commit) basel[tid] = atomicAdd(&p.cnt[tid * 64], cntl[tid]);
        __syncthreads();
        if (tid < 128 && commit) p.list[e * NTOK + basel[e] + posl[tid]] = (blk * 64 + (tid >> 1)) * 2 + (tid & 1);
    }
}

struct ETile { int e, s0, ns, sbase; };
__device__ __forceinline__ int moe_ntiles(const Params& p) { int t = 0; for (int e = 0; e < NEXP; ++e) t += (p.cnt[e * 64] + 255) >> 8; return t; }
__device__ __forceinline__ ETile moe_tile(const Params& p, int tile) {
    int e = 0, base = 0, sb = 0;
    for (;;) { const int c = p.cnt[e * 64], nc = (c + 255) >> 8; if (tile < base + nc) break; base += nc; sb += c; ++e; }
    ETile t; t.e = e; t.s0 = (tile - base) * 256; t.ns = min(256, p.cnt[e * 64] - t.s0); t.sbase = sb; return t;
}

__device__ void ph_moe(const Params& p, float* ldsf) {
    LAS unsigned char* lds = (LAS unsigned char*)ldsf;
    int tid = threadIdx.x; asm volatile("" : "+v"(tid));
    const int lane = tid & 63, wid = tid >> 6, wr = wid >> 2, wc = wid & 3, r = lane & 31, h = lane >> 5;
    const int srow = tid >> 3, sc = SCS(tid);
    const int nt4 = moe_ntiles(p) * 4;
    for (int u = blockIdx.x; u < 2 * nt4; u += gridDim.x) {
        const bool isdown = u >= nt4; const int uu = isdown ? u - nt4 : u;
        const int tile = uu >> 2;
        const ETile t = moe_tile(p, tile); const int fc = uu & 3;
        unsigned po[4], qo[4];
        f32x16 acc[4][2];
        if (!isdown) {
#pragma unroll
            for (int i = 0; i < 4; ++i) {
                const int rt = srow + 64 * i;
                const int ent = rt < t.ns ? p.list[t.e * NTOK + t.s0 + rt] : 0;
                po[i] = (unsigned)(ent >> 1) * (unsigned)(D * 2) + sc * 16;
                const int f = fc * 128 + (rt >> 6) * 32 + (rt & 31), up = (rt >> 5) & 1;
                qo[i] = (unsigned)((up * NEXP + t.e) * DEXP + f) * (unsigned)(D * 2) + sc * 16;
            }
            gemm256(lds, tid, (const char*)p.h2b, po, (const char*)p.WgT, qo, D / 64, acc);
            int opq = 0; asm volatile("" : "+v"(opq));
            const int r_ = r + opq, h_ = h + opq;
            const int f = fc * 128 + wc * 32 + r_;
#pragma unroll
            for (int i = 0; i < 4; ++i) {
                const int s = wr * 128 + i * 32 + 4 * h_;
#pragma unroll
                for (int v = 0; v < 16; ++v) {
                    const int sv = s + (v & 3) + 8 * (v >> 2);
                    const float g = acc[i][0][v], uu_ = acc[i][1][v];
                    if (sv < t.ns) p.act[(unsigned)((t.sbase + t.s0 + sv) * DEXP + f)] = f2bf(g / (1.f + __expf(-g)) * uu_);
                }
                asm volatile("" ::: "memory");
            }
            asm volatile("s_waitcnt vmcnt(0)" ::: "memory");
            __syncthreads();
            if (tid == 0) { __builtin_amdgcn_fence(__ATOMIC_RELEASE, "agent"); asm volatile("s_waitcnt vmcnt(0)" ::: "memory");
                __hip_atomic_fetch_add(p.tilecnt + tile, 1u, __ATOMIC_RELAXED, __HIP_MEMORY_SCOPE_AGENT); }
        } else {
            if (tid == 0) { unsigned sp = 0;
                while (__hip_atomic_load(p.tilecnt + tile, __ATOMIC_RELAXED, __HIP_MEMORY_SCOPE_AGENT) < 4u) { __builtin_amdgcn_s_sleep(2); if (++sp > (1u << 22)) break; }
                __builtin_amdgcn_fence(__ATOMIC_ACQUIRE, "agent"); asm volatile("s_waitcnt vmcnt(0)" ::: "memory"); }
            __syncthreads();
            const int pn = fc;
#pragma unroll
            for (int i = 0; i < 4; ++i) {
                const int rt = srow + 64 * i;
                po[i] = (unsigned)(t.sbase + t.s0 + (rt < t.ns ? rt : 0)) * (unsigned)(DEXP * 2) + sc * 16;
                qo[i] = (unsigned)(t.e * D + pn * 256 + rt) * (unsigned)(DEXP * 2) + sc * 16;
            }
            gemm256(lds, tid, (const char*)p.act, po, (const char*)p.WdT, qo, DEXP / 64, acc);
            int opq = 0; asm volatile("" : "+v"(opq));
            const int r_ = r + opq, h_ = h + opq;
#pragma unroll
            for (int i = 0; i < 4; ++i) {
                const int s = wr * 128 + i * 32 + 4 * h_;
#pragma unroll
                for (int v = 0; v < 16; ++v) {
                    const int sv = s + (v & 3) + 8 * (v >> 2);
                    if (sv < t.ns) {
                        const int ent = p.list[t.e * NTOK + t.s0 + sv]; const float g = p.tokgate[ent];
                        const unsigned base = (unsigned)ent * D + pn * 256 + wc * 64 + r_;
                        p.ybuf[base] = f2bf(g * acc[i][0][v]); p.ybuf[base + 32] = f2bf(g * acc[i][1][v]);
                    }
                }
                asm volatile("" ::: "memory");
            }
        }
    }
}

__device__ void ph_final(const Params& p, float* lds, float* outp) {
    int tid = threadIdx.x; asm volatile("" : "+v"(tid));
    for (int tok = blockIdx.x; tok < NTOK; tok += gridDim.x) {
        const float* gt2 = p.mod + (tok / SEQ) * NMOD * D + 5 * D;
        const unsigned ya = *(const unsigned*)(p.ybuf + (size_t)(2 * tok) * D + 2 * tid), yb = *(const unsigned*)(p.ybuf + (size_t)(2 * tok + 1) * D + 2 * tid);
        const float2 xv = *(const float2*)(p.x1 + (size_t)tok * D + 2 * tid);
        const float m0 = __uint_as_float(ya << 16) + __uint_as_float(yb << 16), m1 = __uint_as_float(ya & 0xffff0000u) + __uint_as_float(yb & 0xffff0000u);
        const float v0 = xv.x + gt2[2 * tid] * m0, v1 = xv.y + gt2[2 * tid + 1] * m1;
        const float ss = block_sum(v0 * v0 + v1 * v1, lds);
        const float rr = rsqrtf(ss / (float)D + EPS);
        *(float2*)(outp + (size_t)tok * D + 2 * tid) = make_float2(v0 * rr * p.g_final[2 * tid], v1 * rr * p.g_final[2 * tid + 1]);
    }
}

extern __shared__ __attribute__((aligned(16))) float smem[];

constexpr int R_P0 = 1, R_INP = 1, R_FOUR = 1, R_ATT = 1, R_OUT = 1, R_MOE = 1, R_RT = 1, R_FIN = 1, R_BAR = 1;
constexpr int LDS_BAR_OFF = 128 * 1024 + 512;
__global__ void __launch_bounds__(NT) mega(Params p) {
    volatile LAS unsigned* st = (volatile LAS unsigned*)((LAS unsigned char*)smem + LDS_BAR_OFF);
    if (threadIdx.x == 0) { st[0] = 0u; st[1] = 0u; }
    __syncthreads();
    const XcdBarrier bar = xcd_barrier_post(p.bar, st);
#define REP(n, call) for (int _r = 0; _r < (n); ++_r) { call; }
    REP(R_P0, ph_adaln_tables(p, smem)) REP(R_BAR, xcd_barrier(bar))
    REP(R_P0, ph_hrows(p, smem)) REP(R_BAR, xcd_barrier(bar))
    ph_inproj(p, smem); ph_filler(p, smem); REP(R_BAR, xcd_barrier(bar))
    REP(R_ATT, ph_attn(p, smem)) REP(R_BAR, xcd_barrier(bar))
    REP(R_OUT, ph_outproj(p, smem)) REP(R_BAR, xcd_barrier(bar))
    REP(R_RT - 1, ph_router(p, smem, false)) ph_router(p, smem); REP(R_BAR, xcd_barrier(bar))
    ph_moe(p, smem); REP(R_BAR, xcd_barrier(bar))
    REP(R_FIN - 1, ph_final(p, smem, (float*)p.h2b)) ph_final(p, smem, p.out);
}

extern "C" void kernel_launch(void* const* d_in, const int* in_sizes, int n_in, void* d_out, int out_size, void* d_ws, size_t ws_size, hipStream_t stream) {
    constexpr size_t kDynLds = 128 * 1024 + 2048;
    static int grid_blocks = 0;
    if (!grid_blocks) {
        int dev = 0, cus = 0, per_cu = 0;
        (void)hipGetDevice(&dev);
        (void)hipDeviceGetAttribute(&cus, hipDeviceAttributeMultiprocessorCount, dev);
        (void)hipFuncSetAttribute((const void*)mega, hipFuncAttributeMaxDynamicSharedMemorySize, (int)kDynLds);
        (void)hipOccupancyMaxActiveBlocksPerMultiprocessor(&per_cu, (const void*)mega, NT, kDynLds);
        if (per_cu > 1) per_cu = 1;
        grid_blocks = cus * per_cu;
    }
    Params p{};
    p.x = (const float*)d_in[0]; p.c = (const float*)d_in[1]; p.ctx = (const float*)d_in[2]; p.c_ctx = (const float*)d_in[3];
    p.w_ada = (const float*)d_in[4]; p.b_ada = (const float*)d_in[5]; p.g_norm1 = (const float*)d_in[6]; p.w_in = (const float*)d_in[7];
    p.w_fmix = (const float*)d_in[8]; p.rpb = (const float*)d_in[9]; p.g_out = (const float*)d_in[10]; p.w_out = (const float*)d_in[11];
    p.g_norm2 = (const float*)d_in[12]; p.w_rg = (const float*)d_in[13]; p.w_re = (const float*)d_in[14]; p.w_gate = (const float*)d_in[15];
    p.w_up = (const float*)d_in[16]; p.w_down = (const float*)d_in[17]; p.g_final = (const float*)d_in[18];
    p.out = (float*)d_out;
    char* w = (char*)d_ws; size_t o = 0;
    auto take = [&](size_t bytes) { char* r = w + o; o += (bytes + 255) & ~(size_t)255; return r; };
    p.mod = (float*)take(3 * NMOD * D * 4); p.cosN = (float*)take(SEQ * 4); p.sinN = (float*)take(SEQ * 4); p.ropeR = (float*)take(GROWS * 32 * 4); p.ropeC = (float*)take(GW * 32 * 4);
    p.bar = (unsigned*)take(XCD_BAR_WORDS * 4); p.WrT = (float*)take(36 * D * 4); p.ssq = (float*)take((size_t)NTOK * NH * 4); p.tilecnt = (unsigned*)take(256 * 4); p.qctl = (unsigned*)take(8 * 64 * 4); p.F2 = (bf16_t*)take((size_t)NTOK * DF * 2); p.cnt = (int*)take(NEXP * 256); p.list = (int*)take((size_t)NEXP * NTOK * 4); p.tokgate = (float*)take(2 * NTOK * 4);
    p.WinT = (bf16_t*)take((size_t)DIN * D * 2); p.WoutT = (bf16_t*)take((size_t)D * D * 2);
    p.W64cs = (bf16_t*)take(256 * 64 * 2); p.G128 = (bf16_t*)take(256 * 256 * 2); p.WmixT = (bf16_t*)take(256 * 512 * 2);
    p.WgT = (bf16_t*)take((size_t)NEXP * DEXP * D * 2); p.WuT = (bf16_t*)take((size_t)NEXP * DEXP * D * 2); p.WdT = (bf16_t*)take((size_t)NEXP * DEXP * D * 2);
    char* R1 = take((size_t)NROWS * D * 2 + 2 * (size_t)NTOK * 512 * 2 + 256);
    p.hb = (bf16_t*)R1; p.A2b = (bf16_t*)R1; p.Zb = (bf16_t*)(R1 + (size_t)NROWS * D * 2); p.P2 = p.Zb + (size_t)NTOK * 512; p.h2b = (bf16_t*)R1; p.act = p.h2b + (size_t)NTOK * D;
    const size_t qkv = (size_t)NTOK * DNA * 2;
    char* R2 = take((size_t)NTOK * DF * 2 + 4 * qkv + 2 * (size_t)NCTX * DNA * 2 + 4096);
    p.fX = (bf16_t*)R2; p.Qr = (bf16_t*)(R2 + (size_t)NTOK * DF * 2); p.Qp = p.Qr + (size_t)NTOK * DNA; p.Kr = p.Qp + (size_t)NTOK * DNA; p.Vt = p.Kr + (size_t)NTOK * DNA;
    p.Kc = p.Vt + (size_t)NTOK * DNA; p.Vct = p.Kc + (size_t)NCTX * DNA;
    p.x1 = (float*)(R2 + (size_t)NTOK * DF * 2 + 4 * qkv + 2 * (size_t)NCTX * DNA * 2 - (size_t)NTOK * D * 4);
    p.ybuf = (bf16_t*)p.out;
    if (o > ws_size) { fprintf(stderr, "workspace too small: need %zu have %zu\n", o, ws_size); return; }
    void* args[] = {&p};
    (void)hipMemsetAsync(p.bar, 0, XCD_BAR_WORDS * 4, stream);
    hipError_t e = hipLaunchCooperativeKernel((const void*)mega, dim3(grid_blocks), dim3(NT), args, kDynLds, stream);
    if (e != hipSuccess) fprintf(stderr, "cooperative launch failed: %s (grid %d)\n", hipGetErrorString(e), grid_blocks);
}
```

```cpp
#include <hip/hip_runtime.h>
#include <cstdio>
#include <cstdint>
#include <type_traits>

constexpr int D = 1024, NBATCH = 2, SEQ = 8192, NTOK = NBATCH * SEQ, LCTX = 256, NCTX = NBATCH * LCTX, NROWS = NTOK + NCTX;
constexpr int DIN = 2560, DF = 256, NH = 12, HD = 64, DNA = 768, QOFF = 256, KOFF = 1024, VOFF = 1792;
constexpr int GW = 64, GROWS = 128, NEXP = 32, DEXP = 512, NMOD = 6;
constexpr float EPS = 1e-6f;
constexpr int NT = 512;
constexpr int TS_PHASE = -1;
constexpr int GPROBE = 0;
constexpr float QSCALE = 0.125f * 1.4426950408889634f;
typedef unsigned short bf16_t;
typedef short bf16x8 __attribute__((ext_vector_type(8)));
typedef float f32x16 __attribute__((ext_vector_type(16)));
typedef float f32x4 __attribute__((ext_vector_type(4)));
__device__ __forceinline__ unsigned cvt_pk_bf16(float lo, float hi) { unsigned r; asm volatile("v_cvt_pk_bf16_f32 %0, %1, %2" : "=v"(r) : "v"(lo), "v"(hi)); return r; }
__device__ __forceinline__ bf16_t f2bf(float v) { return (bf16_t)(cvt_pk_bf16(v, 0.f) & 0xffffu); }
__device__ __forceinline__ float bf2f(bf16_t v) { return __uint_as_float((unsigned)v << 16); }

struct Params {
    const float *x, *c, *ctx, *c_ctx, *w_ada, *b_ada, *g_norm1, *w_in, *w_fmix, *rpb, *g_out, *w_out, *g_norm2, *w_rg, *w_re, *w_gate, *w_up, *w_down, *g_final;
    float* out;
    float *mod, *cosN, *sinN, *ropeR, *ropeC;
    float *x1;
    int *cnt, *list; float* tokgate; unsigned* bar; float* WrT; float* ssq; unsigned* tilecnt; unsigned* qctl; bf16_t* F2;
    bf16_t *WinT, *WoutT, *WgT, *WuT, *WdT;
    bf16_t *hb, *A2b;
    bf16_t *h2b, *act, *ybuf;
    bf16_t *fX, *Qr, *Qp, *Kr, *Vt, *Kc, *Vct;
    bf16_t *W64cs, *G128, *WmixT;
    bf16_t *Zb, *P2;
};

template <int CTRL> __device__ __forceinline__ float dpp(float x) { return __builtin_bit_cast(float, __builtin_amdgcn_mov_dpp(__builtin_bit_cast(int, x), CTRL, 0xf, 0xf, true)); }
__device__ __forceinline__ float xhalf_sum(float x) { auto t = __builtin_amdgcn_permlane32_swap(__float_as_uint(x), __float_as_uint(x), false, false); return __uint_as_float(t[0]) + __uint_as_float(t[1]); }
__device__ __forceinline__ float xhalf_max(float x) { auto t = __builtin_amdgcn_permlane32_swap(__float_as_uint(x), __float_as_uint(x), false, false); return fmaxf(__uint_as_float(t[0]), __uint_as_float(t[1])); }
__device__ __forceinline__ float wave_sum(float x) {
    x += dpp<0xB1>(x); x += dpp<0x4E>(x); x += dpp<0x141>(x); x += dpp<0x128>(x);
    x += __shfl_xor(x, 16);
    return x + __shfl_xor(x, 32);
}
__device__ __forceinline__ float wave_max(float x) {
    x = fmaxf(x, dpp<0xB1>(x)); x = fmaxf(x, dpp<0x4E>(x)); x = fmaxf(x, dpp<0x141>(x)); x = fmaxf(x, dpp<0x128>(x));
    x = fmaxf(x, __shfl_xor(x, 16));
    return fmaxf(x, __shfl_xor(x, 32));
}
__device__ __forceinline__ float block_sum(float v, float* red) {
    v = wave_sum(v);
    const int w = threadIdx.x >> 6, l = threadIdx.x & 63;
    __syncthreads();
    if (l == 0) red[w] = v;
    __syncthreads();
    float s = 0.f;
#pragma unroll
    for (int i = 0; i < NT / 64; ++i) s += red[i];
    return s;
}

#define LAS __attribute__((address_space(3)))
#define SCS(tid) (((tid) & 7) ^ ((((tid) >> 3) >> 1) & 7))
__device__ __forceinline__ void gemm256(LAS unsigned char* lds, const int tid, const char* Pb, const unsigned (&po)[4], const char* Qb, const unsigned (&qo)[4], int nk, f32x16 (&acc)[4][2], const bool zero = true) {
    const int lane = tid & 63, wid = __builtin_amdgcn_readfirstlane(tid >> 6), wr = wid >> 2, wc = wid & 3;
    const int r = lane & 31, h = lane >> 5, swz = (r >> 1) & 7;
    const unsigned ldsw = (unsigned)wid * 1024u;
    if (zero) {
#pragma unroll
        for (int i = 0; i < 4; ++i)
#pragma unroll
            for (int j = 0; j < 2; ++j)
#pragma unroll
                for (int v = 0; v < 16; ++v) acc[i][j][v] = 0.f;
    }
    __syncthreads();
#pragma unroll
    for (int i = 0; i < 4; ++i) {
        __builtin_amdgcn_global_load_lds((const unsigned*)(Pb + po[i]), (LAS unsigned*)(lds + ldsw + i * 8192), 16, 0, 0);
        __builtin_amdgcn_global_load_lds((const unsigned*)(Qb + qo[i]), (LAS unsigned*)(lds + 32768 + ldsw + i * 8192), 16, 0, 0);
    }
    __syncthreads();
    unsigned long long tg0_ = 0; if (GPROBE) tg0_ = __builtin_amdgcn_s_memtime();
    const int prd = (wr * 128 + r) * 128, qrd = 32768 + (wc * 64 + r) * 128;
    const int ko0 = ((0 + h) ^ swz) << 4, ko1 = ((2 + h) ^ swz) << 4, ko2 = ((4 + h) ^ swz) << 4, ko3 = ((6 + h) ^ swz) << 4;
#define G256_LD(pf, qf, ko) do { _Pragma("unroll") for (int i = 0; i < 4; ++i) pf[i] = *(const LAS bf16x8*)(lds + cb + prd + i * 4096 + (ko)); \
                                 _Pragma("unroll") for (int j = 0; j < 2; ++j) qf[j] = *(const LAS bf16x8*)(lds + cb + qrd + j * 4096 + (ko)); } while (0)
#define G256_MM(pf, qf) do { _Pragma("unroll") for (int i = 0; i < 4; ++i) _Pragma("unroll") for (int j = 0; j < 2; ++j) \
                                 acc[i][j] = __builtin_amdgcn_mfma_f32_32x32x16_bf16(pf[i], qf[j], acc[i][j], 0, 0, 0); } while (0)
#pragma unroll 1
    for (int kt = 0; kt < nk; ++kt) {
        const int cb = (kt & 1) * 65536, nb = 65536 - cb;
        {
            const unsigned koff = (unsigned)min(kt + 1, nk - 1) * 128u;
#pragma unroll
            for (int i = 0; i < 4; ++i) {
                __builtin_amdgcn_global_load_lds((const unsigned*)(Pb + (size_t)(po[i] + koff)), (LAS unsigned*)(lds + nb + ldsw + i * 8192), 16, 0, 0);
                __builtin_amdgcn_global_load_lds((const unsigned*)(Qb + (size_t)(qo[i] + koff)), (LAS unsigned*)(lds + nb + 32768 + ldsw + i * 8192), 16, 0, 0);
            }
        }
        bf16x8 pa[4], qa[2], pb[4], qb[2];
        G256_LD(pa, qa, ko0);
        G256_LD(pb, qb, ko1);
        G256_MM(pa, qa);
        G256_LD(pa, qa, ko2);
        G256_MM(pb, qb);
        G256_LD(pb, qb, ko3);
        G256_MM(pa, qa);
        G256_MM(pb, qb);
        if (GPROBE) { const unsigned long long t0_ = __builtin_amdgcn_s_memtime(); __syncthreads(); const unsigned long long t1_ = __builtin_amdgcn_s_memtime();
            if (tid == 0) { volatile LAS unsigned* gp = (volatile LAS unsigned*)(lds + 128 * 1024 + 640); gp[0] += (unsigned)(t1_ - t0_); gp[1] += 1u; } }
        else __syncthreads();
    }
    if (GPROBE && tid == 0) { volatile LAS unsigned* gp = (volatile LAS unsigned*)(lds + 128 * 1024 + 640); const unsigned long long t_ = __builtin_amdgcn_s_memtime(); gp[2] += (unsigned)(t_ - tg0_); }
    asm volatile("" ::: "memory");
}

#define XB_TMO      128
#define XB_XCNT(j)  (256  + 64 * (j))
#define XB_XSUB(j)  (1280 + 64 * (j))
#define XB_XGEN(j)  (2304 + 64 * (j))
#define XB_TOP      3328
#define XB_TOPGEN   3392
#define XCD_BAR_WORDS 3456
#define XB_SPIN_CAP (1u << 18)
__device__ __forceinline__ unsigned xb_ld(unsigned* p)              { return __hip_atomic_load(p, __ATOMIC_RELAXED, __HIP_MEMORY_SCOPE_AGENT); }
__device__ __forceinline__ unsigned xb_add(unsigned* p, unsigned v) { return __hip_atomic_fetch_add(p, v, __ATOMIC_RELAXED, __HIP_MEMORY_SCOPE_AGENT); }
__device__ __forceinline__ unsigned xb_xcc_id() { return (unsigned)__builtin_amdgcn_s_getreg((3 << 11) | 20) & 0xFu; }
#define XB_SPIN(cond, bar) do { unsigned _sp = 0; while (cond) { __builtin_amdgcn_s_sleep(1); \
    if ((++_sp & 255u) == 0u) { if (xb_ld(&(bar)[XB_TMO])) break; if (_sp > XB_SPIN_CAP) { atomicAdd(&(bar)[XB_TMO], 1u); break; } } } } while (0)
struct XcdBarrier { unsigned* bar; unsigned x; volatile LAS unsigned* st; };
__device__ unsigned g_bar[XCD_BAR_WORDS + 64];
__device__ __forceinline__ XcdBarrier xcd_barrier_post(unsigned* bar, volatile LAS unsigned* st) {
    XcdBarrier b; b.bar = bar; b.x = xb_xcc_id(); b.st = st;
    if (threadIdx.x == 0) (void)xb_add(&bar[XB_XCNT(b.x)], 1u);
    return b;
}
__device__ __forceinline__ void xcd_barrier_complete(unsigned* bar, unsigned x, unsigned& nloc, unsigned& nx) {
    const unsigned G = gridDim.x * gridDim.y * gridDim.z;
    unsigned sum, cnt, mine, sp = 0u;
    for (;;) {
        sum = 0u; cnt = 0u; mine = 0u;
#pragma unroll
        for (unsigned j = 0; j < 16; ++j) { const unsigned c = xb_ld(&bar[XB_XCNT(j)]); sum += c; cnt += (c > 0u) ? 1u : 0u; mine = (j == x) ? c : mine; }
        if (sum == G) break;
        __builtin_amdgcn_s_sleep(1);
        if ((++sp & 255u) == 0u) { if (xb_ld(&bar[XB_TMO])) break; if (sp > XB_SPIN_CAP) { atomicAdd(&bar[XB_TMO], 1u); break; } }
    }
    nloc = mine > 0u ? mine : 1u; nx = cnt > 0u ? cnt : 1u;
}
__device__ __forceinline__ void xcd_barrier(const XcdBarrier& b) {
    asm volatile("s_waitcnt vmcnt(0)" ::: "memory");
    __syncthreads();
    if (threadIdx.x == 0) {
        unsigned* bar = b.bar;
        __builtin_amdgcn_s_waitcnt(0);
        unsigned nloc = b.st[0], nx = b.st[1];
        if (nloc == 0u) { xcd_barrier_complete(bar, b.x, nloc, nx); b.st[0] = nloc; b.st[1] = nx; }
        const unsigned old = xb_add(&bar[XB_XSUB(b.x)], 1u);
        const unsigned gen = old / nloc;
        if (old + 1u == (gen + 1u) * nloc) {
            __builtin_amdgcn_fence(__ATOMIC_RELEASE, "agent");
            asm volatile("s_waitcnt vmcnt(0)" ::: "memory");
            const unsigned og = xb_add(&bar[XB_TOP], 1u);
            const unsigned tg = og / nx;
            if (og + 1u == (tg + 1u) * nx) xb_add(&bar[XB_TOPGEN], 1u);
            else XB_SPIN(xb_ld(&bar[XB_TOPGEN]) == tg, bar);
            __builtin_amdgcn_fence(__ATOMIC_ACQUIRE, "agent");
            xb_add(&bar[XB_XGEN(b.x)], 1u);
            asm volatile("s_waitcnt vmcnt(0)" ::: "memory");
        } else {
            XB_SPIN(xb_ld(&bar[XB_XGEN(b.x)]) == gen, bar);
            __builtin_amdgcn_fence(__ATOMIC_ACQUIRE, "agent");
            asm volatile("s_waitcnt vmcnt(0)" ::: "memory");
        }
    }
    __syncthreads();
}

__device__ __forceinline__ void publish_add(unsigned* ctr, int tid) {
    asm volatile("s_waitcnt vmcnt(0)" ::: "memory");
    __syncthreads();
    if (tid == 0) { __builtin_amdgcn_fence(__ATOMIC_RELEASE, "agent"); asm volatile("s_waitcnt vmcnt(0)" ::: "memory");
        __hip_atomic_fetch_add(ctr, 1u, __ATOMIC_RELAXED, __HIP_MEMORY_SCOPE_AGENT); }
}
__device__ __forceinline__ void wait_ge(unsigned* ctr, unsigned want, int tid) {
    if (tid == 0) { unsigned sp = 0;
        while (__hip_atomic_load(ctr, __ATOMIC_RELAXED, __HIP_MEMORY_SCOPE_AGENT) < want) { __builtin_amdgcn_s_sleep(2); if (++sp > (1u << 22)) break; }
        __builtin_amdgcn_fence(__ATOMIC_ACQUIRE, "agent"); asm volatile("s_waitcnt vmcnt(0)" ::: "memory"); }
    __syncthreads();
}
#define QW(i) ((i) * 64)

struct TJob { const float* src; bf16_t* dst; int R, C, ntile; const float* rscale; int smin; };
__device__ void transpose_all(const Params& p, float* lds) {
    int tid = threadIdx.x; asm volatile("" : "+v"(tid));
    const int rr0 = tid >> 6, c4 = (tid & 63) * 4;
    volatile int* qw = (volatile int*)(lds + 64 * 257);
    auto job_of = [&](int id, TJob& j, int& t) {
        if (id < 160) { j = TJob{p.w_in, p.WinT, D, DIN, 160, nullptr, 0}; t = id; }
        else if (id < 224) { j = TJob{p.w_out, p.WoutT, D, D, 64, p.g_out, DF}; t = id - 160; }
        else if (id < 1248) { j = TJob{p.w_gate, p.WgT, D, DEXP, 1024, nullptr, 0}; t = id - 224; }
        else if (id < 2272) { j = TJob{p.w_up, p.WuT, D, DEXP, 1024, nullptr, 0}; t = id - 1248; }
        else { j = TJob{p.w_down, p.WdT, DEXP, D, 1024, nullptr, 0}; t = id - 2272; }
    };
    constexpr int NTILES = 3296;
    auto fetch = [&]() { __syncthreads(); if (tid == 0) qw[0] = (int)__hip_atomic_fetch_add(g_bar + 64, 1u, __ATOMIC_RELAXED, __HIP_MEMORY_SCOPE_AGENT); __syncthreads(); return (int)qw[0]; };
    float4 v[8];
    auto load = [&](int id) { TJob j; int t; job_of(id, j, t); const int tr = j.R / 64, tc = j.C / 256;
        const int bb = t / (tr * tc), rem = t % (tr * tc), r0 = (rem / tc) * 64, c0 = (rem % tc) * 256;
        const float* s = j.src + (size_t)bb * j.R * j.C + (size_t)r0 * j.C + c0;
#pragma unroll
        for (int i = 0; i < 8; ++i) v[i] = *(const float4*)(s + (size_t)(rr0 + 8 * i) * j.C + c4); };
    int id = fetch();
    if (id < NTILES) load(id);
    while (id < NTILES) {
        TJob j; int t; job_of(id, j, t); const int tr = j.R / 64, tc = j.C / 256;
        const int bb = t / (tr * tc), rem = t % (tr * tc), r0 = (rem / tc) * 64, c0 = (rem % tc) * 256;
        bf16_t* d = j.dst + (size_t)bb * j.R * j.C + (size_t)c0 * j.R + r0;
        if (j.rscale) {
#pragma unroll
            for (int i = 0; i < 8; ++i) if (r0 + rr0 + 8 * i >= j.smin) { const float g = j.rscale[r0 + rr0 + 8 * i]; v[i].x *= g; v[i].y *= g; v[i].z *= g; v[i].w *= g; } }
        const int nid = fetch();
#pragma unroll
        for (int i = 0; i < 8; ++i) { float* q = lds + (rr0 + 8 * i) * 257 + c4; q[0] = v[i].x; q[1] = v[i].y; q[2] = v[i].z; q[3] = v[i].w; }
        if (nid < NTILES) load(nid);
        __syncthreads();
#pragma unroll
        for (int i = 0; i < 4; ++i) { const int cc = (tid >> 3) + 64 * i, r8 = (tid & 7) * 8; const float* q = lds + r8 * 257 + cc;
            uint4 w; w.x = cvt_pk_bf16(q[0], q[257]); w.y = cvt_pk_bf16(q[2 * 257], q[3 * 257]); w.z = cvt_pk_bf16(q[4 * 257], q[5 * 257]); w.w = cvt_pk_bf16(q[6 * 257], q[7 * 257]);
            *(uint4*)(d + (size_t)cc * j.R + r8) = w; }
        id = nid;
    }
}

__device__ void ph_hrows(const Params& p, float* lds);
__device__ void ph_adaln_tables(const Params& p, float* lds) {
    int tid = threadIdx.x; asm volatile("" : "+v"(tid));
    const int gid = blockIdx.x * NT + tid, gsz = gridDim.x * NT;
    if (blockIdx.x < NMOD * D / 32) {
        for (int i = tid; i < 3 * D; i += NT) { const int r = i / D, k = i % D; const float v = r < 2 ? p.c[r * D + k] : p.c_ctx[k]; lds[i] = v / (1.f + expf(-v)); }
        __syncthreads();
        const int col = blockIdx.x * 32 + (tid & 31), kg = tid >> 5;
        float a0 = 0.f, a1 = 0.f, a2 = 0.f;
#pragma unroll 8
        for (int kk = 0; kk < 64; ++kk) { const int k = kg * 64 + kk; const float w = p.w_ada[(size_t)k * (NMOD * D) + col]; a0 = fmaf(lds[k], w, a0); a1 = fmaf(lds[D + k], w, a1); a2 = fmaf(lds[2 * D + k], w, a2); }
        float* red = lds + 3 * D;
        red[(0 * 16 + kg) * 32 + (tid & 31)] = a0; red[(1 * 16 + kg) * 32 + (tid & 31)] = a1; red[(2 * 16 + kg) * 32 + (tid & 31)] = a2;
        __syncthreads();
        if (tid < 96) { const int rr = tid >> 5, cc = tid & 31; float s = 0.f;
#pragma unroll
            for (int g = 0; g < 16; ++g) s += red[(rr * 16 + g) * 32 + cc];
            p.mod[rr * NMOD * D + blockIdx.x * 32 + cc] = s + p.b_ada[blockIdx.x * 32 + cc]; }
        publish_add(g_bar + 96, tid);
    }
    for (int i = gid; i < 36 * D; i += gsz) { const int o = i / D, k = i % D; p.WrT[i] = o < 4 ? p.w_rg[k * 4 + o] : p.w_re[k * NEXP + o - 4]; }
    for (int i = gid; i < SEQ; i += gsz) { p.cosN[i] = cospif(2.f * (float)i / (float)SEQ); p.sinN[i] = sinpif(2.f * (float)i / (float)SEQ); }
    for (int i = gid; i < (GROWS + GW) * 16; i += gsz) {
        const int pos = i / 16, f = i % 16; const float inv = powf(10000.f, -(float)f / 16.f);
        if (pos < GROWS) { const float a = (float)pos * inv; p.ropeR[2 * i] = cosf(a); p.ropeR[2 * i + 1] = sinf(a); }
        else { const int pc = pos - GROWS; const float a = (float)pc * inv; p.ropeC[2 * (pc * 16 + f)] = cosf(a); p.ropeC[2 * (pc * 16 + f) + 1] = sinf(a); }
    }
    if (gid < NEXP) p.cnt[gid * 64] = 0;
    if (gid < 256) p.tilecnt[gid] = 0u;
    if (gid < 16) p.qctl[QW(gid)] = 0u;
    for (int i = gid; i < 256 * 64; i += gsz) {
        const int rho = i >> 6, n1 = i & 63, blk = rho >> 5, k1 = (blk >> 1) * 32 + (rho & 31);
        float v = 0.f;
        if (blk < 4) { const float a = 2.f * (float)((k1 * n1) & 63) / 64.f; v = (blk & 1) ? -sinpif(a) : cospif(a); }
        p.W64cs[i] = f2bf(v);
    }
    for (int i = gid; i < 256 * 256; i += gsz) {
        const int rho = i >> 8, kap = i & 255, ro = rho >> 7, k2 = rho & 127, ri = kap >> 7, n2 = kap & 127;
        const float a = 2.f * (float)((k2 * n2) & 127) / 128.f; const float c = cospif(a), s = sinpif(a);
        p.G128[i] = f2bf(ro == ri ? c : (ro == 0 ? s : -s));
    }
    float* cs64 = lds + 3 * D + 1536;
    __syncthreads();
    if (tid < 128) cs64[tid] = tid < 64 ? cospif(2.f * (float)tid / 64.f) : sinpif(2.f * (float)(tid - 64) / 64.f);
    __syncthreads();
    for (int i = gid; i < 256 * 512; i += gsz) {
        const int j = i >> 9, kap = i & 511, ro = kap >> 8, ch = kap & 255, g = ch >> 6, c = ch & 63;
        float acc = 0.f;
        for (int l = 0; l < 64; ++l) acc = fmaf(cs64[ro * 64 + ((l * c) & 63)], p.w_fmix[(size_t)(64 * g + l) * DF + j], acc);
        p.WmixT[i] = f2bf(acc * (1.0f / 724.0773439350247f));
    }
    wait_ge(g_bar + 96, NMOD * D / 32, tid);
    ph_hrows(p, lds);
    transpose_all(p, lds);
}

__device__ void ph_hrows(const Params& p, float* lds) {
    int tid = threadIdx.x; asm volatile("" : "+v"(tid));
    const int lane = tid & 63, nw = gridDim.x * (NT / 64), gw = blockIdx.x * (NT / 64) + (tid >> 6);
    for (int row0 = gw; row0 < NROWS; row0 += 2 * nw) {
        float4 v[2][4]; float ss[2];
#pragma unroll
        for (int q = 0; q < 2; ++q) {
            const int row = min(row0 + q * nw, NROWS - 1);
            const float* src = row < NTOK ? p.x + (size_t)row * D : p.ctx + (size_t)(row - NTOK) * D;
#pragma unroll
            for (int i = 0; i < 4; ++i) v[q][i] = *(const float4*)(src + 4 * lane + 256 * i);
        }
#pragma unroll
        for (int q = 0; q < 2; ++q) { float s = 0.f;
#pragma unroll
            for (int i = 0; i < 4; ++i) s += v[q][i].x * v[q][i].x + v[q][i].y * v[q][i].y + v[q][i].z * v[q][i].z + v[q][i].w * v[q][i].w;
            ss[q] = wave_sum(s); }
#pragma unroll
        for (int q = 0; q < 2; ++q) {
            const int row = row0 + q * nw;
            if (row < NROWS) {
                const int mr = row < NTOK ? row / SEQ : 2;
                const float* sh = p.mod + mr * NMOD * D, * sc = sh + D;
                const float r = rsqrtf(ss[q] / (float)D + EPS);
#pragma unroll
                for (int i = 0; i < 4; ++i) { const int e = 4 * lane + 256 * i;
                    const float4 g = *(const float4*)(p.g_norm1 + e), s4 = *(const float4*)(sc + e), h4 = *(const float4*)(sh + e);
                    uint2 w; w.x = cvt_pk_bf16(v[q][i].x * r * g.x * (1.f + s4.x) + h4.x, v[q][i].y * r * g.y * (1.f + s4.y) + h4.y);
                    w.y = cvt_pk_bf16(v[q][i].z * r * g.z * (1.f + s4.z) + h4.z, v[q][i].w * r * g.w * (1.f + s4.w) + h4.w);
                    *(uint2*)(p.hb + (size_t)row * D + e) = w; }
            }
        }
    }
}

__device__ __forceinline__ void four1_unit(const Params& p, float* ldsf, const int u);
__device__ __forceinline__ void four2_unit(const Params& p, float* ldsf, const int u);
__device__ __forceinline__ void fmix_unit(const Params& p, float* ldsf, const int u);
__device__ void ph_inproj(const Params& p, float* ldsf) {
    LAS unsigned char* lds = (LAS unsigned char*)ldsf;
    int tid = threadIdx.x; asm volatile("" : "+v"(tid));
    const int lane = tid & 63, wid = tid >> 6, wr = wid >> 2, wc = wid & 3, r = lane & 31, h = lane >> 5;
    const int srow = tid >> 3, sc = SCS(tid);
    float* ropeL = ldsf + (128 * 1024 + 4096) / 4;
    __syncthreads();
    for (int i = tid; i < (GROWS + GW) * 32; i += NT) ropeL[i] = i < GROWS * 32 ? p.ropeR[i] : p.ropeC[i - GROWS * 32];
    __syncthreads();
    const bool xa = gridDim.x == 256; const int xcd = xa ? (blockIdx.x & 7) : 0, lj = xa ? (blockIdx.x >> 3) : blockIdx.x, lper = xa ? 32 : gridDim.x, npmx = xa ? 8 : 64;
    const int nloc = npmx * 10 + (xa ? (xcd < 2 ? 6 : 0) : 12);
    for (int rnd = 0; ; ++rnd) {
        const int ul = lj + rnd * lper;
        const bool has = ul < nloc;
        if (!has && !(xa && rnd < 3)) break;
        if (has) {
        int pm, pn;
        if (ul < npmx) { pm = xcd * npmx + ul; pn = 0; } else if (ul < npmx * 10) { pm = xcd * npmx + (ul - npmx) / 9; pn = 1 + (ul - npmx) % 9; }
        else { const int c = ul - npmx * 10; pm = 64 + (xa ? xcd : c / 6); pn = 4 + c % 6; }
        unsigned po[4], qo[4];
#pragma unroll
        for (int i = 0; i < 4; ++i) {
            const int rt = srow + 64 * i;
            po[i] = (unsigned)((pn * 256 + rt) * D * 2 + sc * 16);
            int rowidx;
            if (pn == 0) rowidx = (pm >> 5) * SEQ + 128 * (rt & 63) + 4 * (pm & 31) + (rt >> 6);
            else rowidx = pm * 256 + rt;
            qo[i] = (unsigned)rowidx * (unsigned)(D * 2) + sc * 16;
        }
        f32x16 acc[4][2];
        gemm256(lds, tid, (const char*)p.WinT, po, (const char*)p.hb, qo, D / 64, acc);
        int opq = 0; asm volatile("" : "+v"(opq));
        const int r_ = r + opq, h_ = h + opq;
        if (pn == 0) {
            const int b = pm >> 5, n2 = 4 * (pm & 31) + wc;
#pragma unroll
            for (int i = 0; i < 4; ++i) {
#pragma unroll
                for (int j = 0; j < 2; ++j) {
                    const unsigned base = (unsigned)(((b * DF + wr * 128 + i * 32 + 4 * h_) * 128 + n2) * 64 + j * 32 + r_);
#pragma unroll
                    for (int v = 0; v < 16; ++v) p.fX[base + (unsigned)(((v & 3) + 8 * (v >> 2)) * 128 * 64)] = f2bf(acc[i][j][v]);
                }
                asm volatile("" ::: "memory");
            }
            publish_add(p.qctl + QW(1 + b), tid);
        } else if (pn < 7) {
            const bool isq = pn < 4; const int hg = ((pn - 1) % 3) * 4 + wr * 2;
            const bool isctx = pm >= 64;
            const int b = isctx ? pm - 64 : (pm >> 5);
#pragma unroll
            for (int j = 0; j < 2; ++j) {
                const int n = (isctx ? 0 : (pm & 31) * 256) + wc * 64 + j * 32 + r_;
                const int grow = n >> 6, gcol = n & 63;
#pragma unroll
                for (int i = 0; i < 4; ++i) {
                    const int hh = hg + (i >> 1), blk = i & 1;
                    if (isctx) {
                        const unsigned base = (unsigned)(((b * NH + hh) * LCTX + n) * HD + blk * 32 + 4 * h_);
#pragma unroll
                        for (int q = 0; q < 4; ++q) {
                            uint2 w;
                            w.x = cvt_pk_bf16(acc[i][j][4 * q], acc[i][j][4 * q + 1]); w.y = cvt_pk_bf16(acc[i][j][4 * q + 2], acc[i][j][4 * q + 3]);
                            *(uint2*)(p.Kc + base + 8 * q) = w;
                        }
                    } else {
                        const float* tb = (blk == 0 ? ropeL + 32 * grow : ropeL + GROWS * 32 + 32 * gcol) + 8 * h_;
                        float o1[8], o2[8];
#pragma unroll
                        for (int v = 0; v < 8; ++v) {
                            const float2 cs = *(const float2*)(tb + 2 * ((v & 3) + 8 * (v >> 2)));
                            const float x1 = acc[i][j][v], x2 = acc[i][j][v + 8];
                            o1[v] = x1 * cs.x - x2 * cs.y; o2[v] = x1 * cs.y + x2 * cs.x;
                        }
                        const unsigned base = (unsigned)(((b * NH + hh) * SEQ + n) * HD + blk * 32 + 4 * h_);
                        if (isq) {
#pragma unroll
                            for (int q = 0; q < 2; ++q) {
                                uint2 w;
                                w.x = cvt_pk_bf16(o1[4 * q] * QSCALE, o1[4 * q + 1] * QSCALE); w.y = cvt_pk_bf16(o1[4 * q + 2] * QSCALE, o1[4 * q + 3] * QSCALE);
                                *(uint2*)(p.Qr + base + 8 * q) = w;
                                w.x = cvt_pk_bf16(o2[4 * q] * QSCALE, o2[4 * q + 1] * QSCALE); w.y = cvt_pk_bf16(o2[4 * q + 2] * QSCALE, o2[4 * q + 3] * QSCALE);
                                *(uint2*)(p.Qr + base + 16 + 8 * q) = w;
                            }
#pragma unroll
                            for (int q = 0; q < 4; ++q) {
                                uint2 w;
                                w.x = cvt_pk_bf16(acc[i][j][4 * q] * QSCALE, acc[i][j][4 * q + 1] * QSCALE); w.y = cvt_pk_bf16(acc[i][j][4 * q + 2] * QSCALE, acc[i][j][4 * q + 3] * QSCALE);
                                *(uint2*)(p.Qp + base + 8 * q) = w;
                            }
                        } else {
#pragma unroll
                            for (int q = 0; q < 2; ++q) {
                                uint2 w;
                                w.x = cvt_pk_bf16(o1[4 * q], o1[4 * q + 1]); w.y = cvt_pk_bf16(o1[4 * q + 2], o1[4 * q + 3]);
                                *(uint2*)(p.Kr + base + 8 * q) = w;
                                w.x = cvt_pk_bf16(o2[4 * q], o2[4 * q + 1]); w.y = cvt_pk_bf16(o2[4 * q + 2], o2[4 * q + 3]);
                                *(uint2*)(p.Kr + base + 16 + 8 * q) = w;
                            }
                        }
                    }
                    asm volatile("" ::: "memory");
                }
            }
        } else {
            const int hg = (pn - 7) * 4 + wr * 2;
            const bool isctx = pm >= 64;
            const int b = isctx ? pm - 64 : (pm >> 5);
            const int ntb = isctx ? LCTX / 8 : SEQ / 8; bf16_t* vb = isctx ? p.Vct : p.Vt;
#pragma unroll
            for (int j = 0; j < 2; ++j) {
                const int n = (isctx ? 0 : (pm & 31) * 256) + wc * 64 + j * 32 + r_;
#pragma unroll
                for (int i = 0; i < 4; ++i) {
                    const unsigned base = (unsigned)((((b * NH + hg + (i >> 1)) * ntb + (n >> 3)) * HD + (i & 1) * 32 + 4 * h_) * 8 + (n & 7));
#pragma unroll
                    for (int v = 0; v < 16; ++v) vb[base + (unsigned)(((v & 3) + 8 * (v >> 2)) * 8)] = f2bf(acc[i][j][v]);
                    asm volatile("" ::: "memory");
                }
            }
        }
        }
        if (xa) {
            if (rnd == 0) { const int item = xcd * 32 + lj, b = item >> 7; wait_ge(p.qctl + QW(1 + b), 32u, tid); four1_unit(p, ldsf, item); publish_add(p.qctl + QW(3 + b), tid); }
            else if (rnd == 1 && lj >= 16) { const int u = xcd * 16 + (lj - 16), b = u >> 6; wait_ge(p.qctl + QW(3 + b), 128u, tid); four2_unit(p, ldsf, u); publish_add(p.qctl + QW(5 + b), tid); }
            else if (rnd == 2 && lj >= 24) { const int u = xcd * 8 + (lj - 24), b = u >> 5; wait_ge(p.qctl + QW(5 + b), 64u, tid); fmix_unit(p, ldsf, u); }
        }
    }
}

__device__ __forceinline__ void four1_unit(const Params& p, float* ldsf, const int u) {
    LAS unsigned char* lds = (LAS unsigned char*)ldsf;
    int tid = threadIdx.x; asm volatile("" : "+v"(tid));
    const int lane = tid & 63, wid = tid >> 6, wr = wid >> 2, wc = wid & 3, r = lane & 31, h = lane >> 5;
    const int srow = tid >> 3, sc = SCS(tid);
    {
        unsigned po[4], qo[4];
#pragma unroll
        for (int i = 0; i < 4; ++i) { const int rt = srow + 64 * i; po[i] = (unsigned)rt * 128u + sc * 16; qo[i] = (unsigned)(u * 256 + rt) * 128u + sc * 16; }
        f32x16 acc[4][2];
        gemm256(lds, tid, (const char*)p.W64cs, po, (const char*)p.fX, qo, 1, acc);
        if (wr == 0) {
            int opq = 0; asm volatile("" : "+v"(opq));
            const int r_ = r + opq, h_ = h + opq;
#pragma unroll
            for (int j = 0; j < 2; ++j) {
                const int qrow = u * 256 + wc * 64 + j * 32 + r_;
                const int n2 = qrow & 127, bc = qrow >> 7;
#pragma unroll
                for (int a = 0; a < 2; ++a) {
#pragma unroll
                    for (int v = 0; v < 16; ++v) {
                        const int k1 = a * 32 + (v & 3) + 8 * (v >> 2) + 4 * h_;
                        const float rev = (float)(n2 * k1) * (1.0f / 8192.0f);
                        const float cs = __builtin_amdgcn_cosf(rev), sn = __builtin_amdgcn_sinf(rev);
                        const float yr = acc[2 * a][j][v], yi = acc[2 * a + 1][j][v];
                        const unsigned base = (unsigned)((bc * 64 + k1) * 256 + n2);
                        p.Zb[base] = f2bf(yr * cs + yi * sn); p.Zb[base + 128] = f2bf(yi * cs - yr * sn);
                    }
                    asm volatile("" ::: "memory");
                }
            }
        }
    }
}

__device__ __forceinline__ void four2_unit(const Params& p, float* ldsf, const int u) {
    LAS unsigned char* lds = (LAS unsigned char*)ldsf;
    int tid = threadIdx.x; asm volatile("" : "+v"(tid));
    const int lane = tid & 63, wid = tid >> 6, wr = wid >> 2, wc = wid & 3, r = lane & 31, h = lane >> 5;
    const int srow = tid >> 3, sc = SCS(tid);
    {
        const int b = u >> 6, k1 = u & 63;
        unsigned po[4], qo[4];
#pragma unroll
        for (int i = 0; i < 4; ++i) { const int rt = srow + 64 * i; po[i] = (unsigned)rt * 512u + sc * 16; qo[i] = (unsigned)(((b * DF + rt) * 64 + k1) * 512) + sc * 16; }
        f32x16 acc[4][2];
        gemm256(lds, tid, (const char*)p.G128, po, (const char*)p.Zb, qo, 4, acc);
        int opq = 0; asm volatile("" : "+v"(opq));
        const int r_ = r + opq, h_ = h + opq;
#pragma unroll
        for (int i = 0; i < 4; ++i) {
#pragma unroll
            for (int j = 0; j < 2; ++j) {
                bf16_t* dst = p.P2 + (unsigned)((b * SEQ + k1 + 64 * (i * 32 + 4 * h_)) * 512 + wr * 256 + wc * 64 + j * 32 + r_);
#pragma unroll
                for (int v = 0; v < 16; ++v) dst[((v & 3) + 8 * (v >> 2)) * 64 * 512] = f2bf(acc[i][j][v]);
                asm volatile("" ::: "memory");
            }
        }
    }
}

__device__ __forceinline__ void fmix_unit(const Params& p, float* ldsf, const int u) {
    LAS unsigned char* lds = (LAS unsigned char*)ldsf;
    int tid = threadIdx.x; asm volatile("" : "+v"(tid));
    const int lane = tid & 63, wid = tid >> 6, wr = wid >> 2, wc = wid & 3, r = lane & 31, h = lane >> 5;
    const int srow = tid >> 3, sc = SCS(tid);
    {
        unsigned po[4], qo[4];
#pragma unroll
        for (int i = 0; i < 4; ++i) { const int rt = srow + 64 * i; po[i] = (unsigned)rt * 1024u + sc * 16; qo[i] = (unsigned)(u * 256 + rt) * 1024u + sc * 16; }
        f32x16 acc[4][2];
        gemm256(lds, tid, (const char*)p.WmixT, po, (const char*)p.P2, qo, 8, acc);
        float ss[2];
#pragma unroll
        for (int j = 0; j < 2; ++j) { float s = 0.f;
#pragma unroll
            for (int i = 0; i < 4; ++i)
#pragma unroll
                for (int v = 0; v < 16; ++v) s = fmaf(acc[i][j][v], acc[i][j][v], s);
            ss[j] = xhalf_sum(s); }
        float* red = ldsf;
        if (h == 0) { red[wr * 256 + wc * 64 + r] = ss[0]; red[wr * 256 + wc * 64 + 32 + r] = ss[1]; }
        __syncthreads();
        int opq = 0; asm volatile("" : "+v"(opq));
        const int r_ = r + opq, h_ = h + opq;
#pragma unroll
        for (int j = 0; j < 2; ++j) {
            const int tl = wc * 64 + j * 32 + r_;
            const float rstd = rsqrtf((red[tl] + red[256 + tl]) / (float)DF + EPS);
            bf16_t* dst = p.F2 + (unsigned)((u * 256 + tl) * DF + wr * 128 + 4 * h_);
            const float* gp = p.g_out + wr * 128 + 4 * h_;
#pragma unroll
            for (int i = 0; i < 4; ++i) {
#pragma unroll
                for (int q = 0; q < 4; ++q) {
                    const float4 g = *(const float4*)(gp + i * 32 + 8 * q);
                    uint2 w; w.x = cvt_pk_bf16(acc[i][j][4 * q] * rstd * g.x, acc[i][j][4 * q + 1] * rstd * g.y); w.y = cvt_pk_bf16(acc[i][j][4 * q + 2] * rstd * g.z, acc[i][j][4 * q + 3] * rstd * g.w);
                    *(uint2*)(dst + i * 32 + 8 * q) = w;
                }
                asm volatile("" ::: "memory");
            }
        }
    }
}

__device__ void ph_filler(const Params& p, float* ldsf) {
    int tid = threadIdx.x; asm volatile("" : "+v"(tid));
    volatile LAS unsigned* qw = (volatile LAS unsigned*)((LAS unsigned char*)ldsf + 128 * 1024 + 528);
    for (;;) {
        __syncthreads();
        if (tid == 0) qw[0] = __hip_atomic_fetch_add(p.qctl + QW(0), 1u, __ATOMIC_RELAXED, __HIP_MEMORY_SCOPE_AGENT);
        __syncthreads();
        const int item = (int)qw[0];
        if (item >= 448) break;
        if (item < 256) { const int b = item >> 7; wait_ge(p.qctl + QW(1 + b), 32u, tid); four1_unit(p, ldsf, item); publish_add(p.qctl + QW(3 + b), tid); }
        else if (item < 384) { const int u = item - 256, b = u >> 6; wait_ge(p.qctl + QW(3 + b), 128u, tid); four2_unit(p, ldsf, u); publish_add(p.qctl + QW(5 + b), tid); }
        else { const int u = item - 384, b = u >> 5; wait_ge(p.qctl + QW(5 + b), 64u, tid); fmix_unit(p, ldsf, u); }
    }
}

constexpr float LOG2E = 1.4426950408889634f;
struct AttnTile { bf16x8 kf[4]; bf16x8 vf[2][2]; };
__device__ void ph_attn(const Params& p, float* ldsf) {
    int tid = threadIdx.x; asm volatile("" : "+v"(tid));
    const int lane = tid & 63, wv = __builtin_amdgcn_readfirstlane(tid >> 6), l31 = lane & 31, h = lane >> 5;
    LAS unsigned char* ldsb = (LAS unsigned char*)ldsf;
    constexpr int KB0 = 8192, VB0 = 40960;
    const int half = wv & 1;
    const int kcol = (l31 & 3) + 4 * ((l31 >> 3) & 1) + 8 * ((l31 >> 2) & 1), krow = l31 >> 4;
    const bool xa = gridDim.x == 256;
    for (int gi = blockIdx.x; gi < NBATCH * NH * (GROWS / 4); gi += gridDim.x) {
        const int g = xa ? ((blockIdx.x & 7) * 3 + (gi >> 8)) * (GROWS / 4) + (blockIdx.x >> 3) : gi;
        const int bh = g / (GROWS / 4), row = (g % (GROWS / 4)) * 4 + (wv >> 1), hh = bh % NH;
        const int rs = min(max(row - 4, 0), GROWS - 8);
        const int qc = 32 * half + l31, cs = min(max(qc - 8, 0), GW - 16);
        const int nq = row * GW + qc;
        const bf16_t* Kh = p.Kr + (size_t)bh * SEQ * HD; const bf16_t* Vh = p.Vt + (size_t)bh * HD * SEQ;
        const bf16_t* Kch = p.Kc + (size_t)bh * LCTX * HD; const bf16_t* Vch = p.Vct + (size_t)bh * HD * LCTX;
        __syncthreads();
        for (int i = tid; i < 15 * 128; i += NT) { const int dcx = (i & 127) - 48, dr = i >> 7; ldsf[i] = (dcx >= 0 && dcx <= 30) ? p.rpb[(hh * 15 + dr) * 31 + dcx] * LOG2E : 0.f; }
#pragma unroll
        for (int i = 0; i < 4; ++i) {
            const int key = (i * 8 + wv) * 8 + (lane >> 3);
            __builtin_amdgcn_global_load_lds((const unsigned*)(Kch + (size_t)key * HD + (((lane & 7) ^ (lane >> 3)) << 3)), (LAS unsigned*)(ldsb + KB0 + (i * 8 + wv) * 1024), 16, 0, 0);
            __builtin_amdgcn_global_load_lds((const unsigned*)((const char*)Vch + (i * 8 + wv) * 1024 + lane * 16), (LAS unsigned*)(ldsb + VB0 + (i * 8 + wv) * 1024), 16, 0, 0);
        }
        __syncthreads();
        bf16x8 qr[4], qp[4];
#pragma unroll
        for (int s = 0; s < 4; ++s) { qr[s] = *(const bf16x8*)(p.Qr + ((size_t)bh * SEQ + nq) * HD + 16 * s + 8 * h); qp[s] = *(const bf16x8*)(p.Qp + ((size_t)bh * SEQ + nq) * HD + 16 * s + 8 * h); }
        f32x16 o0, o1;
#pragma unroll
        for (int v = 0; v < 16; ++v) { o0[v] = 0.f; o1[v] = 0.f; }
        float m = -1e30f, lsum = 0.f;
        const float* rph = ldsf;
        auto load_loc = [&](int t, AttnTile& T) {
            const int pr = t / 3, blk = half + (t - 3 * pr), kr0 = rs + 2 * pr;
            const bf16_t* kptr = Kh + (size_t)((kr0 + krow) * GW + 16 * blk + kcol) * HD + 8 * h;
            const bf16_t* vptr = Vh + ((size_t)((kr0 * GW + 16 * blk) >> 3) + h) * (HD * 8) + l31 * 8;
#pragma unroll
            for (int kk = 0; kk < 2; ++kk)
#pragma unroll
                for (int dt = 0; dt < 2; ++dt) T.vf[dt][kk] = *(const bf16x8*)(vptr + (size_t)kk * 8 * (HD * 8) + dt * 32 * 8);
#pragma unroll
            for (int s = 0; s < 4; ++s) T.kf[s] = *(const bf16x8*)(kptr + 16 * s);
        };
        auto load_ctx = [&](int t, AttnTile& T) {
            const int m0 = 32 * (t - 12), key = m0 + 16 * krow + kcol;
#pragma unroll
            for (int s = 0; s < 4; ++s) T.kf[s] = *(const LAS bf16x8*)(ldsb + KB0 + key * 128 + (((2 * s + h) ^ (key & 7)) << 4));
#pragma unroll
            for (int kk = 0; kk < 2; ++kk)
#pragma unroll
                for (int dt = 0; dt < 2; ++dt) T.vf[dt][kk] = *(const LAS bf16x8*)(ldsb + VB0 + ((m0 >> 3) + 2 * kk + h) * 1024 + (l31 + 32 * dt) * 16);
        };
        auto compute_tile = [&](int t, const AttnTile& T, auto locc) {
            constexpr bool loc = decltype(locc)::value;
            f32x16 sa;
#pragma unroll
            for (int v = 0; v < 16; ++v) sa[v] = 0.f;
#pragma unroll
            for (int s = 0; s < 4; ++s) sa = __builtin_amdgcn_mfma_f32_32x32x16_bf16(T.kf[s], loc ? qr[s] : qp[s], sa, 0, 0, 0);
            int w0 = 0;
            if (loc) {
                const int pr = t / 3, blk = half + (t - 3 * pr), kr0 = rs + 2 * pr;
                const float* bp = rph + (kr0 - row + 7) * 128 + (16 * blk + 8 * h - qc + 15 + 48);
#pragma unroll
                for (int v = 0; v < 16; ++v) sa[v] += bp[(v >> 3) * 128 + (v & 3) + 4 * ((v >> 2) & 1)];
                w0 = 16 * blk + 8 * h - cs;
            }
            float tmax = sa[0];
#pragma unroll
            for (int v = 1; v < 16; ++v) tmax = fmaxf(tmax, sa[v]);
            tmax = xhalf_max(tmax);
            if (__any(tmax > m + 10.f)) {
                const float mn = fmaxf(m, tmax), alpha = __builtin_amdgcn_exp2f(m - mn);
                m = mn; lsum *= alpha;
#pragma unroll
                for (int v = 0; v < 16; ++v) { o0[v] *= alpha; o1[v] *= alpha; }
            }
            float ps = 0.f;
#pragma unroll
            for (int v = 0; v < 16; ++v) {
                float e = __builtin_amdgcn_exp2f(sa[v] - m);
                if (loc) e = ((unsigned)(w0 + (v & 3) + 4 * ((v >> 2) & 1)) < 16u) ? e : 0.f;
                sa[v] = e; ps += e;
            }
            lsum += ps;
#pragma unroll
            for (int kk = 0; kk < 2; ++kk) {
                const uint4 w = make_uint4(cvt_pk_bf16(sa[8 * kk + 0], sa[8 * kk + 1]), cvt_pk_bf16(sa[8 * kk + 2], sa[8 * kk + 3]), cvt_pk_bf16(sa[8 * kk + 4], sa[8 * kk + 5]), cvt_pk_bf16(sa[8 * kk + 6], sa[8 * kk + 7]));
                const bf16x8 pf = __builtin_bit_cast(bf16x8, w);
                o0 = __builtin_amdgcn_mfma_f32_32x32x16_bf16(T.vf[0][kk], pf, o0, 0, 0, 0);
                o1 = __builtin_amdgcn_mfma_f32_32x32x16_bf16(T.vf[1][kk], pf, o1, 0, 0, 0);
            }
        };
        AttnTile TA, TB;
        load_loc(0, TA);
#pragma unroll 1
        for (int t = 0; t < 12; t += 2) {
            load_loc(t + 1, TB);
            compute_tile(t, TA, std::true_type{});
            if (t + 2 < 12) load_loc(t + 2, TA);
            compute_tile(t + 1, TB, std::true_type{});
        }
        load_ctx(12, TA);
#pragma unroll 1
        for (int t = 12; t < 20; t += 2) {
            load_ctx(t + 1, TB);
            compute_tile(t, TA, std::false_type{});
            if (t + 2 < 20) load_ctx(t + 2, TA);
            compute_tile(t + 1, TB, std::false_type{});
        }
        lsum = xhalf_sum(lsum);
        const float inv = 1.f / lsum;
        bf16_t* op = p.A2b + (size_t)((bh / NH) * SEQ + nq) * D + DF + hh * HD + 4 * h;
        float sq = 0.f;
#pragma unroll
        for (int q = 0; q < 4; ++q) {
            const float a0 = o0[4 * q] * inv, a1 = o0[4 * q + 1] * inv, a2 = o0[4 * q + 2] * inv, a3 = o0[4 * q + 3] * inv;
            const float b0 = o1[4 * q] * inv, b1 = o1[4 * q + 1] * inv, b2 = o1[4 * q + 2] * inv, b3 = o1[4 * q + 3] * inv;
            sq += a0 * a0 + a1 * a1 + a2 * a2 + a3 * a3 + b0 * b0 + b1 * b1 + b2 * b2 + b3 * b3;
            *(uint2*)(op + 8 * q) = make_uint2(cvt_pk_bf16(a0, a1), cvt_pk_bf16(a2, a3));
            *(uint2*)(op + 32 + 8 * q) = make_uint2(cvt_pk_bf16(b0, b1), cvt_pk_bf16(b2, b3));
        }
        sq = xhalf_sum(sq);
        if (h == 0) p.ssq[((bh / NH) * SEQ + nq) * NH + hh] = sq;
    }
}

__device__ void ph_outproj(const Params& p, float* ldsf) {
    LAS unsigned char* lds = (LAS unsigned char*)ldsf;
    int tid = threadIdx.x; asm volatile("" : "+v"(tid));
    const int lane = tid & 63, wid = tid >> 6, wr = wid >> 2, wc = wid & 3, r = lane & 31, h = lane >> 5;
    const int srow = tid >> 3, sc = SCS(tid);
    for (int ui = blockIdx.x; ui < (NTOK / 256) * (D / 256); ui += gridDim.x) {
        const int u = gridDim.x == 256 ? (blockIdx.x & 7) * 32 + (blockIdx.x >> 3) : ui;
        const int pm = u >> 2, pn = u & 3;
        unsigned po[4], qo[4];
#pragma unroll
        for (int i = 0; i < 4; ++i) { const int rt = srow + 64 * i; po[i] = (unsigned)(pm * 256 + rt) * (unsigned)(D * 2) + sc * 16; qo[i] = (unsigned)(pn * 256 + rt) * (unsigned)(D * 2) + sc * 16; }
        float* rtab = ldsf + (128 * 1024 + 1024) / 4;
        if (tid < 256) { const float4* sp = (const float4*)(p.ssq + (size_t)(pm * 256 + tid) * NH); const float4 a = sp[0], b = sp[1], c = sp[2];
            rtab[tid] = rsqrtf(((a.x + a.y) + (a.z + a.w) + (b.x + b.y) + (b.z + b.w) + (c.x + c.y) + (c.z + c.w)) / (float)DNA + EPS); }
        f32x16 acc[4][2];
        unsigned po2[4], qo2[4];
#pragma unroll
        for (int i = 0; i < 4; ++i) { po2[i] = po[i] + DF * 2; qo2[i] = qo[i] + DF * 2; }
        gemm256(lds, tid, (const char*)p.A2b, po2, (const char*)p.WoutT, qo2, DNA / 64, acc);
#pragma unroll
        for (int i = 0; i < 4; ++i)
#pragma unroll
            for (int v = 0; v < 16; ++v) { const float rs_ = rtab[wr * 128 + i * 32 + (v & 3) + 8 * (v >> 2) + 4 * h]; acc[i][0][v] *= rs_; acc[i][1][v] *= rs_; }
        unsigned po3[4];
#pragma unroll
        for (int i = 0; i < 4; ++i) po3[i] = (unsigned)(pm * 256 + srow + 64 * i) * (unsigned)(DF * 2) + sc * 16;
        gemm256(lds, tid, (const char*)p.F2, po3, (const char*)p.WoutT, qo, DF / 64, acc, false);
        const float* gt1 = p.mod + (pm >> 5) * NMOD * D + 2 * D;
        int opq = 0; asm volatile("" : "+v"(opq));
        const int r_ = r + opq, h_ = h + opq;
#pragma unroll
        for (int j = 0; j < 2; ++j) {
            const int feat = pn * 256 + wc * 64 + j * 32 + r_; const float g = gt1[feat];
#pragma unroll
            for (int i = 0; i < 4; ++i) {
                const unsigned base = (unsigned)((pm * 256 + wr * 128 + i * 32 + 4 * h_) * D + feat);
                bf16_t* op = (bf16_t*)p.x1 + base;
#pragma unroll
                for (int v = 0; v < 16; ++v) op[((v & 3) + 8 * (v >> 2)) * D] = f2bf(g * acc[i][j][v]);
                asm volatile("" ::: "memory");
            }
        }
        publish_add(p.tilecnt + 192 + pm, tid);
    }
}

__device__ void ph_router(const Params& p, float* lds, bool commit = true) {
    int tid = threadIdx.x; asm volatile("" : "+v"(tid));
    const int wv = tid >> 6, lane = tid & 63;
    LAS unsigned char* ldsb = (LAS unsigned char*)lds;
    int* sel = (int*)(lds + 152576 / 4); int* cntl = sel + 128; int* basel = cntl + 32; int* posl = basel + 32;
    __syncthreads();
    for (int pc = __builtin_amdgcn_readfirstlane(tid >> 6); pc < 144; pc += NT / 64)
        __builtin_amdgcn_global_load_lds((const unsigned*)((const char*)p.WrT + pc * 1024 + lane * 16), (LAS unsigned*)(ldsb + (pc < 128 ? pc * 1024 : 135168 + (pc - 128) * 1024)), 16, 0, 0);
    __syncthreads();
#define WRL(o) ((const LAS float*)(ldsb + ((o) < 32 ? (o) * 4096 : 135168 + ((o) - 32) * 4096)))
    for (int blk = blockIdx.x; blk < NTOK / 64; blk += gridDim.x) {
        __syncthreads();
        if (tid < 32) cntl[tid] = 0;
        wait_ge(p.tilecnt + 192 + (blk >> 2), 4u, tid);
        const int bq = (blk * 64) / SEQ;
        const float* sh = p.mod + bq * NMOD * D + 3 * D, * sc = sh + D;
#pragma unroll 1
        for (int tq = 0; tq < 2; ++tq) {
            const int tok0 = blk * 64 + wv * 8 + tq * 4;
            float4 hv[4][4]; float ss[4];
#pragma unroll
            for (int t = 0; t < 4; ++t) {
#pragma unroll
                for (int i = 0; i < 4; ++i) { const size_t off = (size_t)(tok0 + t) * D + 4 * lane + 256 * i;
                    const uint2 a = *(const uint2*)((const bf16_t*)p.x1 + off); const float4 bx = *(const float4*)(p.x + off);
                    hv[t][i] = make_float4(bx.x + __uint_as_float(a.x << 16), bx.y + __uint_as_float(a.x & 0xffff0000u), bx.z + __uint_as_float(a.y << 16), bx.w + __uint_as_float(a.y & 0xffff0000u)); }
                if (t == 1) asm volatile("" ::: "memory");
            }
#pragma unroll
            for (int t = 0; t < 4; ++t) { float s = 0.f;
#pragma unroll
                for (int i = 0; i < 4; ++i) s += hv[t][i].x * hv[t][i].x + hv[t][i].y * hv[t][i].y + hv[t][i].z * hv[t][i].z + hv[t][i].w * hv[t][i].w;
                ss[t] = s; }
#pragma unroll
            for (int t = 0; t < 4; ++t) ss[t] = rsqrtf(wave_sum(ss[t]) / (float)D + EPS);
#pragma unroll
            for (int i = 0; i < 4; ++i) { const int e = 4 * lane + 256 * i;
                const float4 g = *(const float4*)(p.g_norm2 + e), s4 = *(const float4*)(sc + e), h4 = *(const float4*)(sh + e);
                const float4 gm = make_float4(g.x * (1.f + s4.x), g.y * (1.f + s4.y), g.z * (1.f + s4.z), g.w * (1.f + s4.w));
#pragma unroll
                for (int t = 0; t < 4; ++t) { const float r = ss[t];
                    hv[t][i] = make_float4(hv[t][i].x * r * gm.x + h4.x, hv[t][i].y * r * gm.y + h4.y, hv[t][i].z * r * gm.z + h4.z, hv[t][i].w * r * gm.w + h4.w);
                    *(uint2*)(p.h2b + (size_t)(tok0 + t) * D + e) = make_uint2(cvt_pk_bf16(hv[t][i].x, hv[t][i].y), cvt_pk_bf16(hv[t][i].z, hv[t][i].w)); } }
            float lg[4][4];
#pragma unroll
            for (int o = 0; o < 4; ++o) { f32x4 w[4];
#pragma unroll
                for (int i = 0; i < 4; ++i) w[i] = *(const LAS f32x4*)(WRL(o) + 4 * lane + 256 * i);
#pragma unroll
                for (int t = 0; t < 4; ++t) { float a = 0.f;
#pragma unroll
                    for (int i = 0; i < 4; ++i) a += hv[t][i].x * w[i].x + hv[t][i].y * w[i].y + hv[t][i].z * w[i].z + hv[t][i].w * w[i].w;
                    lg[t][o] = a; }
                asm volatile("" ::: "memory"); }
#pragma unroll
            for (int t = 0; t < 4; ++t)
#pragma unroll
                for (int o = 0; o < 4; ++o) lg[t][o] = wave_sum(lg[t][o]);
            int gsel[4]; float pgv[4];
#pragma unroll
            for (int t = 0; t < 4; ++t) { int gs = 0; float gm = lg[t][0];
#pragma unroll
                for (int o = 1; o < 4; ++o) if (lg[t][o] > gm) { gm = lg[t][o]; gs = o; }
                float gz = 0.f;
#pragma unroll
                for (int o = 0; o < 4; ++o) gz += expf(lg[t][o] - gm);
                pgv[t] = 1.f / gz; gsel[t] = __builtin_amdgcn_readfirstlane(gs); }
#pragma unroll
            for (int t = 0; t < 4; ++t) {
                float le[8];
#pragma unroll
                for (int o = 0; o < 8; ++o) { float a = 0.f; const int rowi = 4 + gsel[t] * 8 + o; const LAS float* wre = WRL(rowi) + 4 * lane;
#pragma unroll
                    for (int i = 0; i < 4; ++i) { const f32x4 w = *(const LAS f32x4*)(wre + 256 * i); a += hv[t][i].x * w.x + hv[t][i].y * w.y + hv[t][i].z * w.z + hv[t][i].w * w.w; }
                    le[o] = a; }
#pragma unroll
                for (int o = 0; o < 8; ++o) le[o] = wave_sum(le[o]);
                int i0 = 0; float m0 = le[0];
#pragma unroll
                for (int o = 1; o < 8; ++o) if (le[o] > m0) { m0 = le[o]; i0 = o; }
                int i1 = -1; float m1 = -3.0e38f;
#pragma unroll
                for (int o = 0; o < 8; ++o) if (o != i0 && le[o] > m1) { m1 = le[o]; i1 = o; }
                const float e1 = expf(m1 - m0);
                const float g0 = pgv[t] / (1.f + e1), g1 = pgv[t] * e1 / (1.f + e1);
                if (lane == 0) {
                    const int tl = wv * 8 + tq * 4 + t;
                    sel[tl * 2] = gsel[t] * 8 + i0; sel[tl * 2 + 1] = gsel[t] * 8 + i1;
                    p.tokgate[(tok0 + t) * 2] = g0; p.tokgate[(tok0 + t) * 2 + 1] = g1;
                }
                asm volatile("" ::: "memory");
            }
        }
        __syncthreads();
        int e = 0;
        if (tid < 128) { e = sel[tid]; posl[tid] = atomicAdd(&cntl[e], 1); }
        __syncthreads();
        if (tid < 32 && commit) basel[tid] = atomicAdd(&p.cnt[tid * 64], cntl[tid]);
        __syncthreads();
        if (tid < 128 && commit) p.list[e * NTOK + basel[e] + posl[tid]] = (blk * 64 + (tid >> 1)) * 2 + (tid & 1);
    }
}

struct ETile { int e, s0, ns, sbase; };
__device__ __forceinline__ ETile moe_tile(const int* cl, int tile) {
    int e = 0, base = 0, sb = 0;
    for (;;) { const int c = cl[e], nc = (c + 255) >> 8; if (tile < base + nc) break; base += nc; sb += c; ++e; }
    ETile t; t.e = e; t.s0 = (tile - base) * 256; t.ns = min(256, cl[e] - t.s0); t.sbase = sb; return t;
}

__device__ void ph_moe(const Params& p, float* ldsf) {
    LAS unsigned char* lds = (LAS unsigned char*)ldsf;
    int tid = threadIdx.x; asm volatile("" : "+v"(tid));
    const int lane = tid & 63, wid = tid >> 6, wr = wid >> 2, wc = wid & 3, r = lane & 31, h = lane >> 5;
    const int srow = tid >> 3, sc = SCS(tid);
    const bool xa = false; const int e0 = xa ? (blockIdx.x & 7) * 4 : 0, ne = xa ? 4 : NEXP, lj = xa ? (blockIdx.x >> 3) : blockIdx.x, lper = xa ? 32 : gridDim.x;
    int* cl = (int*)(ldsf + (128 * 1024 + 1024) / 4);
    __syncthreads();
    if (tid < NEXP) cl[tid] = p.cnt[tid * 64];
    __syncthreads();
    int tile0 = 0, ntl = 0;
    for (int e = 0; e < e0 + ne; ++e) { const int nc = (cl[e] + 255) >> 8; if (e < e0) tile0 += nc; else ntl += nc; }
    const int nt4 = ntl * 4;
    volatile LAS unsigned* qw = (volatile LAS unsigned*)((LAS unsigned char*)ldsf + 128 * 1024 + 528);
    for (;;) {
        __syncthreads();
        if (tid == 0) qw[0] = __hip_atomic_fetch_add(p.qctl + QW(9), 1u, __ATOMIC_RELAXED, __HIP_MEMORY_SCOPE_AGENT);
        __syncthreads();
        const int u = (int)qw[0];
        if (u >= 2 * nt4) break;
        const bool isdown = u >= nt4; const int uu = isdown ? u - nt4 : u;
        const int tile = tile0 + (uu >> 2);
        const ETile t = moe_tile(cl, tile); const int fc = uu & 3;
        unsigned po[4], qo[4];
        f32x16 acc[4][2];
        if (!isdown) {
#pragma unroll
            for (int i = 0; i < 4; ++i) {
                const int rt = srow + 64 * i;
                const int ent = rt < t.ns ? p.list[t.e * NTOK + t.s0 + rt] : 0;
                po[i] = (unsigned)(ent >> 1) * (unsigned)(D * 2) + sc * 16;
                const int f = fc * 128 + (rt >> 6) * 32 + (rt & 31), up = (rt >> 5) & 1;
                qo[i] = (unsigned)((up * NEXP + t.e) * DEXP + f) * (unsigned)(D * 2) + sc * 16;
            }
            gemm256(lds, tid, (const char*)p.h2b, po, (const char*)p.WgT, qo, D / 64, acc);
            int opq = 0; asm volatile("" : "+v"(opq));
            const int r_ = r + opq, h_ = h + opq;
            const int f = fc * 128 + wc * 32 + r_;
#pragma unroll
            for (int i = 0; i < 4; ++i) {
                const int s = wr * 128 + i * 32 + 4 * h_;
#pragma unroll
                for (int v = 0; v < 16; ++v) {
                    const int sv = s + (v & 3) + 8 * (v >> 2);
                    const float g = acc[i][0][v], uu_ = acc[i][1][v];
                    if (sv < t.ns) p.act[(unsigned)((t.sbase + t.s0 + sv) * DEXP + f)] = f2bf(g / (1.f + __expf(-g)) * uu_);
                }
                asm volatile("" ::: "memory");
            }
            asm volatile("s_waitcnt vmcnt(0)" ::: "memory");
            __syncthreads();
            if (tid == 0) { __builtin_amdgcn_fence(__ATOMIC_RELEASE, "agent"); asm volatile("s_waitcnt vmcnt(0)" ::: "memory");
                __hip_atomic_fetch_add(p.tilecnt + tile, 1u, __ATOMIC_RELAXED, __HIP_MEMORY_SCOPE_AGENT); }
        } else {
            if (tid == 0) { unsigned sp = 0;
                while (__hip_atomic_load(p.tilecnt + tile, __ATOMIC_RELAXED, __HIP_MEMORY_SCOPE_AGENT) < 4u) { __builtin_amdgcn_s_sleep(2); if (++sp > (1u << 22)) break; }
                __builtin_amdgcn_fence(__ATOMIC_ACQUIRE, "agent"); asm volatile("s_waitcnt vmcnt(0)" ::: "memory"); }
            __syncthreads();
            const int pn = fc;
            int* entl = (int*)(ldsf + (128 * 1024 + 2048) / 4); float* gatel = (float*)(entl + 256);
            if (tid < 256) { const int ent = tid < t.ns ? p.list[t.e * NTOK + t.s0 + tid] : 0; entl[tid] = ent; gatel[tid] = p.tokgate[ent]; }
#pragma unroll
            for (int i = 0; i < 4; ++i) {
                const int rt = srow + 64 * i;
                po[i] = (unsigned)(t.sbase + t.s0 + (rt < t.ns ? rt : 0)) * (unsigned)(DEXP * 2) + sc * 16;
                qo[i] = (unsigned)(t.e * D + pn * 256 + rt) * (unsigned)(DEXP * 2) + sc * 16;
            }
            gemm256(lds, tid, (const char*)p.act, po, (const char*)p.WdT, qo, DEXP / 64, acc);
            int opq = 0; asm volatile("" : "+v"(opq));
            const int r_ = r + opq, h_ = h + opq;
#pragma unroll
            for (int i = 0; i < 4; ++i) {
                const int s = wr * 128 + i * 32 + 4 * h_;
#pragma unroll
                for (int v = 0; v < 16; ++v) {
                    const int sv = s + (v & 3) + 8 * (v >> 2);
                    if (sv < t.ns) {
                        const int ent = entl[sv]; const float g = gatel[sv];
                        const unsigned base = (unsigned)ent * D + pn * 256 + wc * 64 + r_;
                        p.ybuf[base] = f2bf(g * acc[i][0][v]); p.ybuf[base + 32] = f2bf(g * acc[i][1][v]);
                    }
                }
                asm volatile("" ::: "memory");
            }
        }
    }
}

__device__ void ph_final(const Params& p, float* lds, float* outp) {
    int tid = threadIdx.x; asm volatile("" : "+v"(tid));
    const int lane = tid & 63, nw = gridDim.x * (NT / 64), gw = blockIdx.x * (NT / 64) + (tid >> 6);
    float eps_ = 0.f; if (TS_PHASE >= 0) eps_ = __uint_as_float(p.qctl[QW(7)]);
    for (int tok0 = gw; tok0 < NTOK; tok0 += 2 * nw) {
        float4 xv[2][4]; uint2 ya[2][4], yb[2][4]; float ss[2];
#pragma unroll
        for (int q = 0; q < 2; ++q) { const int tok = min(tok0 + q * nw, NTOK - 1);
#pragma unroll
            for (int i = 0; i < 4; ++i) { const int e = 4 * lane + 256 * i;
                { const float4 bx = *(const float4*)(p.x + (size_t)tok * D + e); const uint2 a = *(const uint2*)((const bf16_t*)p.x1 + (size_t)tok * D + e);
                  xv[q][i] = make_float4(bx.x + __uint_as_float(a.x << 16), bx.y + __uint_as_float(a.x & 0xffff0000u), bx.z + __uint_as_float(a.y << 16), bx.w + __uint_as_float(a.y & 0xffff0000u)); }
                ya[q][i] = *(const uint2*)(p.ybuf + (size_t)(2 * tok) * D + e); yb[q][i] = *(const uint2*)(p.ybuf + (size_t)(2 * tok + 1) * D + e); } }
#pragma unroll
        for (int q = 0; q < 2; ++q) { const int tok = min(tok0 + q * nw, NTOK - 1);
            const float* gt2 = p.mod + (tok / SEQ) * NMOD * D + 5 * D; float s = 0.f;
#pragma unroll
            for (int i = 0; i < 4; ++i) { const int e = 4 * lane + 256 * i; const float4 g = *(const float4*)(gt2 + e);
                xv[q][i].x += g.x * (__uint_as_float(ya[q][i].x << 16) + __uint_as_float(yb[q][i].x << 16));
                xv[q][i].y += g.y * (__uint_as_float(ya[q][i].x & 0xffff0000u) + __uint_as_float(yb[q][i].x & 0xffff0000u));
                xv[q][i].z += g.z * (__uint_as_float(ya[q][i].y << 16) + __uint_as_float(yb[q][i].y << 16));
                xv[q][i].w += g.w * (__uint_as_float(ya[q][i].y & 0xffff0000u) + __uint_as_float(yb[q][i].y & 0xffff0000u));
                s += xv[q][i].x * xv[q][i].x + xv[q][i].y * xv[q][i].y + xv[q][i].z * xv[q][i].z + xv[q][i].w * xv[q][i].w; }
            ss[q] = s; }
#pragma unroll
        for (int q = 0; q < 2; ++q) ss[q] = wave_sum(ss[q]);
#pragma unroll
        for (int q = 0; q < 2; ++q) { const int tok = tok0 + q * nw;
            if (tok < NTOK) {
                float rr = rsqrtf(ss[q] / (float)D + EPS);
                if (TS_PHASE >= 0) rr *= 1.f + eps_;
#pragma unroll
                for (int i = 0; i < 4; ++i) { const int e = 4 * lane + 256 * i; const float4 g = *(const float4*)(p.g_final + e);
                    *(float4*)(outp + (size_t)tok * D + e) = make_float4(xv[q][i].x * rr * g.x, xv[q][i].y * rr * g.y, xv[q][i].z * rr * g.z, xv[q][i].w * rr * g.w); } } }
    }
}

extern __shared__ __attribute__((aligned(16))) float smem[];

constexpr int R_P0 = 1, R_INP = 1, R_FOUR = 1, R_ATT = 1, R_OUT = 1, R_MOE = 1, R_RT = 1, R_FIN = 1, R_BAR = 1;
constexpr int LDS_BAR_OFF = 128 * 1024 + 512;
__global__ void __launch_bounds__(NT) mega(Params p) {
    volatile LAS unsigned* st = (volatile LAS unsigned*)((LAS unsigned char*)smem + LDS_BAR_OFF);
    if (threadIdx.x == 0) { st[0] = 0u; st[1] = 0u; }
    __syncthreads();
    const XcdBarrier bar = xcd_barrier_post(g_bar, st);
    volatile LAS unsigned* gpw = (volatile LAS unsigned*)((LAS unsigned char*)smem + 128 * 1024 + 640);
#define REP(n, call) for (int _r = 0; _r < (n); ++_r) { call; }
    unsigned long long ts0 = 0, ts1 = 0;
#define STAMP(k) do { if (TS_PHASE >= 0 && blockIdx.x == 0 && threadIdx.x == 0) { const unsigned long long t_ = __builtin_amdgcn_s_memrealtime(); if ((k) == TS_PHASE) ts0 = t_; if ((k) == TS_PHASE + 1) ts1 = t_; } } while (0)
    STAMP(0);
    REP(R_P0, ph_adaln_tables(p, smem)) REP(R_BAR, xcd_barrier(bar)) STAMP(1);
    STAMP(2);
    unsigned long long tsx = 0; if (TS_PHASE == 12) tsx = __builtin_amdgcn_s_memrealtime();
    ph_inproj(p, smem); if (TS_PHASE == 12 && blockIdx.x == 0 && threadIdx.x == 0) { ts0 = tsx; ts1 = __builtin_amdgcn_s_memrealtime(); }
    if (gridDim.x != 256) ph_filler(p, smem);
    REP(R_BAR, xcd_barrier(bar)) STAMP(3);
    REP(R_ATT, ph_attn(p, smem)) REP(R_BAR, xcd_barrier(bar)) STAMP(4);
    if (GPROBE && threadIdx.x == 0) { gpw[0] = 0u; gpw[1] = 0u; gpw[2] = 0u; }
    REP(R_OUT, ph_outproj(p, smem))
    STAMP(5);
    REP(R_RT - 1, ph_router(p, smem, false)) ph_router(p, smem); REP(R_BAR, xcd_barrier(bar)) STAMP(6);
    if (TS_PHASE >= 0 && (TS_PHASE < 6 || TS_PHASE == 12) && blockIdx.x == 0 && threadIdx.x == 0) p.qctl[QW(7)] = GPROBE ? p.qctl[QW(6) + 1] : __float_as_uint(sqrtf(1e-6f * 0.01f * (float)(ts1 - ts0)));
    ph_moe(p, smem); REP(R_BAR, xcd_barrier(bar)) STAMP(7);
    if (TS_PHASE == 6 && blockIdx.x == 0 && threadIdx.x == 0) p.qctl[QW(7)] = __float_as_uint(sqrtf(1e-6f * 0.01f * (float)(ts1 - ts0)));
    if (TS_PHASE == 6) xcd_barrier(bar);
    if (TS_PHASE == 7) {
        ph_final(p, smem, (float*)p.h2b); xcd_barrier(bar);
        if (blockIdx.x == 0 && threadIdx.x == 0) p.qctl[QW(7)] = __float_as_uint(sqrtf(1e-6f * 0.01f * (float)(__builtin_amdgcn_s_memrealtime() - ts0)));
        xcd_barrier(bar);
    }
    REP(R_FIN - 1, ph_final(p, smem, (float*)p.h2b)) ph_final(p, smem, p.out);
    __syncthreads();
    if (threadIdx.x == 0) st[0] = __hip_atomic_fetch_add(g_bar + XCD_BAR_WORDS, 1u, __ATOMIC_RELAXED, __HIP_MEMORY_SCOPE_AGENT);
    __syncthreads();
    if (st[0] == gridDim.x - 1) { for (int i = threadIdx.x; i < XCD_BAR_WORDS + 64; i += NT) __hip_atomic_store(g_bar + i, 0u, __ATOMIC_RELAXED, __HIP_MEMORY_SCOPE_AGENT); }
}

extern "C" void kernel_launch(void* const* d_in, const int* in_sizes, int n_in, void* d_out, int out_size, void* d_ws, size_t ws_size, hipStream_t stream) {
    constexpr size_t kDynLds = 128 * 1024 + 4096 + 24576;
    static int grid_blocks = 0;
    if (!grid_blocks) {
        int dev = 0, cus = 0, per_cu = 0;
        (void)hipGetDevice(&dev);
        (void)hipDeviceGetAttribute(&cus, hipDeviceAttributeMultiprocessorCount, dev);
        (void)hipFuncSetAttribute((const void*)mega, hipFuncAttributeMaxDynamicSharedMemorySize, (int)kDynLds);
        (void)hipOccupancyMaxActiveBlocksPerMultiprocessor(&per_cu, (const void*)mega, NT, kDynLds);
        if (per_cu > 1) per_cu = 1;
        grid_blocks = cus * per_cu;
    }
    Params p{};
    p.x = (const float*)d_in[0]; p.c = (const float*)d_in[1]; p.ctx = (const float*)d_in[2]; p.c_ctx = (const float*)d_in[3];
    p.w_ada = (const float*)d_in[4]; p.b_ada = (const float*)d_in[5]; p.g_norm1 = (const float*)d_in[6]; p.w_in = (const float*)d_in[7];
    p.w_fmix = (const float*)d_in[8]; p.rpb = (const float*)d_in[9]; p.g_out = (const float*)d_in[10]; p.w_out = (const float*)d_in[11];
    p.g_norm2 = (const float*)d_in[12]; p.w_rg = (const float*)d_in[13]; p.w_re = (const float*)d_in[14]; p.w_gate = (const float*)d_in[15];
    p.w_up = (const float*)d_in[16]; p.w_down = (const float*)d_in[17]; p.g_final = (const float*)d_in[18];
    p.out = (float*)d_out;
    char* w = (char*)d_ws; size_t o = 0;
    auto take = [&](size_t bytes) { char* r = w + o; o += (bytes + 255) & ~(size_t)255; return r; };
    p.mod = (float*)take(3 * NMOD * D * 4); p.cosN = (float*)take(SEQ * 4); p.sinN = (float*)take(SEQ * 4); p.ropeR = (float*)take(GROWS * 32 * 4); p.ropeC = (float*)take(GW * 32 * 4);
    p.bar = (unsigned*)take(XCD_BAR_WORDS * 4); p.WrT = (float*)take(36 * D * 4); p.ssq = (float*)take((size_t)NTOK * NH * 4); p.tilecnt = (unsigned*)take(256 * 4); p.qctl = (unsigned*)take(16 * 64 * 4); p.F2 = (bf16_t*)take((size_t)NTOK * DF * 2); p.cnt = (int*)take(NEXP * 256); p.list = (int*)take((size_t)NEXP * NTOK * 4); p.tokgate = (float*)take(2 * NTOK * 4);
    p.WinT = (bf16_t*)take((size_t)DIN * D * 2); p.WoutT = (bf16_t*)take((size_t)D * D * 2);
    p.W64cs = (bf16_t*)take(256 * 64 * 2); p.G128 = (bf16_t*)take(256 * 256 * 2); p.WmixT = (bf16_t*)take(256 * 512 * 2);
    p.WgT = (bf16_t*)take((size_t)NEXP * DEXP * D * 2); p.WuT = (bf16_t*)take((size_t)NEXP * DEXP * D * 2); p.WdT = (bf16_t*)take((size_t)NEXP * DEXP * D * 2);
    char* R1 = take((size_t)NROWS * D * 2 + 2 * (size_t)NTOK * 512 * 2 + 256);
    p.hb = (bf16_t*)R1; p.A2b = (bf16_t*)R1; p.Zb = (bf16_t*)(R1 + (size_t)NROWS * D * 2); p.P2 = p.Zb + (size_t)NTOK * 512; p.h2b = (bf16_t*)R1; p.act = p.h2b + (size_t)NTOK * D;
    const size_t qkv = (size_t)NTOK * DNA * 2;
    char* R2 = take((size_t)NTOK * DF * 2 + 4 * qkv + 2 * (size_t)NCTX * DNA * 2 + 4096);
    p.fX = (bf16_t*)R2; p.Qr = (bf16_t*)(R2 + (size_t)NTOK * DF * 2); p.Qp = p.Qr + (size_t)NTOK * DNA; p.Kr = p.Qp + (size_t)NTOK * DNA; p.Vt = p.Kr + (size_t)NTOK * DNA;
    p.Kc = p.Vt + (size_t)NTOK * DNA; p.Vct = p.Kc + (size_t)NCTX * DNA;
    p.x1 = (float*)(R2 + (size_t)NTOK * DF * 2 + 4 * qkv + 2 * (size_t)NCTX * DNA * 2 - (size_t)NTOK * D * 4);
    p.ybuf = (bf16_t*)p.out;
    if (o > ws_size) { fprintf(stderr, "workspace too small: need %zu have %zu\n", o, ws_size); return; }
    void* args[] = {&p};
    hipError_t e = hipLaunchCooperativeKernel((const void*)mega, dim3(grid_blocks), dim3(NT), args, kDynLds, stream);
    if (e != hipSuccess) fprintf(stderr, "cooperative launch failed: %s (grid %d)\n", hipGetErrorString(e), grid_blocks);
}
```

```cpp
#include <hip/hip_runtime.h>
#include <cstdio>
#include <cstdint>
#include <type_traits>

constexpr int D = 1024, NBATCH = 2, SEQ = 8192, NTOK = NBATCH * SEQ, LCTX = 256, NCTX = NBATCH * LCTX, NROWS = NTOK + NCTX;
constexpr int DIN = 2560, DF = 256, NH = 12, HD = 64, DNA = 768, QOFF = 256, KOFF = 1024, VOFF = 1792;
constexpr int GW = 64, GROWS = 128, NEXP = 32, DEXP = 512, NMOD = 6;
constexpr float EPS = 1e-6f;
constexpr int NT = 512;
constexpr int TS_PHASE = -1;
constexpr int GPROBE = 0;
constexpr float QSCALE = 0.125f * 1.4426950408889634f;
typedef unsigned short bf16_t;
typedef short bf16x8 __attribute__((ext_vector_type(8)));
typedef float f32x16 __attribute__((ext_vector_type(16)));
typedef float f32x4 __attribute__((ext_vector_type(4)));
typedef unsigned u32x4 __attribute__((ext_vector_type(4)));
__device__ __forceinline__ unsigned cvt_pk_bf16(float lo, float hi) { unsigned r; asm volatile("v_cvt_pk_bf16_f32 %0, %1, %2" : "=v"(r) : "v"(lo), "v"(hi)); return r; }
__device__ __forceinline__ bf16_t f2bf(float v) { return (bf16_t)(cvt_pk_bf16(v, 0.f) & 0xffffu); }
__device__ __forceinline__ float bf2f(bf16_t v) { return __uint_as_float((unsigned)v << 16); }
__device__ __forceinline__ unsigned cvt4_fp8(float a, float b, float c, float d) { int w = __builtin_amdgcn_cvt_pk_fp8_f32(a, b, 0, false); w = __builtin_amdgcn_cvt_pk_fp8_f32(c, d, w, true); return (unsigned)w; }
constexpr float WSCALE_GU = 32.f, WSCALE_DN = 16.f;

struct Params {
    const float *x, *c, *ctx, *c_ctx, *w_ada, *b_ada, *g_norm1, *w_in, *w_fmix, *rpb, *g_out, *w_out, *g_norm2, *w_rg, *w_re, *w_gate, *w_up, *w_down, *g_final;
    float* out;
    float *mod, *cosN, *sinN, *ropeR, *ropeC;
    float *x1;
    int *cnt, *list; float* tokgate; unsigned* bar; float* WrT; float* ssq; unsigned* tilecnt; unsigned* qctl; bf16_t* F2;
    bf16_t *WinT, *WoutT, *WgT, *WuT, *WdT;
    bf16_t *hb, *A2b;
    bf16_t *h2b, *act, *ybuf;
    bf16_t *fX, *Qr, *Qp, *Kr, *Vt, *Kc, *Vct;
    bf16_t *W64cs, *G128, *WmixT;
    bf16_t *Zb, *P2;
};

template <int CTRL> __device__ __forceinline__ float dpp(float x) { return __builtin_bit_cast(float, __builtin_amdgcn_mov_dpp(__builtin_bit_cast(int, x), CTRL, 0xf, 0xf, true)); }
__device__ __forceinline__ float xhalf_sum(float x) { auto t = __builtin_amdgcn_permlane32_swap(__float_as_uint(x), __float_as_uint(x), false, false); return __uint_as_float(t[0]) + __uint_as_float(t[1]); }
__device__ __forceinline__ float xhalf_max(float x) { auto t = __builtin_amdgcn_permlane32_swap(__float_as_uint(x), __float_as_uint(x), false, false); return fmaxf(__uint_as_float(t[0]), __uint_as_float(t[1])); }
__device__ __forceinline__ float wave_sum(float x) {
    x += dpp<0xB1>(x); x += dpp<0x4E>(x); x += dpp<0x141>(x); x += dpp<0x128>(x);
    x += __shfl_xor(x, 16);
    return x + __shfl_xor(x, 32);
}
__device__ __forceinline__ float wave_max(float x) {
    x = fmaxf(x, dpp<0xB1>(x)); x = fmaxf(x, dpp<0x4E>(x)); x = fmaxf(x, dpp<0x141>(x)); x = fmaxf(x, dpp<0x128>(x));
    x = fmaxf(x, __shfl_xor(x, 16));
    return fmaxf(x, __shfl_xor(x, 32));
}
__device__ __forceinline__ float block_sum(float v, float* red) {
    v = wave_sum(v);
    const int w = threadIdx.x >> 6, l = threadIdx.x & 63;
    __syncthreads();
    if (l == 0) red[w] = v;
    __syncthreads();
    float s = 0.f;
#pragma unroll
    for (int i = 0; i < NT / 64; ++i) s += red[i];
    return s;
}

#define LAS __attribute__((address_space(3)))
#define SCS(tid) (((tid) & 7) ^ ((((tid) >> 3) >> 1) & 7))
__device__ __forceinline__ void gemm256(LAS unsigned char* lds, const int tid, const char* Pb, const unsigned (&po)[4], const char* Qb, const unsigned (&qo)[4], int nk, f32x16 (&acc)[4][2], const bool zero = true) {
    const int lane = tid & 63, wid = __builtin_amdgcn_readfirstlane(tid >> 6), wr = wid >> 2, wc = wid & 3;
    const int r = lane & 31, h = lane >> 5, swz = (r >> 1) & 7;
    const unsigned ldsw = (unsigned)wid * 1024u;
    if (zero) {
#pragma unroll
        for (int i = 0; i < 4; ++i)
#pragma unroll
            for (int j = 0; j < 2; ++j)
#pragma unroll
                for (int v = 0; v < 16; ++v) acc[i][j][v] = 0.f;
    }
    __syncthreads();
#pragma unroll
    for (int i = 0; i < 4; ++i) {
        __builtin_amdgcn_global_load_lds((const unsigned*)(Pb + po[i]), (LAS unsigned*)(lds + ldsw + i * 8192), 16, 0, 0);
        __builtin_amdgcn_global_load_lds((const unsigned*)(Qb + qo[i]), (LAS unsigned*)(lds + 32768 + ldsw + i * 8192), 16, 0, 0);
    }
    __syncthreads();
    unsigned long long tg0_ = 0; if (GPROBE) tg0_ = __builtin_amdgcn_s_memtime();
    const int prd = (wr * 128 + r) * 128, qrd = 32768 + (wc * 64 + r) * 128;
    const int ko0 = ((0 + h) ^ swz) << 4, ko1 = ((2 + h) ^ swz) << 4, ko2 = ((4 + h) ^ swz) << 4, ko3 = ((6 + h) ^ swz) << 4;
#define G256_LD(pf, qf, ko) do { _Pragma("unroll") for (int i = 0; i < 4; ++i) pf[i] = *(const LAS bf16x8*)(lds + cb + prd + i * 4096 + (ko)); \
                                 _Pragma("unroll") for (int j = 0; j < 2; ++j) qf[j] = *(const LAS bf16x8*)(lds + cb + qrd + j * 4096 + (ko)); } while (0)
#define G256_MM(pf, qf) do { _Pragma("unroll") for (int i = 0; i < 4; ++i) _Pragma("unroll") for (int j = 0; j < 2; ++j) \
                                 acc[i][j] = __builtin_amdgcn_mfma_f32_32x32x16_bf16(pf[i], qf[j], acc[i][j], 0, 0, 0); } while (0)
#pragma unroll 1
    for (int kt = 0; kt < nk; ++kt) {
        const int cb = (kt & 1) * 65536, nb = 65536 - cb;
        {
            const unsigned koff = (unsigned)min(kt + 1, nk - 1) * 128u;
#pragma unroll
            for (int i = 0; i < 4; ++i) {
                __builtin_amdgcn_global_load_lds((const unsigned*)(Pb + (size_t)(po[i] + koff)), (LAS unsigned*)(lds + nb + ldsw + i * 8192), 16, 0, 0);
                __builtin_amdgcn_global_load_lds((const unsigned*)(Qb + (size_t)(qo[i] + koff)), (LAS unsigned*)(lds + nb + 32768 + ldsw + i * 8192), 16, 0, 0);
            }
        }
        bf16x8 pa[4], qa[2], pb[4], qb[2];
        G256_LD(pa, qa, ko0);
        G256_LD(pb, qb, ko1);
        G256_MM(pa, qa);
        G256_LD(pa, qa, ko2);
        G256_MM(pb, qb);
        G256_LD(pb, qb, ko3);
        G256_MM(pa, qa);
        G256_MM(pb, qb);
        if (GPROBE) { const unsigned long long t0_ = __builtin_amdgcn_s_memtime(); __syncthreads(); const unsigned long long t1_ = __builtin_amdgcn_s_memtime();
            if (tid == 0) { volatile LAS unsigned* gp = (volatile LAS unsigned*)(lds + 128 * 1024 + 640); gp[0] += (unsigned)(t1_ - t0_); gp[1] += 1u; } }
        else __syncthreads();
    }
    if (GPROBE && tid == 0) { volatile LAS unsigned* gp = (volatile LAS unsigned*)(lds + 128 * 1024 + 640); const unsigned long long t_ = __builtin_amdgcn_s_memtime(); gp[2] += (unsigned)(t_ - tg0_); }
    asm volatile("" ::: "memory");
}

#define SROW8(tid, i) ((i) * 128 + ((tid) >> 6) * 16 + (((tid) & 63) >> 2))
#define SCH8(tid) (((tid) & 3) ^ (((tid) >> 4) & 3))
__device__ __forceinline__ void gemm256_f8(LAS unsigned char* lds, const int tid, const char* Pb, const unsigned (&po)[2], const char* Qb, const unsigned (&qo)[2], int nk, f32x16 (&acc)[4][2]) {
    const int lane = tid & 63, wid = __builtin_amdgcn_readfirstlane(tid >> 6), wr = wid >> 2, wc = wid & 3;
    const int r = lane & 31, h = lane >> 5, swz = (r >> 2) & 3;
    const unsigned ldsw = (unsigned)wid * 1024u;
#pragma unroll
    for (int i = 0; i < 4; ++i)
#pragma unroll
        for (int j = 0; j < 2; ++j)
#pragma unroll
            for (int v = 0; v < 16; ++v) acc[i][j][v] = 0.f;
#define G8_ISSUE(t) do { const unsigned koff_ = (unsigned)(t) * 64u; const unsigned bo_ = ((unsigned)(t) & 3u) * 32768u; \
        _Pragma("unroll") for (int i_ = 0; i_ < 2; ++i_) { \
            __builtin_amdgcn_global_load_lds((const unsigned*)(Pb + (size_t)(po[i_] + koff_)), (LAS unsigned*)(lds + bo_ + ldsw + i_ * 8192), 16, 0, 0); \
            __builtin_amdgcn_global_load_lds((const unsigned*)(Qb + (size_t)(qo[i_] + koff_)), (LAS unsigned*)(lds + bo_ + 16384 + ldsw + i_ * 8192), 16, 0, 0); } } while (0)
#define G8_WAIT(rem_) do { if ((rem_) >= 2) asm volatile("s_waitcnt vmcnt(8)" ::: "memory"); else if ((rem_) == 1) asm volatile("s_waitcnt vmcnt(4)" ::: "memory"); \
                           else asm volatile("s_waitcnt vmcnt(0)" ::: "memory"); } while (0)
    asm volatile("s_waitcnt vmcnt(0) lgkmcnt(0)" ::: "memory"); __builtin_amdgcn_s_barrier();
    G8_ISSUE(0);
    if (nk > 1) G8_ISSUE(1);
    if (nk > 2) G8_ISSUE(2);
    const int prd = (wr * 128 + r) * 64 + 8 * h, qrd = 16384 + (wc * 64 + r) * 64 + 8 * h;
    const int ko0 = (0 ^ swz) << 4, ko1 = (1 ^ swz) << 4, ko2 = (2 ^ swz) << 4, ko3 = (3 ^ swz) << 4;
#pragma unroll 1
    for (int kt = 0; kt < nk; ++kt) {
        G8_WAIT(nk - 1 - kt);
        asm volatile("s_waitcnt lgkmcnt(0)" ::: "memory"); __builtin_amdgcn_s_barrier();
        if (kt + 3 < nk) G8_ISSUE(kt + 3);
        const int cb = (kt & 3) * 32768;
#define G8_STEP(ko) do { long pf_[4], qf_[2]; \
        _Pragma("unroll") for (int i = 0; i < 4; ++i) pf_[i] = *(const LAS long*)(lds + cb + prd + i * 2048 + (ko)); \
        _Pragma("unroll") for (int j = 0; j < 2; ++j) qf_[j] = *(const LAS long*)(lds + cb + qrd + j * 2048 + (ko)); \
        _Pragma("unroll") for (int i = 0; i < 4; ++i) _Pragma("unroll") for (int j = 0; j < 2; ++j) \
            acc[i][j] = __builtin_amdgcn_mfma_f32_32x32x16_fp8_fp8(pf_[i], qf_[j], acc[i][j], 0, 0, 0); } while (0)
        G8_STEP(ko0); G8_STEP(ko1); G8_STEP(ko2); G8_STEP(ko3);
    }
    asm volatile("" ::: "memory");
}

#define XB_TMO      128
#define XB_XCNT(j)  (256  + 64 * (j))
#define XB_XSUB(j)  (1280 + 64 * (j))
#define XB_XGEN(j)  (2304 + 64 * (j))
#define XB_TOP      3328
#define XB_TOPGEN   3392
#define XCD_BAR_WORDS 3456
#define XB_SPIN_CAP (1u << 18)
__device__ __forceinline__ unsigned xb_ld(unsigned* p)              { return __hip_atomic_load(p, __ATOMIC_RELAXED, __HIP_MEMORY_SCOPE_AGENT); }
__device__ __forceinline__ unsigned xb_add(unsigned* p, unsigned v) { return __hip_atomic_fetch_add(p, v, __ATOMIC_RELAXED, __HIP_MEMORY_SCOPE_AGENT); }
__device__ __forceinline__ unsigned xb_xcc_id() { return (unsigned)__builtin_amdgcn_s_getreg((3 << 11) | 20) & 0xFu; }
#define XB_SPIN(cond, bar) do { unsigned _sp = 0; while (cond) { __builtin_amdgcn_s_sleep(1); \
    if ((++_sp & 255u) == 0u) { if (xb_ld(&(bar)[XB_TMO])) break; if (_sp > XB_SPIN_CAP) { atomicAdd(&(bar)[XB_TMO], 1u); break; } } } } while (0)
struct XcdBarrier { unsigned* bar; unsigned x; volatile LAS unsigned* st; };
__device__ unsigned g_bar[XCD_BAR_WORDS + 64];
__device__ __forceinline__ XcdBarrier xcd_barrier_post(unsigned* bar, volatile LAS unsigned* st) {
    XcdBarrier b; b.bar = bar; b.x = xb_xcc_id(); b.st = st;
    if (threadIdx.x == 0) (void)xb_add(&bar[XB_XCNT(b.x)], 1u);
    return b;
}
__device__ __forceinline__ void xcd_barrier_complete(unsigned* bar, unsigned x, unsigned& nloc, unsigned& nx) {
    const unsigned G = gridDim.x * gridDim.y * gridDim.z;
    unsigned sum, cnt, mine, sp = 0u;
    for (;;) {
        sum = 0u; cnt = 0u; mine = 0u;
#pragma unroll
        for (unsigned j = 0; j < 16; ++j) { const unsigned c = xb_ld(&bar[XB_XCNT(j)]); sum += c; cnt += (c > 0u) ? 1u : 0u; mine = (j == x) ? c : mine; }
        if (sum == G) break;
        __builtin_amdgcn_s_sleep(1);
        if ((++sp & 255u) == 0u) { if (xb_ld(&bar[XB_TMO])) break; if (sp > XB_SPIN_CAP) { atomicAdd(&bar[XB_TMO], 1u); break; } }
    }
    nloc = mine > 0u ? mine : 1u; nx = cnt > 0u ? cnt : 1u;
}
__device__ __forceinline__ void xcd_barrier(const XcdBarrier& b) {
    asm volatile("s_waitcnt vmcnt(0)" ::: "memory");
    __syncthreads();
    if (threadIdx.x == 0) {
        unsigned* bar = b.bar;
        __builtin_amdgcn_s_waitcnt(0);
        unsigned nloc = b.st[0], nx = b.st[1];
        if (nloc == 0u) { xcd_barrier_complete(bar, b.x, nloc, nx); b.st[0] = nloc; b.st[1] = nx; }
        const unsigned old = xb_add(&bar[XB_XSUB(b.x)], 1u);
        const unsigned gen = old / nloc;
        if (old + 1u == (gen + 1u) * nloc) {
            __builtin_amdgcn_fence(__ATOMIC_RELEASE, "agent");
            asm volatile("s_waitcnt vmcnt(0)" ::: "memory");
            const unsigned og = xb_add(&bar[XB_TOP], 1u);
            const unsigned tg = og / nx;
            if (og + 1u == (tg + 1u) * nx) xb_add(&bar[XB_TOPGEN], 1u);
            else XB_SPIN(xb_ld(&bar[XB_TOPGEN]) == tg, bar);
            __builtin_amdgcn_fence(__ATOMIC_ACQUIRE, "agent");
            xb_add(&bar[XB_XGEN(b.x)], 1u);
            asm volatile("s_waitcnt vmcnt(0)" ::: "memory");
        } else {
            XB_SPIN(xb_ld(&bar[XB_XGEN(b.x)]) == gen, bar);
            __builtin_amdgcn_fence(__ATOMIC_ACQUIRE, "agent");
            asm volatile("s_waitcnt vmcnt(0)" ::: "memory");
        }
    }
    __syncthreads();
}

__device__ __forceinline__ void publish_add(unsigned* ctr, int tid) {
    asm volatile("s_waitcnt vmcnt(0)" ::: "memory");
    __syncthreads();
    if (tid == 0) { __builtin_amdgcn_fence(__ATOMIC_RELEASE, "agent"); asm volatile("s_waitcnt vmcnt(0)" ::: "memory");
        __hip_atomic_fetch_add(ctr, 1u, __ATOMIC_RELAXED, __HIP_MEMORY_SCOPE_AGENT); }
}
__device__ __forceinline__ void wait_ge(unsigned* ctr, unsigned want, int tid) {
    if (tid == 0) { unsigned sp = 0;
        while (__hip_atomic_load(ctr, __ATOMIC_RELAXED, __HIP_MEMORY_SCOPE_AGENT) < want) { __builtin_amdgcn_s_sleep(2); if (++sp > (1u << 22)) break; }
        __builtin_amdgcn_fence(__ATOMIC_ACQUIRE, "agent"); asm volatile("s_waitcnt vmcnt(0)" ::: "memory"); }
    __syncthreads();
}
#define QW(i) ((i) * 64)

struct TJob { const float* src; bf16_t* dst; int R, C, ntile; const float* rscale; int smin; float f8scale; };
__device__ void transpose_all(const Params& p, float* lds) {
    int tid = threadIdx.x; asm volatile("" : "+v"(tid));
    const int rr0 = tid >> 6, c4 = (tid & 63) * 4;
    volatile int* qw = (volatile int*)(lds + 64 * 257);
    auto job_of = [&](int id, TJob& j, int& t) {
        if (id < 160) { j = TJob{p.w_in, p.WinT, D, DIN, 160, nullptr, 0, 0.f}; t = id; }
        else if (id < 224) { j = TJob{p.w_out, p.WoutT, D, D, 64, p.g_out, DF, 0.f}; t = id - 160; }
        else if (id < 1248) { j = TJob{p.w_gate, p.WgT, D, DEXP, 1024, nullptr, 0, WSCALE_GU}; t = id - 224; }
        else if (id < 2272) { j = TJob{p.w_up, p.WuT, D, DEXP, 1024, nullptr, 0, WSCALE_GU}; t = id - 1248; }
        else { j = TJob{p.w_down, p.WdT, DEXP, D, 1024, nullptr, 0, WSCALE_DN}; t = id - 2272; }
    };
    constexpr int NTILES = 3296;
    auto fetch = [&]() { __syncthreads(); if (tid == 0) qw[0] = (int)__hip_atomic_fetch_add(g_bar + 64, 1u, __ATOMIC_RELAXED, __HIP_MEMORY_SCOPE_AGENT); __syncthreads(); return (int)qw[0]; };
    float4 v[8];
    auto load = [&](int id) { TJob j; int t; job_of(id, j, t); const int tr = j.R / 64, tc = j.C / 256;
        const int bb = t / (tr * tc), rem = t % (tr * tc), r0 = (rem / tc) * 64, c0 = (rem % tc) * 256;
        const float* s = j.src + (size_t)bb * j.R * j.C + (size_t)r0 * j.C + c0;
#pragma unroll
        for (int i = 0; i < 8; ++i) v[i] = *(const float4*)(s + (size_t)(rr0 + 8 * i) * j.C + c4); };
    int id = fetch();
    if (id < NTILES) load(id);
    while (id < NTILES) {
        TJob j; int t; job_of(id, j, t); const int tr = j.R / 64, tc = j.C / 256;
        const int bb = t / (tr * tc), rem = t % (tr * tc), r0 = (rem / tc) * 64, c0 = (rem % tc) * 256;
        bf16_t* d = j.dst + (size_t)bb * j.R * j.C + (size_t)c0 * j.R + r0;
        if (j.rscale) {
#pragma unroll
            for (int i = 0; i < 8; ++i) if (r0 + rr0 + 8 * i >= j.smin) { const float g = j.rscale[r0 + rr0 + 8 * i]; v[i].x *= g; v[i].y *= g; v[i].z *= g; v[i].w *= g; } }
        const int nid = fetch();
#pragma unroll
        for (int i = 0; i < 8; ++i) { float* q = lds + (rr0 + 8 * i) * 257 + c4; q[0] = v[i].x; q[1] = v[i].y; q[2] = v[i].z; q[3] = v[i].w; }
        if (nid < NTILES) load(nid);
        __syncthreads();
        if (j.f8scale == 0.f) {
#pragma unroll
            for (int i = 0; i < 4; ++i) { const int cc = (tid >> 3) + 64 * i, r8 = (tid & 7) * 8; const float* q = lds + r8 * 257 + cc;
                uint4 w; w.x = cvt_pk_bf16(q[0], q[257]); w.y = cvt_pk_bf16(q[2 * 257], q[3 * 257]); w.z = cvt_pk_bf16(q[4 * 257], q[5 * 257]); w.w = cvt_pk_bf16(q[6 * 257], q[7 * 257]);
                *(uint4*)(d + (size_t)cc * j.R + r8) = w; }
        } else {
            unsigned char* d8 = (unsigned char*)j.dst + (size_t)bb * j.R * j.C + (size_t)c0 * j.R + r0; const float sc_ = j.f8scale;
#pragma unroll
            for (int i = 0; i < 4; ++i) { const int cc = (tid >> 3) + 64 * i, r8 = (tid & 7) * 8; const float* q = lds + r8 * 257 + cc;
                uint2 w; w.x = cvt4_fp8(q[0] * sc_, q[257] * sc_, q[2 * 257] * sc_, q[3 * 257] * sc_); w.y = cvt4_fp8(q[4 * 257] * sc_, q[5 * 257] * sc_, q[6 * 257] * sc_, q[7 * 257] * sc_);
                *(uint2*)(d8 + (size_t)cc * j.R + r8) = w; }
        }
        id = nid;
    }
}

__device__ void ph_hrows(const Params& p, float* lds);
__device__ void ph_adaln_tables(const Params& p, float* lds) {
    int tid = threadIdx.x; asm volatile("" : "+v"(tid));
    const int gid = blockIdx.x * NT + tid, gsz = gridDim.x * NT;
    if (blockIdx.x < NMOD * D / 32) {
        for (int i = tid; i < 3 * D; i += NT) { const int r = i / D, k = i % D; const float v = r < 2 ? p.c[r * D + k] : p.c_ctx[k]; lds[i] = v / (1.f + expf(-v)); }
        __syncthreads();
        const int col = blockIdx.x * 32 + (tid & 31), kg = tid >> 5;
        float a0 = 0.f, a1 = 0.f, a2 = 0.f;
#pragma unroll 8
        for (int kk = 0; kk < 64; ++kk) { const int k = kg * 64 + kk; const float w = p.w_ada[(size_t)k * (NMOD * D) + col]; a0 = fmaf(lds[k], w, a0); a1 = fmaf(lds[D + k], w, a1); a2 = fmaf(lds[2 * D + k], w, a2); }
        float* red = lds + 3 * D;
        red[(0 * 16 + kg) * 32 + (tid & 31)] = a0; red[(1 * 16 + kg) * 32 + (tid & 31)] = a1; red[(2 * 16 + kg) * 32 + (tid & 31)] = a2;
        __syncthreads();
        if (tid < 96) { const int rr = tid >> 5, cc = tid & 31; float s = 0.f;
#pragma unroll
            for (int g = 0; g < 16; ++g) s += red[(rr * 16 + g) * 32 + cc];
            p.mod[rr * NMOD * D + blockIdx.x * 32 + cc] = s + p.b_ada[blockIdx.x * 32 + cc]; }
        publish_add(g_bar + 96, tid);
    }
    for (int i = gid; i < 36 * D; i += gsz) { const int o = i / D, k = i % D; p.WrT[i] = o < 4 ? p.w_rg[k * 4 + o] : p.w_re[k * NEXP + o - 4]; }
    for (int i = gid; i < SEQ; i += gsz) { p.cosN[i] = cospif(2.f * (float)i / (float)SEQ); p.sinN[i] = sinpif(2.f * (float)i / (float)SEQ); }
    for (int i = gid; i < (GROWS + GW) * 16; i += gsz) {
        const int pos = i / 16, f = i % 16; const float inv = powf(10000.f, -(float)f / 16.f);
        if (pos < GROWS) { const float a = (float)pos * inv; p.ropeR[2 * i] = cosf(a); p.ropeR[2 * i + 1] = sinf(a); }
        else { const int pc = pos - GROWS; const float a = (float)pc * inv; p.ropeC[2 * (pc * 16 + f)] = cosf(a); p.ropeC[2 * (pc * 16 + f) + 1] = sinf(a); }
    }
    if (gid < NEXP) p.cnt[gid * 64] = 0;
    if (gid < 256) p.tilecnt[gid] = 0u;
    if (gid < 16) p.qctl[QW(gid)] = 0u;
    for (int i = gid; i < 256 * 64; i += gsz) {
        const int rho = i >> 6, n1 = i & 63, blk = rho >> 5, k1 = (blk >> 1) * 32 + (rho & 31);
        float v = 0.f;
        if (blk < 4) { const float a = 2.f * (float)((k1 * n1) & 63) / 64.f; v = (blk & 1) ? -sinpif(a) : cospif(a); }
        p.W64cs[i] = f2bf(v);
    }
    for (int i = gid; i < 256 * 256; i += gsz) {
        const int rho = i >> 8, kap = i & 255, ro = rho >> 7, k2 = rho & 127, ri = kap >> 7, n2 = kap & 127;
        const float a = 2.f * (float)((k2 * n2) & 127) / 128.f; const float c = cospif(a), s = sinpif(a);
        p.G128[i] = f2bf(ro == ri ? c : (ro == 0 ? s : -s));
    }
    float* cs64 = lds + 3 * D + 1536;
    __syncthreads();
    if (tid < 128) cs64[tid] = tid < 64 ? cospif(2.f * (float)tid / 64.f) : sinpif(2.f * (float)(tid - 64) / 64.f);
    __syncthreads();
    for (int i = gid; i < 256 * 512; i += gsz) {
        const int j = i >> 9, kap = i & 511, ro = kap >> 8, ch = kap & 255, g = ch >> 6, c = ch & 63;
        float acc = 0.f;
        for (int l = 0; l < 64; ++l) acc = fmaf(cs64[ro * 64 + ((l * c) & 63)], p.w_fmix[(size_t)(64 * g + l) * DF + j], acc);
        p.WmixT[i] = f2bf(acc * (1.0f / 724.0773439350247f));
    }
    wait_ge(g_bar + 96, NMOD * D / 32, tid);
    ph_hrows(p, lds);
    transpose_all(p, lds);
}

__device__ void ph_hrows(const Params& p, float* lds) {
    int tid = threadIdx.x; asm volatile("" : "+v"(tid));
    const int lane = tid & 63, nw = gridDim.x * (NT / 64), gw = blockIdx.x * (NT / 64) + (tid >> 6);
    for (int row0 = gw; row0 < NROWS; row0 += 2 * nw) {
        float4 v[2][4]; float ss[2];
#pragma unroll
        for (int q = 0; q < 2; ++q) {
            const int row = min(row0 + q * nw, NROWS - 1);
            const float* src = row < NTOK ? p.x + (size_t)row * D : p.ctx + (size_t)(row - NTOK) * D;
#pragma unroll
            for (int i = 0; i < 4; ++i) v[q][i] = *(const float4*)(src + 4 * lane + 256 * i);
        }
#pragma unroll
        for (int q = 0; q < 2; ++q) { float s = 0.f;
#pragma unroll
            for (int i = 0; i < 4; ++i) s += v[q][i].x * v[q][i].x + v[q][i].y * v[q][i].y + v[q][i].z * v[q][i].z + v[q][i].w * v[q][i].w;
            ss[q] = wave_sum(s); }
#pragma unroll
        for (int q = 0; q < 2; ++q) {
            const int row = row0 + q * nw;
            if (row < NROWS) {
                const int mr = row < NTOK ? row / SEQ : 2;
                const float* sh = p.mod + mr * NMOD * D, * sc = sh + D;
                const float r = rsqrtf(ss[q] / (float)D + EPS);
#pragma unroll
                for (int i = 0; i < 4; ++i) { const int e = 4 * lane + 256 * i;
                    const float4 g = *(const float4*)(p.g_norm1 + e), s4 = *(const float4*)(sc + e), h4 = *(const float4*)(sh + e);
                    uint2 w; w.x = cvt_pk_bf16(v[q][i].x * r * g.x * (1.f + s4.x) + h4.x, v[q][i].y * r * g.y * (1.f + s4.y) + h4.y);
                    w.y = cvt_pk_bf16(v[q][i].z * r * g.z * (1.f + s4.z) + h4.z, v[q][i].w * r * g.w * (1.f + s4.w) + h4.w);
                    *(uint2*)(p.hb + (size_t)row * D + e) = w; }
            }
        }
    }
}

__device__ __forceinline__ void four1_unit(const Params& p, float* ldsf, const int u);
__device__ __forceinline__ void four2_unit(const Params& p, float* ldsf, const int u);
__device__ __forceinline__ void fmix_unit(const Params& p, float* ldsf, const int u);
__device__ void ph_inproj(const Params& p, float* ldsf) {
    LAS unsigned char* lds = (LAS unsigned char*)ldsf;
    int tid = threadIdx.x; asm volatile("" : "+v"(tid));
    const int lane = tid & 63, wid = tid >> 6, wr = wid >> 2, wc = wid & 3, r = lane & 31, h = lane >> 5;
    const int srow = tid >> 3, sc = SCS(tid);
    float* ropeL = ldsf + (128 * 1024 + 4096) / 4;
    __syncthreads();
    for (int i = tid; i < (GROWS + GW) * 32; i += NT) ropeL[i] = i < GROWS * 32 ? p.ropeR[i] : p.ropeC[i - GROWS * 32];
    __syncthreads();
    const bool xa = gridDim.x == 256; const int xcd = xa ? (blockIdx.x & 7) : 0, lj = xa ? (blockIdx.x >> 3) : blockIdx.x, lper = xa ? 32 : gridDim.x, npmx = xa ? 8 : 64;
    const int nloc = npmx * 10 + (xa ? (xcd < 2 ? 6 : 0) : 12);
    for (int rnd = 0; ; ++rnd) {
        const int ul = lj + rnd * lper;
        const bool has = ul < nloc;
        if (!has && !(xa && rnd < 3)) break;
        if (has) {
        int pm, pn;
        if (ul < npmx) { pm = xcd * npmx + ul; pn = 0; } else if (ul < npmx * 10) { pm = xcd * npmx + (ul - npmx) / 9; pn = 1 + (ul - npmx) % 9; }
        else { const int c = ul - npmx * 10; pm = 64 + (xa ? xcd : c / 6); pn = 4 + c % 6; }
        unsigned po[4], qo[4];
#pragma unroll
        for (int i = 0; i < 4; ++i) {
            const int rt = srow + 64 * i;
            po[i] = (unsigned)((pn * 256 + rt) * D * 2 + sc * 16);
            int rowidx;
            if (pn == 0) rowidx = (pm >> 5) * SEQ + 128 * (rt & 63) + 4 * (pm & 31) + (rt >> 6);
            else rowidx = pm * 256 + rt;
            qo[i] = (unsigned)rowidx * (unsigned)(D * 2) + sc * 16;
        }
        f32x16 acc[4][2];
        gemm256(lds, tid, (const char*)p.WinT, po, (const char*)p.hb, qo, D / 64, acc);
        int opq = 0; asm volatile("" : "+v"(opq));
        const int r_ = r + opq, h_ = h + opq;
        if (pn == 0) {
            const int b = pm >> 5, n2 = 4 * (pm & 31) + wc;
#pragma unroll
            for (int i = 0; i < 4; ++i) {
#pragma unroll
                for (int j = 0; j < 2; ++j) {
                    const unsigned base = (unsigned)(((b * DF + wr * 128 + i * 32 + 4 * h_) * 128 + n2) * 64 + j * 32 + r_);
#pragma unroll
                    for (int v = 0; v < 16; ++v) p.fX[base + (unsigned)(((v & 3) + 8 * (v >> 2)) * 128 * 64)] = f2bf(acc[i][j][v]);
                }
                asm volatile("" ::: "memory");
            }
            publish_add(p.qctl + QW(1 + b), tid);
        } else if (pn < 7) {
            const bool isq = pn < 4; const int hg = ((pn - 1) % 3) * 4 + wr * 2;
            const bool isctx = pm >= 64;
            const int b = isctx ? pm - 64 : (pm >> 5);
#pragma unroll
            for (int j = 0; j < 2; ++j) {
                const int n = (isctx ? 0 : (pm & 31) * 256) + wc * 64 + j * 32 + r_;
                const int grow = n >> 6, gcol = n & 63;
#pragma unroll
                for (int i = 0; i < 4; ++i) {
                    const int hh = hg + (i >> 1), blk = i & 1;
                    if (isctx) {
                        const unsigned base = (unsigned)(((b * NH + hh) * LCTX + n) * HD + blk * 32 + 4 * h_);
#pragma unroll
                        for (int q = 0; q < 4; ++q) {
                            uint2 w;
                            w.x = cvt_pk_bf16(acc[i][j][4 * q], acc[i][j][4 * q + 1]); w.y = cvt_pk_bf16(acc[i][j][4 * q + 2], acc[i][j][4 * q + 3]);
                            *(uint2*)(p.Kc + base + 8 * q) = w;
                        }
                    } else {
                        const float* tb = (blk == 0 ? ropeL + 32 * grow : ropeL + GROWS * 32 + 32 * gcol) + 8 * h_;
                        float o1[8], o2[8];
#pragma unroll
                        for (int v = 0; v < 8; ++v) {
                            const float2 cs = *(const float2*)(tb + 2 * ((v & 3) + 8 * (v >> 2)));
                            const float x1 = acc[i][j][v], x2 = acc[i][j][v + 8];
                            o1[v] = x1 * cs.x - x2 * cs.y; o2[v] = x1 * cs.y + x2 * cs.x;
                        }
                        const unsigned base = (unsigned)(((b * NH + hh) * SEQ + n) * HD + blk * 32 + 4 * h_);
                        if (isq) {
#pragma unroll
                            for (int q = 0; q < 2; ++q) {
                                uint2 w;
                                w.x = cvt_pk_bf16(o1[4 * q] * QSCALE, o1[4 * q + 1] * QSCALE); w.y = cvt_pk_bf16(o1[4 * q + 2] * QSCALE, o1[4 * q + 3] * QSCALE);
                                *(uint2*)(p.Qr + base + 8 * q) = w;
                                w.x = cvt_pk_bf16(o2[4 * q] * QSCALE, o2[4 * q + 1] * QSCALE); w.y = cvt_pk_bf16(o2[4 * q + 2] * QSCALE, o2[4 * q + 3] * QSCALE);
                                *(uint2*)(p.Qr + base + 16 + 8 * q) = w;
                            }
#pragma unroll
                            for (int q = 0; q < 4; ++q) {
                                uint2 w;
                                w.x = cvt_pk_bf16(acc[i][j][4 * q] * QSCALE, acc[i][j][4 * q + 1] * QSCALE); w.y = cvt_pk_bf16(acc[i][j][4 * q + 2] * QSCALE, acc[i][j][4 * q + 3] * QSCALE);
                                *(uint2*)(p.Qp + base + 8 * q) = w;
                            }
                        } else {
#pragma unroll
                            for (int q = 0; q < 2; ++q) {
                                uint2 w;
                                w.x = cvt_pk_bf16(o1[4 * q], o1[4 * q + 1]); w.y = cvt_pk_bf16(o1[4 * q + 2], o1[4 * q + 3]);
                                *(uint2*)(p.Kr + base + 8 * q) = w;
                                w.x = cvt_pk_bf16(o2[4 * q], o2[4 * q + 1]); w.y = cvt_pk_bf16(o2[4 * q + 2], o2[4 * q + 3]);
                                *(uint2*)(p.Kr + base + 16 + 8 * q) = w;
                            }
                        }
                    }
                    asm volatile("" ::: "memory");
                }
            }
        } else {
            const int hg = (pn - 7) * 4 + wr * 2;
            const bool isctx = pm >= 64;
            const int b = isctx ? pm - 64 : (pm >> 5);
            const int ntb = isctx ? LCTX / 8 : SEQ / 8; bf16_t* vb = isctx ? p.Vct : p.Vt;
#pragma unroll
            for (int j = 0; j < 2; ++j) {
                const int n = (isctx ? 0 : (pm & 31) * 256) + wc * 64 + j * 32 + r_;
#pragma unroll
                for (int i = 0; i < 4; ++i) {
                    const unsigned base = (unsigned)((((b * NH + hg + (i >> 1)) * ntb + (n >> 3)) * HD + (i & 1) * 32 + 4 * h_) * 8 + (n & 7));
#pragma unroll
                    for (int v = 0; v < 16; ++v) vb[base + (unsigned)(((v & 3) + 8 * (v >> 2)) * 8)] = f2bf(acc[i][j][v]);
                    asm volatile("" ::: "memory");
                }
            }
        }
        }
        if (xa) {
            if (rnd == 0) { const int item = xcd * 32 + lj, b = item >> 7; wait_ge(p.qctl + QW(1 + b), 32u, tid); four1_unit(p, ldsf, item); publish_add(p.qctl + QW(3 + b), tid); }
            else if (rnd == 1 && lj >= 16) { const int u = xcd * 16 + (lj - 16), b = u >> 6; wait_ge(p.qctl + QW(3 + b), 128u, tid); four2_unit(p, ldsf, u); publish_add(p.qctl + QW(5 + b), tid); }
            else if (rnd == 2 && lj >= 24) { const int u = xcd * 8 + (lj - 24), b = u >> 5; wait_ge(p.qctl + QW(5 + b), 64u, tid); fmix_unit(p, ldsf, u); }
        }
    }
}

__device__ __forceinline__ void four1_unit(const Params& p, float* ldsf, const int u) {
    LAS unsigned char* lds = (LAS unsigned char*)ldsf;
    int tid = threadIdx.x; asm volatile("" : "+v"(tid));
    const int lane = tid & 63, wid = tid >> 6, wr = wid >> 2, wc = wid & 3, r = lane & 31, h = lane >> 5;
    const int srow = tid >> 3, sc = SCS(tid);
    {
        unsigned po[4], qo[4];
#pragma unroll
        for (int i = 0; i < 4; ++i) { const int rt = srow + 64 * i; po[i] = (unsigned)rt * 128u + sc * 16; qo[i] = (unsigned)(u * 256 + rt) * 128u + sc * 16; }
        f32x16 acc[4][2];
        gemm256(lds, tid, (const char*)p.W64cs, po, (const char*)p.fX, qo, 1, acc);
        if (wr == 0) {
            int opq = 0; asm volatile("" : "+v"(opq));
            const int r_ = r + opq, h_ = h + opq;
#pragma unroll
            for (int j = 0; j < 2; ++j) {
                const int qrow = u * 256 + wc * 64 + j * 32 + r_;
                const int n2 = qrow & 127, bc = qrow >> 7;
#pragma unroll
                for (int a = 0; a < 2; ++a) {
#pragma unroll
                    for (int v = 0; v < 16; ++v) {
                        const int k1 = a * 32 + (v & 3) + 8 * (v >> 2) + 4 * h_;
                        const float rev = (float)(n2 * k1) * (1.0f / 8192.0f);
                        const float cs = __builtin_amdgcn_cosf(rev), sn = __builtin_amdgcn_sinf(rev);
                        const float yr = acc[2 * a][j][v], yi = acc[2 * a + 1][j][v];
                        const unsigned base = (unsigned)((bc * 64 + k1) * 256 + n2);
                        p.Zb[base] = f2bf(yr * cs + yi * sn); p.Zb[base + 128] = f2bf(yi * cs - yr * sn);
                    }
                    asm volatile("" ::: "memory");
                }
            }
        }
    }
}

__device__ __forceinline__ void four2_unit(const Params& p, float* ldsf, const int u) {
    LAS unsigned char* lds = (LAS unsigned char*)ldsf;
    int tid = threadIdx.x; asm volatile("" : "+v"(tid));
    const int lane = tid & 63, wid = tid >> 6, wr = wid >> 2, wc = wid & 3, r = lane & 31, h = lane >> 5;
    const int srow = tid >> 3, sc = SCS(tid);
    {
        const int b = u >> 6, k1 = u & 63;
        unsigned po[4], qo[4];
#pragma unroll
        for (int i = 0; i < 4; ++i) { const int rt = srow + 64 * i; po[i] = (unsigned)rt * 512u + sc * 16; qo[i] = (unsigned)(((b * DF + rt) * 64 + k1) * 512) + sc * 16; }
        f32x16 acc[4][2];
        gemm256(lds, tid, (const char*)p.G128, po, (const char*)p.Zb, qo, 4, acc);
        int opq = 0; asm volatile("" : "+v"(opq));
        const int r_ = r + opq, h_ = h + opq;
#pragma unroll
        for (int i = 0; i < 4; ++i) {
#pragma unroll
            for (int j = 0; j < 2; ++j) {
                bf16_t* dst = p.P2 + (unsigned)((b * SEQ + k1 + 64 * (i * 32 + 4 * h_)) * 512 + wr * 256 + wc * 64 + j * 32 + r_);
#pragma unroll
                for (int v = 0; v < 16; ++v) dst[((v & 3) + 8 * (v >> 2)) * 64 * 512] = f2bf(acc[i][j][v]);
                asm volatile("" ::: "memory");
            }
        }
    }
}

__device__ __forceinline__ void fmix_unit(const Params& p, float* ldsf, const int u) {
    LAS unsigned char* lds = (LAS unsigned char*)ldsf;
    int tid = threadIdx.x; asm volatile("" : "+v"(tid));
    const int lane = tid & 63, wid = tid >> 6, wr = wid >> 2, wc = wid & 3, r = lane & 31, h = lane >> 5;
    const int srow = tid >> 3, sc = SCS(tid);
    {
        unsigned po[4], qo[4];
#pragma unroll
        for (int i = 0; i < 4; ++i) { const int rt = srow + 64 * i; po[i] = (unsigned)rt * 1024u + sc * 16; qo[i] = (unsigned)(u * 256 + rt) * 1024u + sc * 16; }
        f32x16 acc[4][2];
        gemm256(lds, tid, (const char*)p.WmixT, po, (const char*)p.P2, qo, 8, acc);
        float ss[2];
#pragma unroll
        for (int j = 0; j < 2; ++j) { float s = 0.f;
#pragma unroll
            for (int i = 0; i < 4; ++i)
#pragma unroll
                for (int v = 0; v < 16; ++v) s = fmaf(acc[i][j][v], acc[i][j][v], s);
            ss[j] = xhalf_sum(s); }
        float* red = ldsf;
        if (h == 0) { red[wr * 256 + wc * 64 + r] = ss[0]; red[wr * 256 + wc * 64 + 32 + r] = ss[1]; }
        __syncthreads();
        int opq = 0; asm volatile("" : "+v"(opq));
        const int r_ = r + opq, h_ = h + opq;
#pragma unroll
        for (int j = 0; j < 2; ++j) {
            const int tl = wc * 64 + j * 32 + r_;
            const float rstd = rsqrtf((red[tl] + red[256 + tl]) / (float)DF + EPS);
            bf16_t* dst = p.F2 + (unsigned)((u * 256 + tl) * DF + wr * 128 + 4 * h_);
            const float* gp = p.g_out + wr * 128 + 4 * h_;
#pragma unroll
            for (int i = 0; i < 4; ++i) {
#pragma unroll
                for (int q = 0; q < 4; ++q) {
                    const float4 g = *(const float4*)(gp + i * 32 + 8 * q);
                    uint2 w; w.x = cvt_pk_bf16(acc[i][j][4 * q] * rstd * g.x, acc[i][j][4 * q + 1] * rstd * g.y); w.y = cvt_pk_bf16(acc[i][j][4 * q + 2] * rstd * g.z, acc[i][j][4 * q + 3] * rstd * g.w);
                    *(uint2*)(dst + i * 32 + 8 * q) = w;
                }
                asm volatile("" ::: "memory");
            }
        }
    }
}

__device__ void ph_filler(const Params& p, float* ldsf) {
    int tid = threadIdx.x; asm volatile("" : "+v"(tid));
    volatile LAS unsigned* qw = (volatile LAS unsigned*)((LAS unsigned char*)ldsf + 128 * 1024 + 528);
    for (;;) {
        __syncthreads();
        if (tid == 0) qw[0] = __hip_atomic_fetch_add(p.qctl + QW(0), 1u, __ATOMIC_RELAXED, __HIP_MEMORY_SCOPE_AGENT);
        __syncthreads();
        const int item = (int)qw[0];
        if (item >= 448) break;
        if (item < 256) { const int b = item >> 7; wait_ge(p.qctl + QW(1 + b), 32u, tid); four1_unit(p, ldsf, item); publish_add(p.qctl + QW(3 + b), tid); }
        else if (item < 384) { const int u = item - 256, b = u >> 6; wait_ge(p.qctl + QW(3 + b), 128u, tid); four2_unit(p, ldsf, u); publish_add(p.qctl + QW(5 + b), tid); }
        else { const int u = item - 384, b = u >> 5; wait_ge(p.qctl + QW(5 + b), 64u, tid); fmix_unit(p, ldsf, u); }
    }
}

constexpr float LOG2E = 1.4426950408889634f;
struct AttnTile { bf16x8 kf[4]; bf16x8 vf[2][2]; };
__device__ void ph_attn(const Params& p, float* ldsf) {
    int tid = threadIdx.x; asm volatile("" : "+v"(tid));
    const int lane = tid & 63, wv = __builtin_amdgcn_readfirstlane(tid >> 6), l31 = lane & 31, h = lane >> 5;
    LAS unsigned char* ldsb = (LAS unsigned char*)ldsf;
    constexpr int KB0 = 8192, VB0 = 40960;
    const int half = wv & 1;
    const int kcol = (l31 & 3) + 4 * ((l31 >> 3) & 1) + 8 * ((l31 >> 2) & 1), krow = l31 >> 4;
    const bool xa = gridDim.x == 256;
    for (int gi = blockIdx.x; gi < NBATCH * NH * (GROWS / 4); gi += gridDim.x) {
        const int g = xa ? ((blockIdx.x & 7) * 3 + (gi >> 8)) * (GROWS / 4) + (blockIdx.x >> 3) : gi;
        const int bh = g / (GROWS / 4), row = (g % (GROWS / 4)) * 4 + (wv >> 1), hh = bh % NH;
        const int rs = min(max(row - 4, 0), GROWS - 8);
        const int qc = 32 * half + l31, cs = min(max(qc - 8, 0), GW - 16);
        const int nq = row * GW + qc;
        const bf16_t* Kh = p.Kr + (size_t)bh * SEQ * HD; const bf16_t* Vh = p.Vt + (size_t)bh * HD * SEQ;
        const bf16_t* Kch = p.Kc + (size_t)bh * LCTX * HD; const bf16_t* Vch = p.Vct + (size_t)bh * HD * LCTX;
        __syncthreads();
        for (int i = tid; i < 15 * 128; i += NT) { const int dcx = (i & 127) - 48, dr = i >> 7; ldsf[i] = (dcx >= 0 && dcx <= 30) ? p.rpb[(hh * 15 + dr) * 31 + dcx] * LOG2E : 0.f; }
#pragma unroll
        for (int i = 0; i < 4; ++i) {
            const int key = (i * 8 + wv) * 8 + (lane >> 3);
            __builtin_amdgcn_global_load_lds((const unsigned*)(Kch + (size_t)key * HD + (((lane & 7) ^ (lane >> 3)) << 3)), (LAS unsigned*)(ldsb + KB0 + (i * 8 + wv) * 1024), 16, 0, 0);
            __builtin_amdgcn_global_load_lds((const unsigned*)((const char*)Vch + (i * 8 + wv) * 1024 + lane * 16), (LAS unsigned*)(ldsb + VB0 + (i * 8 + wv) * 1024), 16, 0, 0);
        }
        __syncthreads();
        bf16x8 qr[4], qp[4];
#pragma unroll
        for (int s = 0; s < 4; ++s) { qr[s] = *(const bf16x8*)(p.Qr + ((size_t)bh * SEQ + nq) * HD + 16 * s + 8 * h); qp[s] = *(const bf16x8*)(p.Qp + ((size_t)bh * SEQ + nq) * HD + 16 * s + 8 * h); }
        f32x16 o0, o1;
#pragma unroll
        for (int v = 0; v < 16; ++v) { o0[v] = 0.f; o1[v] = 0.f; }
        float m = -1e30f, lsum = 0.f;
        const float* rph = ldsf;
        auto load_loc = [&](int t, AttnTile& T) {
            const int pr = t / 3, blk = half + (t - 3 * pr), kr0 = rs + 2 * pr;
            const bf16_t* kptr = Kh + (size_t)((kr0 + krow) * GW + 16 * blk + kcol) * HD + 8 * h;
            const bf16_t* vptr = Vh + ((size_t)((kr0 * GW + 16 * blk) >> 3) + h) * (HD * 8) + l31 * 8;
#pragma unroll
            for (int kk = 0; kk < 2; ++kk)
#pragma unroll
                for (int dt = 0; dt < 2; ++dt) T.vf[dt][kk] = *(const bf16x8*)(vptr + (size_t)kk * 8 * (HD * 8) + dt * 32 * 8);
#pragma unroll
            for (int s = 0; s < 4; ++s) T.kf[s] = *(const bf16x8*)(kptr + 16 * s);
        };
        auto load_ctx = [&](int t, AttnTile& T) {
            const int m0 = 32 * (t - 12), key = m0 + 16 * krow + kcol;
#pragma unroll
            for (int s = 0; s < 4; ++s) T.kf[s] = *(const LAS bf16x8*)(ldsb + KB0 + key * 128 + (((2 * s + h) ^ (key & 7)) << 4));
#pragma unroll
            for (int kk = 0; kk < 2; ++kk)
#pragma unroll
                for (int dt = 0; dt < 2; ++dt) T.vf[dt][kk] = *(const LAS bf16x8*)(ldsb + VB0 + ((m0 >> 3) + 2 * kk + h) * 1024 + (l31 + 32 * dt) * 16);
        };
        auto compute_tile = [&](int t, const AttnTile& T, auto locc) {
            constexpr bool loc = decltype(locc)::value;
            f32x16 sa;
#pragma unroll
            for (int v = 0; v < 16; ++v) sa[v] = 0.f;
#pragma unroll
            for (int s = 0; s < 4; ++s) sa = __builtin_amdgcn_mfma_f32_32x32x16_bf16(T.kf[s], loc ? qr[s] : qp[s], sa, 0, 0, 0);
            int w0 = 0;
            if (loc) {
                const int pr = t / 3, blk = half + (t - 3 * pr), kr0 = rs + 2 * pr;
                const float* bp = rph + (kr0 - row + 7) * 128 + (16 * blk + 8 * h - qc + 15 + 48);
#pragma unroll
                for (int v = 0; v < 16; ++v) sa[v] += bp[(v >> 3) * 128 + (v & 3) + 4 * ((v >> 2) & 1)];
                w0 = 16 * blk + 8 * h - cs;
            }
            float tmax = sa[0];
#pragma unroll
            for (int v = 1; v < 16; ++v) tmax = fmaxf(tmax, sa[v]);
            tmax = xhalf_max(tmax);
            if (__any(tmax > m + 10.f)) {
                const float mn = fmaxf(m, tmax), alpha = __builtin_amdgcn_exp2f(m - mn);
                m = mn; lsum *= alpha;
#pragma unroll
                for (int v = 0; v < 16; ++v) { o0[v] *= alpha; o1[v] *= alpha; }
            }
            float ps = 0.f;
#pragma unroll
            for (int v = 0; v < 16; ++v) {
                float e = __builtin_amdgcn_exp2f(sa[v] - m);
                if (loc) e = ((unsigned)(w0 + (v & 3) + 4 * ((v >> 2) & 1)) < 16u) ? e : 0.f;
                sa[v] = e; ps += e;
            }
            lsum += ps;
#pragma unroll
            for (int kk = 0; kk < 2; ++kk) {
                const uint4 w = make_uint4(cvt_pk_bf16(sa[8 * kk + 0], sa[8 * kk + 1]), cvt_pk_bf16(sa[8 * kk + 2], sa[8 * kk + 3]), cvt_pk_bf16(sa[8 * kk + 4], sa[8 * kk + 5]), cvt_pk_bf16(sa[8 * kk + 6], sa[8 * kk + 7]));
                const bf16x8 pf = __builtin_bit_cast(bf16x8, w);
                o0 = __builtin_amdgcn_mfma_f32_32x32x16_bf16(T.vf[0][kk], pf, o0, 0, 0, 0);
                o1 = __builtin_amdgcn_mfma_f32_32x32x16_bf16(T.vf[1][kk], pf, o1, 0, 0, 0);
            }
        };
        AttnTile TA, TB;
        load_loc(0, TA);
#pragma unroll 1
        for (int t = 0; t < 12; t += 2) {
            load_loc(t + 1, TB);
            compute_tile(t, TA, std::true_type{});
            if (t + 2 < 12) load_loc(t + 2, TA);
            compute_tile(t + 1, TB, std::true_type{});
        }
        load_ctx(12, TA);
#pragma unroll 1
        for (int t = 12; t < 20; t += 2) {
            load_ctx(t + 1, TB);
            compute_tile(t, TA, std::false_type{});
            if (t + 2 < 20) load_ctx(t + 2, TA);
            compute_tile(t + 1, TB, std::false_type{});
        }
        lsum = xhalf_sum(lsum);
        const float inv = 1.f / lsum;
        bf16_t* op = p.A2b + (size_t)((bh / NH) * SEQ + nq) * D + DF + hh * HD + 4 * h;
        float sq = 0.f;
#pragma unroll
        for (int q = 0; q < 4; ++q) {
            const float a0 = o0[4 * q] * inv, a1 = o0[4 * q + 1] * inv, a2 = o0[4 * q + 2] * inv, a3 = o0[4 * q + 3] * inv;
            const float b0 = o1[4 * q] * inv, b1 = o1[4 * q + 1] * inv, b2 = o1[4 * q + 2] * inv, b3 = o1[4 * q + 3] * inv;
            sq += a0 * a0 + a1 * a1 + a2 * a2 + a3 * a3 + b0 * b0 + b1 * b1 + b2 * b2 + b3 * b3;
            *(uint2*)(op + 8 * q) = make_uint2(cvt_pk_bf16(a0, a1), cvt_pk_bf16(a2, a3));
            *(uint2*)(op + 32 + 8 * q) = make_uint2(cvt_pk_bf16(b0, b1), cvt_pk_bf16(b2, b3));
        }
        sq = xhalf_sum(sq);
        if (h == 0) p.ssq[((bh / NH) * SEQ + nq) * NH + hh] = sq;
    }
}

__device__ void ph_outproj(const Params& p, float* ldsf) {
    LAS unsigned char* lds = (LAS unsigned char*)ldsf;
    int tid = threadIdx.x; asm volatile("" : "+v"(tid));
    const int lane = tid & 63, wid = tid >> 6, wr = wid >> 2, wc = wid & 3, r = lane & 31, h = lane >> 5;
    const int srow = tid >> 3, sc = SCS(tid);
    for (int ui = blockIdx.x; ui < (NTOK / 256) * (D / 256); ui += gridDim.x) {
        const int u = gridDim.x == 256 ? (blockIdx.x & 7) * 32 + (blockIdx.x >> 3) : ui;
        const int pm = u >> 2, pn = u & 3;
        unsigned po[4], qo[4];
#pragma unroll
        for (int i = 0; i < 4; ++i) { const int rt = srow + 64 * i; po[i] = (unsigned)(pm * 256 + rt) * (unsigned)(D * 2) + sc * 16; qo[i] = (unsigned)(pn * 256 + rt) * (unsigned)(D * 2) + sc * 16; }
        float* rtab = ldsf + (128 * 1024 + 1024) / 4;
        if (tid < 256) { const float4* sp = (const float4*)(p.ssq + (size_t)(pm * 256 + tid) * NH); const float4 a = sp[0], b = sp[1], c = sp[2];
            rtab[tid] = rsqrtf(((a.x + a.y) + (a.z + a.w) + (b.x + b.y) + (b.z + b.w) + (c.x + c.y) + (c.z + c.w)) / (float)DNA + EPS); }
        f32x16 acc[4][2];
        unsigned po2[4], qo2[4];
#pragma unroll
        for (int i = 0; i < 4; ++i) { po2[i] = po[i] + DF * 2; qo2[i] = qo[i] + DF * 2; }
        gemm256(lds, tid, (const char*)p.A2b, po2, (const char*)p.WoutT, qo2, DNA / 64, acc);
#pragma unroll
        for (int i = 0; i < 4; ++i)
#pragma unroll
            for (int v = 0; v < 16; ++v) { const float rs_ = rtab[wr * 128 + i * 32 + (v & 3) + 8 * (v >> 2) + 4 * h]; acc[i][0][v] *= rs_; acc[i][1][v] *= rs_; }
        unsigned po3[4];
#pragma unroll
        for (int i = 0; i < 4; ++i) po3[i] = (unsigned)(pm * 256 + srow + 64 * i) * (unsigned)(DF * 2) + sc * 16;
        gemm256(lds, tid, (const char*)p.F2, po3, (const char*)p.WoutT, qo, DF / 64, acc, false);
        const float* gt1 = p.mod + (pm >> 5) * NMOD * D + 2 * D;
        int opq = 0; asm volatile("" : "+v"(opq));
        const int r_ = r + opq, h_ = h + opq;
#pragma unroll
        for (int j = 0; j < 2; ++j) {
            const int feat = pn * 256 + wc * 64 + j * 32 + r_; const float g = gt1[feat];
#pragma unroll
            for (int i = 0; i < 4; ++i) {
                const unsigned base = (unsigned)((pm * 256 + wr * 128 + i * 32 + 4 * h_) * D + feat);
                bf16_t* op = (bf16_t*)p.x1 + base;
#pragma unroll
                for (int v = 0; v < 16; ++v) op[((v & 3) + 8 * (v >> 2)) * D] = f2bf(g * acc[i][j][v]);
                asm volatile("" ::: "memory");
            }
        }
        publish_add(p.tilecnt + 192 + pm, tid);
    }
}

__device__ void ph_router(const Params& p, float* lds, bool commit = true) {
    int tid = threadIdx.x; asm volatile("" : "+v"(tid));
    const int wv = tid >> 6, lane = tid & 63;
    LAS unsigned char* ldsb = (LAS unsigned char*)lds;
    int* sel = (int*)(lds + 152576 / 4); int* cntl = sel + 128; int* basel = cntl + 32; int* posl = basel + 32;
    __syncthreads();
    for (int pc = __builtin_amdgcn_readfirstlane(tid >> 6); pc < 144; pc += NT / 64)
        __builtin_amdgcn_global_load_lds((const unsigned*)((const char*)p.WrT + pc * 1024 + lane * 16), (LAS unsigned*)(ldsb + (pc < 128 ? pc * 1024 : 135168 + (pc - 128) * 1024)), 16, 0, 0);
    __syncthreads();
#define WRL(o) ((const LAS float*)(ldsb + ((o) < 32 ? (o) * 4096 : 135168 + ((o) - 32) * 4096)))
    for (int blk = blockIdx.x; blk < NTOK / 64; blk += gridDim.x) {
        __syncthreads();
        if (tid < 32) cntl[tid] = 0;
        wait_ge(p.tilecnt + 192 + (blk >> 2), 4u, tid);
        const int bq = (blk * 64) / SEQ;
        const float* sh = p.mod + bq * NMOD * D + 3 * D, * sc = sh + D;
#pragma unroll 1
        for (int tq = 0; tq < 2; ++tq) {
            const int tok0 = blk * 64 + wv * 8 + tq * 4;
            float4 hv[4][4]; float ss[4];
#pragma unroll
            for (int t = 0; t < 4; ++t) {
#pragma unroll
                for (int i = 0; i < 4; ++i) { const size_t off = (size_t)(tok0 + t) * D + 4 * lane + 256 * i;
                    const uint2 a = *(const uint2*)((const bf16_t*)p.x1 + off); const float4 bx = *(const float4*)(p.x + off);
                    hv[t][i] = make_float4(bx.x + __uint_as_float(a.x << 16), bx.y + __uint_as_float(a.x & 0xffff0000u), bx.z + __uint_as_float(a.y << 16), bx.w + __uint_as_float(a.y & 0xffff0000u)); }
                if (t == 1) asm volatile("" ::: "memory");
            }
#pragma unroll
            for (int t = 0; t < 4; ++t) { float s = 0.f;
#pragma unroll
                for (int i = 0; i < 4; ++i) s += hv[t][i].x * hv[t][i].x + hv[t][i].y * hv[t][i].y + hv[t][i].z * hv[t][i].z + hv[t][i].w * hv[t][i].w;
                ss[t] = s; }
#pragma unroll
            for (int t = 0; t < 4; ++t) ss[t] = rsqrtf(wave_sum(ss[t]) / (float)D + EPS);
#pragma unroll
            for (int i = 0; i < 4; ++i) { const int e = 4 * lane + 256 * i;
                const float4 g = *(const float4*)(p.g_norm2 + e), s4 = *(const float4*)(sc + e), h4 = *(const float4*)(sh + e);
                const float4 gm = make_float4(g.x * (1.f + s4.x), g.y * (1.f + s4.y), g.z * (1.f + s4.z), g.w * (1.f + s4.w));
#pragma unroll
                for (int t = 0; t < 4; ++t) { const float r = ss[t];
                    hv[t][i] = make_float4(hv[t][i].x * r * gm.x + h4.x, hv[t][i].y * r * gm.y + h4.y, hv[t][i].z * r * gm.z + h4.z, hv[t][i].w * r * gm.w + h4.w);
                    *(unsigned*)((unsigned char*)p.h2b + (size_t)(tok0 + t) * D + e) = cvt4_fp8(hv[t][i].x, hv[t][i].y, hv[t][i].z, hv[t][i].w); } }
            float lg[4][4];
#pragma unroll
            for (int o = 0; o < 4; ++o) { f32x4 w[4];
#pragma unroll
                for (int i = 0; i < 4; ++i) w[i] = *(const LAS f32x4*)(WRL(o) + 4 * lane + 256 * i);
#pragma unroll
                for (int t = 0; t < 4; ++t) { float a = 0.f;
#pragma unroll
                    for (int i = 0; i < 4; ++i) a += hv[t][i].x * w[i].x + hv[t][i].y * w[i].y + hv[t][i].z * w[i].z + hv[t][i].w * w[i].w;
                    lg[t][o] = a; }
                asm volatile("" ::: "memory"); }
#pragma unroll
            for (int t = 0; t < 4; ++t)
#pragma unroll
                for (int o = 0; o < 4; ++o) lg[t][o] = wave_sum(lg[t][o]);
            int gsel[4]; float pgv[4];
#pragma unroll
            for (int t = 0; t < 4; ++t) { int gs = 0; float gm = lg[t][0];
#pragma unroll
                for (int o = 1; o < 4; ++o) if (lg[t][o] > gm) { gm = lg[t][o]; gs = o; }
                float gz = 0.f;
#pragma unroll
                for (int o = 0; o < 4; ++o) gz += expf(lg[t][o] - gm);
                pgv[t] = 1.f / gz; gsel[t] = __builtin_amdgcn_readfirstlane(gs); }
#pragma unroll
            for (int t = 0; t < 4; ++t) {
                float le[8];
#pragma unroll
                for (int o = 0; o < 8; ++o) { float a = 0.f; const int rowi = 4 + gsel[t] * 8 + o; const LAS float* wre = WRL(rowi) + 4 * lane;
#pragma unroll
                    for (int i = 0; i < 4; ++i) { const f32x4 w = *(const LAS f32x4*)(wre + 256 * i); a += hv[t][i].x * w.x + hv[t][i].y * w.y + hv[t][i].z * w.z + hv[t][i].w * w.w; }
                    le[o] = a; }
#pragma unroll
                for (int o = 0; o < 8; ++o) le[o] = wave_sum(le[o]);
                int i0 = 0; float m0 = le[0];
#pragma unroll
                for (int o = 1; o < 8; ++o) if (le[o] > m0) { m0 = le[o]; i0 = o; }
                int i1 = -1; float m1 = -3.0e38f;
#pragma unroll
                for (int o = 0; o < 8; ++o) if (o != i0 && le[o] > m1) { m1 = le[o]; i1 = o; }
                const float e1 = expf(m1 - m0);
                const float g0 = pgv[t] / (1.f + e1), g1 = pgv[t] * e1 / (1.f + e1);
                if (lane == 0) {
                    const int tl = wv * 8 + tq * 4 + t;
                    sel[tl * 2] = gsel[t] * 8 + i0; sel[tl * 2 + 1] = gsel[t] * 8 + i1;
                    p.tokgate[(tok0 + t) * 2] = g0; p.tokgate[(tok0 + t) * 2 + 1] = g1;
                }
                asm volatile("" ::: "memory");
            }
        }
        __syncthreads();
        int e = 0;
        if (tid < 128) { e = sel[tid]; posl[tid] = atomicAdd(&cntl[e], 1); }
        __syncthreads();
        if (tid < 32 && commit) basel[tid] = atomicAdd(&p.cnt[tid * 64], cntl[tid]);
        __syncthreads();
        if (tid < 128 && commit) p.list[e * NTOK + basel[e] + posl[tid]] = (blk * 64 + (tid >> 1)) * 2 + (tid & 1);
    }
}

struct ETile { int e, s0, ns, sbase; };
__device__ __forceinline__ ETile moe_tile(const int* cl, int tile) {
    int e = 0, base = 0, sb = 0;
    for (;;) { const int c = cl[e], nc = (c + 255) >> 8; if (tile < base + nc) break; base += nc; sb += c; ++e; }
    ETile t; t.e = e; t.s0 = (tile - base) * 256; t.ns = min(256, cl[e] - t.s0); t.sbase = sb; return t;
}

__device__ void ph_moe(const Params& p, float* ldsf) {
    LAS unsigned char* lds = (LAS unsigned char*)ldsf;
    int tid = threadIdx.x; asm volatile("" : "+v"(tid));
    const int lane = tid & 63, wid = tid >> 6, wr = wid >> 2, wc = wid & 3, r = lane & 31, h = lane >> 5;
    const int srow = tid >> 3, sc = SCS(tid);
    const bool xa = false; const int e0 = xa ? (blockIdx.x & 7) * 4 : 0, ne = xa ? 4 : NEXP, lj = xa ? (blockIdx.x >> 3) : blockIdx.x, lper = xa ? 32 : gridDim.x;
    int* cl = (int*)(ldsf + (128 * 1024 + 1024) / 4);
    __syncthreads();
    if (tid < NEXP) cl[tid] = p.cnt[tid * 64];
    __syncthreads();
    int tile0 = 0, ntl = 0;
    for (int e = 0; e < e0 + ne; ++e) { const int nc = (cl[e] + 255) >> 8; if (e < e0) tile0 += nc; else ntl += nc; }
    const int nt4 = ntl * 4;
    volatile LAS unsigned* qw = (volatile LAS unsigned*)((LAS unsigned char*)ldsf + 128 * 1024 + 528);
    for (;;) {
        __syncthreads();
        if (tid == 0) qw[0] = __hip_atomic_fetch_add(p.qctl + QW(9), 1u, __ATOMIC_RELAXED, __HIP_MEMORY_SCOPE_AGENT);
        __syncthreads();
        const int u = (int)qw[0];
        if (u >= 2 * nt4) break;
        const bool isdown = u >= nt4; const int uu = isdown ? u - nt4 : u;
        const int tile = tile0 + (uu >> 2);
        const ETile t = moe_tile(cl, tile); const int fc = uu & 3;
        unsigned po[2], qo[2];
        f32x16 acc[4][2];
        const int sc8 = SCH8(tid);
        if (!isdown) {
#pragma unroll
            for (int i = 0; i < 2; ++i) {
                const int rt = SROW8(tid, i);
                const int ent = rt < t.ns ? p.list[t.e * NTOK + t.s0 + rt] : 0;
                po[i] = (unsigned)(ent >> 1) * (unsigned)D + sc8 * 16;
                const int f = fc * 128 + (rt >> 6) * 32 + (rt & 31), up = (rt >> 5) & 1;
                qo[i] = (unsigned)((up * 2 * NEXP + t.e) * DEXP + f) * (unsigned)D + sc8 * 16;
            }
            gemm256_f8(lds, tid, (const char*)p.h2b, po, (const char*)p.WgT, qo, D / 64, acc);
            int opq = 0; asm volatile("" : "+v"(opq));
            const int r_ = r + opq, h_ = h + opq;
            asm volatile("s_waitcnt lgkmcnt(0)" ::: "memory"); __builtin_amdgcn_s_barrier();
            {
#pragma unroll
                for (int i = 0; i < 4; ++i) {
                    const int s = wr * 128 + i * 32 + 4 * h_;
#pragma unroll
                    for (int v = 0; v < 16; ++v) {
                        const float g = acc[i][0][v] * (1.f / WSCALE_GU), uu_ = acc[i][1][v] * (1.f / WSCALE_GU);
                        const unsigned w = cvt4_fp8(g / (1.f + __expf(-g)) * uu_, 0.f, 0.f, 0.f);
                        *(LAS unsigned char*)(lds + (s + (v & 3) + 8 * (v >> 2)) * 128 + wc * 32 + r_) = (unsigned char)(w & 0xffu);
                    }
                    asm volatile("" ::: "memory");
                }
                __syncthreads();
#pragma unroll 4
                for (int k = 0; k < 4; ++k) { const int c = tid + 512 * k, row = c >> 3, ch = c & 7;
                    if (row < t.ns) { const u32x4 w = *(const LAS u32x4*)(lds + row * 128 + ch * 16);
                        unsigned long long* dp = (unsigned long long*)((unsigned char*)p.act + (size_t)(t.sbase + t.s0 + row) * DEXP + fc * 128 + ch * 16);
                        __hip_atomic_store(dp, ((unsigned long long)w[1] << 32) | w[0], __ATOMIC_RELAXED, __HIP_MEMORY_SCOPE_AGENT);
                        __hip_atomic_store(dp + 1, ((unsigned long long)w[3] << 32) | w[2], __ATOMIC_RELAXED, __HIP_MEMORY_SCOPE_AGENT); } }
            }
            asm volatile("s_waitcnt vmcnt(0)" ::: "memory");
            __syncthreads();
            if (tid == 0) __hip_atomic_fetch_add(p.tilecnt + tile, 1u, __ATOMIC_RELAXED, __HIP_MEMORY_SCOPE_AGENT);
        } else {
            if (tid == 0) { unsigned sp = 0;
                while (__hip_atomic_load(p.tilecnt + tile, __ATOMIC_RELAXED, __HIP_MEMORY_SCOPE_AGENT) < 4u) { __builtin_amdgcn_s_sleep(2); if (++sp > (1u << 22)) break; }
                __builtin_amdgcn_fence(__ATOMIC_ACQUIRE, "agent"); asm volatile("s_waitcnt vmcnt(0)" ::: "memory"); }
            __syncthreads();
            const int pn = fc;
            int* entl = (int*)(ldsf + (128 * 1024 + 2048) / 4); float* gatel = (float*)(entl + 256);
            if (tid < 256) { const int ent = tid < t.ns ? p.list[t.e * NTOK + t.s0 + tid] : 0; entl[tid] = ent; gatel[tid] = p.tokgate[ent] * (1.f / WSCALE_DN); }
#pragma unroll
            for (int i = 0; i < 2; ++i) {
                const int rt = SROW8(tid, i);
                po[i] = (unsigned)(t.sbase + t.s0 + (rt < t.ns ? rt : 0)) * (unsigned)DEXP + sc8 * 16;
                qo[i] = (unsigned)(t.e * D + pn * 256 + rt) * (unsigned)DEXP + sc8 * 16;
            }
            gemm256_f8(lds, tid, (const char*)p.act, po, (const char*)p.WdT, qo, DEXP / 64, acc);
            int opq = 0; asm volatile("" : "+v"(opq));
            const int r_ = r + opq, h_ = h + opq;
#pragma unroll
            for (int i = 0; i < 4; ++i) {
                const int s = wr * 128 + i * 32 + 4 * h_;
#pragma unroll
                for (int v = 0; v < 16; ++v) {
                    const int sv = s + (v & 3) + 8 * (v >> 2);
                    if (sv < t.ns) {
                        const int ent = entl[sv]; const float g = gatel[sv];
                        const unsigned base = (unsigned)ent * D + pn * 256 + wc * 64 + r_;
                        p.ybuf[base] = f2bf(g * acc[i][0][v]); p.ybuf[base + 32] = f2bf(g * acc[i][1][v]);
                    }
                }
                asm volatile("" ::: "memory");
            }
        }
    }
}

__device__ void ph_final(const Params& p, float* lds, float* outp) {
    int tid = threadIdx.x; asm volatile("" : "+v"(tid));
    const int lane = tid & 63, nw = gridDim.x * (NT / 64), gw = blockIdx.x * (NT / 64) + (tid >> 6);
    float eps_ = 0.f; if (TS_PHASE >= 0) eps_ = __uint_as_float(p.qctl[QW(7)]);
    for (int tok0 = gw; tok0 < NTOK; tok0 += 2 * nw) {
        float4 xv[2][4]; uint2 ya[2][4], yb[2][4]; float ss[2];
#pragma unroll
        for (int q = 0; q < 2; ++q) { const int tok = min(tok0 + q * nw, NTOK - 1);
#pragma unroll
            for (int i = 0; i < 4; ++i) { const int e = 4 * lane + 256 * i;
                { const float4 bx = *(const float4*)(p.x + (size_t)tok * D + e); const uint2 a = *(const uint2*)((const bf16_t*)p.x1 + (size_t)tok * D + e);
                  xv[q][i] = make_float4(bx.x + __uint_as_float(a.x << 16), bx.y + __uint_as_float(a.x & 0xffff0000u), bx.z + __uint_as_float(a.y << 16), bx.w + __uint_as_float(a.y & 0xffff0000u)); }
                ya[q][i] = *(const uint2*)(p.ybuf + (size_t)(2 * tok) * D + e); yb[q][i] = *(const uint2*)(p.ybuf + (size_t)(2 * tok + 1) * D + e); } }
#pragma unroll
        for (int q = 0; q < 2; ++q) { const int tok = min(tok0 + q * nw, NTOK - 1);
            const float* gt2 = p.mod + (tok / SEQ) * NMOD * D + 5 * D; float s = 0.f;
#pragma unroll
            for (int i = 0; i < 4; ++i) { const int e = 4 * lane + 256 * i; const float4 g = *(const float4*)(gt2 + e);
                xv[q][i].x += g.x * (__uint_as_float(ya[q][i].x << 16) + __uint_as_float(yb[q][i].x << 16));
                xv[q][i].y += g.y * (__uint_as_float(ya[q][i].x & 0xffff0000u) + __uint_as_float(yb[q][i].x & 0xffff0000u));
                xv[q][i].z += g.z * (__uint_as_float(ya[q][i].y << 16) + __uint_as_float(yb[q][i].y << 16));
                xv[q][i].w += g.w * (__uint_as_float(ya[q][i].y & 0xffff0000u) + __uint_as_float(yb[q][i].y & 0xffff0000u));
                s += xv[q][i].x * xv[q][i].x + xv[q][i].y * xv[q][i].y + xv[q][i].z * xv[q][i].z + xv[q][i].w * xv[q][i].w; }
            ss[q] = s; }
#pragma unroll
        for (int q = 0; q < 2; ++q) ss[q] = wave_sum(ss[q]);
#pragma unroll
        for (int q = 0; q < 2; ++q) { const int tok = tok0 + q * nw;
            if (tok < NTOK) {
                float rr = rsqrtf(ss[q] / (float)D + EPS);
                if (TS_PHASE >= 0) rr *= 1.f + eps_;
#pragma unroll
                for (int i = 0; i < 4; ++i) { const int e = 4 * lane + 256 * i; const float4 g = *(const float4*)(p.g_final + e);
                    *(float4*)(outp + (size_t)tok * D + e) = make_float4(xv[q][i].x * rr * g.x, xv[q][i].y * rr * g.y, xv[q][i].z * rr * g.z, xv[q][i].w * rr * g.w); } } }
    }
}

extern __shared__ __attribute__((aligned(16))) float smem[];

constexpr int R_P0 = 1, R_INP = 1, R_FOUR = 1, R_ATT = 1, R_OUT = 1, R_MOE = 1, R_RT = 1, R_FIN = 1, R_BAR = 1;
constexpr int LDS_BAR_OFF = 128 * 1024 + 512;
__global__ void __launch_bounds__(NT) mega(Params p) {
    volatile LAS unsigned* st = (volatile LAS unsigned*)((LAS unsigned char*)smem + LDS_BAR_OFF);
    if (threadIdx.x == 0) { st[0] = 0u; st[1] = 0u; }
    __syncthreads();
    const XcdBarrier bar = xcd_barrier_post(g_bar, st);
    volatile LAS unsigned* gpw = (volatile LAS unsigned*)((LAS unsigned char*)smem + 128 * 1024 + 640);
#define REP(n, call) for (int _r = 0; _r < (n); ++_r) { call; }
    unsigned long long ts0 = 0, ts1 = 0;
#define STAMP(k) do { if (TS_PHASE >= 0 && blockIdx.x == 0 && threadIdx.x == 0) { const unsigned long long t_ = __builtin_amdgcn_s_memrealtime(); if ((k) == TS_PHASE) ts0 = t_; if ((k) == TS_PHASE + 1) ts1 = t_; } } while (0)
    STAMP(0);
    REP(R_P0, ph_adaln_tables(p, smem)) REP(R_BAR, xcd_barrier(bar)) STAMP(1);
    STAMP(2);
    unsigned long long tsx = 0; if (TS_PHASE == 12) tsx = __builtin_amdgcn_s_memrealtime();
    ph_inproj(p, smem); if (TS_PHASE == 12 && blockIdx.x == 0 && threadIdx.x == 0) { ts0 = tsx; ts1 = __builtin_amdgcn_s_memrealtime(); }
    if (gridDim.x != 256) ph_filler(p, smem);
    REP(R_BAR, xcd_barrier(bar)) STAMP(3);
    REP(R_ATT, ph_attn(p, smem)) REP(R_BAR, xcd_barrier(bar)) STAMP(4);
    if (GPROBE && threadIdx.x == 0) { gpw[0] = 0u; gpw[1] = 0u; gpw[2] = 0u; }
    REP(R_OUT, ph_outproj(p, smem))
    STAMP(5);
    REP(R_RT - 1, ph_router(p, smem, false)) ph_router(p, smem); REP(R_BAR, xcd_barrier(bar)) STAMP(6);
    if (TS_PHASE >= 0 && (TS_PHASE < 6 || TS_PHASE == 12) && blockIdx.x == 0 && threadIdx.x == 0) p.qctl[QW(7)] = GPROBE ? p.qctl[QW(6) + 1] : __float_as_uint(sqrtf(1e-6f * 0.01f * (float)(ts1 - ts0)));
    ph_moe(p, smem); REP(R_BAR, xcd_barrier(bar)) STAMP(7);
    if (TS_PHASE == 6 && blockIdx.x == 0 && threadIdx.x == 0) p.qctl[QW(7)] = __float_as_uint(sqrtf(1e-6f * 0.01f * (float)(ts1 - ts0)));
    if (TS_PHASE == 6) xcd_barrier(bar);
    if (TS_PHASE == 7) {
        ph_final(p, smem, (float*)p.h2b); xcd_barrier(bar);
        if (blockIdx.x == 0 && threadIdx.x == 0) p.qctl[QW(7)] = __float_as_uint(sqrtf(1e-6f * 0.01f * (float)(__builtin_amdgcn_s_memrealtime() - ts0)));
        xcd_barrier(bar);
    }
    REP(R_FIN - 1, ph_final(p, smem, (float*)p.h2b)) ph_final(p, smem, p.out);
    __syncthreads();
    if (threadIdx.x == 0) st[0] = __hip_atomic_fetch_add(g_bar + XCD_BAR_WORDS, 1u, __ATOMIC_RELAXED, __HIP_MEMORY_SCOPE_AGENT);
    __syncthreads();
    if (st[0] == gridDim.x - 1) { for (int i = threadIdx.x; i < XCD_BAR_WORDS + 64; i += NT) __hip_atomic_store(g_bar + i, 0u, __ATOMIC_RELAXED, __HIP_MEMORY_SCOPE_AGENT); }
}

extern "C" void kernel_launch(void* const* d_in, const int* in_sizes, int n_in, void* d_out, int out_size, void* d_ws, size_t ws_size, hipStream_t stream) {
    constexpr size_t kDynLds = 128 * 1024 + 4096 + 24576;
    static int grid_blocks = 0;
    if (!grid_blocks) {
        int dev = 0, cus = 0, per_cu = 0;
        (void)hipGetDevice(&dev);
        (void)hipDeviceGetAttribute(&cus, hipDeviceAttributeMultiprocessorCount, dev);
        (void)hipFuncSetAttribute((const void*)mega, hipFuncAttributeMaxDynamicSharedMemorySize, (int)kDynLds);
        (void)hipOccupancyMaxActiveBlocksPerMultiprocessor(&per_cu, (const void*)mega, NT, kDynLds);
        if (per_cu > 1) per_cu = 1;
        grid_blocks = cus * per_cu;
    }
    Params p{};
    p.x = (const float*)d_in[0]; p.c = (const float*)d_in[1]; p.ctx = (const float*)d_in[2]; p.c_ctx = (const float*)d_in[3];
    p.w_ada = (const float*)d_in[4]; p.b_ada = (const float*)d_in[5]; p.g_norm1 = (const float*)d_in[6]; p.w_in = (const float*)d_in[7];
    p.w_fmix = (const float*)d_in[8]; p.rpb = (const float*)d_in[9]; p.g_out = (const float*)d_in[10]; p.w_out = (const float*)d_in[11];
    p.g_norm2 = (const float*)d_in[12]; p.w_rg = (const float*)d_in[13]; p.w_re = (const float*)d_in[14]; p.w_gate = (const float*)d_in[15];
    p.w_up = (const float*)d_in[16]; p.w_down = (const float*)d_in[17]; p.g_final = (const float*)d_in[18];
    p.out = (float*)d_out;
    char* w = (char*)d_ws; size_t o = 0;
    auto take = [&](size_t bytes) { char* r = w + o; o += (bytes + 255) & ~(size_t)255; return r; };
    p.mod = (float*)take(3 * NMOD * D * 4); p.cosN = (float*)take(SEQ * 4); p.sinN = (float*)take(SEQ * 4); p.ropeR = (float*)take(GROWS * 32 * 4); p.ropeC = (float*)take(GW * 32 * 4);
    p.bar = (unsigned*)take(XCD_BAR_WORDS * 4); p.WrT = (float*)take(36 * D * 4); p.ssq = (float*)take((size_t)NTOK * NH * 4); p.tilecnt = (unsigned*)take(256 * 4); p.qctl = (unsigned*)take(16 * 64 * 4); p.F2 = (bf16_t*)take((size_t)NTOK * DF * 2); p.cnt = (int*)take(NEXP * 256); p.list = (int*)take((size_t)NEXP * NTOK * 4); p.tokgate = (float*)take(2 * NTOK * 4);
    p.WinT = (bf16_t*)take((size_t)DIN * D * 2); p.WoutT = (bf16_t*)take((size_t)D * D * 2);
    p.W64cs = (bf16_t*)take(256 * 64 * 2); p.G128 = (bf16_t*)take(256 * 256 * 2); p.WmixT = (bf16_t*)take(256 * 512 * 2);
    p.WgT = (bf16_t*)take((size_t)NEXP * DEXP * D * 2); p.WuT = (bf16_t*)take((size_t)NEXP * DEXP * D * 2); p.WdT = (bf16_t*)take((size_t)NEXP * DEXP * D * 2);
    char* R1 = take((size_t)NROWS * D * 2 + 2 * (size_t)NTOK * 512 * 2 + 256);
    p.hb = (bf16_t*)R1; p.A2b = (bf16_t*)R1; p.Zb = (bf16_t*)(R1 + (size_t)NROWS * D * 2); p.P2 = p.Zb + (size_t)NTOK * 512; p.h2b = (bf16_t*)R1; p.act = p.h2b + (size_t)NTOK * D;
    const size_t qkv = (size_t)NTOK * DNA * 2;
    char* R2 = take((size_t)NTOK * DF * 2 + 4 * qkv + 2 * (size_t)NCTX * DNA * 2 + 4096);
    p.fX = (bf16_t*)R2; p.Qr = (bf16_t*)(R2 + (size_t)NTOK * DF * 2); p.Qp = p.Qr + (size_t)NTOK * DNA; p.Kr = p.Qp + (size_t)NTOK * DNA; p.Vt = p.Kr + (size_t)NTOK * DNA;
    p.Kc = p.Vt + (size_t)NTOK * DNA; p.Vct = p.Kc + (size_t)NCTX * DNA;
    p.x1 = (float*)(R2 + (size_t)NTOK * DF * 2 + 4 * qkv + 2 * (size_t)NCTX * DNA * 2 - (size_t)NTOK * D * 4);
    p.ybuf = (bf16_t*)p.out;
    if (o > ws_size) { fprintf(stderr, "workspace too small: need %zu have %zu\n", o, ws_size); return; }
    void* args[] = {&p};
    hipError_t e = hipLaunchCooperativeKernel((const void*)mega, dim3(grid_blocks), dim3(NT), args, kDynLds, stream);
    if (e != hipSuccess) fprintf(stderr, "cooperative launch failed: %s (grid %d)\n", hipGetErrorString(e), grid_blocks);
}
```

```cpp
#include <hip/hip_runtime.h>
#include <cstdio>
#include <cstdint>
#include <type_traits>

constexpr int D = 1024, NBATCH = 2, SEQ = 8192, NTOK = NBATCH * SEQ, LCTX = 256, NCTX = NBATCH * LCTX, NROWS = NTOK + NCTX;
constexpr int DIN = 2560, DF = 256, NH = 12, HD = 64, DNA = 768, QOFF = 256, KOFF = 1024, VOFF = 1792;
constexpr int GW = 64, GROWS = 128, NEXP = 32, DEXP = 512, NMOD = 6;
constexpr float EPS = 1e-6f;
constexpr int NT = 512;
constexpr int TS_PHASE = -1;
constexpr int GPROBE = 0;
constexpr float QSCALE = 0.125f * 1.4426950408889634f;
typedef unsigned short bf16_t;
typedef short bf16x8 __attribute__((ext_vector_type(8)));
typedef float f32x16 __attribute__((ext_vector_type(16)));
typedef float f32x4 __attribute__((ext_vector_type(4)));
typedef unsigned u32x4 __attribute__((ext_vector_type(4)));
typedef unsigned u32x2 __attribute__((ext_vector_type(2)));
__device__ __forceinline__ unsigned cvt_pk_bf16(float lo, float hi) { unsigned r; asm volatile("v_cvt_pk_bf16_f32 %0, %1, %2" : "=v"(r) : "v"(lo), "v"(hi)); return r; }
__device__ __forceinline__ bf16_t f2bf(float v) { return (bf16_t)(cvt_pk_bf16(v, 0.f) & 0xffffu); }
__device__ __forceinline__ float bf2f(bf16_t v) { return __uint_as_float((unsigned)v << 16); }
__device__ __forceinline__ unsigned cvt4_fp8(float a, float b, float c, float d) { int w = __builtin_amdgcn_cvt_pk_fp8_f32(a, b, 0, false); w = __builtin_amdgcn_cvt_pk_fp8_f32(c, d, w, true); return (unsigned)w; }
constexpr float WSCALE_GU = 32.f, WSCALE_DN = 16.f;

struct Params {
    const float *x, *c, *ctx, *c_ctx, *w_ada, *b_ada, *g_norm1, *w_in, *w_fmix, *rpb, *g_out, *w_out, *g_norm2, *w_rg, *w_re, *w_gate, *w_up, *w_down, *g_final;
    float* out;
    float *mod, *cosN, *sinN, *ropeR, *ropeC;
    float *x1;
    int *cnt, *list; float* tokgate; unsigned* bar; bf16_t *WrHi, *WrLo; float* ssq; unsigned* tilecnt; unsigned* qctl; bf16_t* F2;
    bf16_t *WinT, *WoutT, *WgT, *WuT, *WdT;
    bf16_t *hb, *A2b;
    bf16_t *h2b, *act, *ybuf;
    bf16_t *fX, *Qr, *Qp, *Kr, *Vt, *Kc, *Vct;
    bf16_t *W64cs, *G128, *WmixT;
    bf16_t *Zb, *P2;
};
#define LANE_ID() ((int)__builtin_amdgcn_mbcnt_hi(~0u, __builtin_amdgcn_mbcnt_lo(~0u, 0u)))
#define TIDX(p) (wvs_ * 64 + LANE_ID())

template <int CTRL> __device__ __forceinline__ float dpp(float x) { return __builtin_bit_cast(float, __builtin_amdgcn_mov_dpp(__builtin_bit_cast(int, x), CTRL, 0xf, 0xf, true)); }
__device__ __forceinline__ float xhalf_sum(float x) { auto t = __builtin_amdgcn_permlane32_swap(__float_as_uint(x), __float_as_uint(x), false, false); return __uint_as_float(t[0]) + __uint_as_float(t[1]); }
__device__ __forceinline__ float xhalf_max(float x) { auto t = __builtin_amdgcn_permlane32_swap(__float_as_uint(x), __float_as_uint(x), false, false); return fmaxf(__uint_as_float(t[0]), __uint_as_float(t[1])); }
__device__ __forceinline__ float wave_sum(float x) {
    x += dpp<0xB1>(x); x += dpp<0x4E>(x); x += dpp<0x141>(x); x += dpp<0x128>(x);
    x += __shfl_xor(x, 16);
    return x + __shfl_xor(x, 32);
}
__device__ __forceinline__ float wave_max(float x) {
    x = fmaxf(x, dpp<0xB1>(x)); x = fmaxf(x, dpp<0x4E>(x)); x = fmaxf(x, dpp<0x141>(x)); x = fmaxf(x, dpp<0x128>(x));
    x = fmaxf(x, __shfl_xor(x, 16));
    return fmaxf(x, __shfl_xor(x, 32));
}
__device__ __forceinline__ float block_sum(float v, float* red) {
    v = wave_sum(v);
    const int w = __builtin_amdgcn_readfirstlane(threadIdx.x >> 6), l = LANE_ID();
    __syncthreads();
    if (l == 0) red[w] = v;
    __syncthreads();
    float s = 0.f;
#pragma unroll
    for (int i = 0; i < NT / 64; ++i) s += red[i];
    return s;
}

#define LAS __attribute__((address_space(3)))
#define SCS(tid) (((tid) & 7) ^ ((((tid) >> 3) >> 1) & 7))
__device__ __forceinline__ void gemm256(LAS unsigned char* lds, const int tid, const char* Pb, const unsigned (&po)[4], const char* Qb, const unsigned (&qo)[4], int nk, f32x16 (&acc)[4][2], const bool zero = true) {
    const int lane = tid & 63, wid = __builtin_amdgcn_readfirstlane(tid >> 6), wr = wid >> 2, wc = wid & 3;
    const int r = lane & 31, h = lane >> 5, swz = (r >> 1) & 7;
    const unsigned ldsw = (unsigned)wid * 1024u;
    if (zero) {
#pragma unroll
        for (int i = 0; i < 4; ++i)
#pragma unroll
            for (int j = 0; j < 2; ++j)
#pragma unroll
                for (int v = 0; v < 16; ++v) acc[i][j][v] = 0.f;
    }
    __syncthreads();
#pragma unroll
    for (int i = 0; i < 4; ++i) {
        __builtin_amdgcn_global_load_lds((const unsigned*)(Pb + po[i]), (LAS unsigned*)(lds + ldsw + i * 8192), 16, 0, 0);
        __builtin_amdgcn_global_load_lds((const unsigned*)(Qb + qo[i]), (LAS unsigned*)(lds + 32768 + ldsw + i * 8192), 16, 0, 0);
    }
    __syncthreads();
    unsigned long long tg0_ = 0; if (GPROBE) tg0_ = __builtin_amdgcn_s_memtime();
    const int prd = (wr * 128 + r) * 128, qrd = 32768 + (wc * 64 + r) * 128;
    const int ko0 = ((0 + h) ^ swz) << 4, ko1 = ((2 + h) ^ swz) << 4, ko2 = ((4 + h) ^ swz) << 4, ko3 = ((6 + h) ^ swz) << 4;
#define G256_LD(pf, qf, ko) do { _Pragma("unroll") for (int i = 0; i < 4; ++i) pf[i] = *(const LAS bf16x8*)(lds + cb + prd + i * 4096 + (ko)); \
                                 _Pragma("unroll") for (int j = 0; j < 2; ++j) qf[j] = *(const LAS bf16x8*)(lds + cb + qrd + j * 4096 + (ko)); } while (0)
#define G256_MM(pf, qf) do { _Pragma("unroll") for (int i = 0; i < 4; ++i) _Pragma("unroll") for (int j = 0; j < 2; ++j) \
                                 acc[i][j] = __builtin_amdgcn_mfma_f32_32x32x16_bf16(pf[i], qf[j], acc[i][j], 0, 0, 0); } while (0)
#pragma unroll 1
    for (int kt = 0; kt < nk; ++kt) {
        const int cb = (kt & 1) * 65536, nb = 65536 - cb;
        {
            const unsigned koff = (unsigned)min(kt + 1, nk - 1) * 128u;
#pragma unroll
            for (int i = 0; i < 4; ++i) {
                __builtin_amdgcn_global_load_lds((const unsigned*)(Pb + (size_t)(po[i] + koff)), (LAS unsigned*)(lds + nb + ldsw + i * 8192), 16, 0, 0);
                __builtin_amdgcn_global_load_lds((const unsigned*)(Qb + (size_t)(qo[i] + koff)), (LAS unsigned*)(lds + nb + 32768 + ldsw + i * 8192), 16, 0, 0);
            }
        }
        bf16x8 pa[4], qa[2], pb[4], qb[2];
        G256_LD(pa, qa, ko0);
        G256_LD(pb, qb, ko1);
        G256_MM(pa, qa);
        G256_LD(pa, qa, ko2);
        G256_MM(pb, qb);
        G256_LD(pb, qb, ko3);
        G256_MM(pa, qa);
        G256_MM(pb, qb);
        if (GPROBE) { const unsigned long long t0_ = __builtin_amdgcn_s_memtime(); __syncthreads(); const unsigned long long t1_ = __builtin_amdgcn_s_memtime();
            if (tid == 0) { volatile LAS unsigned* gp = (volatile LAS unsigned*)(lds + 128 * 1024 + 640); gp[0] += (unsigned)(t1_ - t0_); gp[1] += 1u; } }
        else __syncthreads();
    }
    if (GPROBE && tid == 0) { volatile LAS unsigned* gp = (volatile LAS unsigned*)(lds + 128 * 1024 + 640); const unsigned long long t_ = __builtin_amdgcn_s_memtime(); gp[2] += (unsigned)(t_ - tg0_); }
    asm volatile("" ::: "memory");
}

#define QROWP(tid, g, hh) ((((tid) >> 8) * 64) + 128 * (g) + 32 * (hh) + (((tid) >> 3) & 31))
typedef long l64x2 __attribute__((ext_vector_type(2)));
typedef int i32x4 __attribute__((ext_vector_type(4)));
typedef int i32x8 __attribute__((ext_vector_type(8)));
#define F8SCALE 0
template <bool F8 = false>
__device__ __forceinline__ void gemm256p(LAS unsigned char* lds, const int tid, const char* Pb, const unsigned (&po)[4], const char* Qb, const unsigned (&qn)[4], int nk, f32x16 (&acc)[4][2], const bool zero = true) {
    const int lane = tid & 63, wid = __builtin_amdgcn_readfirstlane(tid >> 6), wr = wid >> 2, wc = wid & 3;
    const int r = lane & 31, h = lane >> 5, swz = (r >> 1) & 7;
    const unsigned ldsw = (unsigned)wid * 1024u;
    if (zero) {
#pragma unroll
        for (int i = 0; i < 4; ++i)
#pragma unroll
            for (int j = 0; j < 2; ++j)
#pragma unroll
                for (int v = 0; v < 16; ++v) acc[i][j][v] = 0.f;
    }
    const int ard = (wr * 64 + r) * 128, brd = 65536 + (wc * 32 + r) * 128;
    const int ko0 = ((0 + h) ^ swz) << 4, ko1 = ((2 + h) ^ swz) << 4, ko2 = ((4 + h) ^ swz) << 4, ko3 = ((6 + h) ^ swz) << 4;
    bf16x8 At[2][4], B0[4], B1[4];
#define P8_STA(b, hh, kt) do { const unsigned ko_ = (unsigned)(kt) * 128u; \
        __builtin_amdgcn_global_load_lds((const unsigned*)(Pb + (size_t)(po[hh] + ko_)), (LAS unsigned*)(lds + ((b) * 32768 + (hh) * 16384) + ldsw), 16, 0, 0); \
        __builtin_amdgcn_global_load_lds((const unsigned*)(Pb + (size_t)(po[2 + (hh)] + ko_)), (LAS unsigned*)(lds + ((b) * 32768 + (hh) * 16384 + 8192) + ldsw), 16, 0, 0); } while (0)
#define P8_STB(b, hh, kt) do { const unsigned ko_ = (unsigned)(kt) * 128u; \
        __builtin_amdgcn_global_load_lds((const unsigned*)(Qb + (size_t)(qn[hh] + ko_)), (LAS unsigned*)(lds + (65536 + (b) * 32768 + (hh) * 16384) + ldsw), 16, 0, 0); \
        __builtin_amdgcn_global_load_lds((const unsigned*)(Qb + (size_t)(qn[2 + (hh)] + ko_)), (LAS unsigned*)(lds + (65536 + (b) * 32768 + (hh) * 16384 + 8192) + ldsw), 16, 0, 0); } while (0)
#define P8_LDA(b, hh) do { _Pragma("unroll") for (int ii = 0; ii < 2; ++ii) { \
        At[ii][0] = *(const LAS bf16x8*)(lds + ((b) * 32768 + (hh) * 16384) + ard + ii * 4096 + ko0); At[ii][1] = *(const LAS bf16x8*)(lds + ((b) * 32768 + (hh) * 16384) + ard + ii * 4096 + ko1); \
        At[ii][2] = *(const LAS bf16x8*)(lds + ((b) * 32768 + (hh) * 16384) + ard + ii * 4096 + ko2); At[ii][3] = *(const LAS bf16x8*)(lds + ((b) * 32768 + (hh) * 16384) + ard + ii * 4096 + ko3); } } while (0)
#define P8_LDB(Bx, b, hh) do { Bx[0] = *(const LAS bf16x8*)(lds + ((b) * 32768 + (hh) * 16384) + brd + ko0); Bx[1] = *(const LAS bf16x8*)(lds + ((b) * 32768 + (hh) * 16384) + brd + ko1); \
        Bx[2] = *(const LAS bf16x8*)(lds + ((b) * 32768 + (hh) * 16384) + brd + ko2); Bx[3] = *(const LAS bf16x8*)(lds + ((b) * 32768 + (hh) * 16384) + brd + ko3); } while (0)
#define P8_MMA(ah, bj, Bx) do { __builtin_amdgcn_s_setprio(1); \
        if constexpr (F8) { _Pragma("unroll") for (int m = 0; m < 2; ++m) { \
            const i32x8 b_ = __builtin_shufflevector(__builtin_bit_cast(i32x4, Bx[2 * m]), __builtin_bit_cast(i32x4, Bx[2 * m + 1]), 0, 1, 2, 3, 4, 5, 6, 7); \
            _Pragma("unroll") for (int ii = 0; ii < 2; ++ii) { \
                const i32x8 a_ = __builtin_shufflevector(__builtin_bit_cast(i32x4, At[ii][2 * m]), __builtin_bit_cast(i32x4, At[ii][2 * m + 1]), 0, 1, 2, 3, 4, 5, 6, 7); \
                acc[2 * (ah) + ii][bj] = __builtin_amdgcn_mfma_scale_f32_32x32x64_f8f6f4(a_, b_, acc[2 * (ah) + ii][bj], 0, 0, 0, F8SCALE, 0, F8SCALE); } } } \
        else { _Pragma("unroll") for (int s = 0; s < 4; ++s) _Pragma("unroll") for (int ii = 0; ii < 2; ++ii) \
            acc[2 * (ah) + ii][bj] = __builtin_amdgcn_mfma_f32_32x32x16_bf16(At[ii][s], Bx[s], acc[2 * (ah) + ii][bj], 0, 0, 0); } \
        __builtin_amdgcn_s_setprio(0); } while (0)
#define P8_WV(n) asm volatile("s_waitcnt vmcnt(" #n ")" ::: "memory")
#define P8_WL(n) asm volatile("s_waitcnt lgkmcnt(" #n ")" ::: "memory")
#define P8_BAR __builtin_amdgcn_s_barrier()
#define P8_SCHED __builtin_amdgcn_sched_barrier(0)
    asm volatile("s_waitcnt vmcnt(0) lgkmcnt(0)" ::: "memory"); P8_BAR;
    P8_SCHED;
    P8_STB(0, 0, 0); P8_STA(0, 0, 0); P8_STB(0, 1, 0); P8_STA(0, 1, 0);
    if (wr == 1) P8_BAR;
    P8_WV(4); P8_BAR;
    P8_STB(1, 0, 1); P8_STA(1, 0, 1); P8_STB(1, 1, 1);
    P8_WV(6); P8_BAR;
    P8_SCHED;
#pragma unroll 1
    for (int t = 0; t < nk - 2; t += 2) {
        P8_LDB(B0, 0, 0); P8_SCHED; P8_LDA(0, 0); P8_STA(1, 1, t + 1);
        P8_WL(8); P8_BAR; P8_WL(0); P8_MMA(0, 0, B0); P8_BAR; P8_SCHED;
        P8_LDB(B1, 0, 1); P8_STB(0, 0, t + 2);
        P8_BAR; P8_WL(0); P8_MMA(0, 1, B1); P8_BAR; P8_SCHED;
        P8_LDA(0, 1); P8_STA(0, 0, t + 2);
        P8_BAR; P8_WL(0); P8_MMA(1, 0, B0); P8_BAR; P8_SCHED;
        P8_STB(0, 1, t + 2);
        P8_WV(6); P8_BAR; P8_MMA(1, 1, B1); P8_BAR; P8_SCHED;
        P8_LDB(B0, 1, 0); P8_SCHED; P8_LDA(1, 0); P8_STA(0, 1, t + 2);
        P8_WL(8); P8_BAR; P8_WL(0); P8_MMA(0, 0, B0); P8_BAR; P8_SCHED;
        P8_LDB(B1, 1, 1); P8_STB(1, 0, t + 3);
        P8_BAR; P8_WL(0); P8_MMA(0, 1, B1); P8_BAR; P8_SCHED;
        P8_LDA(1, 1); P8_STA(1, 0, t + 3);
        P8_BAR; P8_WL(0); P8_MMA(1, 0, B0); P8_BAR; P8_SCHED;
        P8_STB(1, 1, t + 3);
        P8_WV(6); P8_BAR; P8_MMA(1, 1, B1); P8_BAR; P8_SCHED;
    }
    P8_LDB(B0, 0, 0); P8_SCHED; P8_LDA(0, 0); P8_STA(1, 1, nk - 1);
    P8_BAR; P8_WL(0); P8_MMA(0, 0, B0); P8_BAR; P8_SCHED;
    P8_LDB(B1, 0, 1); P8_BAR; P8_WL(0); P8_MMA(0, 1, B1); P8_BAR; P8_SCHED;
    P8_LDA(0, 1); P8_WV(4); P8_BAR; P8_WL(0); P8_MMA(1, 0, B0); P8_MMA(1, 1, B1); P8_BAR; P8_SCHED;
    P8_LDB(B0, 1, 0); P8_SCHED; P8_LDA(1, 0); P8_WV(2); P8_BAR; P8_WL(0); P8_MMA(0, 0, B0); P8_BAR; P8_SCHED;
    P8_LDB(B1, 1, 1); P8_WV(0); P8_BAR; P8_WL(0); P8_MMA(0, 1, B1); P8_BAR; P8_SCHED;
    P8_LDA(1, 1); P8_BAR; P8_WL(0); P8_MMA(1, 0, B0); P8_MMA(1, 1, B1); P8_BAR; P8_SCHED;
    if (wr == 0) P8_BAR;
    asm volatile("" ::: "memory");
}

#define SROW8(tid, i) ((i) * 128 + ((tid) >> 6) * 16 + (((tid) & 63) >> 2))
#define SCH8(tid) (((tid) & 3) ^ (((tid) >> 4) & 3))
__device__ __forceinline__ void gemm256_f8(LAS unsigned char* lds, const int tid, const char* Pb, const unsigned (&po)[2], const char* Qb, const unsigned (&qo)[2], int nk, f32x16 (&acc)[4][2]) {
    const int lane = tid & 63, wid = __builtin_amdgcn_readfirstlane(tid >> 6), wr = wid >> 2, wc = wid & 3;
    const int r = lane & 31, h = lane >> 5, swz = (r >> 2) & 3;
    const unsigned ldsw = (unsigned)wid * 1024u;
#pragma unroll
    for (int i = 0; i < 4; ++i)
#pragma unroll
        for (int j = 0; j < 2; ++j)
#pragma unroll
            for (int v = 0; v < 16; ++v) acc[i][j][v] = 0.f;
#define G8_ISSUE(t) do { const unsigned koff_ = (unsigned)(t) * 64u; const unsigned bo_ = ((unsigned)(t) & 3u) * 32768u; \
        _Pragma("unroll") for (int i_ = 0; i_ < 2; ++i_) { \
            __builtin_amdgcn_global_load_lds((const unsigned*)(Pb + (size_t)(po[i_] + koff_)), (LAS unsigned*)(lds + bo_ + ldsw + i_ * 8192), 16, 0, 0); \
            __builtin_amdgcn_global_load_lds((const unsigned*)(Qb + (size_t)(qo[i_] + koff_)), (LAS unsigned*)(lds + bo_ + 16384 + ldsw + i_ * 8192), 16, 0, 0); } } while (0)
#define G8_WAIT(rem_) do { if ((rem_) >= 2) asm volatile("s_waitcnt vmcnt(8)" ::: "memory"); else if ((rem_) == 1) asm volatile("s_waitcnt vmcnt(4)" ::: "memory"); \
                           else asm volatile("s_waitcnt vmcnt(0)" ::: "memory"); } while (0)
    asm volatile("s_waitcnt vmcnt(0) lgkmcnt(0)" ::: "memory"); __builtin_amdgcn_s_barrier();
    G8_ISSUE(0);
    if (nk > 1) G8_ISSUE(1);
    if (nk > 2) G8_ISSUE(2);
    const int prd = (wr * 128 + r) * 64 + 8 * h, qrd = 16384 + (wc * 64 + r) * 64 + 8 * h;
    const int ko0 = (0 ^ swz) << 4, ko1 = (1 ^ swz) << 4, ko2 = (2 ^ swz) << 4, ko3 = (3 ^ swz) << 4;
#pragma unroll 1
    for (int kt = 0; kt < nk; ++kt) {
        G8_WAIT(nk - 1 - kt);
        asm volatile("s_waitcnt lgkmcnt(0)" ::: "memory"); __builtin_amdgcn_s_barrier();
        if (kt + 3 < nk) G8_ISSUE(kt + 3);
        const int cb = (kt & 3) * 32768;
#define G8_STEP(ko) do { long pf_[4], qf_[2]; \
        _Pragma("unroll") for (int i = 0; i < 4; ++i) pf_[i] = *(const LAS long*)(lds + cb + prd + i * 2048 + (ko)); \
        _Pragma("unroll") for (int j = 0; j < 2; ++j) qf_[j] = *(const LAS long*)(lds + cb + qrd + j * 2048 + (ko)); \
        _Pragma("unroll") for (int i = 0; i < 4; ++i) _Pragma("unroll") for (int j = 0; j < 2; ++j) \
            acc[i][j] = __builtin_amdgcn_mfma_f32_32x32x16_fp8_fp8(pf_[i], qf_[j], acc[i][j], 0, 0, 0); } while (0)
        G8_STEP(ko0); G8_STEP(ko1); G8_STEP(ko2); G8_STEP(ko3);
    }
    asm volatile("" ::: "memory");
}

#define XB_TMO      128
#define XB_XCNT(j)  (256  + 64 * (j))
#define XB_XSUB(j)  (1280 + 64 * (j))
#define XB_XGEN(j)  (2304 + 64 * (j))
#define XB_TOP      3328
#define XB_TOPGEN   3392
#define XCD_BAR_WORDS 3456
#define XB_SPIN_CAP (1u << 18)
__device__ __forceinline__ unsigned xb_ld(unsigned* p)              { return __hip_atomic_load(p, __ATOMIC_RELAXED, __HIP_MEMORY_SCOPE_AGENT); }
__device__ __forceinline__ unsigned xb_add(unsigned* p, unsigned v) { return __hip_atomic_fetch_add(p, v, __ATOMIC_RELAXED, __HIP_MEMORY_SCOPE_AGENT); }
__device__ __forceinline__ unsigned xb_xcc_id() { return (unsigned)__builtin_amdgcn_s_getreg((3 << 11) | 20) & 0xFu; }
#define XB_SPIN(cond, bar) do { unsigned _sp = 0; while (cond) { __builtin_amdgcn_s_sleep(1); \
    if ((++_sp & 255u) == 0u) { if (xb_ld(&(bar)[XB_TMO])) break; if (_sp > XB_SPIN_CAP) { atomicAdd(&(bar)[XB_TMO], 1u); break; } } } } while (0)
struct XcdBarrier { unsigned* bar; unsigned x; volatile LAS unsigned* st; int wvs; };
__device__ unsigned g_bar[XCD_BAR_WORDS + 64];
__device__ __forceinline__ XcdBarrier xcd_barrier_post(unsigned* bar, volatile LAS unsigned* st, int wvs) {
    XcdBarrier b; b.bar = bar; b.x = xb_xcc_id(); b.st = st; b.wvs = wvs;
    if (wvs * 64 + LANE_ID() == 0) (void)xb_add(&bar[XB_XCNT(b.x)], 1u);
    return b;
}
__device__ __forceinline__ void xcd_barrier_complete(unsigned* bar, unsigned x, unsigned& nloc, unsigned& nx) {
    const unsigned G = gridDim.x * gridDim.y * gridDim.z;
    unsigned sum, cnt, mine, sp = 0u;
    for (;;) {
        sum = 0u; cnt = 0u; mine = 0u;
#pragma unroll
        for (unsigned j = 0; j < 16; ++j) { const unsigned c = xb_ld(&bar[XB_XCNT(j)]); sum += c; cnt += (c > 0u) ? 1u : 0u; mine = (j == x) ? c : mine; }
        if (sum == G) break;
        __builtin_amdgcn_s_sleep(1);
        if ((++sp & 255u) == 0u) { if (xb_ld(&bar[XB_TMO])) break; if (sp > XB_SPIN_CAP) { atomicAdd(&bar[XB_TMO], 1u); break; } }
    }
    nloc = mine > 0u ? mine : 1u; nx = cnt > 0u ? cnt : 1u;
}
__device__ __forceinline__ void xcd_barrier(const XcdBarrier& b) {
    asm volatile("s_waitcnt vmcnt(0)" ::: "memory");
    __syncthreads();
    if (b.wvs * 64 + LANE_ID() == 0) {
        unsigned* bar = b.bar;
        __builtin_amdgcn_s_waitcnt(0);
        unsigned nloc = b.st[0], nx = b.st[1];
        if (nloc == 0u) { xcd_barrier_complete(bar, b.x, nloc, nx); b.st[0] = nloc; b.st[1] = nx; }
        const unsigned old = xb_add(&bar[XB_XSUB(b.x)], 1u);
        const unsigned gen = old / nloc;
        if (old + 1u == (gen + 1u) * nloc) {
            __builtin_amdgcn_fence(__ATOMIC_RELEASE, "agent");
            asm volatile("s_waitcnt vmcnt(0)" ::: "memory");
            __builtin_amdgcn_fence(__ATOMIC_ACQUIRE, "agent");
            asm volatile("s_waitcnt vmcnt(0)" ::: "memory");
            const unsigned og = xb_add(&bar[XB_TOP], 1u);
            const unsigned tg = og / nx;
            if (og + 1u == (tg + 1u) * nx) xb_add(&bar[XB_TOPGEN], 1u);
            else XB_SPIN(xb_ld(&bar[XB_TOPGEN]) == tg, bar);
            asm volatile("buffer_inv sc0\n\ts_waitcnt vmcnt(0)" ::: "memory");
        } else {
            XB_SPIN(xb_ld(&bar[XB_TOPGEN]) == gen, bar);
            asm volatile("buffer_inv sc0\n\ts_waitcnt vmcnt(0)" ::: "memory");
        }
    }
    __syncthreads();
}

__device__ __forceinline__ void publish_add(unsigned* ctr, int tid) {
    asm volatile("s_waitcnt vmcnt(0)" ::: "memory");
    __syncthreads();
    if (tid == 0) { __builtin_amdgcn_fence(__ATOMIC_RELEASE, "agent"); asm volatile("s_waitcnt vmcnt(0)" ::: "memory");
        __hip_atomic_fetch_add(ctr, 1u, __ATOMIC_RELAXED, __HIP_MEMORY_SCOPE_AGENT); }
}
__device__ __forceinline__ void publish_add_wt(unsigned* ctr, int tid) {
    asm volatile("s_waitcnt vmcnt(0)" ::: "memory");
    __syncthreads();
    if (tid == 0) __hip_atomic_fetch_add(ctr, 1u, __ATOMIC_RELAXED, __HIP_MEMORY_SCOPE_AGENT);
}
#define ST_WT16(ptr, val) __hip_atomic_store((ptr), (bf16_t)(val), __ATOMIC_RELAXED, __HIP_MEMORY_SCOPE_AGENT)
__device__ __forceinline__ void wait_ge(unsigned* ctr, unsigned want, int tid) {
    if (tid == 0) { unsigned sp = 0;
        while (__hip_atomic_load(ctr, __ATOMIC_RELAXED, __HIP_MEMORY_SCOPE_AGENT) < want) { __builtin_amdgcn_s_sleep(2); if (++sp > (1u << 22)) break; }
        asm volatile("buffer_inv sc0" ::: "memory");        asm volatile("s_waitcnt vmcnt(0)" ::: "memory"); }
    __syncthreads();
}
#define QW(i) ((i) * 64)

struct TJob { const float* src; bf16_t* dst; int R, C, ntile; const float* rscale; int smin; float f8scale; };
__device__ void transpose_all(const Params& p, const int wvs_, float* lds) {
    int tid = TIDX(p); asm volatile("" : "+v"(tid));
    const int rr0 = tid >> 6, c4 = (tid & 63) * 4;
    volatile int* qw = (volatile int*)(lds + 64 * 257);
    auto job_of = [&](int id, TJob& j, int& t) {
        if (id < 160) { j = TJob{p.w_in, p.WinT, D, DIN, 160, nullptr, 0, 0.f}; t = id; }
        else if (id < 224) { j = TJob{p.w_out, p.WoutT, D, D, 64, p.g_out, DF, 0.f}; t = id - 160; }
        else if (id < 1248) { j = TJob{p.w_gate, p.WgT, D, DEXP, 1024, nullptr, 0, WSCALE_GU}; t = id - 224; }
        else if (id < 2272) { j = TJob{p.w_up, p.WuT, D, DEXP, 1024, nullptr, 0, WSCALE_GU}; t = id - 1248; }
        else { j = TJob{p.w_down, p.WdT, DEXP, D, 1024, nullptr, 0, WSCALE_DN}; t = id - 2272; }
    };
    constexpr int NTILES = 3296;
    auto fetch = [&]() { __syncthreads(); if (tid == 0) qw[0] = (int)__hip_atomic_fetch_add(g_bar + 64, 1u, __ATOMIC_RELAXED, __HIP_MEMORY_SCOPE_AGENT); __syncthreads(); return (int)qw[0]; };
    float4 v[8];
    auto load = [&](int id) { TJob j; int t; job_of(id, j, t); const int tr = j.R / 64, tc = j.C / 256;
        const int bb = t / (tr * tc), rem = t % (tr * tc), r0 = (rem / tc) * 64, c0 = (rem % tc) * 256;
        const float* s = j.src + (size_t)bb * j.R * j.C + (size_t)r0 * j.C + c0;
#pragma unroll
        for (int i = 0; i < 8; ++i) { const f32x4 t_ = __builtin_nontemporal_load((const f32x4*)(s + (size_t)(rr0 + 8 * i) * j.C + c4)); v[i] = make_float4(t_.x, t_.y, t_.z, t_.w); } };
    int id = fetch();
    if (id < NTILES) load(id);
    while (id < NTILES) {
        TJob j; int t; job_of(id, j, t); const int tr = j.R / 64, tc = j.C / 256;
        const int bb = t / (tr * tc), rem = t % (tr * tc), r0 = (rem / tc) * 64, c0 = (rem % tc) * 256;
        bf16_t* d = j.dst + (size_t)bb * j.R * j.C + (size_t)c0 * j.R + r0;
        if (j.rscale) {
#pragma unroll
            for (int i = 0; i < 8; ++i) if (r0 + rr0 + 8 * i >= j.smin) { const float g = j.rscale[r0 + rr0 + 8 * i]; v[i].x *= g; v[i].y *= g; v[i].z *= g; v[i].w *= g; } }
        const int nid = fetch();
#pragma unroll
        for (int i = 0; i < 8; ++i) { float* q = lds + (rr0 + 8 * i) * 257 + c4; q[0] = v[i].x; q[1] = v[i].y; q[2] = v[i].z; q[3] = v[i].w; }
        if (nid < NTILES) load(nid);
        __syncthreads();
        if (j.f8scale == 0.f) {
#pragma unroll
            for (int i = 0; i < 4; ++i) { const int cc = (tid >> 3) + 64 * i, r8 = (tid & 7) * 8; const float* q = lds + r8 * 257 + cc;
                uint4 w; w.x = cvt_pk_bf16(q[0], q[257]); w.y = cvt_pk_bf16(q[2 * 257], q[3 * 257]); w.z = cvt_pk_bf16(q[4 * 257], q[5 * 257]); w.w = cvt_pk_bf16(q[6 * 257], q[7 * 257]);
                *(uint4*)(d + (size_t)cc * j.R + r8) = w; }
        } else {
            unsigned char* d8 = (unsigned char*)j.dst + (size_t)bb * j.R * j.C + (size_t)c0 * j.R + r0; const float sc_ = j.f8scale;
#pragma unroll
            for (int i = 0; i < 4; ++i) { const int cc = (tid >> 3) + 64 * i, r8 = (tid & 7) * 8; const float* q = lds + r8 * 257 + cc;
                uint2 w; w.x = cvt4_fp8(q[0] * sc_, q[257] * sc_, q[2 * 257] * sc_, q[3 * 257] * sc_); w.y = cvt4_fp8(q[4 * 257] * sc_, q[5 * 257] * sc_, q[6 * 257] * sc_, q[7 * 257] * sc_);
                u32x2 w2_; w2_.x = w.x; w2_.y = w.y; __builtin_nontemporal_store(w2_, (u32x2*)(d8 + (size_t)cc * j.R + r8)); }
        }
        id = nid;
    }
}

__device__ void ph_hrows(const Params& p, const int wvs_, float* lds);
__device__ void ph_adaln_tables(const Params& p, const int wvs_, float* lds) {
    int tid = TIDX(p); asm volatile("" : "+v"(tid));
    const int gid = blockIdx.x * NT + tid, gsz = gridDim.x * NT;
    for (int cb = blockIdx.x; cb < NMOD * D / 32; cb += gridDim.x) {
        __syncthreads();
        for (int i = tid; i < 3 * D; i += NT) { const int r = i / D, k = i % D; const float v = r < 2 ? p.c[r * D + k] : p.c_ctx[k]; lds[i] = v / (1.f + expf(-v)); }
        __syncthreads();
        const int col = cb * 32 + (tid & 31), kg = tid >> 5;
        float a0 = 0.f, a1 = 0.f, a2 = 0.f;
#pragma unroll 8
        for (int kk = 0; kk < 64; ++kk) { const int k = kg * 64 + kk; const float w = __builtin_nontemporal_load(p.w_ada + (size_t)k * (NMOD * D) + col); a0 = fmaf(lds[k], w, a0); a1 = fmaf(lds[D + k], w, a1); a2 = fmaf(lds[2 * D + k], w, a2); }
        float* red = lds + 3 * D;
        red[(0 * 16 + kg) * 32 + (tid & 31)] = a0; red[(1 * 16 + kg) * 32 + (tid & 31)] = a1; red[(2 * 16 + kg) * 32 + (tid & 31)] = a2;
        __syncthreads();
        if (tid < 96) { const int rr = tid >> 5, cc = tid & 31; float s = 0.f;
#pragma unroll
            for (int g = 0; g < 16; ++g) s += red[(rr * 16 + g) * 32 + cc];
            __hip_atomic_store(p.mod + rr * NMOD * D + cb * 32 + cc, s + p.b_ada[cb * 32 + cc], __ATOMIC_RELAXED, __HIP_MEMORY_SCOPE_AGENT); }
        publish_add_wt(g_bar + 96, tid);
    }
    for (int i = gid; i < 64 * D; i += gsz) { const int o = i / D, k = i % D; const float w = o < 4 ? p.w_rg[k * 4 + o] : (o < 36 ? p.w_re[k * NEXP + o - 4] : 0.f);
        const bf16_t hi = f2bf(w); p.WrHi[i] = hi; p.WrLo[i] = f2bf(w - bf2f(hi)); }
    for (int i = gid; i < SEQ; i += gsz) { p.cosN[i] = cospif(2.f * (float)i / (float)SEQ); p.sinN[i] = sinpif(2.f * (float)i / (float)SEQ); }
    for (int i = gid; i < (GROWS + GW) * 16; i += gsz) {
        const int pos = i / 16, f = i % 16; const float inv = powf(10000.f, -(float)f / 16.f);
        if (pos < GROWS) { const float a = (float)pos * inv; p.ropeR[2 * i] = cosf(a); p.ropeR[2 * i + 1] = sinf(a); }
        else { const int pc = pos - GROWS; const float a = (float)pc * inv; p.ropeC[2 * (pc * 16 + f)] = cosf(a); p.ropeC[2 * (pc * 16 + f) + 1] = sinf(a); }
    }
    if (gid < NEXP) p.cnt[gid * 64] = 0;
    if (gid < 256) p.tilecnt[gid] = 0u;
    if (gid < 16) p.qctl[QW(gid)] = 0u;
    for (int i = gid; i < 256 * 64; i += gsz) {
        const int rho = i >> 6, n1 = i & 63, blk = (rho >> 5) & 3, k1 = (blk >> 1) * 32 + (rho & 31);
        float v = 0.f;
        { const float a = 2.f * (float)((k1 * n1) & 63) / 64.f; v = (blk & 1) ? -sinpif(a) : cospif(a); }
        p.W64cs[i] = f2bf(v);
    }
    for (int i = gid; i < 256 * 256; i += gsz) {
        const int rho = i >> 8, kap = i & 255, ro = rho >> 7, k2 = rho & 127, ri = kap >> 7, n2 = kap & 127;
        const float a = 2.f * (float)((k2 * n2) & 127) / 128.f; const float c = cospif(a), s = sinpif(a);
        p.G128[i] = f2bf(ro == ri ? c : (ro == 0 ? s : -s));
    }
    float* cs64 = lds + 3 * D + 1536;
    __syncthreads();
    if (tid < 128) cs64[tid] = tid < 64 ? cospif(2.f * (float)tid / 64.f) : sinpif(2.f * (float)(tid - 64) / 64.f);
    __syncthreads();
    for (int i = gid; i < 256 * 512; i += gsz) {
        const int j = i >> 9, kap = i & 511, ro = kap >> 8, ch = kap & 255, g = ch >> 6, c = ch & 63;
        float acc = 0.f;
        for (int l = 0; l < 64; ++l) acc = fmaf(cs64[ro * 64 + ((l * c) & 63)], p.w_fmix[(size_t)(64 * g + l) * DF + j], acc);
        p.WmixT[i] = f2bf(acc * (1.0f / 724.0773439350247f));
    }
    transpose_all(p, wvs_, lds);
    wait_ge(g_bar + 96, NMOD * D / 32, tid);
    ph_hrows(p, wvs_, lds);
}

__device__ void ph_hrows(const Params& p, const int wvs_, float* lds) {
    int tid = TIDX(p); asm volatile("" : "+v"(tid));
    const int lane = tid & 63, nw = gridDim.x * (NT / 64), gw = blockIdx.x * (NT / 64) + (tid >> 6);
    for (int row0 = gw; row0 < NROWS; row0 += 2 * nw) {
        float4 v[2][4]; float ss[2];
#pragma unroll
        for (int q = 0; q < 2; ++q) {
            const int row = min(row0 + q * nw, NROWS - 1);
            const float* src = row < NTOK ? p.x + (size_t)row * D : p.ctx + (size_t)(row - NTOK) * D;
#pragma unroll
            for (int i = 0; i < 4; ++i) { const f32x4 t_ = __builtin_nontemporal_load((const f32x4*)(src + 4 * lane + 256 * i)); v[q][i] = make_float4(t_.x, t_.y, t_.z, t_.w); }
        }
#pragma unroll
        for (int q = 0; q < 2; ++q) { float s = 0.f;
#pragma unroll
            for (int i = 0; i < 4; ++i) s += v[q][i].x * v[q][i].x + v[q][i].y * v[q][i].y + v[q][i].z * v[q][i].z + v[q][i].w * v[q][i].w;
            ss[q] = wave_sum(s); }
#pragma unroll
        for (int q = 0; q < 2; ++q) {
            const int row = row0 + q * nw;
            if (row < NROWS) {
                const int mr = row < NTOK ? row / SEQ : 2;
                const float* sh = p.mod + mr * NMOD * D, * sc = sh + D;
                const float r = rsqrtf(ss[q] / (float)D + EPS);
#pragma unroll
                for (int i = 0; i < 4; ++i) { const int e = 4 * lane + 256 * i;
                    const float4 g = *(const float4*)(p.g_norm1 + e), s4 = *(const float4*)(sc + e), h4 = *(const float4*)(sh + e);
                    uint2 w; w.x = cvt_pk_bf16(v[q][i].x * r * g.x * (1.f + s4.x) + h4.x, v[q][i].y * r * g.y * (1.f + s4.y) + h4.y);
                    w.y = cvt_pk_bf16(v[q][i].z * r * g.z * (1.f + s4.z) + h4.z, v[q][i].w * r * g.w * (1.f + s4.w) + h4.w);
                    *(uint2*)(p.hb + (size_t)row * D + e) = w; }
            }
        }
    }
}

__device__ __forceinline__ void four1_unit(const Params& p, const int wvs_, float* ldsf, const int u);
__device__ __forceinline__ void four2_unit(const Params& p, const int wvs_, float* ldsf, const int u);
__device__ __forceinline__ void fmix_unit(const Params& p, const int wvs_, float* ldsf, const int u);
__device__ void ph_inproj(const Params& p, const int wvs_, float* ldsf) {
    LAS unsigned char* lds = (LAS unsigned char*)ldsf;
    int tid = TIDX(p); asm volatile("" : "+v"(tid));
    float* ropeL = ldsf + (128 * 1024 + 4096) / 4;
    __syncthreads();
    {
        float rv_[(GROWS + GW) * 32 / NT];
#pragma unroll
        for (int k = 0; k < (GROWS + GW) * 32 / NT; ++k) { const int i = tid + NT * k; rv_[k] = i < GROWS * 32 ? p.ropeR[i] : p.ropeC[i - GROWS * 32]; }
#pragma unroll
        for (int k = 0; k < (GROWS + GW) * 32 / NT; ++k) ropeL[tid + NT * k] = rv_[k];
    }
    __syncthreads();
    const bool xa = gridDim.x == 256; const int xcd = xa ? (blockIdx.x & 7) : 0, lj = xa ? (blockIdx.x >> 3) : blockIdx.x, lper = xa ? 32 : gridDim.x, npmx = xa ? 8 : 64;
    const int nloc = npmx * 10 + (xa ? (xcd < 2 ? 6 : 0) : 12);
    for (int rnd = 0; ; ++rnd) {
        const int ul = lj + rnd * lper;
        const bool has = ul < nloc;
        if (!has && !(xa && rnd < 3)) break;
        if (has) {
        int pm, pn;
        if (ul < npmx) { pm = xcd * npmx + ul; pn = 0; } else if (ul < npmx * 10) { pm = xcd * npmx + (ul - npmx) / 9; pn = 1 + (ul - npmx) % 9; }
        else { const int c = ul - npmx * 10; pm = 64 + (xa ? xcd : c / 6); pn = 4 + c % 6; }
        tid = TIDX(p); asm volatile("" : "+v"(tid));
        const int srow = tid >> 3, sc = SCS(tid);
        unsigned po[4], qo[4];
#pragma unroll
        for (int i = 0; i < 4; ++i) {
            const int rt = srow + 64 * i;
            po[i] = (unsigned)((pn * 256 + rt) * D * 2 + sc * 16);
            int rowidx;
            if (pn == 0) rowidx = (pm >> 5) * SEQ + 128 * (rt & 63) + 4 * (pm & 31) + (rt >> 6);
            else rowidx = pm * 256 + rt;
            qo[i] = (unsigned)rowidx * (unsigned)(D * 2) + sc * 16;
        }
        unsigned qn[4];
#pragma unroll
        for (int i = 0; i < 4; ++i) {
            const int rt = QROWP(tid, i >> 1, i & 1);
            int rowidx;
            if (pn == 0) rowidx = (pm >> 5) * SEQ + 128 * (rt & 63) + 4 * (pm & 31) + (rt >> 6);
            else rowidx = pm * 256 + rt;
            qn[i] = (unsigned)rowidx * (unsigned)(D * 2) + sc * 16;
        }
        f32x16 acc[4][2];
        gemm256p(lds, tid, (const char*)p.WinT, po, (const char*)p.hb, qn, D / 64, acc);
        tid = TIDX(p); asm volatile("" : "+v"(tid));
        const int wr = tid >> 8, wc = (tid >> 6) & 3, r_ = tid & 31, h_ = (tid >> 5) & 1, r = r_, h = h_, lane = tid & 63;
        if (pn == 0) {
            const int b = pm >> 5, n2 = 4 * (pm & 31) + wc;
#pragma unroll
            for (int i = 0; i < 4; ++i) {
#pragma unroll
                for (int j = 0; j < 2; ++j) {
                    const unsigned base = (unsigned)(((b * DF + wr * 128 + i * 32 + 4 * h_) * 128 + n2) * 64 + j * 32 + r_);
#pragma unroll
                    for (int v = 0; v < 16; ++v) ST_WT16(p.fX + base + (unsigned)(((v & 3) + 8 * (v >> 2)) * 128 * 64), f2bf(acc[i][j][v]));
                }
                asm volatile("" ::: "memory");
            }
            publish_add_wt(p.qctl + QW(1 + b), tid);
        } else if (pn < 7) {
            const bool isq = pn < 4; const int hg = ((pn - 1) % 3) * 4 + wr * 2;
            const bool isctx = pm >= 64;
            const int b = isctx ? pm - 64 : (pm >> 5);
            if (isctx) {
#pragma unroll
                for (int j = 0; j < 2; ++j) {
                    const int n = wc * 64 + j * 32 + r_;
#pragma unroll
                    for (int i = 0; i < 4; ++i) {
                        const int hh = hg + (i >> 1), blk = i & 1;
                        const unsigned base = (unsigned)(((b * NH + hh) * LCTX + n) * HD + blk * 32 + 4 * h_);
#pragma unroll
                        for (int q = 0; q < 4; ++q) {
                            uint2 w;
                            w.x = cvt_pk_bf16(acc[i][j][4 * q], acc[i][j][4 * q + 1]); w.y = cvt_pk_bf16(acc[i][j][4 * q + 2], acc[i][j][4 * q + 3]);
                            *(uint2*)(p.Kc + base + 8 * q) = w;
                        }
                        asm volatile("" ::: "memory");
                    }
                }
            } else {
                const int wreg = (tid >> 6) * 9216, lrow = (tid & 63) >> 3, lch = tid & 7;
                const float qs = isq ? QSCALE : 1.f;
                const float qs8 = isq ? QSCALE * 8.f : 1.f;
#pragma unroll
                for (int hd = 0; hd < 2; ++hd) {
                    const int hh = hg + hd;
                    const unsigned obase = (unsigned)(((b * NH + hh) * SEQ + (pm & 31) * 256 + wc * 64) * HD);
#pragma unroll
                    for (int pass = 0; pass < 2; ++pass) {
                        if (pass == 1 && !isq) break;
#pragma unroll
                        for (int ii = 0; ii < 2; ++ii) {
                            const int i = 2 * hd + ii;
#pragma unroll
                            for (int j = 0; j < 2; ++j) {
                                const int n = (pm & 31) * 256 + wc * 64 + j * 32 + r_;
                                LAS unsigned char* lp = lds + wreg + (j * 32 + r_) * 144 + ii * 64 + 8 * h_;
                                if (pass == 0) {
                                    const int grow = n >> 6, gcol = n & 63;
                                    const float* tb = (ii == 0 ? ropeL + 32 * grow : ropeL + GROWS * 32 + 32 * gcol) + 8 * h_;
                                    float o1[8], o2[8];
#pragma unroll
                                    for (int v = 0; v < 8; ++v) {
                                        const float2 cs = *(const float2*)(tb + 2 * ((v & 3) + 8 * (v >> 2)));
                                        const float x1 = acc[i][j][v] * qs8, x2 = acc[i][j][v + 8] * qs8;
                                        o1[v] = x1 * cs.x - x2 * cs.y; o2[v] = x1 * cs.y + x2 * cs.x;
                                    }
                                    LAS unsigned char* l8 = lds + wreg + (j * 32 + r_) * 80 + ii * 32 + 4 * h_;
#pragma unroll
                                    for (int q = 0; q < 2; ++q) {
                                        *(LAS unsigned*)(l8 + 8 * q) = cvt4_fp8(o1[4 * q], o1[4 * q + 1], o1[4 * q + 2], o1[4 * q + 3]);
                                        *(LAS unsigned*)(l8 + 16 + 8 * q) = cvt4_fp8(o2[4 * q], o2[4 * q + 1], o2[4 * q + 2], o2[4 * q + 3]);
                                    }
                                } else {
#pragma unroll
                                    for (int q = 0; q < 4; ++q) {
                                        u32x2 w; w.x = cvt_pk_bf16(acc[i][j][4 * q] * qs, acc[i][j][4 * q + 1] * qs); w.y = cvt_pk_bf16(acc[i][j][4 * q + 2] * qs, acc[i][j][4 * q + 3] * qs);
                                        *(LAS u32x2*)(lp + 16 * q) = w;
                                    }
                                }
                            }
                        }
                        if (pass == 1) {
                            bf16_t* ob = p.Qp + obase;
#pragma unroll
                            for (int it = 0; it < 8; ++it) {
                                const u32x4 w = *(const LAS u32x4*)(lds + wreg + (lrow + 8 * it) * 144 + lch * 16);
                                *(u32x4*)((char*)ob + (lrow + 8 * it) * 128 + lch * 16) = w;
                            }
                        } else {
                            unsigned char* ob8 = (isq ? (unsigned char*)p.Qr : (unsigned char*)p.Kr) + obase;
#pragma unroll
                            for (int it = 0; it < 4; ++it) {
                                const int pi = it * 64 + (tid & 63);
                                const u32x4 w = *(const LAS u32x4*)(lds + wreg + (pi >> 2) * 80 + (pi & 3) * 16);
                                *(u32x4*)(ob8 + pi * 16) = w;
                            }
                        }
                        asm volatile("" ::: "memory");
                    }
                }
            }
        } else {
            const int hg = (pn - 7) * 4 + wr * 2;
            const bool isctx = pm >= 64;
            const int b = isctx ? pm - 64 : (pm >> 5);
            const int ntb = isctx ? LCTX / 8 : SEQ / 8; bf16_t* vb = isctx ? p.Vct : p.Vt;
            const int wreg = (tid >> 6) * 9216, ln = tid & 63;
            const int n0 = (isctx ? 0 : (pm & 31) * 256) + wc * 64;
            if (isctx) {
#pragma unroll
                for (int hd = 0; hd < 2; ++hd) {
#pragma unroll
                    for (int ii = 0; ii < 2; ++ii)
#pragma unroll
                        for (int j = 0; j < 2; ++j) {
                            const int tl = j * 32 + r_;
                            LAS unsigned char* lp = lds + wreg + (tl >> 3) * 1040 + (ii * 32 + 4 * h_) * 16 + (tl & 7) * 2;
#pragma unroll
                            for (int v = 0; v < 16; ++v) *(LAS bf16_t*)(lp + ((v & 3) + 8 * (v >> 2)) * 16) = f2bf(acc[2 * hd + ii][j][v]);
                        }
                    char* ob = (char*)(vb + (size_t)(((b * NH + hg + hd) * ntb + (n0 >> 3)) * HD) * 8);
#pragma unroll
                    for (int it = 0; it < 8; ++it) {
                        const u32x4 w = *(const LAS u32x4*)(lds + wreg + it * 1040 + ln * 16);
                        *(u32x4*)(ob + it * 1024 + ln * 16) = w;
                    }
                    asm volatile("" ::: "memory");
                }
            } else {
#pragma unroll
                for (int hd = 0; hd < 2; ++hd) {
#pragma unroll
                    for (int ii = 0; ii < 2; ++ii)
#pragma unroll
                        for (int j = 0; j < 2; ++j) {
                            const int tl = j * 32 + r_;
                            LAS unsigned char* lp = lds + wreg + (tl >> 3) * 528 + (4 * h_) * 16 + ii * 8 + (tl & 7);
#pragma unroll
                            for (int v = 0; v < 16; ++v) *(lp + ((v & 3) + 8 * (v >> 2)) * 16) = (unsigned char)(__builtin_amdgcn_cvt_pk_fp8_f32(acc[2 * hd + ii][j][v], 0.f, 0, false) & 0xff);
                        }
                    unsigned char* ob = (unsigned char*)p.Vt + (size_t)(((b * NH + hg + hd) * ntb + (n0 >> 3)) * HD) * 8;
#pragma unroll
                    for (int it = 0; it < 4; ++it) {
                        const int pi = it * 64 + ln;
                        const u32x4 w = *(const LAS u32x4*)(lds + wreg + (pi >> 5) * 528 + (pi & 31) * 16);
                        *(u32x4*)(ob + pi * 16) = w;
                    }
                    asm volatile("" ::: "memory");
                }
            }
        }
        }
        if (xa) {
            if (rnd == 0) {
                const int e = (xcd - 2) * 2 + (lj - 16);
                const int it0 = (xcd < 2 && lj >= 16 && lj < 22) ? -1 : xcd * 32 + lj, it1 = (xcd >= 2 && lj >= 16 && lj < 18) ? (e / 6) * 32 + 16 + (e % 6) : -1;
#pragma unroll 1
                for (int k = 0; k < 2; ++k) { const int item = k == 0 ? it0 : it1;
                    if (item >= 0) { const int b = item >> 7; wait_ge(p.qctl + QW(1 + b), 32u, tid); four1_unit(p, wvs_, ldsf, item); publish_add_wt(p.qctl + QW(3 + b), tid); } }
            }
            else if (rnd == 1 && lj >= 16) { const int u = xcd * 16 + (lj - 16), b = u >> 6; wait_ge(p.qctl + QW(3 + b), 128u, tid); four2_unit(p, wvs_, ldsf, u); publish_add_wt(p.qctl + QW(5 + b), tid); }
            else if (rnd == 2 && lj >= 24) { const int u = xcd * 8 + (lj - 24), b = u >> 5; wait_ge(p.qctl + QW(5 + b), 64u, tid); fmix_unit(p, wvs_, ldsf, u); }
        }
    }
}

__device__ __forceinline__ void four1_unit(const Params& p, const int wvs_, float* ldsf, const int u) {
    LAS unsigned char* lds = (LAS unsigned char*)ldsf;
    int tid = TIDX(p); asm volatile("" : "+v"(tid));
    const int lane = tid & 63, wid = tid >> 6, wr = wid >> 2, wc = wid & 3, r = lane & 31, h = lane >> 5;
    const int srow = tid >> 3, sc = SCS(tid);
    {
        unsigned po[4], qo[4];
#pragma unroll
        for (int i = 0; i < 4; ++i) { const int rt = srow + 64 * i; po[i] = (unsigned)rt * 128u + sc * 16; qo[i] = (unsigned)(u * 256 + rt) * 128u + sc * 16; }
        f32x16 acc[4][2];
        gemm256(lds, tid, (const char*)p.W64cs, po, (const char*)p.fX, qo, 1, acc);
        {
            int opq = 0; asm volatile("" : "+v"(opq));
            const int r_ = r + opq, h_ = h + opq;
#pragma unroll
            for (int j = 0; j < 2; ++j) {
                if (j != wr) continue;
                const int qrow = u * 256 + wc * 64 + j * 32 + r_;
                const int n2 = qrow & 127, bc = qrow >> 7;
#pragma unroll
                for (int a = 0; a < 2; ++a) {
#pragma unroll
                    for (int v = 0; v < 16; ++v) {
                        const int k1 = a * 32 + (v & 3) + 8 * (v >> 2) + 4 * h_;
                        const float rev = (float)(n2 * k1) * (1.0f / 8192.0f);
                        const float cs = __builtin_amdgcn_cosf(rev), sn = __builtin_amdgcn_sinf(rev);
                        const float yr = acc[2 * a][j][v], yi = acc[2 * a + 1][j][v];
                        const unsigned base = (unsigned)((bc * 64 + k1) * 256 + n2);
                        ST_WT16(p.Zb + base, f2bf(yr * cs + yi * sn)); ST_WT16(p.Zb + base + 128, f2bf(yi * cs - yr * sn));
                    }
                    asm volatile("" ::: "memory");
                }
            }
        }
    }
}

__device__ __forceinline__ void four2_unit(const Params& p, const int wvs_, float* ldsf, const int u) {
    LAS unsigned char* lds = (LAS unsigned char*)ldsf;
    int tid = TIDX(p); asm volatile("" : "+v"(tid));
    const int srow = tid >> 3, sc = SCS(tid);
    {
        const int b = u >> 6, k1 = u & 63;
        unsigned po[4], qo[4];
#pragma unroll
        for (int i = 0; i < 4; ++i) { const int rt = srow + 64 * i; po[i] = (unsigned)rt * 512u + sc * 16; qo[i] = (unsigned)(((b * DF + QROWP(tid, i >> 1, i & 1)) * 64 + k1) * 512) + sc * 16; }
        f32x16 acc[4][2];
        gemm256p(lds, tid, (const char*)p.G128, po, (const char*)p.Zb, qo, 4, acc);
        tid = TIDX(p); asm volatile("" : "+v"(tid));
        const int wr = tid >> 8, wc = (tid >> 6) & 3, r_ = tid & 31, h_ = (tid >> 5) & 1;
#pragma unroll
        for (int i = 0; i < 4; ++i) {
#pragma unroll
            for (int j = 0; j < 2; ++j) {
                bf16_t* dst = p.P2 + (unsigned)((b * SEQ + k1 + 64 * (i * 32 + 4 * h_)) * 512 + wr * 256 + wc * 64 + j * 32 + r_);
#pragma unroll
                for (int v = 0; v < 16; ++v) ST_WT16(dst + ((v & 3) + 8 * (v >> 2)) * 64 * 512, f2bf(acc[i][j][v]));
                asm volatile("" ::: "memory");
            }
        }
    }
}

__device__ __forceinline__ void fmix_unit(const Params& p, const int wvs_, float* ldsf, const int u) {
    LAS unsigned char* lds = (LAS unsigned char*)ldsf;
    int tid = TIDX(p); asm volatile("" : "+v"(tid));
    const int srow = tid >> 3, sc = SCS(tid);
    {
        unsigned po[4], qo[4];
#pragma unroll
        for (int i = 0; i < 4; ++i) { const int rt = srow + 64 * i; po[i] = (unsigned)rt * 1024u + sc * 16; qo[i] = (unsigned)(u * 256 + QROWP(tid, i >> 1, i & 1)) * 1024u + sc * 16; }
        f32x16 acc[4][2];
        gemm256p(lds, tid, (const char*)p.WmixT, po, (const char*)p.P2, qo, 8, acc);
        tid = TIDX(p); asm volatile("" : "+v"(tid));
        const int wr = tid >> 8, wc = (tid >> 6) & 3, r = tid & 31, h = (tid >> 5) & 1;
        float ss[2];
#pragma unroll
        for (int j = 0; j < 2; ++j) { float s = 0.f;
#pragma unroll
            for (int i = 0; i < 4; ++i)
#pragma unroll
                for (int v = 0; v < 16; ++v) s = fmaf(acc[i][j][v], acc[i][j][v], s);
            ss[j] = xhalf_sum(s); }
        float* red = ldsf;
        if (h == 0) { red[wr * 256 + wc * 64 + r] = ss[0]; red[wr * 256 + wc * 64 + 32 + r] = ss[1]; }
        __syncthreads();
        int opq = 0; asm volatile("" : "+v"(opq));
        const int r_ = r + opq, h_ = h + opq;
#pragma unroll
        for (int j = 0; j < 2; ++j) {
            const int tl = wc * 64 + j * 32 + r_;
            const float rstd = rsqrtf((red[tl] + red[256 + tl]) / (float)DF + EPS);
            const float* gp = p.g_out + wr * 128 + 4 * h_;
            LAS unsigned char* lp = lds + 4096 + (tid >> 6) * 9216 + r_ * 272 + 8 * h_;
#pragma unroll
            for (int i = 0; i < 4; ++i) {
#pragma unroll
                for (int q = 0; q < 4; ++q) {
                    const float4 g = *(const float4*)(gp + i * 32 + 8 * q);
                    u32x2 w; w.x = cvt_pk_bf16(acc[i][j][4 * q] * rstd * g.x, acc[i][j][4 * q + 1] * rstd * g.y); w.y = cvt_pk_bf16(acc[i][j][4 * q + 2] * rstd * g.z, acc[i][j][4 * q + 3] * rstd * g.w);
                    *(LAS u32x2*)(lp + (i * 32 + 8 * q) * 2) = w;
                }
            }
            {
                const int ln = tid & 63, lrow = ln >> 4, lch = ln & 15;
                char* ob = (char*)(p.F2 + (size_t)(u * 256 + wc * 64 + j * 32) * DF + wr * 128);
#pragma unroll
                for (int it = 0; it < 8; ++it) {
                    const u32x4 w = *(const LAS u32x4*)(lds + 4096 + (tid >> 6) * 9216 + (lrow + 4 * it) * 272 + lch * 16);
                    *(u32x4*)(ob + (size_t)(lrow + 4 * it) * (DF * 2) + lch * 16) = w;
                }
            }
            asm volatile("" ::: "memory");
        }
    }
}

__device__ void ph_filler(const Params& p, const int wvs_, float* ldsf) {
    int tid = TIDX(p); asm volatile("" : "+v"(tid));
    volatile LAS unsigned* qw = (volatile LAS unsigned*)((LAS unsigned char*)ldsf + 128 * 1024 + 528);
    for (;;) {
        __syncthreads();
        if (tid == 0) qw[0] = __hip_atomic_fetch_add(p.qctl + QW(0), 1u, __ATOMIC_RELAXED, __HIP_MEMORY_SCOPE_AGENT);
        __syncthreads();
        const int item = (int)qw[0];
        if (item >= 448) break;
        if (item < 256) { const int b = item >> 7; wait_ge(p.qctl + QW(1 + b), 32u, tid); four1_unit(p, wvs_, ldsf, item); publish_add_wt(p.qctl + QW(3 + b), tid); }
        else if (item < 384) { const int u = item - 256, b = u >> 6; wait_ge(p.qctl + QW(3 + b), 128u, tid); four2_unit(p, wvs_, ldsf, u); publish_add_wt(p.qctl + QW(5 + b), tid); }
        else { const int u = item - 384, b = u >> 5; wait_ge(p.qctl + QW(5 + b), 64u, tid); fmix_unit(p, wvs_, ldsf, u); }
    }
}

constexpr float LOG2E = 1.4426950408889634f;
struct AttnTile { bf16x8 kf[4]; bf16x8 vf[2][2]; long vl[2][2]; u32x4 k8[2]; };
__device__ void ph_attn(const Params& p, const int wvs_, float* ldsf) {
    int tid = TIDX(p); asm volatile("" : "+v"(tid));
    const int lane = tid & 63, wv = __builtin_amdgcn_readfirstlane(tid >> 6), l31 = lane & 31, h = lane >> 5;
    LAS unsigned char* ldsb = (LAS unsigned char*)ldsf;
    constexpr int KB0 = 24576, VB0 = 57344;
    constexpr float NEGM = -3.0e38f;
    const int half = wv & 1;
    const int kcol = (l31 & 3) + 4 * ((l31 >> 3) & 1) + 8 * ((l31 >> 2) & 1), krow = l31 >> 4;
    const bool xa = gridDim.x == 256;
    int cur_bh = -1;
    for (int gi = blockIdx.x; gi < NBATCH * NH * (GROWS / 4); gi += gridDim.x) {
        const int g = xa ? (blockIdx.x & 7) * 3 * (GROWS / 4) + 3 * (blockIdx.x >> 3) + (gi >> 8) : gi;
        const int bh = g / (GROWS / 4), row = (g % (GROWS / 4)) * 4 + (wv >> 1), hh = bh % NH;
        const int rs = min(max(row - 4, 0), GROWS - 8);
        const int qc = 32 * half + l31, cs = min(max(qc - 8, 0), GW - 16);
        const int nq = row * GW + qc;
        const bool lb = qc < 8, rb = qc > 56;
        const int tb0 = (lb ? (half == 0 ? 1 : 2) : rb ? 2 : 0) * 1920, tb1 = ((lb || rb) ? 2 : 0) * 1920, tb2 = (rb ? (half == 1 ? 1 : 2) : lb ? 2 : 0) * 1920;
        const bf16_t* Kh = p.Kr + (size_t)bh * SEQ * HD; const bf16_t* Vh = p.Vt + (size_t)bh * HD * SEQ;
        const bf16_t* Kch = p.Kc + (size_t)bh * LCTX * HD; const bf16_t* Vch = p.Vct + (size_t)bh * HD * LCTX;
        if (bh != cur_bh) {
        cur_bh = bh;
        __syncthreads();
        {
            float bv_[4];
#pragma unroll
            for (int k = 0; k < 4; ++k) { const int i = min(tid + NT * k, 15 * 128 - 1), dcx = (i & 127) - 48, dr = i >> 7; const bool in = dcx >= 0 && dcx <= 30;
                bv_[k] = in ? p.rpb[(hh * 15 + dr) * 31 + dcx] * LOG2E : NEGM; }
#pragma unroll
            for (int k = 0; k < 4; ++k) { const int i = tid + NT * k, dcx = (i & 127) - 48;
                if (i < 15 * 128) { ldsf[i] = (dcx >= 7 && dcx <= 22) ? bv_[k] : NEGM; ldsf[1920 + i] = bv_[k]; ldsf[3840 + i] = NEGM; } }
        }
#pragma unroll
        for (int i = 0; i < 4; ++i) {
            const int key = (i * 8 + wv) * 8 + (lane >> 3);
            __builtin_amdgcn_global_load_lds((const unsigned*)(Kch + (size_t)key * HD + (((lane & 7) ^ (lane >> 3)) << 3)), (LAS unsigned*)(ldsb + KB0 + (i * 8 + wv) * 1024), 16, 0, 0);
            __builtin_amdgcn_global_load_lds((const unsigned*)((const char*)Vch + (i * 8 + wv) * 1024 + lane * 16), (LAS unsigned*)(ldsb + VB0 + (i * 8 + wv) * 1024), 16, 0, 0);
        }
        __syncthreads();
        }
        bf16x8 qp[4];
#pragma unroll
        for (int s = 0; s < 4; ++s) qp[s] = *(const bf16x8*)(p.Qp + ((size_t)bh * SEQ + nq) * HD + 16 * s + 8 * h);
        const u32x4 q8a = *(const u32x4*)((const unsigned char*)p.Qr + ((size_t)bh * SEQ + nq) * HD + 32 * h), q8b = *(const u32x4*)((const unsigned char*)p.Qr + ((size_t)bh * SEQ + nq) * HD + 32 * h + 16);
        const i32x8 q8 = __builtin_shufflevector(__builtin_bit_cast(i32x4, q8a), __builtin_bit_cast(i32x4, q8b), 0, 1, 2, 3, 4, 5, 6, 7);
        f32x16 o0, o1;
#pragma unroll
        for (int v = 0; v < 16; ++v) { o0[v] = 0.f; o1[v] = 0.f; }
        float m = -1e30f, lsum = 0.f;
        const float* rph = ldsf;
        auto load_loc = [&](int t, AttnTile& T) __attribute__((always_inline)) {
            const int pr = t / 3, blk = half + (t - 3 * pr), kr0 = rs + 2 * pr;
            const unsigned char* kptr = (const unsigned char*)p.Kr + (size_t)bh * SEQ * HD + (size_t)((kr0 + krow) * GW + 16 * blk + kcol) * HD + 32 * h;
            const unsigned char* vptr = (const unsigned char*)p.Vt + (size_t)bh * HD * SEQ + ((size_t)((kr0 * GW + 16 * blk) >> 3) + h) * (HD * 8) + l31 * 16;
#pragma unroll
            for (int kk = 0; kk < 2; ++kk) { const l64x2 t_ = *(const l64x2*)(vptr + (size_t)kk * 8 * (HD * 8)); T.vl[0][kk] = t_[0]; T.vl[1][kk] = t_[1]; }
#pragma unroll
            for (int s = 0; s < 2; ++s) T.k8[s] = *(const u32x4*)(kptr + 16 * s);
        };
        auto load_ctx = [&](int t, AttnTile& T) __attribute__((always_inline)) {
            const int m0 = 32 * (t - 12), key = m0 + 16 * krow + kcol;
#pragma unroll
            for (int s = 0; s < 4; ++s) T.kf[s] = *(const LAS bf16x8*)(ldsb + KB0 + key * 128 + (((2 * s + h) ^ (key & 7)) << 4));
#pragma unroll
            for (int kk = 0; kk < 2; ++kk)
#pragma unroll
                for (int dt = 0; dt < 2; ++dt) T.vf[dt][kk] = *(const LAS bf16x8*)(ldsb + VB0 + ((m0 >> 3) + 2 * kk + h) * 1024 + (l31 + 32 * dt) * 16);
        };
        auto compute_tile = [&](int t, const AttnTile& T, auto locc) __attribute__((always_inline)) {
            constexpr bool loc = decltype(locc)::value;
            f32x16 sa;
            if (loc) {
                const int pr = t / 3, c = t - 3 * pr, blk = half + c, kr0 = rs + 2 * pr;
                const int toff = tb0 + (c == 1) * (tb1 - tb0) + (c == 2) * (tb2 - tb0);
                const LAS float* bp = (const LAS float*)ldsf + (toff + (kr0 - row + 7) * 128 + (16 * blk + 8 * h - qc + 15 + 48));
#pragma unroll
                for (int v = 0; v < 16; ++v) sa[v] = bp[(v >> 3) * 128 + (v & 3) + 4 * ((v >> 2) & 1)];
            } else {
#pragma unroll
                for (int v = 0; v < 16; ++v) sa[v] = 0.f;
            }
            if (loc) {
                const i32x8 k8 = __builtin_shufflevector(__builtin_bit_cast(i32x4, T.k8[0]), __builtin_bit_cast(i32x4, T.k8[1]), 0, 1, 2, 3, 4, 5, 6, 7);
                sa = __builtin_amdgcn_mfma_scale_f32_32x32x64_f8f6f4(k8, q8, sa, 0, 0, 0, 127, 0, 124);
            } else {
#pragma unroll
                for (int s = 0; s < 4; ++s) sa = __builtin_amdgcn_mfma_f32_32x32x16_bf16(T.kf[s], qp[s], sa, 0, 0, 0);
            }
            float tmax = sa[0];
#pragma unroll
            for (int v = 1; v < 16; ++v) tmax = fmaxf(tmax, sa[v]);
            tmax = xhalf_max(tmax);
            if (__any(tmax > m + 8.f)) {
                const float mn = fmaxf(m, tmax), alpha = __builtin_amdgcn_exp2f(m - mn);
                m = mn; lsum *= alpha;
#pragma unroll
                for (int v = 0; v < 16; ++v) { o0[v] *= alpha; o1[v] *= alpha; }
            }
            float ps = 0.f;
#pragma unroll
            for (int v = 0; v < 16; ++v) {
                const float e = __builtin_amdgcn_exp2f(sa[v] - m);
                sa[v] = e; ps += e;
            }
            lsum += ps;
#pragma unroll
            for (int kk = 0; kk < 2; ++kk) {
                if (loc) {
                    int lo_ = __builtin_amdgcn_cvt_pk_fp8_f32(sa[8 * kk + 0], sa[8 * kk + 1], 0, false); lo_ = __builtin_amdgcn_cvt_pk_fp8_f32(sa[8 * kk + 2], sa[8 * kk + 3], lo_, true);
                    int hi_ = __builtin_amdgcn_cvt_pk_fp8_f32(sa[8 * kk + 4], sa[8 * kk + 5], 0, false); hi_ = __builtin_amdgcn_cvt_pk_fp8_f32(sa[8 * kk + 6], sa[8 * kk + 7], hi_, true);
                    const long pf8 = (long)(((unsigned long long)(unsigned)hi_ << 32) | (unsigned long long)(unsigned)lo_);
                    o0 = __builtin_amdgcn_mfma_f32_32x32x16_fp8_fp8(T.vl[0][kk], pf8, o0, 0, 0, 0);
                    o1 = __builtin_amdgcn_mfma_f32_32x32x16_fp8_fp8(T.vl[1][kk], pf8, o1, 0, 0, 0);
                } else {
                    const uint4 w = make_uint4(cvt_pk_bf16(sa[8 * kk + 0], sa[8 * kk + 1]), cvt_pk_bf16(sa[8 * kk + 2], sa[8 * kk + 3]), cvt_pk_bf16(sa[8 * kk + 4], sa[8 * kk + 5]), cvt_pk_bf16(sa[8 * kk + 6], sa[8 * kk + 7]));
                    const bf16x8 pf = __builtin_bit_cast(bf16x8, w);
                    o0 = __builtin_amdgcn_mfma_f32_32x32x16_bf16(T.vf[0][kk], pf, o0, 0, 0, 0);
                    o1 = __builtin_amdgcn_mfma_f32_32x32x16_bf16(T.vf[1][kk], pf, o1, 0, 0, 0);
                }
            }
        };
        AttnTile TA, TB;
        load_loc(0, TA);
#pragma unroll 1
        for (int t = 0; t < 12; t += 2) {
            load_loc(t + 1, TB);
            compute_tile(t, TA, std::true_type{});
            if (t + 2 < 12) load_loc(t + 2, TA);
            compute_tile(t + 1, TB, std::true_type{});
        }
        load_ctx(12, TA);
#pragma unroll 1
        for (int t = 12; t < 20; t += 2) {
            load_ctx(t + 1, TB);
            compute_tile(t, TA, std::false_type{});
            if (t + 2 < 20) load_ctx(t + 2, TA);
            compute_tile(t + 1, TB, std::false_type{});
        }
        lsum = xhalf_sum(lsum);
        const float inv = 1.f / lsum;
        bf16_t* op = p.A2b + (size_t)((bh / NH) * SEQ + nq) * D + DF + hh * HD + 4 * h;
        float sq = 0.f;
#pragma unroll
        for (int q = 0; q < 4; ++q) {
            const float a0 = o0[4 * q] * inv, a1 = o0[4 * q + 1] * inv, a2 = o0[4 * q + 2] * inv, a3 = o0[4 * q + 3] * inv;
            const float b0 = o1[4 * q] * inv, b1 = o1[4 * q + 1] * inv, b2 = o1[4 * q + 2] * inv, b3 = o1[4 * q + 3] * inv;
            sq += a0 * a0 + a1 * a1 + a2 * a2 + a3 * a3 + b0 * b0 + b1 * b1 + b2 * b2 + b3 * b3;
            *(uint2*)(op + 8 * q) = make_uint2(cvt_pk_bf16(a0, a1), cvt_pk_bf16(a2, a3));
            *(uint2*)(op + 32 + 8 * q) = make_uint2(cvt_pk_bf16(b0, b1), cvt_pk_bf16(b2, b3));
        }
        sq = xhalf_sum(sq);
        if (h == 0) p.ssq[((bh / NH) * SEQ + nq) * NH + hh] = sq;
    }
}

__device__ void ph_outproj(const Params& p, const int wvs_, float* ldsf) {
    LAS unsigned char* lds = (LAS unsigned char*)ldsf;
    for (int ui = blockIdx.x; ui < (NTOK / 256) * (D / 256); ui += gridDim.x) {
        const int u = gridDim.x == 256 ? (blockIdx.x & 7) * 32 + (blockIdx.x >> 3) : ui;
        const int pm = u >> 2, pn = u & 3;
        int tid = TIDX(p); asm volatile("" : "+v"(tid));
        float* rtab = ldsf + (128 * 1024 + 1024) / 4;
        if (tid < 256) { const float4* sp = (const float4*)(p.ssq + (size_t)(pm * 256 + tid) * NH); const float4 a = sp[0], b = sp[1], c = sp[2];
            rtab[tid] = rsqrtf(((a.x + a.y) + (a.z + a.w) + (b.x + b.y) + (b.z + b.w) + (c.x + c.y) + (c.z + c.w)) / (float)DNA + EPS); }
        f32x16 acc[4][2];
        unsigned qn[4];
        {
            unsigned po[4];
            const int srow = tid >> 3, sc = SCS(tid);
#pragma unroll
            for (int i = 0; i < 4; ++i) { po[i] = (unsigned)(pm * 256 + srow + 64 * i) * (unsigned)(D * 2) + sc * 16; qn[i] = (unsigned)(pn * 256 + QROWP(tid, i >> 1, i & 1)) * (unsigned)(D * 2) + sc * 16; }
            gemm256p(lds, tid, (const char*)p.A2b + DF * 2, po, (const char*)p.WoutT + DF * 2, qn, DNA / 64, acc);
        }
        {
            int tid2 = TIDX(p); asm volatile("" : "+v"(tid2));
            const int wr2 = tid2 >> 8, h2 = (tid2 >> 5) & 1;
#pragma unroll
            for (int i = 0; i < 4; ++i)
#pragma unroll
                for (int v = 0; v < 16; ++v) { const float rs_ = rtab[wr2 * 128 + i * 32 + (v & 3) + 8 * (v >> 2) + 4 * h2]; acc[i][0][v] *= rs_; acc[i][1][v] *= rs_; }
            unsigned po3[4];
            const int srow = tid2 >> 3, sc = SCS(tid2);
#pragma unroll
            for (int i = 0; i < 4; ++i) po3[i] = (unsigned)(pm * 256 + srow + 64 * i) * (unsigned)(DF * 2) + sc * 16;
            gemm256p(lds, tid2, (const char*)p.F2, po3, (const char*)p.WoutT, qn, DF / 64, acc, false);
        }
        tid = TIDX(p); asm volatile("" : "+v"(tid));
        const int wr = tid >> 8, wc = (tid >> 6) & 3, r = tid & 31, h = (tid >> 5) & 1;
        float xa[32], xc[32];
#define LDX(dst, j, ih) { int o_ = 0; asm volatile("" : "+v"(o_)); const unsigned lb = (unsigned)((pm * 256 + wr * 128 + (ih) * 64 + 4 * (h + o_)) * D + pn * 256 + wc * 64 + (j) * 32 + r); \
            _Pragma("unroll") for (int ii = 0; ii < 2; ++ii) _Pragma("unroll") for (int v = 0; v < 16; ++v) dst[ii * 16 + v] = __builtin_nontemporal_load(p.x + lb + (unsigned)((ii * 32 + (v & 3) + 8 * (v >> 2)) * D)); }
#define STX(src_, j, ih) { int o_ = 0; asm volatile("" : "+v"(o_)); const int feat = pn * 256 + wc * 64 + (j) * 32 + r + o_; const float g = gt1[feat]; \
            const unsigned sb = (unsigned)((pm * 256 + wr * 128 + (ih) * 64 + 4 * h) * D + feat); \
            _Pragma("unroll") for (int ii = 0; ii < 2; ++ii) _Pragma("unroll") for (int v = 0; v < 16; ++v) ST_WT16((bf16_t*)p.x1 + sb + (unsigned)((ii * 32 + (v & 3) + 8 * (v >> 2)) * D), f2bf(src_[ii * 16 + v] + g * acc[(ih) * 2 + ii][j][v])); }
        const float* gt1 = p.mod + (pm >> 5) * NMOD * D + 2 * D;
        LDX(xa, 0, 0)
        LDX(xc, 0, 1)
        asm volatile("" ::: "memory");
        STX(xa, 0, 0)
        asm volatile("" ::: "memory");
        LDX(xa, 1, 0)
        asm volatile("" ::: "memory");
        STX(xc, 0, 1)
        asm volatile("" ::: "memory");
        LDX(xc, 1, 1)
        asm volatile("" ::: "memory");
        STX(xa, 1, 0)
        asm volatile("" ::: "memory");
        STX(xc, 1, 1)
#undef LDX
#undef STX
        publish_add_wt(p.tilecnt + 192 + pm, tid);
    }
}

__device__ void ph_router(const Params& p, const int wvs_, float* lds, bool commit = true) {
    int tid = TIDX(p); asm volatile("" : "+v"(tid));
    const int wv = __builtin_amdgcn_readfirstlane(tid >> 6), lane = tid & 63, l31 = lane & 31, h = lane >> 5;
    LAS unsigned char* ldsb = (LAS unsigned char*)lds;
    constexpr int LG0 = 135168;
    int* sel = (int*)(lds + 152576 / 4); int* cntl = sel + 128; int* basel = cntl + 32; int* posl = basel + 32;
    for (int blk = blockIdx.x; blk < NTOK / 64; blk += gridDim.x) {
        __syncthreads();
        if (tid < 32) cntl[tid] = 0;
        bf16x8 ah[8][2];
        {
            const bf16_t* wbh = p.WrHi + (size_t)l31 * D + 128 * wv + 8 * h;
#pragma unroll
            for (int s8 = 0; s8 < 8; ++s8)
#pragma unroll
                for (int ot = 0; ot < 2; ++ot) ah[s8][ot] = *(const bf16x8*)(wbh + ot * 32 * D + 16 * s8);
        }
        wait_ge(p.tilecnt + 192 + (blk >> 2), 4u, tid);
        const int bq = (blk * 64) / SEQ;
        const float* sh = p.mod + bq * NMOD * D + 3 * D, * sc = sh + D;
#pragma unroll 1
        for (int rd = 0; rd < 2; ++rd) {
            const int tok0 = blk * 64 + wv * 8 + rd * 4;
            float4 hv[4][4]; float ss[4];
            {
                uint2 raw[4][4];
#pragma unroll
                for (int t = 0; t < 4; ++t)
#pragma unroll
                    for (int i = 0; i < 4; ++i) raw[t][i] = *(const uint2*)((const bf16_t*)p.x1 + (size_t)(tok0 + t) * D + 4 * lane + 256 * i);
#pragma unroll
                for (int t = 0; t < 4; ++t)
#pragma unroll
                    for (int i = 0; i < 4; ++i) hv[t][i] = make_float4(__uint_as_float(raw[t][i].x << 16), __uint_as_float(raw[t][i].x & 0xffff0000u), __uint_as_float(raw[t][i].y << 16), __uint_as_float(raw[t][i].y & 0xffff0000u));
            }
#pragma unroll
            for (int t = 0; t < 4; ++t) { float s = 0.f;
#pragma unroll
                for (int i = 0; i < 4; ++i) s += hv[t][i].x * hv[t][i].x + hv[t][i].y * hv[t][i].y + hv[t][i].z * hv[t][i].z + hv[t][i].w * hv[t][i].w;
                ss[t] = s; }
#pragma unroll
            for (int t = 0; t < 4; ++t) ss[t] = rsqrtf(wave_sum(ss[t]) / (float)D + EPS);
#pragma unroll
            for (int i = 0; i < 4; ++i) { const int e = 4 * lane + 256 * i;
                const float4 g = *(const float4*)(p.g_norm2 + e), s4 = *(const float4*)(sc + e), h4 = *(const float4*)(sh + e);
                const float4 gm = make_float4(g.x * (1.f + s4.x), g.y * (1.f + s4.y), g.z * (1.f + s4.z), g.w * (1.f + s4.w));
#pragma unroll
                for (int t = 0; t < 4; ++t) { const float r = ss[t];
                    const float4 v = make_float4(hv[t][i].x * r * gm.x + h4.x, hv[t][i].y * r * gm.y + h4.y, hv[t][i].z * r * gm.z + h4.z, hv[t][i].w * r * gm.w + h4.w);
                    *(unsigned*)((unsigned char*)p.h2b + (size_t)(tok0 + t) * D + e) = cvt4_fp8(v.x, v.y, v.z, v.w);
                    const int tl = wv * 8 + rd * 4 + t, pos = tl * 2048 + ((((e >> 3) ^ (tl & 31)) & 127) << 4) + ((lane & 1) << 3);
                    u32x2 wh; wh.x = cvt_pk_bf16(v.x, v.y); wh.y = cvt_pk_bf16(v.z, v.w); *(LAS u32x2*)(ldsb + pos) = wh; }
            }
        }
        __syncthreads();
        f32x16 lacc[2][2];
#pragma unroll
        for (int nt = 0; nt < 2; ++nt)
#pragma unroll
            for (int ot = 0; ot < 2; ++ot)
#pragma unroll
                for (int v = 0; v < 16; ++v) lacc[nt][ot][v] = 0.f;
#pragma unroll
        for (int s8 = 0; s8 < 8; ++s8) {
            const int s = wv * 8 + s8;
#pragma unroll
            for (int nt = 0; nt < 2; ++nt) {
                const bf16x8 bh = *(const LAS bf16x8*)(ldsb + (nt * 32 + l31) * 2048 + ((((2 * s + h) ^ l31) & 127) << 4));
#pragma unroll
                for (int ot = 0; ot < 2; ++ot) lacc[nt][ot] = __builtin_amdgcn_mfma_f32_32x32x16_bf16(ah[s8][ot], bh, lacc[nt][ot], 0, 0, 0);
            }
        }
        __syncthreads();
#pragma unroll
        for (int nt = 0; nt < 2; ++nt)
#pragma unroll
            for (int ot = 0; ot < 2; ++ot)
#pragma unroll
                for (int v = 0; v < 16; ++v) *(LAS float*)(ldsb + (((wv * 64 + ot * 32 + (v & 3) + 8 * (v >> 2) + 4 * h) * 64 + nt * 32 + l31) << 2)) = lacc[nt][ot][v];
        __syncthreads();
        for (int i = tid; i < 36 * 64; i += NT) { float s = 0.f;
#pragma unroll
            for (int w = 0; w < 8; ++w) s += *(const LAS float*)(ldsb + ((w * 4096 + i) << 2));
            *(LAS float*)(ldsb + LG0 + (i << 2)) = s; }
        __syncthreads();
        if (tid < 64) {
            const LAS float* lgp = (const LAS float*)(ldsb + LG0) + tid;
            float lg[4];
#pragma unroll
            for (int o = 0; o < 4; ++o) lg[o] = lgp[o * 64];
            int gs = 0; float gm = lg[0];
#pragma unroll
            for (int o = 1; o < 4; ++o) if (lg[o] > gm) { gm = lg[o]; gs = o; }
            float gz = 0.f;
#pragma unroll
            for (int o = 0; o < 4; ++o) gz += expf(lg[o] - gm);
            const float pg = 1.f / gz;
            float le[8];
#pragma unroll
            for (int o = 0; o < 8; ++o) le[o] = lgp[(4 + gs * 8 + o) * 64];
            int i0 = 0; float m0 = le[0];
#pragma unroll
            for (int o = 1; o < 8; ++o) if (le[o] > m0) { m0 = le[o]; i0 = o; }
            int i1 = -1; float m1 = -3.0e38f;
#pragma unroll
            for (int o = 0; o < 8; ++o) if (o != i0 && le[o] > m1) { m1 = le[o]; i1 = o; }
            const float e1 = expf(m1 - m0);
            const int tok = blk * 64 + tid;
            sel[tid * 2] = gs * 8 + i0; sel[tid * 2 + 1] = gs * 8 + i1;
            p.tokgate[tok * 2] = pg / (1.f + e1); p.tokgate[tok * 2 + 1] = pg * e1 / (1.f + e1);
        }
        __syncthreads();
        int e = 0;
        if (tid < 128) { e = sel[tid]; posl[tid] = atomicAdd(&cntl[e], 1); }
        __syncthreads();
        if (tid < 32 && commit) basel[tid] = atomicAdd(&p.cnt[tid * 64], cntl[tid]);
        __syncthreads();
        if (tid < 128 && commit) p.list[e * NTOK + basel[e] + posl[tid]] = (blk * 64 + (tid >> 1)) * 2 + (tid & 1);
    }
}

struct ETile { int e, s0, ns, sbase; };
__device__ __forceinline__ ETile moe_tile(const int* cl, int tile) {
    int e = 0, base = 0, sb = 0;
    for (;;) { const int c = cl[e], nc = (c + 255) >> 8; if (tile < base + nc) break; base += nc; sb += c; ++e; }
    ETile t; t.e = e; t.s0 = (tile - base) * 256; t.ns = min(256, cl[e] - t.s0); t.sbase = sb; return t;
}

__device__ void ph_moe(const Params& p, const int wvs_, float* ldsf) {
    LAS unsigned char* lds = (LAS unsigned char*)ldsf;
    int tid = TIDX(p); asm volatile("" : "+v"(tid));
    const bool xa = false; const int e0 = xa ? (blockIdx.x & 7) * 4 : 0, ne = xa ? 4 : NEXP, lj = xa ? (blockIdx.x >> 3) : blockIdx.x, lper = xa ? 32 : gridDim.x;
    int* cl = (int*)(ldsf + (128 * 1024 + 1024) / 4);
    __syncthreads();
    if (tid < NEXP) cl[tid] = p.cnt[tid * 64];
    __syncthreads();
    int tile0 = 0, ntl = 0;
    for (int e = 0; e < e0 + ne; ++e) { const int nc = (cl[e] + 255) >> 8; if (e < e0) tile0 += nc; else ntl += nc; }
    const int nt4 = ntl * 4;
    volatile LAS unsigned* qw = (volatile LAS unsigned*)((LAS unsigned char*)ldsf + 128 * 1024 + 528);
    for (;;) {
        __syncthreads();
        if (tid == 0) qw[0] = __hip_atomic_fetch_add(p.qctl + QW(9), 1u, __ATOMIC_RELAXED, __HIP_MEMORY_SCOPE_AGENT);
        __syncthreads();
        const int u = (int)qw[0];
        if (u >= 2 * nt4) break;
        const bool isdown = u >= nt4; const int uu = isdown ? u - nt4 : u;
        const int tile = tile0 + (uu >> 2);
        const ETile t = moe_tile(cl, tile); const int fc = uu & 3;
        tid = TIDX(p); asm volatile("" : "+v"(tid));
        const int srow = tid >> 3, sc = SCS(tid);
        unsigned po[4], qn[4];
        f32x16 acc[4][2];
        if (!isdown) {
#pragma unroll
            for (int i = 0; i < 4; ++i) {
                const int rt = srow + 64 * i;
                const int ent = rt < t.ns ? p.list[t.e * NTOK + t.s0 + rt] : 0;
                po[i] = (unsigned)(ent >> 1) * (unsigned)D + sc * 16;
                const int rq = QROWP(tid, i >> 1, i & 1);
                const int f = fc * 128 + (rq >> 6) * 32 + (rq & 31), up = (rq >> 5) & 1;
                qn[i] = (unsigned)((up * 2 * NEXP + t.e) * DEXP + f) * (unsigned)D + sc * 16;
            }
            gemm256p<true>(lds, tid, (const char*)p.h2b, po, (const char*)p.WgT, qn, D / 128, acc);
            tid = TIDX(p); asm volatile("" : "+v"(tid));
            const int wr = tid >> 8, wc = (tid >> 6) & 3, r_ = tid & 31, h_ = (tid >> 5) & 1;
            asm volatile("s_waitcnt lgkmcnt(0)" ::: "memory"); __builtin_amdgcn_s_barrier();
            {
#pragma unroll
                for (int i = 0; i < 4; ++i) {
                    const int s = wr * 128 + i * 32 + 4 * h_;
#pragma unroll
                    for (int v = 0; v < 16; ++v) {
                        const float g = acc[i][0][v] * (1.f / WSCALE_GU), uu_ = acc[i][1][v] * (1.f / WSCALE_GU);
                        const unsigned w = (unsigned)__builtin_amdgcn_cvt_pk_fp8_f32(g * __builtin_amdgcn_rcpf(1.f + __expf(-g)) * uu_, 0.f, 0, false);
                        *(LAS unsigned char*)(lds + (s + (v & 3) + 8 * (v >> 2)) * 128 + wc * 32 + r_) = (unsigned char)(w & 0xffu);
                    }
                    asm volatile("" ::: "memory");
                }
                __syncthreads();
#pragma unroll 4
                for (int k = 0; k < 4; ++k) { const int c = tid + 512 * k, row = c >> 3, ch = c & 7;
                    if (row < t.ns) { const u32x4 w = *(const LAS u32x4*)(lds + row * 128 + ch * 16);
                        unsigned long long* dp = (unsigned long long*)((unsigned char*)p.act + (size_t)(t.sbase + t.s0 + row) * DEXP + fc * 128 + ch * 16);
                        __hip_atomic_store(dp, ((unsigned long long)w[1] << 32) | w[0], __ATOMIC_RELAXED, __HIP_MEMORY_SCOPE_AGENT);
                        __hip_atomic_store(dp + 1, ((unsigned long long)w[3] << 32) | w[2], __ATOMIC_RELAXED, __HIP_MEMORY_SCOPE_AGENT); } }
            }
            asm volatile("s_waitcnt vmcnt(0)" ::: "memory");
            __syncthreads();
            if (tid == 0) __hip_atomic_fetch_add(p.tilecnt + tile, 1u, __ATOMIC_RELAXED, __HIP_MEMORY_SCOPE_AGENT);
        } else {
            if (tid == 0) { unsigned sp = 0;
                while (__hip_atomic_load(p.tilecnt + tile, __ATOMIC_RELAXED, __HIP_MEMORY_SCOPE_AGENT) < 4u) { __builtin_amdgcn_s_sleep(2); if (++sp > (1u << 22)) break; }
                asm volatile("buffer_inv sc0" ::: "memory");        asm volatile("s_waitcnt vmcnt(0)" ::: "memory"); }
            __syncthreads();
            const int pn = fc;
            int* entl = (int*)(ldsf + (128 * 1024 + 2048) / 4); float* gatel = (float*)(entl + 256);
            if (tid < 256) { const int ent = tid < t.ns ? p.list[t.e * NTOK + t.s0 + tid] : 0; entl[tid] = ent; gatel[tid] = p.tokgate[ent] * (1.f / WSCALE_DN); }
#pragma unroll
            for (int i = 0; i < 4; ++i) {
                const int rt = srow + 64 * i;
                po[i] = (unsigned)(t.sbase + t.s0 + (rt < t.ns ? rt : 0)) * (unsigned)DEXP + sc * 16;
                qn[i] = (unsigned)(t.e * D + pn * 256 + QROWP(tid, i >> 1, i & 1)) * (unsigned)DEXP + sc * 16;
            }
            gemm256p<true>(lds, tid, (const char*)p.act, po, (const char*)p.WdT, qn, DEXP / 128, acc);
            tid = TIDX(p); asm volatile("" : "+v"(tid));
            const int wr = tid >> 8, wc = (tid >> 6) & 3, r_ = tid & 31, h_ = (tid >> 5) & 1;
            auto down_store = [&](auto fullc) __attribute__((always_inline)) {
                constexpr bool full = decltype(fullc)::value;
#pragma unroll
                for (int i = 0; i < 4; ++i) {
                    const int s = wr * 128 + i * 32 + 4 * h_;
#pragma unroll
                    for (int v = 0; v < 16; ++v) {
                        const int sv = s + (v & 3) + 8 * (v >> 2);
                        if (full || sv < t.ns) {
                            const int ent = entl[sv]; const float g = gatel[sv];
                            const unsigned base = (unsigned)ent * D + pn * 256 + wc * 64 + r_;
                            __builtin_nontemporal_store(f2bf(g * acc[i][0][v]), p.ybuf + base); __builtin_nontemporal_store(f2bf(g * acc[i][1][v]), p.ybuf + base + 32);
                        }
                    }
                    asm volatile("" ::: "memory");
                }
            };
            if (t.ns == 256) down_store(std::true_type{}); else down_store(std::false_type{});
        }
    }
}

__device__ void ph_final(const Params& p, const int wvs_, float* lds, float* outp) {
    int tid = TIDX(p); asm volatile("" : "+v"(tid));
    const int lane = tid & 63, nw = gridDim.x * (NT / 64), gw = blockIdx.x * (NT / 64) + (tid >> 6);
    float eps_ = 0.f; if (TS_PHASE >= 0) eps_ = __uint_as_float(p.qctl[QW(7)]);
    for (int tok0 = gw; tok0 < NTOK; tok0 += 2 * nw) {
        float4 xv[2][4]; uint2 ya[2][4], yb[2][4]; float ss[2];
#pragma unroll
        for (int q = 0; q < 2; ++q) { const int tok = min(tok0 + q * nw, NTOK - 1);
#pragma unroll
            for (int i = 0; i < 4; ++i) { const int e = 4 * lane + 256 * i;
                { const uint2 a = *(const uint2*)((const bf16_t*)p.x1 + (size_t)tok * D + e);
                  xv[q][i] = make_float4(__uint_as_float(a.x << 16), __uint_as_float(a.x & 0xffff0000u), __uint_as_float(a.y << 16), __uint_as_float(a.y & 0xffff0000u)); }
                { const u32x2 t0_ = __builtin_nontemporal_load((const u32x2*)(p.ybuf + (size_t)(2 * tok) * D + e)), t1_ = __builtin_nontemporal_load((const u32x2*)(p.ybuf + (size_t)(2 * tok + 1) * D + e));
                  ya[q][i] = make_uint2(t0_.x, t0_.y); yb[q][i] = make_uint2(t1_.x, t1_.y); } } }
#pragma unroll
        for (int q = 0; q < 2; ++q) { const int tok = min(tok0 + q * nw, NTOK - 1);
            const float* gt2 = p.mod + (tok / SEQ) * NMOD * D + 5 * D; float s = 0.f;
#pragma unroll
            for (int i = 0; i < 4; ++i) { const int e = 4 * lane + 256 * i; const float4 g = *(const float4*)(gt2 + e);
                xv[q][i].x += g.x * (__uint_as_float(ya[q][i].x << 16) + __uint_as_float(yb[q][i].x << 16));
                xv[q][i].y += g.y * (__uint_as_float(ya[q][i].x & 0xffff0000u) + __uint_as_float(yb[q][i].x & 0xffff0000u));
                xv[q][i].z += g.z * (__uint_as_float(ya[q][i].y << 16) + __uint_as_float(yb[q][i].y << 16));
                xv[q][i].w += g.w * (__uint_as_float(ya[q][i].y & 0xffff0000u) + __uint_as_float(yb[q][i].y & 0xffff0000u));
                s += xv[q][i].x * xv[q][i].x + xv[q][i].y * xv[q][i].y + xv[q][i].z * xv[q][i].z + xv[q][i].w * xv[q][i].w; }
            ss[q] = s; }
#pragma unroll
        for (int q = 0; q < 2; ++q) ss[q] = wave_sum(ss[q]);
#pragma unroll
        for (int q = 0; q < 2; ++q) { const int tok = tok0 + q * nw;
            if (tok < NTOK) {
                float rr = rsqrtf(ss[q] / (float)D + EPS);
                if (TS_PHASE >= 0) rr *= 1.f + eps_;
#pragma unroll
                for (int i = 0; i < 4; ++i) { const int e = 4 * lane + 256 * i; const float4 g = *(const float4*)(p.g_final + e);
                    f32x4 o_; o_.x = xv[q][i].x * rr * g.x; o_.y = xv[q][i].y * rr * g.y; o_.z = xv[q][i].z * rr * g.z; o_.w = xv[q][i].w * rr * g.w;
                    __builtin_nontemporal_store(o_, (f32x4*)(outp + (size_t)tok * D + e)); } } }
    }
}

extern __shared__ __attribute__((aligned(16))) float smem[];

constexpr int R_P0 = 1, R_INP = 1, R_FOUR = 1, R_ATT = 1, R_OUT = 1, R_MOE = 1, R_RT = 1, R_FIN = 1, R_BAR = 1;
constexpr int LDS_BAR_OFF = 128 * 1024 + 512;
__global__ void __launch_bounds__(NT) mega(Params p) {
    const int wvs_ = __builtin_amdgcn_readfirstlane(threadIdx.x >> 6);
#define TID0 (TIDX(p) == 0)
    volatile LAS unsigned* st = (volatile LAS unsigned*)((LAS unsigned char*)smem + LDS_BAR_OFF);
    if (TID0) { st[0] = 0u; st[1] = 0u; }
    __syncthreads();
    const XcdBarrier bar = xcd_barrier_post(g_bar, st, wvs_);
    volatile LAS unsigned* gpw = (volatile LAS unsigned*)((LAS unsigned char*)smem + 128 * 1024 + 640);
#define REP(n, call) for (int _r = 0; _r < (n); ++_r) { call; }
    unsigned long long ts0 = 0, ts1 = 0;
#define STAMP(k) do { if (TS_PHASE >= 0 && blockIdx.x == 0 && TID0) { const unsigned long long t_ = __builtin_amdgcn_s_memrealtime(); if ((k) == TS_PHASE) ts0 = t_; if ((k) == TS_PHASE + 1) ts1 = t_; } } while (0)
    STAMP(0);
    REP(R_P0, ph_adaln_tables(p, wvs_, smem)) REP(R_BAR, xcd_barrier(bar)) STAMP(1);
    STAMP(2);
    unsigned long long tsx = 0; if (TS_PHASE == 12) tsx = __builtin_amdgcn_s_memrealtime();
    ph_inproj(p, wvs_, smem); if (TS_PHASE == 12 && blockIdx.x == 0 && TID0) { ts0 = tsx; ts1 = __builtin_amdgcn_s_memrealtime(); }
    if (gridDim.x != 256) ph_filler(p, wvs_, smem);
    REP(R_BAR, xcd_barrier(bar)) STAMP(3);
    REP(R_ATT, ph_attn(p, wvs_, smem)) REP(R_BAR, xcd_barrier(bar)) STAMP(4);
    if (GPROBE && TID0) { gpw[0] = 0u; gpw[1] = 0u; gpw[2] = 0u; }
    REP(R_OUT, ph_outproj(p, wvs_, smem))
    STAMP(5);
    REP(R_RT - 1, ph_router(p, wvs_, smem, false)) ph_router(p, wvs_, smem); REP(R_BAR, xcd_barrier(bar)) STAMP(6);
    if (TS_PHASE >= 0 && (TS_PHASE < 6 || TS_PHASE == 12) && blockIdx.x == 0 && TID0) p.qctl[QW(7)] = GPROBE ? p.qctl[QW(6) + 1] : __float_as_uint(sqrtf(1e-6f * 0.01f * (float)(ts1 - ts0)));
    ph_moe(p, wvs_, smem); REP(R_BAR, xcd_barrier(bar)) STAMP(7);
    if (TS_PHASE == 6 && blockIdx.x == 0 && TID0) p.qctl[QW(7)] = __float_as_uint(sqrtf(1e-6f * 0.01f * (float)(ts1 - ts0)));
    if (TS_PHASE == 6) xcd_barrier(bar);
    if (TS_PHASE == 7) {
        ph_final(p, wvs_, smem, (float*)p.h2b); xcd_barrier(bar);
        if (blockIdx.x == 0 && TID0) p.qctl[QW(7)] = __float_as_uint(sqrtf(1e-6f * 0.01f * (float)(__builtin_amdgcn_s_memrealtime() - ts0)));
        xcd_barrier(bar);
    }
    REP(R_FIN - 1, ph_final(p, wvs_, smem, (float*)p.h2b)) ph_final(p, wvs_, smem, p.out);
    __syncthreads();
    if (TID0) st[0] = __hip_atomic_fetch_add(g_bar + XCD_BAR_WORDS, 1u, __ATOMIC_RELAXED, __HIP_MEMORY_SCOPE_AGENT);
    __syncthreads();
    if (st[0] == gridDim.x - 1) { for (int i = TIDX(p); i < XCD_BAR_WORDS + 64; i += NT) __hip_atomic_store(g_bar + i, 0u, __ATOMIC_RELAXED, __HIP_MEMORY_SCOPE_AGENT); }
}

extern "C" void kernel_launch(void* const* d_in, const int* in_sizes, int n_in, void* d_out, int out_size, void* d_ws, size_t ws_size, hipStream_t stream) {
    constexpr size_t kDynLds = 128 * 1024 + 4096 + 24576;
    static int grid_blocks = 0;
    if (!grid_blocks) {
        int dev = 0, cus = 0, per_cu = 0;
        (void)hipGetDevice(&dev);
        (void)hipDeviceGetAttribute(&cus, hipDeviceAttributeMultiprocessorCount, dev);
        (void)hipFuncSetAttribute((const void*)mega, hipFuncAttributeMaxDynamicSharedMemorySize, (int)kDynLds);
        (void)hipOccupancyMaxActiveBlocksPerMultiprocessor(&per_cu, (const void*)mega, NT, kDynLds);
        if (per_cu > 1) per_cu = 1;
        grid_blocks = cus * per_cu;
    }
    Params p{};
    p.x = (const float*)d_in[0]; p.c = (const float*)d_in[1]; p.ctx = (const float*)d_in[2]; p.c_ctx = (const float*)d_in[3];
    p.w_ada = (const float*)d_in[4]; p.b_ada = (const float*)d_in[5]; p.g_norm1 = (const float*)d_in[6]; p.w_in = (const float*)d_in[7];
    p.w_fmix = (const float*)d_in[8]; p.rpb = (const float*)d_in[9]; p.g_out = (const float*)d_in[10]; p.w_out = (const float*)d_in[11];
    p.g_norm2 = (const float*)d_in[12]; p.w_rg = (const float*)d_in[13]; p.w_re = (const float*)d_in[14]; p.w_gate = (const float*)d_in[15];
    p.w_up = (const float*)d_in[16]; p.w_down = (const float*)d_in[17]; p.g_final = (const float*)d_in[18];
    p.out = (float*)d_out;
    char* w = (char*)d_ws; size_t o = 0;
    auto take = [&](size_t bytes) { char* r = w + o; o += (bytes + 255) & ~(size_t)255; return r; };
    p.mod = (float*)take(3 * NMOD * D * 4); p.cosN = (float*)take(SEQ * 4); p.sinN = (float*)take(SEQ * 4); p.ropeR = (float*)take(GROWS * 32 * 4); p.ropeC = (float*)take(GW * 32 * 4);
    p.bar = (unsigned*)take(XCD_BAR_WORDS * 4); p.WrHi = (bf16_t*)take(64 * D * 2); p.WrLo = (bf16_t*)take(64 * D * 2); p.ssq = (float*)take((size_t)NTOK * NH * 4); p.tilecnt = (unsigned*)take(256 * 4); p.qctl = (unsigned*)take(16 * 64 * 4); p.F2 = (bf16_t*)take((size_t)NTOK * DF * 2); p.cnt = (int*)take(NEXP * 256); p.list = (int*)take((size_t)NEXP * NTOK * 4); p.tokgate = (float*)take(2 * NTOK * 4);
    p.WinT = (bf16_t*)take((size_t)DIN * D * 2); p.WoutT = (bf16_t*)take((size_t)D * D * 2);
    p.W64cs = (bf16_t*)take(256 * 64 * 2); p.G128 = (bf16_t*)take(256 * 256 * 2); p.WmixT = (bf16_t*)take(256 * 512 * 2);
    p.WgT = (bf16_t*)take((size_t)NEXP * DEXP * D * 2); p.WuT = (bf16_t*)take((size_t)NEXP * DEXP * D * 2); p.WdT = (bf16_t*)take((size_t)NEXP * DEXP * D * 2);
    char* R1 = take((size_t)NROWS * D * 2 + 2 * (size_t)NTOK * 512 * 2 + 256);
    p.hb = (bf16_t*)R1; p.A2b = (bf16_t*)R1; p.Zb = (bf16_t*)(R1 + (size_t)NROWS * D * 2); p.P2 = p.Zb + (size_t)NTOK * 512; p.h2b = (bf16_t*)R1; p.act = p.h2b + (size_t)NTOK * D;
    const size_t qkv = (size_t)NTOK * DNA * 2;
    char* R2 = take((size_t)NTOK * DF * 2 + 4 * qkv + 2 * (size_t)NCTX * DNA * 2 + 4096);
    p.fX = (bf16_t*)R2; p.Qr = (bf16_t*)(R2 + (size_t)NTOK * DF * 2); p.Qp = p.Qr + (size_t)NTOK * DNA; p.Kr = p.Qp + (size_t)NTOK * DNA; p.Vt = p.Kr + (size_t)NTOK * DNA;
    p.Kc = p.Vt + (size_t)NTOK * DNA; p.Vct = p.Kc + (size_t)NCTX * DNA;
    p.x1 = (float*)(R2 + (size_t)NTOK * DF * 2 + 4 * qkv + 2 * (size_t)NCTX * DNA * 2 - (size_t)NTOK * D * 4);
    p.ybuf = (bf16_t*)p.out;
    if (o > ws_size) { fprintf(stderr, "workspace too small: need %zu have %zu\n", o, ws_size); return; }
    void* args[] = {&p};
    hipError_t e = hipLaunchCooperativeKernel((const void*)mega, dim3(grid_blocks), dim3(NT), args, kDynLds, stream);
    if (e != hipSuccess) fprintf(stderr, "cooperative launch failed: %s (grid %d)\n", hipGetErrorString(e), grid_blocks);
}
```
